# Optimizing an MI355X kernel written in HIP

```python
import math
import jax
import jax.numpy as jnp
from jax import lax
import numpy as np


D_MODEL = 1024
BATCH = 8
SEQ = 4096
DEPTH = 2

MEM_LEN = 256
MIX_W = 512
N_BRANCH = 3
S5_GROUP_CH = 16
S5_GROUPS = MIX_W // S5_GROUP_CH
S5_STATE = 64
GLA_HEADS = 4
GLA_DK = 64
GLA_DV = 128
GLA_GATE_RANK = 16
GLA_TAU = 16.0
GLA_CHUNK = 64
ATT_GROUPS = ((128, 1), (512, 4), (2048, 16))
ATT_HEADS_PER_GROUP = 4
N_ATT_HEADS = ATT_HEADS_PER_GROUP * len(ATT_GROUPS)
ATT_HEAD_DIM = MIX_W // ATT_HEADS_PER_GROUP
ATT_BLOCK = 128
ALIBI_MAX_EXP = 8.0
X_HEADS = 4
X_HEAD_DIM = D_MODEL // X_HEADS
D_FF = 4 * D_MODEL
RMS_EPS = 1e-6
PROJ_WIDTHS = (MIX_W,
               GLA_HEADS * GLA_DK,
               GLA_HEADS * GLA_DK,
               GLA_HEADS * GLA_DV,
               GLA_GATE_RANK,
               GLA_HEADS * GLA_DV,
               N_ATT_HEADS * ATT_HEAD_DIM,
               N_ATT_HEADS * ATT_HEAD_DIM,
               N_ATT_HEADS * ATT_HEAD_DIM,
               N_BRANCH * D_MODEL)
D_IN = sum(PROJ_WIDTHS)

kernel_name = 'hybrid_s5_gla_dilated_block'


def rms_norm(x, gain):
    xf = x.astype(jnp.float32)
    y = xf * lax.rsqrt(jnp.mean(xf * xf, axis=-1, keepdims=True) + RMS_EPS)
    return (y * gain.astype(jnp.float32)).astype(x.dtype)


def alibi_slopes(n):
    return 2.0 ** (-ALIBI_MAX_EXP * jnp.arange(1, n + 1, dtype=jnp.float32) / n)


def s5_branch(u, a_re, a_im, log_step, b_re, b_im, c_re, c_im, d_skip, w_glu, b_glu):
    f32 = jnp.float32
    bsz, seq, _ = u.shape
    uf = u.astype(f32)
    lam = lax.complex(a_re.astype(f32), a_im.astype(f32))
    step = jnp.exp(log_step.astype(f32))[:, None]
    lam_bar = jnp.exp(lam * step)
    b_bar = ((lam_bar - 1.0) / lam)[:, :, None] * lax.complex(b_re.astype(f32), b_im.astype(f32))
    ug = uf.reshape(bsz, seq, S5_GROUPS, S5_GROUP_CH).astype(jnp.complex64)
    bu = jnp.einsum('gpc,bsgc->bsgp', b_bar, ug)
    a_seq = jnp.broadcast_to(lam_bar, (1, seq) + lam_bar.shape)

    def combine(left, right):
        a_l, b_l = left
        a_r, b_r = right
        return a_r * a_l, a_r * b_l + b_r

    _, states = lax.associative_scan(combine, (a_seq, bu), axis=1)
    c_mat = lax.complex(c_re.astype(f32), c_im.astype(f32))
    y = jnp.einsum('gcp,bsgp->bsgc', c_mat, states).real.reshape(bsz, seq, MIX_W)
    y = y + d_skip.astype(f32) * uf
    g = jax.nn.gelu(y)
    return (g * jax.nn.sigmoid(g @ w_glu.astype(f32) + b_glu.astype(f32))).astype(u.dtype)


def gla_chunked(q, k, v, log_a):
    bsz, seq, nh, dk = q.shape
    dv = v.shape[-1]
    nc = seq // GLA_CHUNK

    def chunks(t):
        return t.reshape(bsz, nc, GLA_CHUNK, nh, t.shape[-1]).transpose(1, 0, 3, 2, 4)

    causal = jnp.tril(jnp.ones((GLA_CHUNK, GLA_CHUNK), dtype=bool))

    def step(state, inp):
        qc, kc, vc, lac = inp
        b = jnp.cumsum(lac, axis=2)
        inter = jnp.einsum('bhcd,bhde->bhce', qc * jnp.exp(b), state)
        diff = b[:, :, :, None, :] - b[:, :, None, :, :]
        decay = jnp.exp(jnp.where(causal[:, :, None], diff, -jnp.inf))
        scores = jnp.einsum('bhijd,bhjd->bhij', qc[:, :, :, None, :] * decay, kc)
        intra = jnp.einsum('bhij,bhje->bhie', scores, vc)
        b_end = b[:, :, -1:, :]
        new_state = jnp.exp(b_end[:, :, 0, :])[..., None] * state + jnp.einsum('bhjd,bhje->bhde', kc * jnp.exp(b_end - b), vc)
        return new_state, inter + intra

    state0 = jnp.zeros((bsz, nh, dk, dv), jnp.float32)
    _, out = lax.scan(step, state0, (chunks(q), chunks(k), chunks(v), chunks(log_a)))
    return out.transpose(1, 0, 3, 2, 4).reshape(bsz, seq, nh, dv)


def gla_branch(q, k, v, g_lr, r, w_gate, b_gate, g_out):
    f32 = jnp.float32
    bsz, seq, _ = q.shape
    qh = q.astype(f32).reshape(bsz, seq, GLA_HEADS, GLA_DK) * GLA_DK ** -0.5
    kh = k.astype(f32).reshape(bsz, seq, GLA_HEADS, GLA_DK)
    vh = v.astype(f32).reshape(bsz, seq, GLA_HEADS, GLA_DV)
    log_a = jax.nn.log_sigmoid(g_lr.astype(f32) @ w_gate.astype(f32) + b_gate.astype(f32)) / GLA_TAU
    log_a = log_a.reshape(bsz, seq, GLA_HEADS, GLA_DK)
    o = rms_norm(gla_chunked(qh, kh, vh, log_a), g_out)
    return (o.reshape(bsz, seq, MIX_W) * jax.nn.silu(r.astype(f32))).astype(q.dtype)


def dilated_window_attention(q, k, v, slopes, window, dilation):
    bsz, seq, hg, dh = q.shape
    sub_len = seq // dilation
    n_blk = -(-sub_len // ATT_BLOCK)
    pad_len = n_blk * ATT_BLOCK
    steps = window // dilation

    def to_sub(t):
        t = t.reshape(bsz, sub_len, dilation, hg, dh).transpose(0, 2, 1, 3, 4).reshape(bsz * dilation, sub_len, hg, dh)
        return jnp.pad(t, ((0, 0), (0, pad_len - sub_len), (0, 0), (0, 0)))

    def kv_blocks(t):
        tp = jnp.pad(t, ((0, 0), (ATT_BLOCK, 0), (0, 0), (0, 0)))
        prev = tp[:, :pad_len].reshape(-1, n_blk, ATT_BLOCK, hg, dh)
        cur = tp[:, ATT_BLOCK:].reshape(-1, n_blk, ATT_BLOCK, hg, dh)
        return jnp.concatenate([prev, cur], axis=2)

    qb = to_sub(q).reshape(-1, n_blk, ATT_BLOCK, hg, dh)
    kb = kv_blocks(to_sub(k))
    vb = kv_blocks(to_sub(v))
    scores = jnp.einsum('rnqhd,rnkhd->rnhqk', qb, kb) * dh ** -0.5
    blk = jnp.arange(n_blk)[:, None] * ATT_BLOCK
    q_pos = blk + jnp.arange(ATT_BLOCK)[None, :]
    k_pos = blk - ATT_BLOCK + jnp.arange(2 * ATT_BLOCK)[None, :]
    dist = q_pos[:, :, None] - k_pos[:, None, :]
    valid = (dist >= 0) & (dist <= steps) & (k_pos[:, None, :] >= 0)
    bias = -slopes[None, :, None, None] * (dilation * dist).astype(jnp.float32)[:, None]
    logits = jnp.where(valid[:, None], scores + bias, -jnp.inf)
    lse = jax.nn.logsumexp(logits, axis=-1)
    probs = jnp.exp(logits - lse[..., None])
    out = jnp.einsum('rnhqk,rnkhd->rnqhd', probs, vb).reshape(bsz, dilation, pad_len, hg, dh)[:, :, :sub_len]
    out = out.transpose(0, 2, 1, 3, 4).reshape(bsz, seq, hg, dh)
    lse = lse.transpose(0, 1, 3, 2).reshape(bsz, dilation, pad_len, hg)[:, :, :sub_len]
    lse = lse.transpose(0, 2, 1, 3).reshape(bsz, seq, hg)
    return out, lse


def dilated_branch(q, k, v):
    f32 = jnp.float32
    bsz, seq, _ = q.shape
    qh = q.astype(f32).reshape(bsz, seq, N_ATT_HEADS, ATT_HEAD_DIM)
    kh = k.astype(f32).reshape(bsz, seq, N_ATT_HEADS, ATT_HEAD_DIM)
    vh = v.astype(f32).reshape(bsz, seq, N_ATT_HEADS, ATT_HEAD_DIM)
    slopes = alibi_slopes(N_ATT_HEADS)
    outs, lses = [], []
    for g, (window, dilation) in enumerate(ATT_GROUPS):
        hs = slice(g * ATT_HEADS_PER_GROUP, (g + 1) * ATT_HEADS_PER_GROUP)
        o, lse = dilated_window_attention(qh[:, :, hs], kh[:, :, hs], vh[:, :, hs], slopes[hs], window, dilation)
        outs.append(o)
        lses.append(lse)
    outs = jnp.stack(outs, axis=2)
    weights = jax.nn.softmax(jnp.stack(lses, axis=2), axis=2)
    return jnp.sum(weights[..., None] * outs, axis=2).reshape(bsz, seq, MIX_W).astype(q.dtype)


def cross_attention(h, mem_n, w_q, w_kv, w_o):
    bsz, seq, _ = h.shape
    q = (h @ w_q).reshape(bsz, seq, X_HEADS, X_HEAD_DIM)
    k, v = jnp.split(mem_n @ w_kv, 2, axis=-1)
    k = k.reshape(bsz, MEM_LEN, X_HEADS, X_HEAD_DIM)
    v = v.reshape(bsz, MEM_LEN, X_HEADS, X_HEAD_DIM)
    scores = jnp.einsum('bshd,bmhd->bhsm', q, k).astype(jnp.float32) * X_HEAD_DIM ** -0.5
    probs = jax.nn.softmax(scores, axis=-1).astype(v.dtype)
    o = jnp.einsum('bhsm,bmhd->bshd', probs, v).reshape(bsz, seq, D_MODEL)
    return o @ w_o


def squared_relu_mlp(h, w_up, w_down):
    return jnp.square(jax.nn.relu(h @ w_up)) @ w_down


def setup_inputs(seed: int = 0) -> dict:
    key = jax.random.key(seed)
    ks = jax.random.split(key, 32)
    f32 = jnp.float32

    def nrm(k, shape, scale):
        return jax.random.normal(k, shape, f32) * scale

    def gain(k, shape):
        return 1.0 + 0.01 * jax.random.normal(k, shape, f32)

    return {
        'x': nrm(ks[0], (BATCH, SEQ, D_MODEL), 1.0),
        'mem': nrm(ks[1], (BATCH, MEM_LEN, D_MODEL), 1.0),
        'g_mix': gain(ks[2], (DEPTH, D_MODEL)),
        'w_in': nrm(ks[3], (DEPTH, D_MODEL, D_IN), D_MODEL ** -0.5),
        's5_a_re': -0.5 + nrm(ks[4], (DEPTH, S5_GROUPS, S5_STATE), 0.01),
        's5_a_im': math.pi * jnp.arange(S5_STATE, dtype=f32)[None, None, :] + nrm(ks[5], (DEPTH, S5_GROUPS, S5_STATE), 0.01),
        's5_log_step': jax.random.uniform(ks[6], (DEPTH, S5_GROUPS), f32, math.log(1e-3), math.log(1e-1)),
        's5_b_re': nrm(ks[7], (DEPTH, S5_GROUPS, S5_STATE, S5_GROUP_CH), (2 * S5_GROUP_CH) ** -0.5),
        's5_b_im': nrm(ks[8], (DEPTH, S5_GROUPS, S5_STATE, S5_GROUP_CH), (2 * S5_GROUP_CH) ** -0.5),
        's5_c_re': nrm(ks[9], (DEPTH, S5_GROUPS, S5_GROUP_CH, S5_STATE), S5_STATE ** -0.25),
        's5_c_im': nrm(ks[10], (DEPTH, S5_GROUPS, S5_GROUP_CH, S5_STATE), S5_STATE ** -0.25),
        's5_d': nrm(ks[11], (DEPTH, MIX_W), 1.0),
        'w_glu': nrm(ks[12], (DEPTH, MIX_W, MIX_W), MIX_W ** -0.5),
        'b_glu': nrm(ks[13], (DEPTH, MIX_W), 0.01),
        'w_gla_gate': nrm(ks[14], (DEPTH, GLA_GATE_RANK, GLA_HEADS * GLA_DK), GLA_GATE_RANK ** -0.5),
        'b_gla_gate': nrm(ks[15], (DEPTH, GLA_HEADS * GLA_DK), 0.01),
        'g_gla_out': gain(ks[16], (DEPTH, GLA_DV)),
        'w_branch': nrm(ks[17], (DEPTH, N_BRANCH, MIX_W, D_MODEL), MIX_W ** -0.5),
        'w_out': nrm(ks[18], (DEPTH, D_MODEL, D_MODEL), D_MODEL ** -0.5),
        'g_mem': gain(ks[19], (D_MODEL,)),
        'g_cross': gain(ks[20], (DEPTH, D_MODEL)),
        'w_xq': nrm(ks[21], (DEPTH, D_MODEL, D_MODEL), D_MODEL ** -0.5),
        'w_xkv': nrm(ks[22], (DEPTH, D_MODEL, 2 * D_MODEL), D_MODEL ** -0.5),
        'w_xo': nrm(ks[23], (DEPTH, D_MODEL, D_MODEL), D_MODEL ** -0.5),
        'g_mlp': gain(ks[24], (DEPTH, D_MODEL)),
        'w_up': nrm(ks[25], (DEPTH, D_MODEL, D_FF), D_MODEL ** -0.5),
        'w_down': nrm(ks[26], (DEPTH, D_FF, D_MODEL), D_FF ** -0.5),
        'g_final': gain(ks[27], (D_MODEL,)),
    }


def reference(x, mem, g_mix, w_in, s5_a_re, s5_a_im, s5_log_step, s5_b_re, s5_b_im, s5_c_re, s5_c_im, s5_d,
              w_glu, b_glu, w_gla_gate, b_gla_gate, g_gla_out, w_branch, w_out, g_mem, g_cross, w_xq, w_xkv,
              w_xo, g_mlp, w_up, w_down, g_final):
    bsz, seq, _ = x.shape
    mem_n = rms_norm(mem, g_mem)
    split_points = [int(p) for p in np.cumsum(PROJ_WIDTHS)[:-1]]
    for l in range(DEPTH):
        h = rms_norm(x, g_mix[l])
        (u_s5, q_gla, k_gla, v_gla, lr_gla, r_gla, q_att, k_att, v_att, gate_logits) = jnp.split(h @ w_in[l], split_points, axis=-1)
        y_a = s5_branch(u_s5, s5_a_re[l], s5_a_im[l], s5_log_step[l], s5_b_re[l], s5_b_im[l], s5_c_re[l], s5_c_im[l],
                        s5_d[l], w_glu[l], b_glu[l])
        y_b = gla_branch(q_gla, k_gla, v_gla, lr_gla, r_gla, w_gla_gate[l], b_gla_gate[l], g_gla_out[l])
        y_c = dilated_branch(q_att, k_att, v_att)
        branches = jnp.stack([y_a, y_b, y_c], axis=2)
        gates = jax.nn.sigmoid(gate_logits.reshape(bsz, seq, N_BRANCH, D_MODEL))
        merged = jnp.sum(gates * jnp.einsum('bsnc,ncd->bsnd', branches, w_branch[l]), axis=2)
        x = x + merged @ w_out[l]
        x = x + cross_attention(rms_norm(x, g_cross[l]), mem_n, w_xq[l], w_xkv[l], w_xo[l])
        x = x + squared_relu_mlp(rms_norm(x, g_mlp[l]), w_up[l], w_down[l])
    return rms_norm(x, g_final)
```

```cpp
#include <hip/hip_runtime.h>
#include <hip/hip_cooperative_groups.h>
#include <cstdio>
namespace cg = cooperative_groups;

#ifndef MULTI_LAUNCH
#define MULTI_LAUNCH 0
#endif

#define LAS __attribute__((address_space(3)))
#define DI __device__ __forceinline__
typedef unsigned short bf16_t;
typedef short bf16x8 __attribute__((ext_vector_type(8)));
typedef float f32x4 __attribute__((ext_vector_type(4)));
typedef float f32x2 __attribute__((ext_vector_type(2)));
typedef unsigned u32x4 __attribute__((ext_vector_type(4)));
typedef unsigned u32x2 __attribute__((ext_vector_type(2)));
typedef __bf16 bfv2 __attribute__((ext_vector_type(2)));

constexpr int DM = 1024, SEQ = 4096, NB = 8, MTOK = NB * SEQ, DEPTH = 2;
constexpr int NGRP = 2, MG = MTOK / NGRP, BPG = NB / NGRP;
constexpr int DINP = 9984;
constexpr int NTHREADS = 512;
constexpr int LDS_BYTES = 139264;

constexpr size_t AL(size_t x) { return (x + 255) & ~(size_t)255; }
constexpr size_t WS_WIN = 0;
constexpr size_t WS_WGLU = WS_WIN + AL((size_t)DEPTH * DINP * 1024 * 2);
constexpr size_t WS_WBR = WS_WGLU + AL((size_t)DEPTH * 512 * 512 * 2);
constexpr size_t WS_WOUT = WS_WBR + AL((size_t)DEPTH * 3 * 1024 * 512 * 2);
constexpr size_t WS_WXQ = WS_WOUT + AL((size_t)DEPTH * 1024 * 1024 * 2);
constexpr size_t WS_WXO = WS_WXQ + AL((size_t)DEPTH * 1024 * 1024 * 2);
constexpr size_t WS_WXKV = WS_WXO + AL((size_t)DEPTH * 1024 * 1024 * 2);
constexpr size_t WS_WUP = WS_WXKV + AL((size_t)DEPTH * 2048 * 1024 * 2);
constexpr size_t WS_WDN = WS_WUP + AL((size_t)DEPTH * 4096 * 1024 * 2);
constexpr size_t WS_MEMN = WS_WDN + AL((size_t)DEPTH * 4096 * 1024 * 2);
constexpr size_t WS_MEMKV = WS_MEMN + AL((size_t)2048 * 1024 * 2);
constexpr size_t WS_LSE = WS_MEMKV + AL((size_t)2048 * 4096 * 2);
constexpr size_t WS_S5E = WS_LSE + AL((size_t)MG * 12 * 4);
constexpr size_t WS_GDEC = WS_S5E + AL((size_t)BPG * 32 * 64 * 64 * 8);
constexpr size_t WS_H = WS_GDEC + AL((size_t)BPG * 4 * 64 * 64 * 4);
constexpr size_t WS_GST = WS_H + (size_t)MG * 1024 * 2;
constexpr size_t WS_P = WS_H + AL((size_t)MTOK * 1024 * 2);
constexpr size_t WS_END = WS_P + AL((size_t)MG * DINP * 2);
constexpr size_t PE(int tile) { return (size_t)MG * 256 * tile; }
constexpr size_t P_U = PE(0), P_QK = PE(2), P_VG = PE(4), P_R = PE(6), P_QA = PE(8), P_KA = PE(14), P_VA = PE(20), P_GATE = PE(26), P_LR = PE(38);

DI float bf_lo(unsigned u) { return __uint_as_float(u << 16); }
DI float bf_hi(unsigned u) { return __uint_as_float(u & 0xffff0000u); }
DI unsigned pk2(float lo, float hi) { f32x2 v = {lo, hi}; bfv2 r = __builtin_convertvector(v, bfv2); return __builtin_bit_cast(unsigned, r); }
DI float wave_sum(float v) {
#pragma unroll
  for (int m = 32; m >= 1; m >>= 1) v += __shfl_xor(v, m, 64);
  return v;
}
DI float sigmoidf_(float x) { return 1.0f / (1.0f + __expf(-x)); }
DI f32x4 mfma16(bf16x8 a, bf16x8 b, f32x4 c) { return __builtin_amdgcn_mfma_f32_16x16x32_bf16(a, b, c, 0, 0, 0); }
DI bf16x8 mk8(u32x4 v) { return __builtin_bit_cast(bf16x8, v); }

DI int tid_() { int t = threadIdx.x; asm volatile("" : "+v"(t)); return t; }
namespace pg8 {
constexpr int BM = 256, BK = 64, HALF = 128, HTB = HALF * BK * 2, STAGE_BYTES = 8 * HTB, NXCD = 8, WGM = 8;
DI int lds_byte(int r, int c) { const int st = (r >> 4) * 2 + (c >> 5), rr = r & 15, cc = c & 31, ob = rr * 64 + cc * 2; return st * 1024 + (ob ^ (((ob >> 9) & 1) << 5)); }
DI void stage_rc(int b, int& R, int& C) { const int st = b / 1024, sb = b % 1024, swz = sb ^ (((sb >> 9) & 1) << 5); R = (st >> 1) * 16 + swz / 64; C = (st & 1) * 32 + (swz % 64) / 2; }
DI int perm32(int rho) { const int n = rho >> 4, i = rho & 15; return 8 * (i >> 2) + 4 * n + (i & 3); }
struct Unit { int pm, pn; };
struct Gemm { const bf16_t* A; const bf16_t* Bt; int M, N, K, lda; };
struct StaticOrder {
  int nM, nN, nwg, G, c;
  DI void init(int M, int N, int G_, int c_) { nM = M / BM; nN = N / BM; nwg = nM * nN; G = G_; c = c_; }
  DI bool next(int i, Unit& u) const {
    const long L = (long)i * G + c; if (L >= nwg) return false;
    int wgid = (int)L; { const int q = nwg / NXCD, r = nwg % NXCD, xcd = wgid % NXCD, off = wgid / NXCD; wgid = (xcd < r ? xcd * (q + 1) : r * (q + 1) + (xcd - r) * q) + off; }
    const int nig = WGM * nN, gid = wgid / nig, fm = gid * WGM, gsz = (nM - fm) < WGM ? (nM - fm) : WGM;
    u.pm = fm + ((wgid % nig) % gsz); u.pn = (wgid % nig) / gsz; return true;
  }
};

template <class Epi>
DI void gemm_phase(LAS unsigned char* lds, const Gemm g, const StaticOrder& S, const Epi& E) {
  const int tid = tid_(), wid = __builtin_amdgcn_readfirstlane(tid >> 6), lane = tid & 63, wr = wid >> 2, wc = wid & 3, fr = lane & 15, fq = lane >> 4;
  const int K = g.K, nt = K / BK, lda = g.lda;
  unsigned voffA[2], voffB[2];
#pragma unroll
  for (int i = 0; i < 2; ++i) { int R, C; stage_rc(tid * 16 + i * 8192, R, C); const int Rb = (R & ~31) + perm32(R & 31);
    voffA[i] = (unsigned)(R * lda + C) * 2u; voffB[i] = (unsigned)(Rb * K + C) * 2u; }
  const size_t kstep = (size_t)(BK * 2);
  const size_t hstA = (size_t)HALF * lda * 2, hstB = (size_t)HALF * K * 2;
  const size_t tstA = 2 * hstA, tstB = 2 * hstB;
  const unsigned ldsw = (unsigned)wid * 1024u;
  const int aoff = lds_byte(wr * 64 + fr, fq * 8), boff = lds_byte(wc * 32 + fr, fq * 8);
#define PG8_SA(b, h) (((b) * 2 + (h)) * HTB)
#define PG8_SB(b, h) ((4 + (b) * 2 + (h)) * HTB)
#define PG8_STAGE(bufoff, gbase, voff) do { _Pragma("unroll") for (int _i = 0; _i < 2; ++_i) \
    __builtin_amdgcn_global_load_lds((const unsigned*)((const char*)(gbase) + (voff)[_i]), (LAS unsigned*)(lds + (bufoff) + ldsw + _i * 8192), 16, 0, 0); } while (0)
#define PG8_LDA(dst, b, h) do { _Pragma("unroll") for (int m = 0; m < 4; ++m) _Pragma("unroll") for (int k = 0; k < 2; ++k) dst[m][k] = *(const LAS bf16x8*)(lds + PG8_SA(b, h) + aoff + m * 2048 + k * 1024); } while (0)
#define PG8_LDB(dst, b, h) do { _Pragma("unroll") for (int n = 0; n < 2; ++n) _Pragma("unroll") for (int k = 0; k < 2; ++k) dst[n][k] = *(const LAS bf16x8*)(lds + PG8_SB(b, h) + boff + n * 2048 + k * 1024); } while (0)
#define PG8_MMA(ai, bj, At, Bt) do { __builtin_amdgcn_s_setprio(1); _Pragma("unroll") for (int m = 0; m < 4; ++m) _Pragma("unroll") for (int n = 0; n < 2; ++n) _Pragma("unroll") for (int k = 0; k < 2; ++k) \
    acc[ai][bj][m][n] = __builtin_amdgcn_mfma_f32_16x16x32_bf16(Bt[n][k], At[m][k], acc[ai][bj][m][n], 0, 0, 0); __builtin_amdgcn_s_setprio(0); } while (0)
#define PG8_WAIT_V(n) asm volatile("s_waitcnt vmcnt(" #n ")" ::: "memory")
#define PG8_WAIT_L(n) asm volatile("s_waitcnt lgkmcnt(" #n ")" ::: "memory")
#define PG8_BAR __builtin_amdgcn_s_barrier()
#define PG8_SCHED __builtin_amdgcn_sched_barrier(0)
  Unit cur, nxt; int ui = 0;
  if (!S.next(0, cur)) return;
  f32x4 acc[2][2][4][2];
#pragma unroll
  for (int a = 0; a < 2; ++a)
#pragma unroll
    for (int b = 0; b < 2; ++b)
#pragma unroll
      for (int m = 0; m < 4; ++m)
#pragma unroll
        for (int n = 0; n < 2; ++n) acc[a][b][m][n] = (f32x4){0.f, 0.f, 0.f, 0.f};
  bf16x8 At[4][2], B0[2][2], B1[2][2];
  const char* cA = (const char*)g.A + (size_t)cur.pm * tstA; const char* cB = (const char*)g.Bt + (size_t)cur.pn * tstB;
  PG8_STAGE(PG8_SB(0, 0), cB, voffB); PG8_STAGE(PG8_SA(0, 0), cA, voffA); PG8_STAGE(PG8_SB(0, 1), cB + hstB, voffB); PG8_STAGE(PG8_SA(0, 1), cA + hstA, voffA);
  if (wr == 1) PG8_BAR;
  PG8_WAIT_V(4); PG8_BAR;
  PG8_STAGE(PG8_SB(1, 0), cB + kstep, voffB); PG8_STAGE(PG8_SA(1, 0), cA + kstep, voffA); PG8_STAGE(PG8_SB(1, 1), cB + hstB + kstep, voffB);
  PG8_WAIT_V(6); PG8_BAR;
  for (;;) {
    const bool has_next = S.next(ui + 1, nxt);
    const char* nA = has_next ? (const char*)g.A + (size_t)nxt.pm * tstA : cA; const char* nB = has_next ? (const char*)g.Bt + (size_t)nxt.pn * tstB : cB;
    for (int t = 0; t < nt; t += 2) {
      const bool last = (t == nt - 2);
      const char* a1 = cA + (size_t)(t + 1) * kstep;
      const char* a2 = last ? nA : cA + (size_t)(t + 2) * kstep; const char* b2 = last ? nB : cB + (size_t)(t + 2) * kstep;
      const char* a3 = a2 + kstep; const char* b3 = b2 + kstep;
      PG8_LDB(B0, 0, 0); PG8_SCHED; PG8_LDA(At, 0, 0); PG8_STAGE(PG8_SA(1, 1), a1 + hstA, voffA);
      PG8_WAIT_L(8); PG8_BAR; PG8_WAIT_L(0); PG8_MMA(0, 0, At, B0); PG8_BAR; PG8_SCHED;
      PG8_LDB(B1, 0, 1); PG8_STAGE(PG8_SB(0, 0), b2, voffB);
      PG8_BAR; PG8_WAIT_L(0); PG8_MMA(0, 1, At, B1); PG8_BAR;
      PG8_LDA(At, 0, 1); PG8_STAGE(PG8_SA(0, 0), a2, voffA);
      PG8_BAR; PG8_WAIT_L(0); PG8_MMA(1, 0, At, B0); PG8_BAR; PG8_SCHED;
      PG8_STAGE(PG8_SB(0, 1), b2 + hstB, voffB);
      PG8_WAIT_V(6); PG8_BAR; PG8_MMA(1, 1, At, B1); PG8_BAR;
      PG8_LDB(B0, 1, 0); PG8_SCHED; PG8_LDA(At, 1, 0); PG8_STAGE(PG8_SA(0, 1), a2 + hstA, voffA);
      PG8_WAIT_L(8); PG8_BAR; PG8_WAIT_L(0); PG8_MMA(0, 0, At, B0); PG8_BAR; PG8_SCHED;
      PG8_LDB(B1, 1, 1); PG8_STAGE(PG8_SB(1, 0), b3, voffB);
      PG8_BAR; PG8_WAIT_L(0); PG8_MMA(0, 1, At, B1); PG8_BAR;
      PG8_LDA(At, 1, 1); PG8_STAGE(PG8_SA(1, 0), a3, voffA);
      PG8_BAR; PG8_WAIT_L(0); PG8_MMA(1, 0, At, B0); PG8_BAR; PG8_SCHED;
      PG8_STAGE(PG8_SB(1, 1), b3 + hstB, voffB);
      PG8_WAIT_V(6); PG8_BAR; PG8_MMA(1, 1, At, B1); PG8_BAR;
    }
    E(acc, cur, wr, wc, fr, fq);
    if (!has_next) break;
#pragma unroll
    for (int a = 0; a < 2; ++a)
#pragma unroll
      for (int b = 0; b < 2; ++b)
#pragma unroll
        for (int m = 0; m < 4; ++m)
#pragma unroll
          for (int n = 0; n < 2; ++n) acc[a][b][m][n] = (f32x4){0.f, 0.f, 0.f, 0.f};
    cur = nxt; cA = nA; cB = nB; ++ui;
  }
  PG8_WAIT_V(0);
  if (wr == 0) PG8_BAR;
  PG8_BAR;
#undef PG8_SA
#undef PG8_SB
#undef PG8_STAGE
#undef PG8_LDA
#undef PG8_LDB
#undef PG8_MMA
#undef PG8_WAIT_V
#undef PG8_WAIT_L
#undef PG8_BAR
#undef PG8_SCHED
}
}

enum { EM_PROJ = 0, EM_BF16, EM_GLU, EM_MERGE0, EM_MERGE1, EM_MERGE2, EM_RESID, EM_RELU2 };
struct Epi {
  int mode;
  bf16_t* o16; int ld16;
  float* o32; const float* r32; int ld32;
  const bf16_t* aux; int ldaux;
  const float* bias;
  DI void operator()(const f32x4 (&acc)[2][2][4][2], const pg8::Unit& u, int wr, int wc, int fr, int fq) const {
    const int row0 = u.pm * 256 + wr * 64 + fr;
    int colt = u.pn * 256; bf16_t* ob = o16; int ldo = ld16;
    if (mode == EM_PROJ) {
      const int pn = u.pn; int s, ldp;
      if (pn < 8) { s = pn & ~1; ldp = 512; } else if (pn < 14) { s = 8; ldp = 1536; } else if (pn < 20) { s = 14; ldp = 1536; } else if (pn < 26) { s = 20; ldp = 1536; }
      else if (pn < 38) { s = 26; ldp = 3072; } else { s = 38; ldp = 256; }
      ob = o16 + PE(s); ldo = ldp; colt = (pn - s) * 256;
    }
    const int col0 = colt + wc * 32 + 8 * fq;
#pragma unroll
    for (int ai = 0; ai < 2; ++ai)
#pragma unroll
      for (int m = 0; m < 4; ++m) {
        const size_t row = (size_t)(row0 + ai * 128 + m * 16);
#pragma unroll
        for (int bj = 0; bj < 2; ++bj) {
          const int col = col0 + bj * 128;
          f32x4 v0 = acc[ai][bj][m][0], v1 = acc[ai][bj][m][1];
          if (mode == EM_PROJ || mode == EM_BF16) {
            u32x4 w; w.x = pk2(v0[0], v0[1]); w.y = pk2(v0[2], v0[3]); w.z = pk2(v1[0], v1[1]); w.w = pk2(v1[2], v1[3]);
            *(u32x4*)(ob + row * ldo + col) = w;
          } else if (mode == EM_RELU2) {
#pragma unroll
            for (int j = 0; j < 4; ++j) { float a = fmaxf(v0[j], 0.f), b = fmaxf(v1[j], 0.f); v0[j] = a * a; v1[j] = b * b; }
            u32x4 w; w.x = pk2(v0[0], v0[1]); w.y = pk2(v0[2], v0[3]); w.z = pk2(v1[0], v1[1]); w.w = pk2(v1[2], v1[3]);
            *(u32x4*)(ob + row * ldo + col) = w;
          } else if (mode == EM_RESID) {
            const f32x4 r0 = *(const f32x4*)(r32 + row * ld32 + col), r1 = *(const f32x4*)(r32 + row * ld32 + col + 4);
            *(f32x4*)(o32 + row * ld32 + col) = r0 + v0; *(f32x4*)(o32 + row * ld32 + col + 4) = r1 + v1;
          } else if (mode == EM_GLU) {
            const u32x4 gq = *(const u32x4*)(aux + row * ldaux + col);
            const f32x4 b0 = *(const f32x4*)(bias + col), b1 = *(const f32x4*)(bias + col + 4);
            float gv[8] = {bf_lo(gq.x), bf_hi(gq.x), bf_lo(gq.y), bf_hi(gq.y), bf_lo(gq.z), bf_hi(gq.z), bf_lo(gq.w), bf_hi(gq.w)};
            float o[8];
#pragma unroll
            for (int j = 0; j < 4; ++j) { o[j] = gv[j] * sigmoidf_(v0[j] + b0[j]); o[4 + j] = gv[4 + j] * sigmoidf_(v1[j] + b1[j]); }
            u32x4 w; w.x = pk2(o[0], o[1]); w.y = pk2(o[2], o[3]); w.z = pk2(o[4], o[5]); w.w = pk2(o[6], o[7]);
            *(u32x4*)(ob + row * ldo + col) = w;
          } else {
            const u32x4 gq = *(const u32x4*)(aux + row * ldaux + col);
            float gv[8] = {bf_lo(gq.x), bf_hi(gq.x), bf_lo(gq.y), bf_hi(gq.y), bf_lo(gq.z), bf_hi(gq.z), bf_lo(gq.w), bf_hi(gq.w)};
            f32x4 t0, t1;
#pragma unroll
            for (int j = 0; j < 4; ++j) { t0[j] = sigmoidf_(gv[j]) * v0[j]; t1[j] = sigmoidf_(gv[4 + j]) * v1[j]; }
            if (mode != EM_MERGE0) { t0 += *(const f32x4*)(o32 + row * ld32 + col); t1 += *(const f32x4*)(o32 + row * ld32 + col + 4); }
            if (mode == EM_MERGE2) {
              u32x4 w; w.x = pk2(t0[0], t0[1]); w.y = pk2(t0[2], t0[3]); w.z = pk2(t1[0], t1[1]); w.w = pk2(t1[2], t1[3]);
              *(u32x4*)(ob + row * ldo + col) = w;
            } else { *(f32x4*)(o32 + row * ld32 + col) = t0; *(f32x4*)(o32 + row * ld32 + col + 4) = t1; }
          }
        }
      }
  }
};

DI void norm_rows_bf16(const float* x, const float* gain, bf16_t* H, int nrows) {
  const int lane = tid_() & 63, gw = blockIdx.x * 8 + (tid_() >> 6), nw = gridDim.x * 8;
  for (int r = gw; r < nrows; r += nw) {
    const float* xr = x + (size_t)r * 1024;
    f32x4 v[4]; float ss = 0.f;
#pragma unroll
    for (int i = 0; i < 4; ++i) { v[i] = *(const f32x4*)(xr + i * 256 + lane * 4); ss += v[i][0] * v[i][0] + v[i][1] * v[i][1] + v[i][2] * v[i][2] + v[i][3] * v[i][3]; }
    ss = wave_sum(ss);
    const float rs = rsqrtf(ss * (1.0f / 1024.0f) + 1e-6f);
#pragma unroll
    for (int i = 0; i < 4; ++i) { const f32x4 g = *(const f32x4*)(gain + i * 256 + lane * 4);
      u32x2 w; w.x = pk2(v[i][0] * rs * g[0], v[i][1] * rs * g[1]); w.y = pk2(v[i][2] * rs * g[2], v[i][3] * rs * g[3]);
      *(u32x2*)(H + (size_t)r * 1024 + i * 256 + lane * 4) = w; }
  }
}
DI void norm_rows_f32_inplace(float* x, const float* gain, int nrows) {
  const int lane = tid_() & 63, gw = blockIdx.x * 8 + (tid_() >> 6), nw = gridDim.x * 8;
  for (int r = gw; r < nrows; r += nw) {
    float* xr = x + (size_t)r * 1024;
    f32x4 v[4]; float ss = 0.f;
#pragma unroll
    for (int i = 0; i < 4; ++i) { v[i] = *(const f32x4*)(xr + i * 256 + lane * 4); ss += v[i][0] * v[i][0] + v[i][1] * v[i][1] + v[i][2] * v[i][2] + v[i][3] * v[i][3]; }
    ss = wave_sum(ss);
    const float rs = rsqrtf(ss * (1.0f / 1024.0f) + 1e-6f);
#pragma unroll
    for (int i = 0; i < 4; ++i) { const f32x4 g = *(const f32x4*)(gain + i * 256 + lane * 4);
      f32x4 o; o[0] = v[i][0] * rs * g[0]; o[1] = v[i][1] * rs * g[1]; o[2] = v[i][2] * rs * g[2]; o[3] = v[i][3] * rs * g[3];
      *(f32x4*)(xr + i * 256 + lane * 4) = o; }
  }
}

DI int win_map(int n) { return n < 1536 ? n : (n < 9728 ? n + 16 : (n < 9744 ? n - 9728 + 1536 : -1)); }
DI void transpose_w(LAS unsigned char* sm, const float* src, int K, int Ns, bf16_t* dst, int Nd, int mapmode) {
  LAS float* tile = (LAS float*)sm;
  const int tid = tid_(), tn = Nd / 64, tk = K / 64;
  for (int t = blockIdx.x; t < tn * tk; t += gridDim.x) {
    const int n0 = (t / tk) * 64, k0 = (t % tk) * 64;
#pragma unroll
    for (int it = 0; it < 8; ++it) { const int idx = it * 512 + tid, kk = idx >> 6, nn = idx & 63;
      const int sc = mapmode ? win_map(n0 + nn) : (n0 + nn);
      tile[kk * 65 + nn] = sc >= 0 ? src[(size_t)(k0 + kk) * Ns + sc] : 0.f; }
    __syncthreads();
    { const int nn = tid >> 3, kc = tid & 7; float f[8];
#pragma unroll
      for (int e = 0; e < 8; ++e) f[e] = tile[(kc * 8 + e) * 65 + nn];
      u32x4 w; w.x = pk2(f[0], f[1]); w.y = pk2(f[2], f[3]); w.z = pk2(f[4], f[5]); w.w = pk2(f[6], f[7]);
      *(u32x4*)(dst + (size_t)(n0 + nn) * K + k0 + kc * 8) = w; }
    __syncthreads();
  }
}

DI void attn_task(LAS unsigned char* sm, int task, bf16_t* QA, const bf16_t* KA, const bf16_t* VA, float* LSE) {
  const int tid = tid_(), lane = tid & 63, w = tid >> 6, li = lane & 15, quad = lane >> 4;
  const int bh = task >> 5, sub = task & 31;
  const int b = bh / 12, h = bh - b * 12, g = h >> 2, dsh = g * 2, dil = 1 << dsh, nblk = 32 >> dsh;
  const int r = sub / nblk, n = sub - r * nblk;
  LAS unsigned char* ks = sm;
  LAS unsigned short* vt = (LAS unsigned short*)(sm + 69632);
#pragma unroll
  for (int it = 0; it < 8; ++it) {
    const int id = it * 512 + tid, row = id >> 4, cc = id & 15, sp = n * 128 - 128 + row;
    u32x4 v = {0u, 0u, 0u, 0u};
    if (sp >= 0) v = *(const u32x4*)(KA + ((size_t)b * 4096 + (size_t)(sp * dil + r)) * 1536 + h * 128 + cc * 8);
    *(LAS u32x4*)(ks + row * 272 + cc * 16) = v;
  }
#pragma unroll
  for (int it = 0; it < 8; ++it) {
    const int id = it * 512 + tid, key = id & 255, cc = id >> 8, sp = n * 128 - 128 + key;
    u32x4 v = {0u, 0u, 0u, 0u};
    if (sp >= 0) v = *(const u32x4*)(VA + ((size_t)b * 4096 + (size_t)(sp * dil + r)) * 1536 + h * 128 + cc * 8);
#pragma unroll
    for (int e = 0; e < 4; ++e) { vt[(cc * 8 + 2 * e) * 264 + key] = (unsigned short)(v[e] & 0xffffu); vt[(cc * 8 + 2 * e + 1) * 264 + key] = (unsigned short)(v[e] >> 16); }
  }
  __syncthreads();
  const int qsp = n * 128 + w * 16 + li;
  const size_t qtok = (size_t)b * 4096 + (size_t)(qsp * dil + r);
  bf16_t* qptr = QA + qtok * 1536 + h * 128;
  bf16x8 qf[4];
#pragma unroll
  for (int kk = 0; kk < 4; ++kk) qf[kk] = *(const bf16x8*)(qptr + kk * 32 + quad * 8);
  const int kt0 = w < 6 ? w : 6;
  const float sc = 0.08838834764831845f * 1.4426950408889634f;
  const float sl = exp2f(-8.0f * (float)(h + 1) / 12.0f) * (float)dil * 1.4426950408889634f;
  float s[10][4]; float mx = -1e30f;
#pragma unroll
  for (int tt = 0; tt < 10; ++tt) {
    const int kt = kt0 + tt; f32x4 acc = {0.f, 0.f, 0.f, 0.f};
#pragma unroll
    for (int kk = 0; kk < 4; ++kk) { const bf16x8 a = *(const LAS bf16x8*)(ks + (kt * 16 + li) * 272 + kk * 64 + quad * 16); acc = mfma16(a, qf[kk], acc); }
#pragma unroll
    for (int j = 0; j < 4; ++j) { const int kl = kt * 16 + quad * 4 + j, dist = 128 + w * 16 + li - kl;
      const bool valid = dist >= 0 && dist <= 128 && (n > 0 || kl >= 128);
      const float v = acc[j] * sc - sl * (float)dist; s[tt][j] = valid ? v : -1e30f; mx = fmaxf(mx, s[tt][j]); }
  }
  mx = fmaxf(mx, __shfl_xor(mx, 16, 64)); mx = fmaxf(mx, __shfl_xor(mx, 32, 64));
  float lsum = 0.f;
#pragma unroll
  for (int tt = 0; tt < 10; ++tt)
#pragma unroll
    for (int j = 0; j < 4; ++j) { const float p = exp2f(s[tt][j] - mx); s[tt][j] = p; lsum += p; }
  lsum += __shfl_xor(lsum, 16, 64); lsum += __shfl_xor(lsum, 32, 64);
  bf16x8 pf[5];
#pragma unroll
  for (int pp = 0; pp < 5; ++pp) { u32x4 t; t.x = pk2(s[2 * pp][0], s[2 * pp][1]); t.y = pk2(s[2 * pp][2], s[2 * pp][3]); t.z = pk2(s[2 * pp + 1][0], s[2 * pp + 1][1]); t.w = pk2(s[2 * pp + 1][2], s[2 * pp + 1][3]); pf[pp] = mk8(t); }
  const float inv = 1.0f / lsum;
#pragma unroll
  for (int dvt = 0; dvt < 8; ++dvt) {
    f32x4 acc = {0.f, 0.f, 0.f, 0.f};
#pragma unroll
    for (int pp = 0; pp < 5; ++pp) { const int kA = (kt0 + 2 * pp) * 16 + quad * 4;
      const u32x2 lo = *(const LAS u32x2*)(vt + (dvt * 16 + li) * 264 + kA), hi = *(const LAS u32x2*)(vt + (dvt * 16 + li) * 264 + kA + 16);
      u32x4 t; t.x = lo.x; t.y = lo.y; t.z = hi.x; t.w = hi.y; acc = mfma16(mk8(t), pf[pp], acc); }
    u32x2 o; o.x = pk2(acc[0] * inv, acc[1] * inv); o.y = pk2(acc[2] * inv, acc[3] * inv);
    *(u32x2*)(qptr + dvt * 16 + quad * 4) = o;
  }
  if (quad == 0) LSE[qtok * 12 + h] = (mx + log2f(lsum)) * 0.6931471805599453f;
  __syncthreads();
}

DI void attn_combine(bf16_t* QA, const float* LSE) {
  const int nitem = MG * 4 * 16;
  for (int it = blockIdx.x * NTHREADS + tid_(); it < nitem; it += gridDim.x * NTHREADS) {
    const int t = it >> 6, hg = (it >> 4) & 3, dc = it & 15;
    const float l0 = LSE[(size_t)t * 12 + hg], l1 = LSE[(size_t)t * 12 + 4 + hg], l2 = LSE[(size_t)t * 12 + 8 + hg];
    const float m = fmaxf(l0, fmaxf(l1, l2));
    float w0 = __expf(l0 - m), w1 = __expf(l1 - m), w2 = __expf(l2 - m); const float iv = 1.0f / (w0 + w1 + w2); w0 *= iv; w1 *= iv; w2 *= iv;
    bf16_t* p = QA + (size_t)t * 1536 + hg * 128 + dc * 8;
    const u32x4 a = *(const u32x4*)p, b = *(const u32x4*)(p + 512), c = *(const u32x4*)(p + 1024);
    u32x4 o;
#pragma unroll
    for (int e = 0; e < 4; ++e) o[e] = pk2(w0 * bf_lo(a[e]) + w1 * bf_lo(b[e]) + w2 * bf_lo(c[e]), w0 * bf_hi(a[e]) + w1 * bf_hi(b[e]) + w2 * bf_hi(c[e]));
    *(u32x4*)p = o;
  }
}

DI void xattn_task(LAS unsigned char* sm, int task, bf16_t* XQ, const bf16_t* MKV, int l) {
  const int tid = tid_(), lane = tid & 63, w = tid >> 6, li = lane & 15, quad = lane >> 4;
  const int b = task >> 7, hx = (task >> 5) & 3, n = task & 31;
  LAS unsigned short* vt = (LAS unsigned short*)sm;
#pragma unroll
  for (int it = 0; it < 16; ++it) { const int id = it * 512 + tid, row = id >> 5, cc = id & 31;
    const u32x4 v = *(const u32x4*)(MKV + (size_t)(b * 256 + row) * 4096 + l * 2048 + hx * 256 + cc * 8);
    *(LAS u32x4*)(sm + row * 528 + cc * 16) = v; }
  __syncthreads();
  const size_t qtok = (size_t)b * 4096 + n * 128 + w * 16 + li;
  bf16_t* qptr = XQ + qtok * 1024 + hx * 256;
  bf16x8 qf[8];
#pragma unroll
  for (int kk = 0; kk < 8; ++kk) qf[kk] = *(const bf16x8*)(qptr + kk * 32 + quad * 8);
  float s[16][4]; float mx = -1e30f;
  const float sc = 0.0625f * 1.4426950408889634f;
#pragma unroll
  for (int kt = 0; kt < 16; ++kt) { f32x4 acc = {0.f, 0.f, 0.f, 0.f};
#pragma unroll
    for (int kk = 0; kk < 8; ++kk) { const bf16x8 a = *(const LAS bf16x8*)(sm + (kt * 16 + li) * 528 + kk * 64 + quad * 16); acc = mfma16(a, qf[kk], acc); }
#pragma unroll
    for (int j = 0; j < 4; ++j) { s[kt][j] = acc[j] * sc; mx = fmaxf(mx, s[kt][j]); } }
  mx = fmaxf(mx, __shfl_xor(mx, 16, 64)); mx = fmaxf(mx, __shfl_xor(mx, 32, 64));
  float lsum = 0.f;
#pragma unroll
  for (int kt = 0; kt < 16; ++kt)
#pragma unroll
    for (int j = 0; j < 4; ++j) { const float p = exp2f(s[kt][j] - mx); s[kt][j] = p; lsum += p; }
  lsum += __shfl_xor(lsum, 16, 64); lsum += __shfl_xor(lsum, 32, 64);
  bf16x8 pf[8];
#pragma unroll
  for (int pp = 0; pp < 8; ++pp) { u32x4 t; t.x = pk2(s[2 * pp][0], s[2 * pp][1]); t.y = pk2(s[2 * pp][2], s[2 * pp][3]); t.z = pk2(s[2 * pp + 1][0], s[2 * pp + 1][1]); t.w = pk2(s[2 * pp + 1][2], s[2 * pp + 1][3]); pf[pp] = mk8(t); }
  const float inv = 1.0f / lsum;
  __syncthreads();
#pragma unroll
  for (int it = 0; it < 16; ++it) { const int id = it * 512 + tid, key = id & 255, cc = id >> 8;
    const u32x4 v = *(const u32x4*)(MKV + (size_t)(b * 256 + key) * 4096 + l * 2048 + 1024 + hx * 256 + cc * 8);
#pragma unroll
    for (int e = 0; e < 4; ++e) { vt[(cc * 8 + 2 * e) * 264 + key] = (unsigned short)(v[e] & 0xffffu); vt[(cc * 8 + 2 * e + 1) * 264 + key] = (unsigned short)(v[e] >> 16); } }
  __syncthreads();
#pragma unroll
  for (int dvt = 0; dvt < 16; ++dvt) {
    f32x4 acc = {0.f, 0.f, 0.f, 0.f};
#pragma unroll
    for (int pp = 0; pp < 8; ++pp) { const int kA = 2 * pp * 16 + quad * 4;
      const u32x2 lo = *(const LAS u32x2*)(vt + (dvt * 16 + li) * 264 + kA), hi = *(const LAS u32x2*)(vt + (dvt * 16 + li) * 264 + kA + 16);
      u32x4 t; t.x = lo.x; t.y = lo.y; t.z = hi.x; t.w = hi.y; acc = mfma16(mk8(t), pf[pp], acc); }
    u32x2 o; o.x = pk2(acc[0] * inv, acc[1] * inv); o.y = pk2(acc[2] * inv, acc[3] * inv);
    *(u32x2*)(qptr + dvt * 16 + quad * 4) = o;
  }
  __syncthreads();
}

struct S5P { const float *a_re, *a_im, *log_step, *b_re, *b_im, *c_re, *c_im, *d; };
DI void s5_task(LAS unsigned char* sm, int task, int mode, bf16_t* U, f32x2* E, const S5P& P) {
  const int tid = tid_(), lane = tid & 63, w = tid >> 6, li = lane & 15, quad = lane >> 4;
  const int b = task >> 8, c = (task >> 2) & 63, oct = task & 3;
  const size_t row0 = (size_t)b * 4096 + c * 64;
  LAS float* us = (LAS float*)sm;
#pragma unroll
  for (int it = 0; it < 2; ++it) { const int id = it * 512 + tid, t = id >> 4, cc = id & 15;
    const u32x4 v = *(const u32x4*)(U + (row0 + t) * 512 + oct * 128 + cc * 8);
    f32x4 f0 = {bf_lo(v.x), bf_hi(v.x), bf_lo(v.y), bf_hi(v.y)}, f1 = {bf_lo(v.z), bf_hi(v.z), bf_lo(v.w), bf_hi(v.w)};
    *(LAS f32x4*)(us + t * 128 + cc * 8) = f0; *(LAS f32x4*)(us + t * 128 + cc * 8 + 4) = f1; }
  __syncthreads();
  const int g = oct * 8 + w, p = lane;
  const float step = __expf(P.log_step[g]);
  const float ar = P.a_re[g * 64 + p], ai = P.a_im[g * 64 + p];
  const float mag = __expf(ar * step);
  float sn, cs; { const float x = ai * step; const float k = rintf(x * 0.15915494309189535f); float rr = fmaf(-k, 6.2831854820251465f, x); rr = fmaf(-k, -1.7484556000744883e-07f, rr); sn = sinf(rr); cs = cosf(rr); }
  const float lbr = mag * cs, lbi = mag * sn;
  float bbr[16], bbi[16];
  { const float iv = 1.0f / (ar * ar + ai * ai), nr = lbr - 1.0f, ni = lbi;
    const float cr = (nr * ar + ni * ai) * iv, ci = (ni * ar - nr * ai) * iv;
#pragma unroll
    for (int q4 = 0; q4 < 4; ++q4) { const f32x4 br = *(const f32x4*)(P.b_re + ((size_t)g * 64 + p) * 16 + q4 * 4), bi = *(const f32x4*)(P.b_im + ((size_t)g * 64 + p) * 16 + q4 * 4);
#pragma unroll
      for (int e = 0; e < 4; ++e) { bbr[q4 * 4 + e] = cr * br[e] - ci * bi[e]; bbi[q4 * 4 + e] = cr * bi[e] + ci * br[e]; } } }
  float sr = 0.f, si = 0.f;
  const size_t ebase = (((size_t)b * 32 + g) * 64) * 64 + p;
  bf16x8 cm[4]; f32x4 dsk = {0.f, 0.f, 0.f, 0.f};
  LAS unsigned char* ss = sm + 32768 + w * 4352;
  if (mode == 1) {
    float lr_ = lbr, li_ = lbi;
#pragma unroll
    for (int q = 0; q < 6; ++q) { const float t0 = lr_ * lr_ - li_ * li_, t1 = 2.0f * lr_ * li_; lr_ = t0; li_ = t1; }
    for (int cp = 0; cp < c; ++cp) { const f32x2 e = E[ebase + (size_t)cp * 64]; const float t0 = lr_ * sr - li_ * si + e[0], t1 = lr_ * si + li_ * sr + e[1]; sr = t0; si = t1; }
#pragma unroll
    for (int kk = 0; kk < 4; ++kk) { const int p0 = kk * 16 + quad * 4;
      const f32x4 cr4 = *(const f32x4*)(P.c_re + ((size_t)g * 16 + li) * 64 + p0), ci4 = *(const f32x4*)(P.c_im + ((size_t)g * 16 + li) * 64 + p0);
      u32x4 t; t.x = pk2(cr4[0], -ci4[0]); t.y = pk2(cr4[1], -ci4[1]); t.z = pk2(cr4[2], -ci4[2]); t.w = pk2(cr4[3], -ci4[3]); cm[kk] = mk8(t); }
    dsk = *(const f32x4*)(P.d + g * 16 + quad * 4);
  }
  for (int sb = 0; sb < 4; ++sb) {
#pragma unroll 4
    for (int tt = 0; tt < 16; ++tt) {
      const int t = sb * 16 + tt;
      float bur = 0.f, bui = 0.f;
#pragma unroll
      for (int q4 = 0; q4 < 4; ++q4) { const f32x4 u4 = *(const LAS f32x4*)(us + t * 128 + w * 16 + q4 * 4);
#pragma unroll
        for (int e = 0; e < 4; ++e) { bur = fmaf(bbr[q4 * 4 + e], u4[e], bur); bui = fmaf(bbi[q4 * 4 + e], u4[e], bui); } }
      const float t0 = lbr * sr - lbi * si + bur, t1 = lbr * si + lbi * sr + bui; sr = t0; si = t1;
      if (mode == 1) *(LAS unsigned*)(ss + tt * 272 + p * 4) = pk2(sr, si);
    }
    if (mode == 1) {
      asm volatile("s_waitcnt lgkmcnt(0)" ::: "memory");
      f32x4 acc = {0.f, 0.f, 0.f, 0.f};
#pragma unroll
      for (int kk = 0; kk < 4; ++kk) { const bf16x8 bq = *(const LAS bf16x8*)(ss + li * 272 + kk * 64 + quad * 16); acc = mfma16(cm[kk], bq, acc); }
      const f32x4 u4 = *(const LAS f32x4*)(us + (sb * 16 + li) * 128 + w * 16 + quad * 4);
      float o[4];
#pragma unroll
      for (int j = 0; j < 4; ++j) { const float y = acc[j] + dsk[j] * u4[j]; const float z = 0.7978845608028654f * (y + 0.044715f * y * y * y);
        const float th = 1.0f - 2.0f / (__expf(2.0f * z) + 1.0f); o[j] = 0.5f * y * (1.0f + th); }
      asm volatile("s_waitcnt lgkmcnt(0)" ::: "memory");
      u32x2 ov; ov.x = pk2(o[0], o[1]); ov.y = pk2(o[2], o[3]);
      *(u32x2*)(U + (row0 + sb * 16 + li) * 512 + g * 16 + quad * 4) = ov;
    }
  }
  if (mode == 0) { f32x2 e = {sr, si}; E[ebase + (size_t)c * 64] = e; }
  __syncthreads();
}

struct GLAP { const float *wg, *bg, *gout; };
constexpr int GL_LR = 0;
constexpr int GL_WG = 4096;
constexpr int GL_BS = 8192;
constexpr int GL_Q = 24832;
constexpr int GL_K = 34048;
constexpr int GL_VT = 43264;
constexpr int GL_ST = 61696;
constexpr int GL_RED = 80128;
DI void gla_cumdecay(LAS unsigned char* sm, const bf16_t* LR, size_t row0, int h, const GLAP& P) {
  const int tid = tid_();
  LAS float* lrs = (LAS float*)(sm + GL_LR); LAS float* wgs = (LAS float*)(sm + GL_WG); LAS float* bs = (LAS float*)(sm + GL_BS);
  if (tid < 128) { const int t = tid >> 1, hf = tid & 1; const u32x4 v = *(const u32x4*)(LR + (row0 + t) * 256 + hf * 8);
    f32x4 f0 = {bf_lo(v.x), bf_hi(v.x), bf_lo(v.y), bf_hi(v.y)}, f1 = {bf_lo(v.z), bf_hi(v.z), bf_lo(v.w), bf_hi(v.w)};
    *(LAS f32x4*)(lrs + t * 16 + hf * 8) = f0; *(LAS f32x4*)(lrs + t * 16 + hf * 8 + 4) = f1; }
  { const int rr = tid >> 5, c2 = (tid & 31) * 2; wgs[rr * 64 + c2] = P.wg[rr * 256 + h * 64 + c2]; wgs[rr * 64 + c2 + 1] = P.wg[rr * 256 + h * 64 + c2 + 1]; }
  __syncthreads();
  { const int dk = tid & 63, t0 = (tid >> 6) * 8; const float bias = P.bg[h * 64 + dk];
#pragma unroll
    for (int e = 0; e < 8; ++e) { float z = bias;
#pragma unroll
      for (int rr = 0; rr < 16; ++rr) z = fmaf(lrs[(t0 + e) * 16 + rr], wgs[rr * 64 + dk], z);
      const float ls = fminf(z, 0.f) - log1pf(__expf(-fabsf(z)));
      bs[(t0 + e) * 65 + dk] = ls * 0.0625f; } }
  __syncthreads();
  if (tid < 64) { float a = 0.f; for (int t = 0; t < 64; ++t) { a += bs[t * 65 + tid]; bs[t * 65 + tid] = a; } }
  __syncthreads();
}
DI void gla_stage_vt(LAS unsigned char* sm, const bf16_t* VG, size_t row0, int h) {
  LAS unsigned short* vt = (LAS unsigned short*)(sm + GL_VT);
#pragma unroll
  for (int it = 0; it < 2; ++it) { const int id = it * 512 + tid_(), t = id & 63, cc = id >> 6;
    const u32x4 v = *(const u32x4*)(VG + (row0 + t) * 512 + h * 128 + cc * 8);
#pragma unroll
    for (int e = 0; e < 4; ++e) { vt[(cc * 8 + 2 * e) * 72 + t] = (unsigned short)(v[e] & 0xffffu); vt[(cc * 8 + 2 * e + 1) * 72 + t] = (unsigned short)(v[e] >> 16); } }
}
DI void gla_a_task(LAS unsigned char* sm, int task, const bf16_t* QK, const bf16_t* VG, const bf16_t* LR, float* GST, float* GDEC, const GLAP& P) {
  const int tid = tid_(), lane = tid & 63, w = tid >> 6, li = lane & 15, quad = lane >> 4;
  const int bh = task >> 6, c = task & 63, b = bh >> 2, h = bh & 3;
  const size_t row0 = (size_t)b * 4096 + c * 64;
  gla_cumdecay(sm, LR, row0, h, P);
  LAS float* bs = (LAS float*)(sm + GL_BS);
  LAS unsigned short* kht = (LAS unsigned short*)(sm + GL_Q);
  { const int t = tid & 63, dkc = tid >> 6; const u32x4 v = *(const u32x4*)(QK + (row0 + t) * 512 + 256 + h * 64 + dkc * 8);
#pragma unroll
    for (int e = 0; e < 4; ++e) { const int d0 = dkc * 8 + 2 * e;
      const float k0 = bf_lo(v[e]) * __expf(bs[63 * 65 + d0] - bs[t * 65 + d0]), k1 = bf_hi(v[e]) * __expf(bs[63 * 65 + d0 + 1] - bs[t * 65 + d0 + 1]);
      const unsigned pk = pk2(k0, k1); kht[d0 * 72 + t] = (unsigned short)(pk & 0xffffu); kht[(d0 + 1) * 72 + t] = (unsigned short)(pk >> 16); } }
  gla_stage_vt(sm, VG, row0, h);
  if (tid < 64) GDEC[(size_t)task * 64 + tid] = __expf(bs[63 * 65 + tid]);
  __syncthreads();
  LAS unsigned short* vt = (LAS unsigned short*)(sm + GL_VT);
#pragma unroll
  for (int dkt = 0; dkt < 4; ++dkt) { f32x4 acc = {0.f, 0.f, 0.f, 0.f};
#pragma unroll
    for (int kk = 0; kk < 2; ++kk) { const bf16x8 a = *(const LAS bf16x8*)(vt + (w * 16 + li) * 72 + kk * 32 + quad * 8), bq = *(const LAS bf16x8*)(kht + (dkt * 16 + li) * 72 + kk * 32 + quad * 8); acc = mfma16(a, bq, acc); }
#pragma unroll
    for (int j = 0; j < 4; ++j) GST[((size_t)task * 128 + w * 16 + quad * 4 + j) * 64 + dkt * 16 + li] = acc[j]; }
  __syncthreads();
}
DI void gla_prefix(float* GST, const float* GDEC) {
  const int total = BPG * 4 * 8192;
  for (int gid = blockIdx.x * NTHREADS + tid_(); gid < total; gid += gridDim.x * NTHREADS) {
    const int bh = gid >> 13, e = gid & 8191, dk = e & 63; float S = 0.f;
#pragma unroll 8
    for (int c = 0; c < 64; ++c) { const size_t idx = ((size_t)(bh * 64 + c)) * 8192 + e; const float tmp = GST[idx], d = GDEC[(size_t)(bh * 64 + c) * 64 + dk]; GST[idx] = S; S = fmaf(d, S, tmp); }
  }
}
DI void gla_c_task(LAS unsigned char* sm, int task, const bf16_t* QK, bf16_t* VG, const bf16_t* LR, const bf16_t* R, const float* GST, const GLAP& P) {
  const int tid = tid_(), lane = tid & 63, w = tid >> 6, li = lane & 15, quad = lane >> 4;
  const int bh = task >> 6, c = task & 63, b = bh >> 2, h = bh & 3;
  const size_t row0 = (size_t)b * 4096 + c * 64;
  gla_cumdecay(sm, LR, row0, h, P);
  LAS float* bs = (LAS float*)(sm + GL_BS);
  LAS unsigned short* qs = (LAS unsigned short*)(sm + GL_Q); LAS unsigned short* ksm = (LAS unsigned short*)(sm + GL_K);
  LAS unsigned short* vt = (LAS unsigned short*)(sm + GL_VT); LAS unsigned short* st = (LAS unsigned short*)(sm + GL_ST); LAS float* red = (LAS float*)(sm + GL_RED);
  { const int t = tid >> 3, ch = tid & 7;
    const u32x4 qv = *(const u32x4*)(QK + (row0 + t) * 512 + h * 64 + ch * 8), kv = *(const u32x4*)(QK + (row0 + t) * 512 + 256 + h * 64 + ch * 8);
    u32x4 qo, ko;
#pragma unroll
    for (int e = 0; e < 4; ++e) { const int d0 = ch * 8 + 2 * e; const float b0 = bs[t * 65 + d0], b1 = bs[t * 65 + d0 + 1];
      qo[e] = pk2(bf_lo(qv[e]) * 0.125f * __expf(b0), bf_hi(qv[e]) * 0.125f * __expf(b1));
      ko[e] = pk2(bf_lo(kv[e]) * __expf(-b0), bf_hi(kv[e]) * __expf(-b1)); }
    *(LAS u32x4*)(qs + t * 72 + ch * 8) = qo; *(LAS u32x4*)(ksm + t * 72 + ch * 8) = ko; }
  gla_stage_vt(sm, VG, row0, h);
#pragma unroll
  for (int it = 0; it < 4; ++it) { const int id = it * 512 + tid, dv = id >> 4, c4 = id & 15;
    const f32x4 v = *(const f32x4*)(GST + ((size_t)task * 128 + dv) * 64 + c4 * 4);
    u32x2 o; o.x = pk2(v[0], v[1]); o.y = pk2(v[2], v[3]); *(LAS u32x2*)(st + dv * 72 + c4 * 4) = o; }
  __syncthreads();
  const int qt = w & 3, dvh = w >> 2;
  bf16x8 qf[2];
#pragma unroll
  for (int kk = 0; kk < 2; ++kk) qf[kk] = *(const LAS bf16x8*)(qs + (qt * 16 + li) * 72 + kk * 32 + quad * 8);
  float s[4][4];
#pragma unroll
  for (int jt = 0; jt < 4; ++jt) { f32x4 acc = {0.f, 0.f, 0.f, 0.f};
#pragma unroll
    for (int kk = 0; kk < 2; ++kk) { const bf16x8 a = *(const LAS bf16x8*)(ksm + (jt * 16 + li) * 72 + kk * 32 + quad * 8); acc = mfma16(a, qf[kk], acc); }
#pragma unroll
    for (int j = 0; j < 4; ++j) { const int kj = jt * 16 + quad * 4 + j, qi = qt * 16 + li; s[jt][j] = (kj <= qi) ? acc[j] : 0.f; } }
  bf16x8 pf[2];
#pragma unroll
  for (int pp = 0; pp < 2; ++pp) { u32x4 t; t.x = pk2(s[2 * pp][0], s[2 * pp][1]); t.y = pk2(s[2 * pp][2], s[2 * pp][3]); t.z = pk2(s[2 * pp + 1][0], s[2 * pp + 1][1]); t.w = pk2(s[2 * pp + 1][2], s[2 * pp + 1][3]); pf[pp] = mk8(t); }
  f32x4 o[4]; float ssq = 0.f;
#pragma unroll
  for (int dvt = 0; dvt < 4; ++dvt) { const int dv0 = dvh * 64 + dvt * 16; f32x4 acc = {0.f, 0.f, 0.f, 0.f};
#pragma unroll
    for (int pp = 0; pp < 2; ++pp) { const int kA = 2 * pp * 16 + quad * 4;
      const u32x2 lo = *(const LAS u32x2*)(vt + (dv0 + li) * 72 + kA), hi = *(const LAS u32x2*)(vt + (dv0 + li) * 72 + kA + 16);
      u32x4 t; t.x = lo.x; t.y = lo.y; t.z = hi.x; t.w = hi.y; acc = mfma16(mk8(t), pf[pp], acc); }
#pragma unroll
    for (int kk = 0; kk < 2; ++kk) { const bf16x8 a = *(const LAS bf16x8*)(st + (dv0 + li) * 72 + kk * 32 + quad * 8); acc = mfma16(a, qf[kk], acc); }
    o[dvt] = acc; ssq += acc[0] * acc[0] + acc[1] * acc[1] + acc[2] * acc[2] + acc[3] * acc[3]; }
  ssq += __shfl_xor(ssq, 16, 64); ssq += __shfl_xor(ssq, 32, 64);
  if (quad == 0) red[dvh * 64 + qt * 16 + li] = ssq;
  __syncthreads();
  const float tot = red[qt * 16 + li] + red[64 + qt * 16 + li];
  const float rs = rsqrtf(tot * (1.0f / 128.0f) + 1e-6f);
  const size_t row = row0 + qt * 16 + li;
#pragma unroll
  for (int dvt = 0; dvt < 4; ++dvt) { const int dv = dvh * 64 + dvt * 16 + quad * 4;
    const f32x4 gg = *(const f32x4*)(P.gout + dv); const u32x2 rv = *(const u32x2*)(R + row * 512 + h * 128 + dv);
    const float r4[4] = {bf_lo(rv.x), bf_hi(rv.x), bf_lo(rv.y), bf_hi(rv.y)}; float y[4];
#pragma unroll
    for (int j = 0; j < 4; ++j) y[j] = o[dvt][j] * rs * gg[j] * (r4[j] * sigmoidf_(r4[j]));
    u32x2 ov; ov.x = pk2(y[0], y[1]); ov.y = pk2(y[2], y[3]); *(u32x2*)(VG + row * 512 + h * 128 + dv) = ov; }
  __syncthreads();
}

struct Args { const float* in[28]; float* out; unsigned char* ws; int ph_lo, ph_hi; };
constexpr int NPH = 2 + DEPTH * 23 + 1;

__global__ void __launch_bounds__(NTHREADS, 2) mega(Args A) {
  extern __shared__ __attribute__((aligned(16))) unsigned char lds_raw[];
  LAS unsigned char* sm = (LAS unsigned char*)lds_raw;
  cg::grid_group grid = cg::this_grid();
  const int G = gridDim.x, bid = blockIdx.x;

  for (int ph = A.ph_lo; ph < A.ph_hi; ++ph) {
    size_t zo; asm volatile("s_mov_b64 %0, 0" : "=s"(zo));
    unsigned char* ws = A.ws + zo;
    const float* x_in = A.in[0] + zo;
    float* xo = A.out + zo;
    bf16_t* H = (bf16_t*)(ws + WS_H); bf16_t* PB = (bf16_t*)(ws + WS_P);
    bf16_t* MEMN = (bf16_t*)(ws + WS_MEMN); bf16_t* MKV = (bf16_t*)(ws + WS_MEMKV);
    float* LSE = (float*)(ws + WS_LSE); f32x2* S5E = (f32x2*)(ws + WS_S5E); float* GDEC = (float*)(ws + WS_GDEC); float* GST = (float*)(ws + WS_GST);
#define IN(i) (A.in[i] + zo)
    int kind, l = 0, grp = 0;
    if (ph == 0) kind = 0; else if (ph == 1) kind = 1; else if (ph == NPH - 1) kind = 17;
    else { const int q = ph - 2; l = q / 23; const int k = q % 23; if (k < 16) { grp = k >> 3; kind = 2 + (k & 7); } else kind = 10 + (k - 16); }
    const float* xsrc = (l == 0) ? x_in : xo;
    bool isgemm = false; int nrep = 1;
    switch (kind) {
      case 0: {
        for (int ll = 0; ll < DEPTH; ++ll) {
          transpose_w(sm, IN(3) + (size_t)ll * 1024 * 9744, 1024, 9744, (bf16_t*)(ws + WS_WIN) + (size_t)ll * DINP * 1024, DINP, 1);
          transpose_w(sm, IN(12) + (size_t)ll * 512 * 512, 512, 512, (bf16_t*)(ws + WS_WGLU) + (size_t)ll * 512 * 512, 512, 0);
          for (int n = 0; n < 3; ++n) transpose_w(sm, IN(17) + ((size_t)ll * 3 + n) * 512 * 1024, 512, 1024, (bf16_t*)(ws + WS_WBR) + ((size_t)ll * 3 + n) * 1024 * 512, 1024, 0);
          transpose_w(sm, IN(18) + (size_t)ll * 1024 * 1024, 1024, 1024, (bf16_t*)(ws + WS_WOUT) + (size_t)ll * 1024 * 1024, 1024, 0);
          transpose_w(sm, IN(21) + (size_t)ll * 1024 * 1024, 1024, 1024, (bf16_t*)(ws + WS_WXQ) + (size_t)ll * 1024 * 1024, 1024, 0);
          transpose_w(sm, IN(23) + (size_t)ll * 1024 * 1024, 1024, 1024, (bf16_t*)(ws + WS_WXO) + (size_t)ll * 1024 * 1024, 1024, 0);
          transpose_w(sm, IN(22) + (size_t)ll * 1024 * 2048, 1024, 2048, (bf16_t*)(ws + WS_WXKV) + (size_t)ll * 2048 * 1024, 2048, 0);
          transpose_w(sm, IN(25) + (size_t)ll * 1024 * 4096, 1024, 4096, (bf16_t*)(ws + WS_WUP) + (size_t)ll * 4096 * 1024, 4096, 0);
          transpose_w(sm, IN(26) + (size_t)ll * 4096 * 1024, 4096, 1024, (bf16_t*)(ws + WS_WDN) + (size_t)ll * 1024 * 4096, 1024, 0);
        }
        norm_rows_bf16(IN(1), IN(19), MEMN, 2048);
      } break;
      case 1: case 3: case 7: case 9: case 11: case 13: case 15: case 16: isgemm = true; break;
      case 8: isgemm = true; nrep = 3; break;
      case 2: norm_rows_bf16(xsrc + (size_t)grp * MG * 1024, IN(2) + l * 1024, H, MG); break;
      case 4: {
        S5P sp{IN(4) + l * 2048, IN(5) + l * 2048, IN(6) + l * 32, IN(7) + (size_t)l * 32768, IN(8) + (size_t)l * 32768, IN(9) + (size_t)l * 32768, IN(10) + (size_t)l * 32768, IN(11) + l * 512};
        GLAP gp{IN(14) + l * 4096, IN(15) + l * 256, IN(16) + l * 128};
        constexpr int NA = BPG * 12 * 32, NS = BPG * 256, NGL = BPG * 4 * 64;
        for (int t = bid; t < NA + NS + NGL; t += G) {
          if (t < NA) attn_task(sm, t, PB + P_QA, PB + P_KA, PB + P_VA, LSE);
          else if (t < NA + NS) s5_task(sm, t - NA, 0, PB + P_U, S5E, sp);
          else gla_a_task(sm, t - NA - NS, PB + P_QK, PB + P_VG, PB + P_LR, GST, GDEC, gp);
        }
      } break;
      case 5: gla_prefix(GST, GDEC); break;
      case 6: {
        S5P sp{IN(4) + l * 2048, IN(5) + l * 2048, IN(6) + l * 32, IN(7) + (size_t)l * 32768, IN(8) + (size_t)l * 32768, IN(9) + (size_t)l * 32768, IN(10) + (size_t)l * 32768, IN(11) + l * 512};
        GLAP gp{IN(14) + l * 4096, IN(15) + l * 256, IN(16) + l * 128};
        constexpr int NS = BPG * 256, NGL = BPG * 4 * 64;
        for (int t = bid; t < NS + NGL; t += G) {
          if (t < NS) s5_task(sm, t, 1, PB + P_U, S5E, sp);
          else gla_c_task(sm, t - NS, PB + P_QK, PB + P_VG, PB + P_LR, PB + P_R, GST, gp);
        }
        attn_combine(PB + P_QA, LSE);
      } break;
      case 10: norm_rows_bf16(xo, IN(20) + l * 1024, H, MTOK); break;
      case 12: for (int t = bid; t < NB * 4 * 32; t += G) xattn_task(sm, t, PB, MKV, l); break;
      case 14: norm_rows_bf16(xo, IN(24) + l * 1024, H, MTOK); break;
      case 17: norm_rows_f32_inplace(xo, IN(27), MTOK); break;
      default: break;
    }
    if (isgemm) {
      for (int rep = 0; rep < nrep; ++rep) {
        pg8::Gemm g; Epi E; E.mode = EM_BF16; E.o16 = nullptr; E.ld16 = 0; E.o32 = nullptr; E.r32 = nullptr; E.ld32 = 1024; E.aux = nullptr; E.ldaux = 0; E.bias = nullptr;
        float* MF = (float*)(PB + P_KA);
        bf16_t* MB = PB + P_KA + (size_t)MG * 2048;
        switch (kind) {
          case 1: g = pg8::Gemm{MEMN, (bf16_t*)(ws + WS_WXKV), 2048, 4096, 1024, 1024}; E.mode = EM_BF16; E.o16 = MKV; E.ld16 = 4096; break;
          case 3: g = pg8::Gemm{H, (bf16_t*)(ws + WS_WIN) + (size_t)l * DINP * 1024, MG, DINP, 1024, 1024}; E.mode = EM_PROJ; E.o16 = PB; break;
          case 7: g = pg8::Gemm{PB + P_U, (bf16_t*)(ws + WS_WGLU) + (size_t)l * 512 * 512, MG, 512, 512, 512}; E.mode = EM_GLU; E.o16 = PB + P_QK; E.ld16 = 512; E.aux = PB + P_U; E.ldaux = 512; E.bias = IN(13) + l * 512; break;
          case 8: { const bf16_t* Ab = rep == 0 ? PB + P_QK : (rep == 1 ? PB + P_VG : PB + P_QA);
            g = pg8::Gemm{Ab, (bf16_t*)(ws + WS_WBR) + ((size_t)l * 3 + rep) * 1024 * 512, MG, 1024, 512, rep == 2 ? 1536 : 512};
            E.mode = EM_MERGE0 + rep; E.o32 = MF; E.ld32 = 1024; E.o16 = MB; E.ld16 = 1024; E.aux = PB + P_GATE + rep * 1024; E.ldaux = 3072; } break;
          case 9: g = pg8::Gemm{MB, (bf16_t*)(ws + WS_WOUT) + (size_t)l * 1024 * 1024, MG, 1024, 1024, 1024}; E.mode = EM_RESID; E.r32 = xsrc + (size_t)grp * MG * 1024; E.o32 = xo + (size_t)grp * MG * 1024; break;
          case 11: g = pg8::Gemm{H, (bf16_t*)(ws + WS_WXQ) + (size_t)l * 1024 * 1024, MTOK, 1024, 1024, 1024}; E.mode = EM_BF16; E.o16 = PB; E.ld16 = 1024; break;
          case 13: g = pg8::Gemm{PB, (bf16_t*)(ws + WS_WXO) + (size_t)l * 1024 * 1024, MTOK, 1024, 1024, 1024}; E.mode = EM_RESID; E.r32 = xo; E.o32 = xo; break;
          case 15: g = pg8::Gemm{H, (bf16_t*)(ws + WS_WUP) + (size_t)l * 4096 * 1024, MTOK, 4096, 1024, 1024}; E.mode = EM_RELU2; E.o16 = PB; E.ld16 = 4096; break;
          default: g = pg8::Gemm{PB, (bf16_t*)(ws + WS_WDN) + (size_t)l * 1024 * 4096, MTOK, 1024, 4096, 4096}; E.mode = EM_RESID; E.r32 = xo; E.o32 = xo; break;
        }
        pg8::StaticOrder S; S.init(g.M, g.N, G, bid);
        pg8::gemm_phase<Epi>(sm, g, S, E);
      }
    }
    if (ph + 1 < A.ph_hi) grid.sync();
  }
}

extern "C" void kernel_launch(void* const* d_in, const int* in_sizes, int n_in, void* d_out, int out_size, void* d_ws, size_t ws_size, hipStream_t stream) {
  static int grid = 0;
  if (grid == 0) {
    if (n_in != 28 || out_size != MTOK * DM || ws_size < WS_END) { fprintf(stderr, "kernel_launch: unexpected shapes (n_in %d out %d ws %zu need %zu)\n", n_in, out_size, ws_size, (size_t)WS_END); grid = -1; return; }
    int dev = 0, cus = 0, per_cu = 0;
    hipGetDevice(&dev); hipDeviceGetAttribute(&cus, hipDeviceAttributeMultiprocessorCount, dev);
    if (hipFuncSetAttribute((const void*)mega, hipFuncAttributeMaxDynamicSharedMemorySize, LDS_BYTES) != hipSuccess) { fprintf(stderr, "kernel_launch: hipFuncSetAttribute failed\n"); grid = -1; return; }
    hipOccupancyMaxActiveBlocksPerMultiprocessor(&per_cu, (const void*)mega, NTHREADS, LDS_BYTES);
    (void)hipGetLastError();
    if (per_cu < 1) { fprintf(stderr, "kernel_launch: occupancy query says %d blocks per CU\n", per_cu); per_cu = 1; }
    grid = cus;
  }
  if (grid < 0) return;
  Args a{};
  for (int i = 0; i < 28; ++i) a.in[i] = (const float*)d_in[i];
  a.out = (float*)d_out; a.ws = (unsigned char*)d_ws;
#if MULTI_LAUNCH
  for (int ph = 0; ph < NPH; ++ph) { a.ph_lo = ph; a.ph_hi = ph + 1; hipLaunchKernelGGL(mega, dim3(grid), dim3(NTHREADS), LDS_BYTES, stream, a); }
#else
  a.ph_lo = 0; a.ph_hi = NPH;
  void* args[] = {&a};
  hipError_t e = hipLaunchCooperativeKernel((const void*)mega, dim3(grid), dim3(NTHREADS), args, LDS_BYTES, stream);
  if (e != hipSuccess) fprintf(stderr, "kernel_launch: cooperative launch failed: %s (grid %d)\n", hipGetErrorString(e), grid);
#endif
}
```

```cpp
#include <hip/hip_runtime.h>
#include <hip/hip_cooperative_groups.h>
#include <cstdio>
namespace cg = cooperative_groups;

#ifndef MULTI_LAUNCH
#define MULTI_LAUNCH 0
#endif

#define LAS __attribute__((address_space(3)))
#define DI __device__ __forceinline__
typedef unsigned short bf16_t;
typedef short bf16x8 __attribute__((ext_vector_type(8)));
typedef float f32x4 __attribute__((ext_vector_type(4)));
typedef float f32x2 __attribute__((ext_vector_type(2)));
typedef unsigned u32x4 __attribute__((ext_vector_type(4)));
typedef unsigned u32x2 __attribute__((ext_vector_type(2)));
typedef __bf16 bfv2 __attribute__((ext_vector_type(2)));

constexpr int DM = 1024, SEQ = 4096, NB = 8, MTOK = NB * SEQ, DEPTH = 2;
constexpr int NGRP = 2, MG = MTOK / NGRP, BPG = NB / NGRP;
constexpr int DINP = 9984;
constexpr int NTHREADS = 512;
constexpr int LDS_BYTES = 139264;

constexpr size_t AL(size_t x) { return (x + 255) & ~(size_t)255; }
constexpr size_t WS_WIN = 0;
constexpr size_t WS_WGLU = WS_WIN + AL((size_t)DEPTH * DINP * 1024 * 2);
constexpr size_t WS_WBR = WS_WGLU + AL((size_t)DEPTH * 512 * 512 * 2);
constexpr size_t WS_WOUT = WS_WBR + AL((size_t)DEPTH * 3 * 1024 * 512 * 2);
constexpr size_t WS_WXQ = WS_WOUT + AL((size_t)DEPTH * 1024 * 1024 * 2);
constexpr size_t WS_WXO = WS_WXQ + AL((size_t)DEPTH * 1024 * 1024 * 2);
constexpr size_t WS_WXKV = WS_WXO + AL((size_t)DEPTH * 1024 * 1024 * 2);
constexpr size_t WS_WUP = WS_WXKV + AL((size_t)DEPTH * 2048 * 1024 * 2);
constexpr size_t WS_WDN = WS_WUP + AL((size_t)DEPTH * 4096 * 1024 * 2);
constexpr size_t WS_MEMN = WS_WDN + AL((size_t)DEPTH * 4096 * 1024 * 2);
constexpr size_t WS_MEMKV = WS_MEMN + AL((size_t)2048 * 1024 * 2);
constexpr size_t WS_LSE = WS_MEMKV + AL((size_t)2048 * 4096 * 2);
constexpr size_t WS_S5E = WS_LSE + AL((size_t)MG * 12 * 4);
constexpr size_t WS_S5C = WS_S5E + AL((size_t)BPG * 32 * 64 * 64 * 8);
constexpr size_t WS_GDEC = WS_S5C + AL((size_t)BPG * 32 * 64 * 64 * 8);
constexpr size_t WS_H = WS_GDEC + AL((size_t)BPG * 4 * 64 * 64 * 4);
constexpr size_t WS_GST = WS_H + (size_t)MG * 1024 * 2;
constexpr size_t WS_P = WS_H + AL((size_t)MTOK * 1024 * 2);
constexpr size_t WS_BAR = WS_P + AL((size_t)MG * DINP * 2);
constexpr size_t WS_END = WS_BAR + 16384;
constexpr size_t PE(int tile) { return (size_t)MG * 256 * tile; }
constexpr size_t P_U = PE(0), P_QK = PE(2), P_VG = PE(4), P_R = PE(6), P_QA = PE(8), P_KA = PE(14), P_VA = PE(20), P_GATE = PE(26), P_LR = PE(38);

DI float bf_lo(unsigned u) { return __uint_as_float(u << 16); }
DI float bf_hi(unsigned u) { return __uint_as_float(u & 0xffff0000u); }
DI unsigned pk2(float lo, float hi) { f32x2 v = {lo, hi}; bfv2 r = __builtin_convertvector(v, bfv2); return __builtin_bit_cast(unsigned, r); }
DI int tid_() { int t = threadIdx.x; asm volatile("" : "+v"(t)); return t; }
DI float shx(float v, int m, int lane) { return __builtin_bit_cast(float, __builtin_amdgcn_ds_bpermute((lane ^ m) << 2, __builtin_bit_cast(int, v))); }
DI float wave_sum(float v, int lane) {
#pragma unroll
  for (int m = 32; m >= 1; m >>= 1) v += shx(v, m, lane);
  return v;
}
DI float sigmoidf_(float x) { return 1.0f / (1.0f + __expf(-x)); }
DI f32x4 mfma16(bf16x8 a, bf16x8 b, f32x4 c) { return __builtin_amdgcn_mfma_f32_16x16x32_bf16(a, b, c, 0, 0, 0); }
DI bf16x8 mk8(u32x4 v) { return __builtin_bit_cast(bf16x8, v); }

namespace pg8 {
constexpr int BM = 256, BK = 64, HALF = 128, HTB = HALF * BK * 2, STAGE_BYTES = 8 * HTB, NXCD = 8, WGM = 4;
DI int lds_byte(int r, int c) { const int st = (r >> 4) * 2 + (c >> 5), rr = r & 15, cc = c & 31, ob = rr * 64 + cc * 2; return st * 1024 + (ob ^ (((ob >> 9) & 1) << 5)); }
DI void stage_rc(int b, int& R, int& C) { const int st = b / 1024, sb = b % 1024, swz = sb ^ (((sb >> 9) & 1) << 5); R = (st >> 1) * 16 + swz / 64; C = (st & 1) * 32 + (swz % 64) / 2; }
DI int perm32(int rho) { const int n = rho >> 4, i = rho & 15; return 8 * (i >> 2) + 4 * n + (i & 3); }
struct Unit { int pm, pn, z; };
struct Gemm { const bf16_t* A; const bf16_t* Bt; int M, N, K, lda; long zA1, zA2, zB; int nz, perm; };
struct StaticOrder {
  int nM, nN, nwg, G, c, nz, wgm;
  DI void init(int M, int N, int G_, int c_, int nz_) { nM = M / BM; nN = N / BM; nwg = nM * nN; G = G_; c = c_; nz = nz_; wgm = (nN > 4) ? 4 : 8; }
  DI bool next(int i, Unit& u) const {
    const int ib = (nz == 1) ? i : i / nz; u.z = i - ib * nz;
    const long L = (long)ib * G + c; if (L >= nwg) return false;
    int wgid = (int)L; { const int q = nwg / NXCD, r = nwg % NXCD, xcd = wgid % NXCD, off = wgid / NXCD; wgid = (xcd < r ? xcd * (q + 1) : r * (q + 1) + (xcd - r) * q) + off; }
    const int nig = wgm * nN, gid = wgid / nig, fm = gid * wgm, gsz = (nM - fm) < wgm ? (nM - fm) : wgm;
    u.pm = fm + ((wgid % nig) % gsz); u.pn = (wgid % nig) / gsz; return true;
  }
};

template <bool CHAIN, class Epi>
DI void gemm_phase(LAS unsigned char* lds, const Gemm g, const StaticOrder& S, const Epi& E) {
  const int tid = tid_(), wid = __builtin_amdgcn_readfirstlane(tid >> 6), lane = tid & 63, wr = wid >> 2, wc = wid & 3, fr = lane & 15, fq = lane >> 4;
  const int K = g.K, nt = K / BK, lda = g.lda;
  unsigned voffA[2], voffB[2];
#pragma unroll
  for (int i = 0; i < 2; ++i) { int R, C; stage_rc(tid * 16 + i * 8192, R, C); const int Rb = g.perm ? ((R & ~31) + perm32(R & 31)) : R;
    voffA[i] = (unsigned)(R * lda + C) * 2u; voffB[i] = (unsigned)(Rb * K + C) * 2u; }
  const size_t kstep = (size_t)(BK * 2);
  const size_t hstA = (size_t)HALF * lda * 2, hstB = (size_t)HALF * K * 2;
  const size_t tstA = 2 * hstA, tstB = 2 * hstB;
  const unsigned ldsw = (unsigned)wid * 1024u;
  const int aoff = lds_byte(wr * 64 + fr, fq * 8), boff = lds_byte(wc * 32 + fr, fq * 8);
#define PG8_SA(b, h) (((b) * 2 + (h)) * HTB)
#define PG8_SB(b, h) ((4 + (b) * 2 + (h)) * HTB)
#define PG8_STAGE(bufoff, gbase, voff) do { _Pragma("unroll") for (int _i = 0; _i < 2; ++_i) \
    __builtin_amdgcn_global_load_lds((const unsigned*)((const char*)(gbase) + (voff)[_i]), (LAS unsigned*)(lds + (bufoff) + ldsw + _i * 8192), 16, 0, 0); } while (0)
#define PG8_LDA(dst, b, h) do { _Pragma("unroll") for (int m = 0; m < 4; ++m) _Pragma("unroll") for (int k = 0; k < 2; ++k) dst[m][k] = *(const LAS bf16x8*)(lds + PG8_SA(b, h) + aoff + m * 2048 + k * 1024); } while (0)
#define PG8_LDB(dst, b, h) do { _Pragma("unroll") for (int n = 0; n < 2; ++n) _Pragma("unroll") for (int k = 0; k < 2; ++k) dst[n][k] = *(const LAS bf16x8*)(lds + PG8_SB(b, h) + boff + n * 2048 + k * 1024); } while (0)
#define PG8_MMA(ai, bj, At, Bt) do { __builtin_amdgcn_s_setprio(1); _Pragma("unroll") for (int m = 0; m < 4; ++m) _Pragma("unroll") for (int n = 0; n < 2; ++n) _Pragma("unroll") for (int k = 0; k < 2; ++k) \
    acc[ai][bj][m][n] = __builtin_amdgcn_mfma_f32_16x16x32_bf16(Bt[n][k], At[m][k], acc[ai][bj][m][n], 0, 0, 0); __builtin_amdgcn_s_setprio(0); } while (0)
#define PG8_WAIT_V(n) asm volatile("s_waitcnt vmcnt(" #n ")" ::: "memory")
#define PG8_WAIT_L(n) asm volatile("s_waitcnt lgkmcnt(" #n ")" ::: "memory")
#define PG8_BAR __builtin_amdgcn_s_barrier()
#define PG8_SCHED __builtin_amdgcn_sched_barrier(0)
  Unit cur, nxt; int ui = 0;
  if (!S.next(0, cur)) return;
  f32x4 acc[2][2][4][2];
#pragma unroll
  for (int a = 0; a < 2; ++a)
#pragma unroll
    for (int b = 0; b < 2; ++b)
#pragma unroll
      for (int m = 0; m < 4; ++m)
#pragma unroll
        for (int n = 0; n < 2; ++n) acc[a][b][m][n] = (f32x4){0.f, 0.f, 0.f, 0.f};
  bf16x8 At[4][2], B0[2][2], B1[2][2];
#define PG8_ZA(z) ((z) == 0 ? 0l : ((z) == 1 ? g.zA1 : g.zA2))
  const char* cA = (const char*)g.A + PG8_ZA(cur.z) + (size_t)cur.pm * tstA; const char* cB = (const char*)g.Bt + (long)cur.z * g.zB + (size_t)cur.pn * tstB;
  PG8_STAGE(PG8_SB(0, 0), cB, voffB); PG8_STAGE(PG8_SA(0, 0), cA, voffA); PG8_STAGE(PG8_SB(0, 1), cB + hstB, voffB); PG8_STAGE(PG8_SA(0, 1), cA + hstA, voffA);
  if (wr == 1) PG8_BAR;
  PG8_WAIT_V(4); PG8_BAR;
  PG8_STAGE(PG8_SB(1, 0), cB + kstep, voffB); PG8_STAGE(PG8_SA(1, 0), cA + kstep, voffA); PG8_STAGE(PG8_SB(1, 1), cB + hstB + kstep, voffB);
  PG8_WAIT_V(6); PG8_BAR;
  for (;;) {
    const bool has_next = S.next(ui + 1, nxt);
    const char* nA = has_next ? (const char*)g.A + PG8_ZA(nxt.z) + (size_t)nxt.pm * tstA : cA; const char* nB = has_next ? (const char*)g.Bt + (long)nxt.z * g.zB + (size_t)nxt.pn * tstB : cB;
    for (int t = 0; t < nt; t += 2) {
      const bool last = (t == nt - 2);
      const char* a1 = cA + (size_t)(t + 1) * kstep;
      const char* a2 = last ? nA : cA + (size_t)(t + 2) * kstep; const char* b2 = last ? nB : cB + (size_t)(t + 2) * kstep;
      const char* a3 = a2 + kstep; const char* b3 = b2 + kstep;
      PG8_LDB(B0, 0, 0); PG8_SCHED; PG8_LDA(At, 0, 0); PG8_STAGE(PG8_SA(1, 1), a1 + hstA, voffA);
      PG8_WAIT_L(8); PG8_BAR; PG8_WAIT_L(0); PG8_MMA(0, 0, At, B0); PG8_BAR; PG8_SCHED;
      PG8_LDB(B1, 0, 1); PG8_STAGE(PG8_SB(0, 0), b2, voffB);
      PG8_BAR; PG8_WAIT_L(0); PG8_MMA(0, 1, At, B1); PG8_BAR;
      PG8_LDA(At, 0, 1); PG8_STAGE(PG8_SA(0, 0), a2, voffA);
      PG8_BAR; PG8_WAIT_L(0); PG8_MMA(1, 0, At, B0); PG8_BAR; PG8_SCHED;
      PG8_STAGE(PG8_SB(0, 1), b2 + hstB, voffB);
      PG8_WAIT_V(6); PG8_BAR; PG8_MMA(1, 1, At, B1); PG8_BAR;
      PG8_LDB(B0, 1, 0); PG8_SCHED; PG8_LDA(At, 1, 0); PG8_STAGE(PG8_SA(0, 1), a2 + hstA, voffA);
      PG8_WAIT_L(8); PG8_BAR; PG8_WAIT_L(0); PG8_MMA(0, 0, At, B0); PG8_BAR; PG8_SCHED;
      PG8_LDB(B1, 1, 1); PG8_STAGE(PG8_SB(1, 0), b3, voffB);
      PG8_BAR; PG8_WAIT_L(0); PG8_MMA(0, 1, At, B1); PG8_BAR;
      PG8_LDA(At, 1, 1); PG8_STAGE(PG8_SA(1, 0), a3, voffA);
      PG8_BAR; PG8_WAIT_L(0); PG8_MMA(1, 0, At, B0); PG8_BAR; PG8_SCHED;
      PG8_STAGE(PG8_SB(1, 1), b3 + hstB, voffB);
      PG8_WAIT_V(6); PG8_BAR; PG8_MMA(1, 1, At, B1); PG8_BAR;
    }
#define PG8_ZERO() do { _Pragma("unroll") for (int a = 0; a < 2; ++a) _Pragma("unroll") for (int b = 0; b < 2; ++b) _Pragma("unroll") for (int m = 0; m < 4; ++m) _Pragma("unroll") for (int n = 0; n < 2; ++n) acc[a][b][m][n] = (f32x4){0.f, 0.f, 0.f, 0.f}; } while (0)
    if constexpr (CHAIN) { E.merge(acc, cur, wr, wc, fr, fq); if (!has_next) break; if (cur.z == E.nzm1) PG8_ZERO(); }
    else { E(acc, cur, wr, wc, fr, fq); if (!has_next) break; PG8_ZERO(); }
    cur = nxt; cA = nA; cB = nB; ++ui;
  }
  PG8_WAIT_V(0);
  if (wr == 0) PG8_BAR;
  PG8_BAR;
#undef PG8_ZA
#undef PG8_ZERO
#undef PG8_SA
#undef PG8_SB
#undef PG8_STAGE
#undef PG8_LDA
#undef PG8_LDB
#undef PG8_MMA
#undef PG8_WAIT_V
#undef PG8_WAIT_L
#undef PG8_BAR
#undef PG8_SCHED
}
}

enum { EM_PROJ = 0, EM_BF16, EM_GLU, EM_MERGEZ, EM_RESID, EM_RELU2, EM_DRY };
struct Epi {
  int mode;
  bf16_t* o16; int ld16;
  float* o32; const float* r32; int ld32;
  const bf16_t* r16; int ldr16;
  const bf16_t* aux; int ldaux;
  const float* bias;
  int nzm1;
  DI bool is_chain() const { return nzm1 != 0; }
  DI void operator()(const f32x4 (&acc)[2][2][4][2], const pg8::Unit& u, int wr, int wc, int fr, int fq) const {
    if (mode == EM_DRY) return;
    const int row0 = u.pm * 256 + wr * 64 + fr;
    int colt = u.pn * 256; bf16_t* ob = o16; int ldo = ld16;
    if (mode == EM_PROJ) {
      const int pn = u.pn; int s, ldp;
      if (pn < 8) { s = pn & ~1; ldp = 512; } else if (pn < 14) { s = 8; ldp = 1536; } else if (pn < 20) { s = 14; ldp = 1536; } else if (pn < 26) { s = 20; ldp = 1536; }
      else if (pn < 38) { s = 26; ldp = 3072; } else { s = 38; ldp = 256; }
      ob = o16 + PE(s); ldo = ldp; colt = (pn - s) * 256;
    }
    const int col0 = colt + wc * 32 + 8 * fq;
    if (mode == EM_PROJ || mode == EM_BF16 || mode == EM_RELU2) {
      const bool sq = (mode == EM_RELU2);
#pragma unroll
      for (int ai = 0; ai < 2; ++ai)
#pragma unroll
        for (int m = 0; m < 4; ++m) {
          const size_t row = (size_t)(row0 + ai * 128 + m * 16);
#pragma unroll
          for (int bj = 0; bj < 2; ++bj) {
            f32x4 v0 = acc[ai][bj][m][0], v1 = acc[ai][bj][m][1];
            if (sq) {
#pragma unroll
              for (int j = 0; j < 4; ++j) { const float a = fmaxf(v0[j], 0.f), b = fmaxf(v1[j], 0.f); v0[j] = a * a; v1[j] = b * b; }
            }
            u32x4 w; w.x = pk2(v0[0], v0[1]); w.y = pk2(v0[2], v0[3]); w.z = pk2(v1[0], v1[1]); w.w = pk2(v1[2], v1[3]);
            *(u32x4*)(ob + row * ldo + col0 + bj * 128) = w;
          }
        }
    } else if (mode == EM_RESID) {
      if (r32) {
#pragma unroll
        for (int ai = 0; ai < 2; ++ai)
#pragma unroll
          for (int mp = 0; mp < 2; ++mp) {
            f32x4 rr[2][2][2];
#pragma unroll
            for (int mm = 0; mm < 2; ++mm)
#pragma unroll
              for (int bj = 0; bj < 2; ++bj) { const float* p = r32 + (size_t)(row0 + ai * 128 + (mp * 2 + mm) * 16) * ld32 + col0 + bj * 128; rr[mm][bj][0] = *(const f32x4*)p; rr[mm][bj][1] = *(const f32x4*)(p + 4); }
#pragma unroll
            for (int mm = 0; mm < 2; ++mm)
#pragma unroll
              for (int bj = 0; bj < 2; ++bj) { const size_t row = (size_t)(row0 + ai * 128 + (mp * 2 + mm) * 16);
                const f32x4 t0 = rr[mm][bj][0] + acc[ai][bj][mp * 2 + mm][0], t1 = rr[mm][bj][1] + acc[ai][bj][mp * 2 + mm][1];
                u32x4 w; w.x = pk2(t0[0], t0[1]); w.y = pk2(t0[2], t0[3]); w.z = pk2(t1[0], t1[1]); w.w = pk2(t1[2], t1[3]);
                *(u32x4*)(ob + row * ldo + col0 + bj * 128) = w; }
          }
      } else {
#pragma unroll
        for (int ai = 0; ai < 2; ++ai) {
          u32x4 q[4][2];
#pragma unroll
          for (int m = 0; m < 4; ++m)
#pragma unroll
            for (int bj = 0; bj < 2; ++bj) q[m][bj] = *(const u32x4*)(r16 + (size_t)(row0 + ai * 128 + m * 16) * ldr16 + col0 + bj * 128);
#pragma unroll
          for (int m = 0; m < 4; ++m)
#pragma unroll
            for (int bj = 0; bj < 2; ++bj) { const u32x4 v = q[m][bj];
              const f32x4 t0 = (f32x4){bf_lo(v.x), bf_hi(v.x), bf_lo(v.y), bf_hi(v.y)} + acc[ai][bj][m][0], t1 = (f32x4){bf_lo(v.z), bf_hi(v.z), bf_lo(v.w), bf_hi(v.w)} + acc[ai][bj][m][1];
              u32x4 w; w.x = pk2(t0[0], t0[1]); w.y = pk2(t0[2], t0[3]); w.z = pk2(t1[0], t1[1]); w.w = pk2(t1[2], t1[3]);
              *(u32x4*)(ob + (size_t)(row0 + ai * 128 + m * 16) * ldo + col0 + bj * 128) = w; }
        }
      }
    } else if (mode == EM_GLU) {
      f32x4 bb[2][2];
#pragma unroll
      for (int bj = 0; bj < 2; ++bj) { bb[bj][0] = *(const f32x4*)(bias + col0 + bj * 128); bb[bj][1] = *(const f32x4*)(bias + col0 + bj * 128 + 4); }
#pragma unroll
      for (int ai = 0; ai < 2; ++ai) {
        u32x4 gq[4][2];
#pragma unroll
        for (int m = 0; m < 4; ++m)
#pragma unroll
          for (int bj = 0; bj < 2; ++bj) gq[m][bj] = *(const u32x4*)(aux + (size_t)(row0 + ai * 128 + m * 16) * ldaux + col0 + bj * 128);
#pragma unroll
        for (int m = 0; m < 4; ++m)
#pragma unroll
          for (int bj = 0; bj < 2; ++bj) {
            const u32x4 q = gq[m][bj]; const f32x4 v0 = acc[ai][bj][m][0], v1 = acc[ai][bj][m][1];
            const float gv[8] = {bf_lo(q.x), bf_hi(q.x), bf_lo(q.y), bf_hi(q.y), bf_lo(q.z), bf_hi(q.z), bf_lo(q.w), bf_hi(q.w)};
            float o[8];
#pragma unroll
            for (int j = 0; j < 4; ++j) { o[j] = gv[j] * sigmoidf_(v0[j] + bb[bj][0][j]); o[4 + j] = gv[4 + j] * sigmoidf_(v1[j] + bb[bj][1][j]); }
            u32x4 w; w.x = pk2(o[0], o[1]); w.y = pk2(o[2], o[3]); w.z = pk2(o[4], o[5]); w.w = pk2(o[6], o[7]);
            *(u32x4*)(ob + (size_t)(row0 + ai * 128 + m * 16) * ldo + col0 + bj * 128) = w;
          }
      }
    }
  }
  DI void merge(f32x4 (&acc)[2][2][4][2], const pg8::Unit& u, int wr, int wc, int fr, int fq) const {
    if (mode == EM_DRY) return;
    const int row0 = u.pm * 256 + wr * 64 + fr, col0 = u.pn * 256 + wc * 32 + 8 * fq;
    bf16_t* ob = o16; const int ldo = ld16;
    {
      const int z = u.z;
#pragma unroll
      for (int ai = 0; ai < 2; ++ai)
#pragma unroll
        for (int mp = 0; mp < 2; ++mp) {
          u32x4 g0[2][2], g1[2][2];
#pragma unroll
          for (int mm = 0; mm < 2; ++mm)
#pragma unroll
            for (int bj = 0; bj < 2; ++bj) { const bf16_t* p = aux + (size_t)(row0 + ai * 128 + (mp * 2 + mm) * 16) * ldaux + z * 1024 + col0 + bj * 128;
              g0[mm][bj] = *(const u32x4*)p; g1[mm][bj] = (z < 2) ? *(const u32x4*)(p + 1024) : (u32x4){0u, 0u, 0u, 0u}; }
#pragma unroll
          for (int mm = 0; mm < 2; ++mm)
#pragma unroll
            for (int bj = 0; bj < 2; ++bj) {
              const int m = mp * 2 + mm; const size_t row = (size_t)(row0 + ai * 128 + m * 16);
              f32x4& a0 = acc[ai][bj][m][0]; f32x4& a1 = acc[ai][bj][m][1];
#pragma unroll
              for (int e2 = 0; e2 < 4; ++e2) {
                const float l0a = bf_lo(g0[mm][bj][e2]), l0b = bf_hi(g0[mm][bj][e2]), l1a = bf_lo(g1[mm][bj][e2]), l1b = bf_hi(g1[mm][bj][e2]);
                float fa = __builtin_amdgcn_rcpf(1.0f + __expf(-l0a)), fb = __builtin_amdgcn_rcpf(1.0f + __expf(-l0b));
                if (z < 2) { fa *= 1.0f + __expf(-l1a); fb *= 1.0f + __expf(-l1b); }
                if (e2 < 2) { a0[2 * e2] *= fa; a0[2 * e2 + 1] *= fb; } else { a1[2 * e2 - 4] *= fa; a1[2 * e2 - 3] *= fb; }
              }
              if (z == 2) { u32x4 w; w.x = pk2(a0[0], a0[1]); w.y = pk2(a0[2], a0[3]); w.z = pk2(a1[0], a1[1]); w.w = pk2(a1[2], a1[3]);
                *(u32x4*)(ob + row * ldo + col0 + bj * 128) = w; }
            }
        }
    }
  }
};

DI void norm_rows_bf16(const float* x, const float* gain, bf16_t* H, int nrows) {
  const int tid = tid_(), lane = tid & 63, gw = blockIdx.x * 8 + (tid >> 6), nw = gridDim.x * 8;
  f32x4 g[4];
#pragma unroll
  for (int i = 0; i < 4; ++i) g[i] = *(const f32x4*)(gain + i * 256 + lane * 4);
  for (int r = gw * 2; r < nrows; r += nw * 2) {
    f32x4 v[2][4];
#pragma unroll
    for (int q = 0; q < 2; ++q)
#pragma unroll
      for (int i = 0; i < 4; ++i) v[q][i] = *(const f32x4*)(x + (size_t)(r + q) * 1024 + i * 256 + lane * 4);
#pragma unroll
    for (int q = 0; q < 2; ++q) {
      float ss = 0.f;
#pragma unroll
      for (int i = 0; i < 4; ++i) ss += v[q][i][0] * v[q][i][0] + v[q][i][1] * v[q][i][1] + v[q][i][2] * v[q][i][2] + v[q][i][3] * v[q][i][3];
      ss = wave_sum(ss, lane);
      const float rs = rsqrtf(ss * (1.0f / 1024.0f) + 1e-6f);
#pragma unroll
      for (int i = 0; i < 4; ++i) { u32x2 w; w.x = pk2(v[q][i][0] * rs * g[i][0], v[q][i][1] * rs * g[i][1]); w.y = pk2(v[q][i][2] * rs * g[i][2], v[q][i][3] * rs * g[i][3]);
        *(u32x2*)(H + (size_t)(r + q) * 1024 + i * 256 + lane * 4) = w; }
    }
  }
}
DI void norm_rows_from_bf16(const bf16_t* xb, int ldx, const float* gain, bf16_t* H, int nrows) {
  const int tid = tid_(), lane = tid & 63, gw = blockIdx.x * 8 + (tid >> 6), nw = gridDim.x * 8;
  f32x4 g[4];
#pragma unroll
  for (int i = 0; i < 2; ++i) { g[2 * i] = *(const f32x4*)(gain + i * 512 + lane * 8); g[2 * i + 1] = *(const f32x4*)(gain + i * 512 + lane * 8 + 4); }
  for (int r = gw * 8; r < nrows; r += nw * 8) {
    u32x4 v[8][2];
#pragma unroll
    for (int q = 0; q < 8; ++q)
#pragma unroll
      for (int i = 0; i < 2; ++i) v[q][i] = *(const u32x4*)(xb + (size_t)(r + q) * ldx + i * 512 + lane * 8);
#pragma unroll
    for (int q = 0; q < 8; ++q) {
      float f[16];
#pragma unroll
      for (int i = 0; i < 2; ++i)
#pragma unroll
        for (int e = 0; e < 4; ++e) { f[i * 8 + 2 * e] = bf_lo(v[q][i][e]); f[i * 8 + 2 * e + 1] = bf_hi(v[q][i][e]); }
      float ss = 0.f;
#pragma unroll
      for (int e = 0; e < 16; ++e) ss += f[e] * f[e];
      ss = wave_sum(ss, lane);
      const float rs = rsqrtf(ss * (1.0f / 1024.0f) + 1e-6f);
#pragma unroll
      for (int i = 0; i < 2; ++i) { u32x4 w;
#pragma unroll
        for (int e = 0; e < 4; ++e) w[e] = pk2(f[i * 8 + 2 * e] * rs * g[2 * i + (e >> 1)][(2 * e) & 3], f[i * 8 + 2 * e + 1] * rs * g[2 * i + (e >> 1)][(2 * e + 1) & 3]);
        *(u32x4*)(H + (size_t)(r + q) * 1024 + i * 512 + lane * 8) = w; }
    }
  }
}
DI void final_norm_expand(float* out, const float* gain, int nrows) {
  const int tid = tid_(), lane = tid & 63, gw = blockIdx.x * 8 + (tid >> 6), nw = gridDim.x * 8;
  f32x4 g[4];
#pragma unroll
  for (int i = 0; i < 2; ++i) { g[2 * i] = *(const f32x4*)(gain + i * 512 + lane * 8); g[2 * i + 1] = *(const f32x4*)(gain + i * 512 + lane * 8 + 4); }
  for (int r = gw; r < nrows; r += nw) {
    const bf16_t* xb = (const bf16_t*)(out + (size_t)r * 1024);
    u32x4 v[2];
#pragma unroll
    for (int i = 0; i < 2; ++i) v[i] = *(const u32x4*)(xb + i * 512 + lane * 8);
    float f[16];
#pragma unroll
    for (int i = 0; i < 2; ++i)
#pragma unroll
      for (int e = 0; e < 4; ++e) { f[i * 8 + 2 * e] = bf_lo(v[i][e]); f[i * 8 + 2 * e + 1] = bf_hi(v[i][e]); }
    float ss = 0.f;
#pragma unroll
    for (int e = 0; e < 16; ++e) ss += f[e] * f[e];
    ss = wave_sum(ss, lane);
    const float rs = rsqrtf(ss * (1.0f / 1024.0f) + 1e-6f);
    asm volatile("s_waitcnt vmcnt(0)" ::: "memory");
#pragma unroll
    for (int i = 0; i < 2; ++i) { f32x4 o0, o1;
#pragma unroll
      for (int e = 0; e < 4; ++e) { o0[e] = f[i * 8 + e] * rs * g[2 * i][e]; o1[e] = f[i * 8 + 4 + e] * rs * g[2 * i + 1][e]; }
      *(f32x4*)(out + (size_t)r * 1024 + i * 512 + lane * 8) = o0; *(f32x4*)(out + (size_t)r * 1024 + i * 512 + lane * 8 + 4) = o1; }
  }
}
DI void final_norm_from_bf16(const bf16_t* xb, float* out, const float* gain, int nrows) {
  const int tid = tid_(), lane = tid & 63, gw = blockIdx.x * 8 + (tid >> 6), nw = gridDim.x * 8;
  f32x4 g[4];
#pragma unroll
  for (int i = 0; i < 2; ++i) { g[2 * i] = *(const f32x4*)(gain + i * 512 + lane * 8); g[2 * i + 1] = *(const f32x4*)(gain + i * 512 + lane * 8 + 4); }
  for (int r = gw * 2; r < nrows; r += nw * 2) {
    u32x4 v[2][2];
#pragma unroll
    for (int q = 0; q < 2; ++q)
#pragma unroll
      for (int i = 0; i < 2; ++i) v[q][i] = *(const u32x4*)(xb + (size_t)(r + q) * 1024 + i * 512 + lane * 8);
#pragma unroll
    for (int q = 0; q < 2; ++q) {
      float f[16];
#pragma unroll
      for (int i = 0; i < 2; ++i)
#pragma unroll
        for (int e = 0; e < 4; ++e) { f[i * 8 + 2 * e] = bf_lo(v[q][i][e]); f[i * 8 + 2 * e + 1] = bf_hi(v[q][i][e]); }
      float ss = 0.f;
#pragma unroll
      for (int e = 0; e < 16; ++e) ss += f[e] * f[e];
      ss = wave_sum(ss, lane);
      const float rs = rsqrtf(ss * (1.0f / 1024.0f) + 1e-6f);
#pragma unroll
      for (int i = 0; i < 2; ++i) { f32x4 o0, o1;
#pragma unroll
        for (int e = 0; e < 4; ++e) { o0[e] = f[i * 8 + e] * rs * g[2 * i][e]; o1[e] = f[i * 8 + 4 + e] * rs * g[2 * i + 1][e]; }
        *(f32x4*)(out + (size_t)(r + q) * 1024 + i * 512 + lane * 8) = o0; *(f32x4*)(out + (size_t)(r + q) * 1024 + i * 512 + lane * 8 + 4) = o1; }
    }
  }
}
DI void norm_rows_f32_inplace(float* x, const float* gain, int nrows) {
  const int tid = tid_(), lane = tid & 63, gw = blockIdx.x * 8 + (tid >> 6), nw = gridDim.x * 8;
  f32x4 g[4];
#pragma unroll
  for (int i = 0; i < 4; ++i) g[i] = *(const f32x4*)(gain + i * 256 + lane * 4);
  for (int r = gw * 2; r < nrows; r += nw * 2) {
    f32x4 v[2][4];
#pragma unroll
    for (int q = 0; q < 2; ++q)
#pragma unroll
      for (int i = 0; i < 4; ++i) v[q][i] = *(const f32x4*)(x + (size_t)(r + q) * 1024 + i * 256 + lane * 4);
#pragma unroll
    for (int q = 0; q < 2; ++q) {
      float ss = 0.f;
#pragma unroll
      for (int i = 0; i < 4; ++i) ss += v[q][i][0] * v[q][i][0] + v[q][i][1] * v[q][i][1] + v[q][i][2] * v[q][i][2] + v[q][i][3] * v[q][i][3];
      ss = wave_sum(ss, lane);
      const float rs = rsqrtf(ss * (1.0f / 1024.0f) + 1e-6f);
#pragma unroll
      for (int i = 0; i < 4; ++i) { f32x4 o; o[0] = v[q][i][0] * rs * g[i][0]; o[1] = v[q][i][1] * rs * g[i][1]; o[2] = v[q][i][2] * rs * g[i][2]; o[3] = v[q][i][3] * rs * g[i][3];
        *(f32x4*)(x + (size_t)(r + q) * 1024 + i * 256 + lane * 4) = o; }
    }
  }
}

DI int win_map(int n) { return n < 1536 ? n : (n < 9728 ? n + 16 : (n < 9744 ? n - 9728 + 1536 : -1)); }
DI void transpose_w(LAS unsigned char* sm, const float* src, int K, int Ns, bf16_t* dst, int Nd, int mapmode) {
  LAS float* tile = (LAS float*)sm;
  const int tid = tid_(), tn = Nd / 64, tk = K / 64;
  for (int t = blockIdx.x; t < tn * tk; t += gridDim.x) {
    const int n0 = (t / tk) * 64, k0 = (t % tk) * 64;
    float tv[8];
#pragma unroll
    for (int it = 0; it < 8; ++it) { const int idx = it * 512 + tid, kk = idx >> 6, nn = idx & 63;
      const int sc = mapmode ? win_map(n0 + nn) : (n0 + nn);
      tv[it] = sc >= 0 ? src[(size_t)(k0 + kk) * Ns + sc] : 0.f; }
#pragma unroll
    for (int it = 0; it < 8; ++it) { const int idx = it * 512 + tid, kk = idx >> 6, nn = idx & 63; tile[kk * 65 + nn] = tv[it]; }
    __syncthreads();
    { const int nn = tid >> 3, kc = tid & 7; float f[8];
#pragma unroll
      for (int e = 0; e < 8; ++e) f[e] = tile[(kc * 8 + e) * 65 + nn];
      u32x4 w; w.x = pk2(f[0], f[1]); w.y = pk2(f[2], f[3]); w.z = pk2(f[4], f[5]); w.w = pk2(f[6], f[7]);
      *(u32x4*)(dst + (size_t)(n0 + nn) * K + k0 + kc * 8) = w; }
    __syncthreads();
  }
}

DI void attn_task(LAS unsigned char* sm, int task, bf16_t* QA, const bf16_t* KA, const bf16_t* VA, float* LSE, bool dry) {
  const int tid = tid_(), lane = tid & 63, w = tid >> 6, li = lane & 15, quad = lane >> 4;
  const int bh = task >> 5, sub = task & 31;
  const int b = bh / 12, h = bh - b * 12, g = h >> 2, dsh = g * 2, dil = 1 << dsh, nblk = 32 >> dsh;
  const int r = sub / nblk, n = sub - r * nblk;
  LAS unsigned char* ks = sm;
  LAS unsigned short* vt = (LAS unsigned short*)(sm + 69632);
  {
    u32x4 kv[8], vv[8];
#pragma unroll
    for (int it = 0; it < 8; ++it) {
      const int id = it * 512 + tid, row = id >> 4, cc = id & 15, sp = n * 128 - 128 + row;
      kv[it] = (u32x4){0u, 0u, 0u, 0u};
      if (sp >= 0) kv[it] = *(const u32x4*)(KA + ((size_t)b * 4096 + (size_t)(sp * dil + r)) * 1536 + h * 128 + cc * 8);
    }
#pragma unroll
    for (int it = 0; it < 8; ++it) {
      const int id = it * 512 + tid, key = id & 255, cc = id >> 8, sp = n * 128 - 128 + key;
      vv[it] = (u32x4){0u, 0u, 0u, 0u};
      if (sp >= 0) vv[it] = *(const u32x4*)(VA + ((size_t)b * 4096 + (size_t)(sp * dil + r)) * 1536 + h * 128 + cc * 8);
    }
#pragma unroll
    for (int it = 0; it < 8; ++it) { const int id = it * 512 + tid, row = id >> 4, cc = id & 15; *(LAS u32x4*)(ks + row * 272 + cc * 16) = kv[it]; }
#pragma unroll
    for (int it = 0; it < 8; ++it) { const int id = it * 512 + tid, key = id & 255, cc = id >> 8;
#pragma unroll
      for (int e = 0; e < 4; ++e) { vt[(cc * 8 + 2 * e) * 264 + key] = (unsigned short)(vv[it][e] & 0xffffu); vt[(cc * 8 + 2 * e + 1) * 264 + key] = (unsigned short)(vv[it][e] >> 16); } }
  }
  __syncthreads();
  const int qsp = n * 128 + w * 16 + li;
  const size_t qtok = (size_t)b * 4096 + (size_t)(qsp * dil + r);
  bf16_t* qptr = QA + qtok * 1536 + h * 128;
  bf16x8 qf[4];
#pragma unroll
  for (int kk = 0; kk < 4; ++kk) qf[kk] = *(const bf16x8*)(qptr + kk * 32 + quad * 8);
  const int kt0 = w < 6 ? w : 6;
  const float sc = 0.08838834764831845f * 1.4426950408889634f;
  const float sl = exp2f(-8.0f * (float)(h + 1) / 12.0f) * (float)dil * 1.4426950408889634f;
  float s[10][4]; float mx = -1e30f;
#pragma unroll
  for (int tt = 0; tt < 10; ++tt) {
    const int kt = kt0 + tt; f32x4 acc = {0.f, 0.f, 0.f, 0.f};
#pragma unroll
    for (int kk = 0; kk < 4; ++kk) { const bf16x8 a = *(const LAS bf16x8*)(ks + (kt * 16 + li) * 272 + kk * 64 + quad * 16); acc = mfma16(a, qf[kk], acc); }
#pragma unroll
    for (int j = 0; j < 4; ++j) { const int kl = kt * 16 + quad * 4 + j, dist = 128 + w * 16 + li - kl;
      const bool valid = dist >= 0 && dist <= 128 && (n > 0 || kl >= 128);
      const float v = acc[j] * sc - sl * (float)dist; s[tt][j] = valid ? v : -1e30f; mx = fmaxf(mx, s[tt][j]); }
  }
  mx = fmaxf(mx, shx(mx, 16, lane)); mx = fmaxf(mx, shx(mx, 32, lane));
  float lsum = 0.f;
#pragma unroll
  for (int tt = 0; tt < 10; ++tt)
#pragma unroll
    for (int j = 0; j < 4; ++j) { const float p = exp2f(s[tt][j] - mx); s[tt][j] = p; lsum += p; }
  lsum += shx(lsum, 16, lane); lsum += shx(lsum, 32, lane);
  bf16x8 pf[5];
#pragma unroll
  for (int pp = 0; pp < 5; ++pp) { u32x4 t; t.x = pk2(s[2 * pp][0], s[2 * pp][1]); t.y = pk2(s[2 * pp][2], s[2 * pp][3]); t.z = pk2(s[2 * pp + 1][0], s[2 * pp + 1][1]); t.w = pk2(s[2 * pp + 1][2], s[2 * pp + 1][3]); pf[pp] = mk8(t); }
  const float inv = 1.0f / lsum;
#pragma unroll
  for (int dvt = 0; dvt < 8; ++dvt) {
    f32x4 acc = {0.f, 0.f, 0.f, 0.f};
#pragma unroll
    for (int pp = 0; pp < 5; ++pp) { const int kA = (kt0 + 2 * pp) * 16 + quad * 4;
      const u32x2 lo = *(const LAS u32x2*)(vt + (dvt * 16 + li) * 264 + kA), hi = *(const LAS u32x2*)(vt + (dvt * 16 + li) * 264 + kA + 16);
      u32x4 t; t.x = lo.x; t.y = lo.y; t.z = hi.x; t.w = hi.y; acc = mfma16(mk8(t), pf[pp], acc); }
    u32x2 o; o.x = pk2(acc[0] * inv, acc[1] * inv); o.y = pk2(acc[2] * inv, acc[3] * inv);
    if (!dry) *(u32x2*)(qptr + dvt * 16 + quad * 4) = o;
  }
  if (quad == 0 && !dry) LSE[qtok * 12 + h] = (mx + log2f(lsum)) * 0.6931471805599453f;
  __syncthreads();
}

DI void attn_combine(const bf16_t* QA, bf16_t* YC, const float* LSE, bool dry) {
  const int nitem = MG * 4 * 16;
  for (int it = blockIdx.x * NTHREADS + tid_(); it < nitem; it += gridDim.x * NTHREADS) {
    const int t = it >> 6, hg = (it >> 4) & 3, dc = it & 15;
    const float l0 = LSE[(size_t)t * 12 + hg], l1 = LSE[(size_t)t * 12 + 4 + hg], l2 = LSE[(size_t)t * 12 + 8 + hg];
    const float m = fmaxf(l0, fmaxf(l1, l2));
    float w0 = __expf(l0 - m), w1 = __expf(l1 - m), w2 = __expf(l2 - m); const float iv = 1.0f / (w0 + w1 + w2); w0 *= iv; w1 *= iv; w2 *= iv;
    const bf16_t* p = QA + (size_t)t * 1536 + hg * 128 + dc * 8;
    const u32x4 a = *(const u32x4*)p, b = *(const u32x4*)(p + 512), c = *(const u32x4*)(p + 1024);
    u32x4 o;
#pragma unroll
    for (int e = 0; e < 4; ++e) o[e] = pk2(w0 * bf_lo(a[e]) + w1 * bf_lo(b[e]) + w2 * bf_lo(c[e]), w0 * bf_hi(a[e]) + w1 * bf_hi(b[e]) + w2 * bf_hi(c[e]));
    if (!dry) *(u32x4*)(YC + (size_t)t * 512 + hg * 128 + dc * 8) = o;
  }
}

DI void xattn_task(LAS unsigned char* sm, int task, bf16_t* XQ, const bf16_t* MKV, int l, bool dry) {
  const int tid = tid_(), lane = tid & 63, w = tid >> 6, li = lane & 15, quad = lane >> 4;
  const int b = task >> 7, hx = (task >> 5) & 3, n = task & 31;
  LAS unsigned short* vt = (LAS unsigned short*)sm;
  {
    u32x4 kv[16];
#pragma unroll
    for (int it = 0; it < 16; ++it) { const int id = it * 512 + tid, row = id >> 5, cc = id & 31;
      kv[it] = *(const u32x4*)(MKV + (size_t)(b * 256 + row) * 4096 + l * 2048 + hx * 256 + cc * 8); }
#pragma unroll
    for (int it = 0; it < 16; ++it) { const int id = it * 512 + tid, row = id >> 5, cc = id & 31; *(LAS u32x4*)(sm + row * 528 + cc * 16) = kv[it]; }
  }
  __syncthreads();
  const size_t qtok = (size_t)b * 4096 + n * 128 + w * 16 + li;
  bf16_t* qptr = XQ + qtok * 1024 + hx * 256;
  bf16x8 qf[8];
#pragma unroll
  for (int kk = 0; kk < 8; ++kk) qf[kk] = *(const bf16x8*)(qptr + kk * 32 + quad * 8);
  float s[16][4]; float mx = -1e30f;
  const float sc = 0.0625f * 1.4426950408889634f;
#pragma unroll
  for (int kt = 0; kt < 16; ++kt) { f32x4 acc = {0.f, 0.f, 0.f, 0.f};
#pragma unroll
    for (int kk = 0; kk < 8; ++kk) { const bf16x8 a = *(const LAS bf16x8*)(sm + (kt * 16 + li) * 528 + kk * 64 + quad * 16); acc = mfma16(a, qf[kk], acc); }
#pragma unroll
    for (int j = 0; j < 4; ++j) { s[kt][j] = acc[j] * sc; mx = fmaxf(mx, s[kt][j]); } }
  mx = fmaxf(mx, shx(mx, 16, lane)); mx = fmaxf(mx, shx(mx, 32, lane));
  float lsum = 0.f;
#pragma unroll
  for (int kt = 0; kt < 16; ++kt)
#pragma unroll
    for (int j = 0; j < 4; ++j) { const float p = exp2f(s[kt][j] - mx); s[kt][j] = p; lsum += p; }
  lsum += shx(lsum, 16, lane); lsum += shx(lsum, 32, lane);
  bf16x8 pf[8];
#pragma unroll
  for (int pp = 0; pp < 8; ++pp) { u32x4 t; t.x = pk2(s[2 * pp][0], s[2 * pp][1]); t.y = pk2(s[2 * pp][2], s[2 * pp][3]); t.z = pk2(s[2 * pp + 1][0], s[2 * pp + 1][1]); t.w = pk2(s[2 * pp + 1][2], s[2 * pp + 1][3]); pf[pp] = mk8(t); }
  const float inv = 1.0f / lsum;
  {
    u32x4 vv[16];
#pragma unroll
    for (int it = 0; it < 16; ++it) { const int id = it * 512 + tid, key = id & 255, cc = id >> 8;
      vv[it] = *(const u32x4*)(MKV + (size_t)(b * 256 + key) * 4096 + l * 2048 + 1024 + hx * 256 + cc * 8); }
    __syncthreads();
#pragma unroll
    for (int it = 0; it < 16; ++it) { const int id = it * 512 + tid, key = id & 255, cc = id >> 8;
#pragma unroll
      for (int e = 0; e < 4; ++e) { vt[(cc * 8 + 2 * e) * 264 + key] = (unsigned short)(vv[it][e] & 0xffffu); vt[(cc * 8 + 2 * e + 1) * 264 + key] = (unsigned short)(vv[it][e] >> 16); } }
  }
  __syncthreads();
#pragma unroll
  for (int dvt = 0; dvt < 16; ++dvt) {
    f32x4 acc = {0.f, 0.f, 0.f, 0.f};
#pragma unroll
    for (int pp = 0; pp < 8; ++pp) { const int kA = 2 * pp * 16 + quad * 4;
      const u32x2 lo = *(const LAS u32x2*)(vt + (dvt * 16 + li) * 264 + kA), hi = *(const LAS u32x2*)(vt + (dvt * 16 + li) * 264 + kA + 16);
      u32x4 t; t.x = lo.x; t.y = lo.y; t.z = hi.x; t.w = hi.y; acc = mfma16(mk8(t), pf[pp], acc); }
    u32x2 o; o.x = pk2(acc[0] * inv, acc[1] * inv); o.y = pk2(acc[2] * inv, acc[3] * inv);
    if (!dry) *(u32x2*)(qptr + dvt * 16 + quad * 4) = o;
  }
  __syncthreads();
}

struct S5P { const float *a_re, *a_im, *log_step, *b_re, *b_im, *c_re, *c_im, *d; };
DI void s5_lambar(const S5P& P, int g, int p, float& lbr, float& lbi) {
  const float step = __expf(P.log_step[g]);
  const float ar = P.a_re[g * 64 + p], ai = P.a_im[g * 64 + p];
  const float mag = __expf(ar * step);
  float sn, cs; { const float x = ai * step; const float k = rintf(x * 0.15915494309189535f); float rr = fmaf(-k, 6.2831854820251465f, x); rr = fmaf(-k, -1.7484556000744883e-07f, rr); sn = sinf(rr); cs = cosf(rr); }
  lbr = mag * cs; lbi = mag * sn;
}
DI void s5_carry_scan(const f32x2* E, f32x2* C, const S5P& P, bool dry) {
  const int total = BPG * 32 * 64;
  for (int gid = blockIdx.x * NTHREADS + tid_(); gid < total; gid += gridDim.x * NTHREADS) {
    const int p = gid & 63, g = (gid >> 6) & 31, b = gid >> 11;
    float lr_, li_; s5_lambar(P, g, p, lr_, li_);
#pragma unroll
    for (int q = 0; q < 6; ++q) { const float t0 = lr_ * lr_ - li_ * li_, t1 = 2.0f * lr_ * li_; lr_ = t0; li_ = t1; }
    const size_t base = (((size_t)b * 32 + g) * 64) * 64 + p;
    float sr = 0.f, si = 0.f;
    for (int c0 = 0; c0 < 64; c0 += 8) { f32x2 ev[8];
#pragma unroll
      for (int q = 0; q < 8; ++q) ev[q] = E[base + (size_t)(c0 + q) * 64];
#pragma unroll
      for (int q = 0; q < 8; ++q) { if (!dry) { f32x2 o = {sr, si}; C[base + (size_t)(c0 + q) * 64] = o; }
        const float t0 = lr_ * sr - li_ * si + ev[q][0], t1 = lr_ * si + li_ * sr + ev[q][1]; sr = t0; si = t1; } }
  }
}
DI float bperm(float v, int srclane) { return __builtin_bit_cast(float, __builtin_amdgcn_ds_bpermute(srclane << 2, __builtin_bit_cast(int, v))); }
DI void s5_task(LAS unsigned char* sm, int task, int mode, bf16_t* U, f32x2* E, const S5P& P, bool dry) {
  const int tid = tid_(), lane = tid & 63, w = tid >> 6, li = lane & 15, quad = lane >> 4;
  const int b = task >> 8, c = (task >> 2) & 63, oct = task & 3;
  const size_t row0 = (size_t)b * 4096 + c * 64;
  { u32x4 v[2];
#pragma unroll
    for (int it = 0; it < 2; ++it) { const int id = it * 512 + tid, t = id >> 4, cc = id & 15; v[it] = *(const u32x4*)(U + (row0 + t) * 512 + oct * 128 + cc * 8); }
#pragma unroll
    for (int it = 0; it < 2; ++it) { const int id = it * 512 + tid, t = id >> 4, cc = id & 15; *(LAS u32x4*)(sm + t * 272 + cc * 16) = v[it]; } }
  __syncthreads();
  const int g = oct * 8 + w;
  float l1r[4], l1i[4], l2r[4], l2i[4], l3r[4], l3i[4], l4r[4], l4i[4], spr[4], spi[4];
  bf16x8 Bre[4], Bim[4];
#pragma unroll
  for (int pb = 0; pb < 4; ++pb) {
    const int p = pb * 16 + li;
    float lr, lim; s5_lambar(P, g, p, lr, lim);
    const float ar = P.a_re[g * 64 + p], ai = P.a_im[g * 64 + p];
    const float iv = 1.0f / (ar * ar + ai * ai), nr = lr - 1.0f, ni = lim;
    const float cr = (nr * ar + ni * ai) * iv, ci = (ni * ar - nr * ai) * iv;
    u32x4 tre = {0u, 0u, 0u, 0u}, tim = {0u, 0u, 0u, 0u};
    if (quad < 2) {
      const float* pr = P.b_re + ((size_t)g * 64 + p) * 16 + quad * 8; const float* pi = P.b_im + ((size_t)g * 64 + p) * 16 + quad * 8;
      const f32x4 br0 = *(const f32x4*)pr, br1 = *(const f32x4*)(pr + 4), bi0 = *(const f32x4*)pi, bi1 = *(const f32x4*)(pi + 4);
      tre.x = pk2(cr * br0[0] - ci * bi0[0], cr * br0[1] - ci * bi0[1]); tre.y = pk2(cr * br0[2] - ci * bi0[2], cr * br0[3] - ci * bi0[3]);
      tre.z = pk2(cr * br1[0] - ci * bi1[0], cr * br1[1] - ci * bi1[1]); tre.w = pk2(cr * br1[2] - ci * bi1[2], cr * br1[3] - ci * bi1[3]);
      tim.x = pk2(cr * bi0[0] + ci * br0[0], cr * bi0[1] + ci * br0[1]); tim.y = pk2(cr * bi0[2] + ci * br0[2], cr * bi0[3] + ci * br0[3]);
      tim.z = pk2(cr * bi1[0] + ci * br1[0], cr * bi1[1] + ci * br1[1]); tim.w = pk2(cr * bi1[2] + ci * br1[2], cr * bi1[3] + ci * br1[3]);
    }
    Bre[pb] = mk8(tre); Bim[pb] = mk8(tim);
    l1r[pb] = lr; l1i[pb] = lim;
    l2r[pb] = lr * lr - lim * lim; l2i[pb] = 2.0f * lr * lim;
    l3r[pb] = l2r[pb] * lr - l2i[pb] * lim; l3i[pb] = l2r[pb] * lim + l2i[pb] * lr;
    l4r[pb] = l2r[pb] * l2r[pb] - l2i[pb] * l2i[pb]; l4i[pb] = 2.0f * l2r[pb] * l2i[pb];
    spr[pb] = 0.f; spi[pb] = 0.f;
    if (mode == 1) { const f32x2 e = E[(((size_t)b * 32 + g) * 64 + c) * 64 + p]; spr[pb] = e[0]; spi[pb] = e[1]; }
  }
  bf16x8 cm[4]; f32x4 dsk = {0.f, 0.f, 0.f, 0.f};
  LAS unsigned char* ss = sm + 17408 + w * 4352;
  if (mode == 1) {
#pragma unroll
    for (int kk = 0; kk < 4; ++kk) { const int p0 = kk * 16 + quad * 4;
      const f32x4 cr4 = *(const f32x4*)(P.c_re + ((size_t)g * 16 + li) * 64 + p0), ci4 = *(const f32x4*)(P.c_im + ((size_t)g * 16 + li) * 64 + p0);
      u32x4 t; t.x = pk2(cr4[0], -ci4[0]); t.y = pk2(cr4[1], -ci4[1]); t.z = pk2(cr4[2], -ci4[2]); t.w = pk2(cr4[3], -ci4[3]); cm[kk] = mk8(t); }
    dsk = *(const f32x4*)(P.d + g * 16 + quad * 4);
  }
  const int src_up = (lane - 16) & 63, src_q3 = 48 + li;
  for (int sb = 0; sb < 4; ++sb) {
    u32x4 araw = {0u, 0u, 0u, 0u};
    if (quad < 2) araw = *(const LAS u32x4*)(sm + (sb * 16 + li) * 272 + (w * 16 + quad * 8) * 2);
    const bf16x8 a = mk8(araw);
#pragma unroll
    for (int pb = 0; pb < 4; ++pb) {
      const f32x4 z4 = {0.f, 0.f, 0.f, 0.f};
      const f32x4 are = mfma16(a, Bre[pb], z4), aim = mfma16(a, Bim[pb], z4);
      float s0r = are[0], s0i = aim[0];
      float s1r = l1r[pb] * s0r - l1i[pb] * s0i + are[1], s1i = l1r[pb] * s0i + l1i[pb] * s0r + aim[1];
      float s2r = l1r[pb] * s1r - l1i[pb] * s1i + are[2], s2i = l1r[pb] * s1i + l1i[pb] * s1r + aim[2];
      float s3r = l1r[pb] * s2r - l1i[pb] * s2i + are[3], s3i = l1r[pb] * s2i + l1i[pb] * s2r + aim[3];
      float cr_ = (quad == 0) ? spr[pb] : 0.f, ci_ = (quad == 0) ? spi[pb] : 0.f;
#pragma unroll
      for (int r = 0; r < 3; ++r) {
        const float er = l4r[pb] * cr_ - l4i[pb] * ci_ + s3r, ei = l4r[pb] * ci_ + l4i[pb] * cr_ + s3i;
        const float gr = bperm(er, src_up), gi = bperm(ei, src_up);
        if (quad == r + 1) { cr_ = gr; ci_ = gi; }
      }
      s0r += l1r[pb] * cr_ - l1i[pb] * ci_; s0i += l1r[pb] * ci_ + l1i[pb] * cr_;
      s1r += l2r[pb] * cr_ - l2i[pb] * ci_; s1i += l2r[pb] * ci_ + l2i[pb] * cr_;
      s2r += l3r[pb] * cr_ - l3i[pb] * ci_; s2i += l3r[pb] * ci_ + l3i[pb] * cr_;
      s3r += l4r[pb] * cr_ - l4i[pb] * ci_; s3i += l4r[pb] * ci_ + l4i[pb] * cr_;
      spr[pb] = bperm(s3r, src_q3); spi[pb] = bperm(s3i, src_q3);
      if (mode == 1) { LAS unsigned char* q = ss + (quad * 4) * 272 + (pb * 16 + li) * 4;
        *(LAS unsigned*)(q) = pk2(s0r, s0i); *(LAS unsigned*)(q + 272) = pk2(s1r, s1i); *(LAS unsigned*)(q + 544) = pk2(s2r, s2i); *(LAS unsigned*)(q + 816) = pk2(s3r, s3i); }
    }
    if (mode == 1) {
      asm volatile("s_waitcnt lgkmcnt(0)" ::: "memory");
      f32x4 acc = {0.f, 0.f, 0.f, 0.f};
#pragma unroll
      for (int kk = 0; kk < 4; ++kk) { const bf16x8 bq = *(const LAS bf16x8*)(ss + li * 272 + kk * 64 + quad * 16); acc = mfma16(cm[kk], bq, acc); }
      const u32x2 uq = *(const LAS u32x2*)(sm + (sb * 16 + li) * 272 + (w * 16 + quad * 4) * 2);
      const float u4[4] = {bf_lo(uq.x), bf_hi(uq.x), bf_lo(uq.y), bf_hi(uq.y)};
      float o[4];
#pragma unroll
      for (int j = 0; j < 4; ++j) { const float y = acc[j] + dsk[j] * u4[j]; const float z = 0.7978845608028654f * (y + 0.044715f * y * y * y);
        const float th = 1.0f - 2.0f / (__expf(2.0f * z) + 1.0f); o[j] = 0.5f * y * (1.0f + th); }
      asm volatile("s_waitcnt lgkmcnt(0)" ::: "memory");
      u32x2 ov; ov.x = pk2(o[0], o[1]); ov.y = pk2(o[2], o[3]);
      if (!dry) *(u32x2*)(U + (row0 + sb * 16 + li) * 512 + g * 16 + quad * 4) = ov;
    }
  }
  if (mode == 0 && !dry && quad == 0) {
#pragma unroll
    for (int pb = 0; pb < 4; ++pb) { f32x2 e = {spr[pb], spi[pb]}; E[(((size_t)b * 32 + g) * 64 + c) * 64 + pb * 16 + li] = e; }
  }
  __syncthreads();
}

struct GLAP { const float *wg, *bg, *gout; };
constexpr int GL_LR = 0;
constexpr int GL_WG = 4096;
constexpr int GL_BS = 8192;
constexpr int GL_Q = 24832;
constexpr int GL_K = 34048;
constexpr int GL_VT = 43264;
constexpr int GL_ST = 61696;
constexpr int GL_RED = 80128;
constexpr int GL_SEG = 80640;
DI void gla_cumdecay(LAS unsigned char* sm, const bf16_t* LR, size_t row0, int h, const GLAP& P) {
  const int tid = tid_();
  LAS float* lrs = (LAS float*)(sm + GL_LR); LAS float* bs = (LAS float*)(sm + GL_BS); LAS float* segs = (LAS float*)(sm + GL_SEG);
  const int dk = tid & 63, seg = tid >> 6, t0 = seg * 8;
  u32x4 lrv = {0u, 0u, 0u, 0u};
  if (tid < 128) lrv = *(const u32x4*)(LR + (row0 + (tid >> 1)) * 256 + (tid & 1) * 8);
  float wcol[16];
#pragma unroll
  for (int rr = 0; rr < 16; ++rr) wcol[rr] = P.wg[rr * 256 + h * 64 + dk];
  const float bias = P.bg[h * 64 + dk];
  if (tid < 128) { const int t = tid >> 1, hf = tid & 1;
    f32x4 f0 = {bf_lo(lrv.x), bf_hi(lrv.x), bf_lo(lrv.y), bf_hi(lrv.y)}, f1 = {bf_lo(lrv.z), bf_hi(lrv.z), bf_lo(lrv.w), bf_hi(lrv.w)};
    *(LAS f32x4*)(lrs + t * 16 + hf * 8) = f0; *(LAS f32x4*)(lrs + t * 16 + hf * 8 + 4) = f1; }
  __syncthreads();
  float la[8]; float run = 0.f;
#pragma unroll
  for (int e = 0; e < 8; ++e) { float z = bias;
#pragma unroll
    for (int q4 = 0; q4 < 4; ++q4) { const f32x4 r4 = *(const LAS f32x4*)(lrs + (t0 + e) * 16 + q4 * 4);
      z = fmaf(r4[0], wcol[q4 * 4], z); z = fmaf(r4[1], wcol[q4 * 4 + 1], z); z = fmaf(r4[2], wcol[q4 * 4 + 2], z); z = fmaf(r4[3], wcol[q4 * 4 + 3], z); }
    const float ls = fminf(z, 0.f) - log1pf(__expf(-fabsf(z)));
    run += ls * 0.0625f; la[e] = run; }
  segs[seg * 64 + dk] = run;
  __syncthreads();
  float off = 0.f;
#pragma unroll
  for (int s2 = 0; s2 < 7; ++s2) off += (s2 < seg) ? segs[s2 * 64 + dk] : 0.f;
#pragma unroll
  for (int e = 0; e < 8; ++e) bs[(t0 + e) * 65 + dk] = la[e] + off;
  __syncthreads();
}
DI void gla_stage_vt(LAS unsigned char* sm, const bf16_t* VG, size_t row0, int h) {
  LAS unsigned short* vt = (LAS unsigned short*)(sm + GL_VT);
#pragma unroll
  for (int it = 0; it < 2; ++it) { const int id = it * 512 + tid_(), t = id & 63, cc = id >> 6;
    const u32x4 v = *(const u32x4*)(VG + (row0 + t) * 512 + h * 128 + cc * 8);
#pragma unroll
    for (int e = 0; e < 4; ++e) { vt[(cc * 8 + 2 * e) * 72 + t] = (unsigned short)(v[e] & 0xffffu); vt[(cc * 8 + 2 * e + 1) * 72 + t] = (unsigned short)(v[e] >> 16); } }
}
DI void gla_a_task(LAS unsigned char* sm, int task, const bf16_t* QK, const bf16_t* VG, const bf16_t* LR, bf16_t* GST, float* GDEC, const GLAP& P, bool dry) {
  const int tid = tid_(), lane = tid & 63, w = tid >> 6, li = lane & 15, quad = lane >> 4;
  const int bh = task >> 6, c = task & 63, b = bh >> 2, h = bh & 3;
  const size_t row0 = (size_t)b * 4096 + c * 64;
  gla_cumdecay(sm, LR, row0, h, P);
  LAS float* bs = (LAS float*)(sm + GL_BS);
  LAS unsigned short* kht = (LAS unsigned short*)(sm + GL_Q);
  { const int t = tid & 63, dkc = tid >> 6; const u32x4 v = *(const u32x4*)(QK + (row0 + t) * 512 + 256 + h * 64 + dkc * 8);
#pragma unroll
    for (int e = 0; e < 4; ++e) { const int d0 = dkc * 8 + 2 * e;
      const float k0 = bf_lo(v[e]) * __expf(bs[63 * 65 + d0] - bs[t * 65 + d0]), k1 = bf_hi(v[e]) * __expf(bs[63 * 65 + d0 + 1] - bs[t * 65 + d0 + 1]);
      const unsigned pk = pk2(k0, k1); kht[d0 * 72 + t] = (unsigned short)(pk & 0xffffu); kht[(d0 + 1) * 72 + t] = (unsigned short)(pk >> 16); } }
  gla_stage_vt(sm, VG, row0, h);
  if (tid < 64 && !dry) GDEC[(size_t)task * 64 + tid] = __expf(bs[63 * 65 + tid]);
  __syncthreads();
  LAS unsigned short* vt = (LAS unsigned short*)(sm + GL_VT);
#pragma unroll
  for (int dkt = 0; dkt < 4; ++dkt) { f32x4 acc = {0.f, 0.f, 0.f, 0.f};
#pragma unroll
    for (int kk = 0; kk < 2; ++kk) { const bf16x8 a = *(const LAS bf16x8*)(vt + (w * 16 + li) * 72 + kk * 32 + quad * 8), bq = *(const LAS bf16x8*)(kht + (dkt * 16 + li) * 72 + kk * 32 + quad * 8); acc = mfma16(a, bq, acc); }
#pragma unroll
    for (int j = 0; j < 4; ++j) if (!dry) GST[((size_t)task * 128 + w * 16 + quad * 4 + j) * 64 + dkt * 16 + li] = (bf16_t)(pk2(acc[j], 0.f) & 0xffffu); }
  __syncthreads();
}
DI void gla_prefix(const bf16_t* GST, bf16_t* GSO, const float* GDEC, bool dry) {
  const int total = BPG * 4 * 8192;
  for (int gid = blockIdx.x * NTHREADS + tid_(); gid < total; gid += gridDim.x * NTHREADS) {
    const int bh = gid >> 13, e = gid & 8191, dk = e & 63; float S = 0.f;
    for (int c0 = 0; c0 < 64; c0 += 16) { float tv[16], dv[16];
#pragma unroll
      for (int q = 0; q < 16; ++q) { tv[q] = __uint_as_float((unsigned)GST[((size_t)(bh * 64 + c0 + q)) * 8192 + e] << 16); dv[q] = GDEC[(size_t)(bh * 64 + c0 + q) * 64 + dk]; }
#pragma unroll
      for (int q = 0; q < 16; ++q) { if (!dry) GSO[((size_t)(bh * 64 + c0 + q)) * 8192 + e] = (bf16_t)(pk2(S, 0.f) & 0xffffu); S = fmaf(dv[q], S, tv[q]); } }
  }
}
DI void gla_c_task(LAS unsigned char* sm, int task, const bf16_t* QK, bf16_t* VG, const bf16_t* LR, const bf16_t* R, const bf16_t* GST, const GLAP& P, bool dry) {
  const int tid = tid_(), lane = tid & 63, w = tid >> 6, li = lane & 15, quad = lane >> 4;
  const int bh = task >> 6, c = task & 63, b = bh >> 2, h = bh & 3;
  const size_t row0 = (size_t)b * 4096 + c * 64;
  gla_cumdecay(sm, LR, row0, h, P);
  LAS float* bs = (LAS float*)(sm + GL_BS);
  LAS unsigned short* qs = (LAS unsigned short*)(sm + GL_Q); LAS unsigned short* ksm = (LAS unsigned short*)(sm + GL_K);
  LAS unsigned short* vt = (LAS unsigned short*)(sm + GL_VT); LAS unsigned short* st = (LAS unsigned short*)(sm + GL_ST); LAS float* red = (LAS float*)(sm + GL_RED);
  { const int t = tid >> 3, ch = tid & 7;
    const u32x4 qv = *(const u32x4*)(QK + (row0 + t) * 512 + h * 64 + ch * 8), kv = *(const u32x4*)(QK + (row0 + t) * 512 + 256 + h * 64 + ch * 8);
    u32x4 qo, ko;
#pragma unroll
    for (int e = 0; e < 4; ++e) { const int d0 = ch * 8 + 2 * e; const float b0 = bs[t * 65 + d0], b1 = bs[t * 65 + d0 + 1];
      qo[e] = pk2(bf_lo(qv[e]) * 0.125f * __expf(b0), bf_hi(qv[e]) * 0.125f * __expf(b1));
      ko[e] = pk2(bf_lo(kv[e]) * __expf(-b0), bf_hi(kv[e]) * __expf(-b1)); }
    *(LAS u32x4*)(qs + t * 72 + ch * 8) = qo; *(LAS u32x4*)(ksm + t * 72 + ch * 8) = ko; }
  gla_stage_vt(sm, VG, row0, h);
#pragma unroll
  for (int it = 0; it < 2; ++it) { const int id = it * 512 + tid, dv = id >> 3, c8 = id & 7;
    const u32x4 v = *(const u32x4*)(GST + ((size_t)task * 128 + dv) * 64 + c8 * 8);
    *(LAS u32x4*)(st + dv * 72 + c8 * 8) = v; }
  __syncthreads();
  const int qt = w & 3, dvh = w >> 2;
  bf16x8 qf[2];
#pragma unroll
  for (int kk = 0; kk < 2; ++kk) qf[kk] = *(const LAS bf16x8*)(qs + (qt * 16 + li) * 72 + kk * 32 + quad * 8);
  float s[4][4];
#pragma unroll
  for (int jt = 0; jt < 4; ++jt) { f32x4 acc = {0.f, 0.f, 0.f, 0.f};
#pragma unroll
    for (int kk = 0; kk < 2; ++kk) { const bf16x8 a = *(const LAS bf16x8*)(ksm + (jt * 16 + li) * 72 + kk * 32 + quad * 8); acc = mfma16(a, qf[kk], acc); }
#pragma unroll
    for (int j = 0; j < 4; ++j) { const int kj = jt * 16 + quad * 4 + j, qi = qt * 16 + li; s[jt][j] = (kj <= qi) ? acc[j] : 0.f; } }
  bf16x8 pf[2];
#pragma unroll
  for (int pp = 0; pp < 2; ++pp) { u32x4 t; t.x = pk2(s[2 * pp][0], s[2 * pp][1]); t.y = pk2(s[2 * pp][2], s[2 * pp][3]); t.z = pk2(s[2 * pp + 1][0], s[2 * pp + 1][1]); t.w = pk2(s[2 * pp + 1][2], s[2 * pp + 1][3]); pf[pp] = mk8(t); }
  f32x4 o[4]; float ssq = 0.f;
#pragma unroll
  for (int dvt = 0; dvt < 4; ++dvt) { const int dv0 = dvh * 64 + dvt * 16; f32x4 acc = {0.f, 0.f, 0.f, 0.f};
#pragma unroll
    for (int pp = 0; pp < 2; ++pp) { const int kA = 2 * pp * 16 + quad * 4;
      const u32x2 lo = *(const LAS u32x2*)(vt + (dv0 + li) * 72 + kA), hi = *(const LAS u32x2*)(vt + (dv0 + li) * 72 + kA + 16);
      u32x4 t; t.x = lo.x; t.y = lo.y; t.z = hi.x; t.w = hi.y; acc = mfma16(mk8(t), pf[pp], acc); }
#pragma unroll
    for (int kk = 0; kk < 2; ++kk) { const bf16x8 a = *(const LAS bf16x8*)(st + (dv0 + li) * 72 + kk * 32 + quad * 8); acc = mfma16(a, qf[kk], acc); }
    o[dvt] = acc; ssq += acc[0] * acc[0] + acc[1] * acc[1] + acc[2] * acc[2] + acc[3] * acc[3]; }
  ssq += shx(ssq, 16, lane); ssq += shx(ssq, 32, lane);
  if (quad == 0) red[dvh * 64 + qt * 16 + li] = ssq;
  __syncthreads();
  const float tot = red[qt * 16 + li] + red[64 + qt * 16 + li];
  const float rs = rsqrtf(tot * (1.0f / 128.0f) + 1e-6f);
  const size_t row = row0 + qt * 16 + li;
#pragma unroll
  for (int dvt = 0; dvt < 4; ++dvt) { const int dv = dvh * 64 + dvt * 16 + quad * 4;
    const f32x4 gg = *(const f32x4*)(P.gout + dv); const u32x2 rv = *(const u32x2*)(R + row * 512 + h * 128 + dv);
    const float r4[4] = {bf_lo(rv.x), bf_hi(rv.x), bf_lo(rv.y), bf_hi(rv.y)}; float y[4];
#pragma unroll
    for (int j = 0; j < 4; ++j) y[j] = o[dvt][j] * rs * gg[j] * (r4[j] * sigmoidf_(r4[j]));
    u32x2 ov; ov.x = pk2(y[0], y[1]); ov.y = pk2(y[2], y[3]); if (!dry) *(u32x2*)(VG + row * 512 + h * 128 + dv) = ov; }
  __syncthreads();
}

#define XB_TMO      128
#define XB_XCNT(j)  (256  + 64 * (j))
#define XB_XSUB(j)  (1280 + 64 * (j))
#define XB_XGEN(j)  (2304 + 64 * (j))
#define XB_TOP      3328
#define XB_TOPGEN   3392
#define XCD_BAR_WORDS 3456
#define XB_SPIN_CAP (1u << 18)
DI unsigned xb_ld(unsigned* p)              { return __hip_atomic_load(p, __ATOMIC_RELAXED, __HIP_MEMORY_SCOPE_AGENT); }
DI unsigned xb_add(unsigned* p, unsigned v) { return __hip_atomic_fetch_add(p, v, __ATOMIC_RELAXED, __HIP_MEMORY_SCOPE_AGENT); }
DI unsigned xb_xcc_id() { return (unsigned)__builtin_amdgcn_s_getreg((3 << 11) | 20) & 0xFu; }
#define XB_SPIN(cond, bar) do { unsigned _sp = 0; while (cond) { __builtin_amdgcn_s_sleep(1); \
    if ((++_sp & 255u) == 0u) { if (xb_ld(&(bar)[XB_TMO])) break; if (_sp > XB_SPIN_CAP) { atomicAdd(&(bar)[XB_TMO], 1u); break; } } } } while (0)
struct XcdBarrier { unsigned* bar; unsigned x; volatile LAS unsigned* st; };
DI XcdBarrier xcd_barrier_post(unsigned* bar, volatile LAS unsigned* st) {
  XcdBarrier b; b.bar = bar; b.x = xb_xcc_id(); b.st = st;
  if (threadIdx.x == 0) (void)xb_add(&bar[XB_XCNT(b.x)], 1u);
  return b;
}
DI void xcd_barrier_complete(unsigned* bar, unsigned x, unsigned& nloc, unsigned& nx) {
  asm volatile("" : "+s"(bar));
  const unsigned G = gridDim.x * gridDim.y * gridDim.z;
  unsigned sum, cnt, mine, sp = 0u;
  for (;;) {
    sum = 0u; cnt = 0u; mine = 0u;
#pragma unroll
    for (unsigned j = 0; j < 16; ++j) { const unsigned c = xb_ld(&bar[XB_XCNT(j)]); sum += c; cnt += (c > 0u) ? 1u : 0u; mine = (j == x) ? c : mine; }
    if (sum == G) break;
    __builtin_amdgcn_s_sleep(1);
    if ((++sp & 255u) == 0u) { if (xb_ld(&bar[XB_TMO])) break; if (sp > XB_SPIN_CAP) { atomicAdd(&bar[XB_TMO], 1u); break; } }
  }
  nloc = mine > 0u ? mine : 1u; nx = cnt > 0u ? cnt : 1u;
}
DI void xcd_barrier(const XcdBarrier& b) {
  asm volatile("s_waitcnt vmcnt(0)" ::: "memory");
  __syncthreads();
  if (threadIdx.x == 0) {
    unsigned* bar = b.bar; asm volatile("" : "+s"(bar));
    __builtin_amdgcn_s_waitcnt(0);
    unsigned nloc = b.st[0], nx = b.st[1];
    if (nloc == 0u) { xcd_barrier_complete(bar, b.x, nloc, nx); b.st[0] = nloc; b.st[1] = nx; }
    const unsigned old = xb_add(&bar[XB_XSUB(b.x)], 1u);
    const unsigned gen = old / nloc;
    if (old + 1u == (gen + 1u) * nloc) {
      __builtin_amdgcn_fence(__ATOMIC_RELEASE, "agent");
      asm volatile("s_waitcnt vmcnt(0)" ::: "memory");
      const unsigned og = xb_add(&bar[XB_TOP], 1u);
      const unsigned tg = og / nx;
      if (og + 1u == (tg + 1u) * nx) xb_add(&bar[XB_TOPGEN], 1u);
      else XB_SPIN(xb_ld(&bar[XB_TOPGEN]) == tg, bar);
      __builtin_amdgcn_fence(__ATOMIC_ACQUIRE, "agent");
      xb_add(&bar[XB_XGEN(b.x)], 1u);
      asm volatile("s_waitcnt vmcnt(0)" ::: "memory");
    } else {
      XB_SPIN(xb_ld(&bar[XB_XGEN(b.x)]) == gen, bar);
      __builtin_amdgcn_fence(__ATOMIC_ACQUIRE, "agent");
      asm volatile("s_waitcnt vmcnt(0)" ::: "memory");
    }
  }
  __syncthreads();
}

struct Args { const float* in[28]; float* out; unsigned char* ws; int ph_lo, ph_hi; };
constexpr int NPH = 1 + DEPTH * 23 + 1;

__global__ void __launch_bounds__(NTHREADS, 2) mega(Args A) {
  extern __shared__ __attribute__((aligned(16))) unsigned char lds_raw[];
  LAS unsigned char* sm = (LAS unsigned char*)lds_raw;
  cg::grid_group grid = cg::this_grid();
  const int G = gridDim.x, bid = blockIdx.x;
  volatile LAS unsigned* xst = (volatile LAS unsigned*)(sm + LDS_BYTES - 16);
  if (threadIdx.x < 4) xst[threadIdx.x] = 0u;
  __syncthreads();
  XcdBarrier xbar; xbar.bar = (unsigned*)(A.ws + WS_BAR); xbar.x = 0; xbar.st = xst;
  if (A.ph_hi - A.ph_lo > 1) xbar = xcd_barrier_post((unsigned*)(A.ws + WS_BAR), xst);
#ifdef PROBE_A
  unsigned long long tA = 0, tB = 0, tprev = wall_clock64();
#endif

  for (int ph = A.ph_lo; ph < A.ph_hi; ++ph) {
    size_t zo; asm volatile("s_mov_b64 %0, 0" : "=s"(zo));
    unsigned char* ws = A.ws + zo;
    const float* x_in = A.in[0] + zo;
    float* xo = A.out + zo;
    bf16_t* XB = (bf16_t*)(ws + WS_H);
    bf16_t* H = (bf16_t*)xo; bf16_t* PB = (bf16_t*)(ws + WS_P);
    bf16_t* MEMN = (bf16_t*)(ws + WS_MEMN); bf16_t* MKV = (bf16_t*)(ws + WS_MEMKV);
    float* LSE = (float*)(ws + WS_LSE); f32x2* S5E = (f32x2*)(ws + WS_S5E); f32x2* S5C = (f32x2*)(ws + WS_S5C); float* GDEC = (float*)(ws + WS_GDEC); bf16_t* GST = (bf16_t*)((unsigned char*)xo + (size_t)MTOK * 1024 * 2); bf16_t* GSO = GST + (size_t)BPG * 4 * 64 * 8192;
#define IN(i) (A.in[i] + zo)
    int kind, l = 0, grp = 0;
    if (ph == 0) kind = 0; else if (ph == NPH - 1) kind = 17;
    else { const int q = ph - 1; l = q / 23; const int k = q % 23; if (k < 16) { grp = k >> 3; kind = 2 + (k & 7); } else kind = 10 + (k - 16); }
    const float* xsrc = (l == 0) ? x_in : xo;
#ifdef PROBE_REPEAT_MASK
    const int ndry = (int)((PROBE_REPEAT_MASK >> kind) & 1);
#else
    const int ndry = 0;
#endif
    for (int dryi = ndry; dryi >= 0; --dryi) {
    const bool dry = dryi != 0;
    bool isgemm = false; int nrep = 1;
    const int vb = ((G & 7) == 0) ? (bid & 7) * (G >> 3) + (bid >> 3) : bid;
    switch (kind) {
      case 0: {
        for (int ll = 0; ll < DEPTH; ++ll) {
          transpose_w(sm, IN(3) + (size_t)ll * 1024 * 9744, 1024, 9744, (bf16_t*)(ws + WS_WIN) + (size_t)ll * DINP * 1024, DINP, 1);
          transpose_w(sm, IN(12) + (size_t)ll * 512 * 512, 512, 512, (bf16_t*)(ws + WS_WGLU) + (size_t)ll * 512 * 512, 512, 0);
          for (int n = 0; n < 3; ++n) transpose_w(sm, IN(17) + ((size_t)ll * 3 + n) * 512 * 1024, 512, 1024, (bf16_t*)(ws + WS_WBR) + ((size_t)ll * 3 + n) * 1024 * 512, 1024, 0);
          transpose_w(sm, IN(18) + (size_t)ll * 1024 * 1024, 1024, 1024, (bf16_t*)(ws + WS_WOUT) + (size_t)ll * 1024 * 1024, 1024, 0);
          transpose_w(sm, IN(21) + (size_t)ll * 1024 * 1024, 1024, 1024, (bf16_t*)(ws + WS_WXQ) + (size_t)ll * 1024 * 1024, 1024, 0);
          transpose_w(sm, IN(23) + (size_t)ll * 1024 * 1024, 1024, 1024, (bf16_t*)(ws + WS_WXO) + (size_t)ll * 1024 * 1024, 1024, 0);
          transpose_w(sm, IN(22) + (size_t)ll * 1024 * 2048, 1024, 2048, (bf16_t*)(ws + WS_WXKV) + (size_t)ll * 2048 * 1024, 2048, 0);
          transpose_w(sm, IN(25) + (size_t)ll * 1024 * 4096, 1024, 4096, (bf16_t*)(ws + WS_WUP) + (size_t)ll * 4096 * 1024, 4096, 0);
          transpose_w(sm, IN(26) + (size_t)ll * 4096 * 1024, 4096, 1024, (bf16_t*)(ws + WS_WDN) + (size_t)ll * 1024 * 4096, 1024, 0);
        }
        norm_rows_bf16(IN(1), IN(19), MEMN, 2048);
      } break;
      case 3: isgemm = true; nrep = (l == 0 && grp == 0) ? 2 : 1; break;
      case 7: case 8: case 9: case 11: case 13: case 15: case 16: isgemm = true; break;
      case 2: if (l == 0) norm_rows_bf16(x_in + (size_t)grp * MG * 1024, IN(2) + l * 1024, H, MG); else norm_rows_from_bf16(XB + (size_t)grp * MG * 1024, 1024, IN(2) + l * 1024, H, MG); break;
      case 4: {
        S5P sp{IN(4) + l * 2048, IN(5) + l * 2048, IN(6) + l * 32, IN(7) + (size_t)l * 32768, IN(8) + (size_t)l * 32768, IN(9) + (size_t)l * 32768, IN(10) + (size_t)l * 32768, IN(11) + l * 512};
        GLAP gp{IN(14) + l * 4096, IN(15) + l * 256, IN(16) + l * 128};
        constexpr int NA = BPG * 12 * 32, NS = BPG * 256, NGL = BPG * 4 * 64;
        for (int t = vb; t < NA + NS + NGL; t += G) {
          if (t < NA) attn_task(sm, t, PB + P_QA, PB + P_KA, PB + P_VA, LSE, dry);
          else if (t < NA + NS) s5_task(sm, t - NA, 0, PB + P_U, S5E, sp, dry);
          else gla_a_task(sm, t - NA - NS, PB + P_QK, PB + P_VG, PB + P_LR, GST, GDEC, gp, dry);
        }
      } break;
      case 5: { gla_prefix(GST, GSO, GDEC, dry);
        S5P sp{IN(4) + l * 2048, IN(5) + l * 2048, IN(6) + l * 32, IN(7) + (size_t)l * 32768, IN(8) + (size_t)l * 32768, IN(9) + (size_t)l * 32768, IN(10) + (size_t)l * 32768, IN(11) + l * 512};
        s5_carry_scan(S5E, S5C, sp, dry); } break;
      case 6: {
        S5P sp{IN(4) + l * 2048, IN(5) + l * 2048, IN(6) + l * 32, IN(7) + (size_t)l * 32768, IN(8) + (size_t)l * 32768, IN(9) + (size_t)l * 32768, IN(10) + (size_t)l * 32768, IN(11) + l * 512};
        GLAP gp{IN(14) + l * 4096, IN(15) + l * 256, IN(16) + l * 128};
        constexpr int NS = BPG * 256, NGL = BPG * 4 * 64;
        for (int t = bid; t < NS + NGL; t += G) {
          if (t < NS) s5_task(sm, t, 1, PB + P_U, S5C, sp, dry);
          else gla_c_task(sm, t - NS, PB + P_QK, PB + P_VG, PB + P_LR, PB + P_R, GSO, gp, dry);
        }
        attn_combine(PB + P_QA, H, LSE, dry);
      } break;
      case 10: norm_rows_from_bf16(XB, 1024, IN(20) + l * 1024, H, MTOK); break;
      case 12: for (int t = vb; t < NB * 4 * 32; t += G) xattn_task(sm, t, PB, MKV, l, dry); break;
      case 14: norm_rows_from_bf16(XB, 1024, IN(24) + l * 1024, H, MTOK); break;
      case 17: final_norm_from_bf16(XB, xo, IN(27), MTOK); break;
      default: break;
    }
    if (isgemm) {
      for (int rep = 0; rep < nrep; ++rep) {
        pg8::Gemm g; Epi E; E.mode = EM_BF16; E.o16 = nullptr; E.ld16 = 0; E.o32 = nullptr; E.r32 = nullptr; E.ld32 = 1024; E.aux = nullptr; E.ldaux = 0; E.bias = nullptr; E.nzm1 = 0; E.r16 = nullptr; E.ldr16 = 1024; int nz = 1;
        bf16_t* MB = PB + P_KA;
        switch (rep == 1 ? 1 : kind) {
          case 1: g = pg8::Gemm{MEMN, (bf16_t*)(ws + WS_WXKV), 2048, 4096, 1024, 1024}; E.mode = EM_BF16; E.o16 = MKV; E.ld16 = 4096; break;
          case 3: g = pg8::Gemm{H, (bf16_t*)(ws + WS_WIN) + (size_t)l * DINP * 1024, MG, DINP, 1024, 1024}; E.mode = EM_PROJ; E.o16 = PB; break;
          case 7: g = pg8::Gemm{PB + P_U, (bf16_t*)(ws + WS_WGLU) + (size_t)l * 512 * 512, MG, 512, 512, 512}; E.mode = EM_GLU; E.o16 = PB + P_QK; E.ld16 = 512; E.aux = PB + P_U; E.ldaux = 512; E.bias = IN(13) + l * 512; break;
          case 8: g = pg8::Gemm{PB + P_QK, (bf16_t*)(ws + WS_WBR) + (size_t)l * 3 * 1024 * 512, MG, 1024, 512, 512};
            g.zA1 = (long)((const char*)(PB + P_VG) - (const char*)(PB + P_QK)); g.zA2 = (long)((const char*)H - (const char*)(PB + P_QK)); g.zB = (long)1024 * 512 * 2; nz = 3;
            E.mode = EM_MERGEZ; E.nzm1 = 2; E.o16 = MB; E.ld16 = 1024; E.aux = PB + P_GATE; E.ldaux = 3072; break;
          case 9: g = pg8::Gemm{MB, (bf16_t*)(ws + WS_WOUT) + (size_t)l * 1024 * 1024, MG, 1024, 1024, 1024}; E.mode = EM_RESID; E.o16 = XB + (size_t)grp * MG * 1024; E.ld16 = 1024; if (l == 0) E.r32 = x_in + (size_t)grp * MG * 1024; else E.r16 = XB + (size_t)grp * MG * 1024; break;
          case 11: g = pg8::Gemm{H, (bf16_t*)(ws + WS_WXQ) + (size_t)l * 1024 * 1024, MTOK, 1024, 1024, 1024}; E.mode = EM_BF16; E.o16 = PB; E.ld16 = 1024; break;
          case 13: g = pg8::Gemm{PB, (bf16_t*)(ws + WS_WXO) + (size_t)l * 1024 * 1024, MTOK, 1024, 1024, 1024}; E.mode = EM_RESID; E.r16 = XB; E.o16 = XB; E.ld16 = 1024; break;
          case 15: g = pg8::Gemm{H, (bf16_t*)(ws + WS_WUP) + (size_t)l * 4096 * 1024, MTOK, 4096, 1024, 1024}; E.mode = EM_RELU2; E.o16 = PB; E.ld16 = 4096; break;
          default: g = pg8::Gemm{PB, (bf16_t*)(ws + WS_WDN) + (size_t)l * 1024 * 4096, MTOK, 1024, 4096, 4096}; E.mode = EM_RESID; E.r16 = XB; E.o16 = XB; E.ld16 = 1024; break;
        }
        g.nz = nz; if (nz == 1) { g.zA1 = 0; g.zA2 = 0; g.zB = 0; }
        g.perm = 1;
        pg8::StaticOrder S; S.init(g.M, g.N, G, bid, nz);
        if (dry) { E.mode = EM_DRY; E.nzm1 = nz - 1; }
        if (nz == 1) pg8::gemm_phase<false, Epi>(sm, g, S, E); else pg8::gemm_phase<true, Epi>(sm, g, S, E);
      }
    }
    }
#ifdef PROBE_A
    { const unsigned long long tn = wall_clock64(); const unsigned long long dt = tn - tprev; tprev = tn;
      if ((PROBE_A >> kind) & 1) tA += dt; if ((PROBE_B >> kind) & 1) tB += dt; }
#endif
    if (ph + 1 < A.ph_hi) { if (ph == A.ph_lo) grid.sync(); else xcd_barrier(xbar); }
#ifdef PROBE_EXTRA_SYNCS
    if (ph == 1) for (int i = 0; i < PROBE_EXTRA_SYNCS; ++i) xcd_barrier(xbar);
#endif
#ifdef PROBE_A
    { const unsigned long long tn = wall_clock64(); const unsigned long long dt = tn - tprev; tprev = tn;
      if ((PROBE_A >> 18) & 1) tA += dt; if ((PROBE_B >> 18) & 1) tB += dt; }
#endif
  }
#ifdef PROBE_A
  {
    float* tw = (float*)(A.ws + WS_LSE);
    if (bid == 0 && tid_() == 0) { tw[0] = (float)tA * 0.01f; tw[1] = (float)tB * 0.01f; __threadfence(); }
    grid.sync();
    const float fa = __builtin_nontemporal_load(tw), fb = __builtin_nontemporal_load(tw + 1);
    for (size_t i = (size_t)bid * NTHREADS + tid_(); i < (size_t)16777216; i += (size_t)G * NTHREADS) A.out[i] += fb;
    if (bid == 1 && tid_() == 0) A.out[(size_t)MTOK * DM - 1] += 64.0f * fa;
  }
#endif
}

extern "C" void kernel_launch(void* const* d_in, const int* in_sizes, int n_in, void* d_out, int out_size, void* d_ws, size_t ws_size, hipStream_t stream) {
  static int grid = 0;
  if (grid == 0) {
    if (n_in != 28 || out_size != MTOK * DM || ws_size < WS_END) { fprintf(stderr, "kernel_launch: unexpected shapes (n_in %d out %d ws %zu need %zu)\n", n_in, out_size, ws_size, (size_t)WS_END); grid = -1; return; }
    int dev = 0, cus = 0, per_cu = 0;
    hipGetDevice(&dev); hipDeviceGetAttribute(&cus, hipDeviceAttributeMultiprocessorCount, dev);
    if (hipFuncSetAttribute((const void*)mega, hipFuncAttributeMaxDynamicSharedMemorySize, LDS_BYTES) != hipSuccess) { fprintf(stderr, "kernel_launch: hipFuncSetAttribute failed\n"); grid = -1; return; }
    hipOccupancyMaxActiveBlocksPerMultiprocessor(&per_cu, (const void*)mega, NTHREADS, LDS_BYTES);
    (void)hipGetLastError();
    if (per_cu < 1) { fprintf(stderr, "kernel_launch: occupancy query says %d blocks per CU\n", per_cu); per_cu = 1; }
    grid = cus;
  }
  if (grid < 0) return;
  if (hipMemsetAsync((unsigned char*)d_ws + WS_BAR, 0, 16384, stream) != hipSuccess) { fprintf(stderr, "kernel_launch: memset of barrier words failed\n"); return; }
  Args a{};
  for (int i = 0; i < 28; ++i) a.in[i] = (const float*)d_in[i];
  a.out = (float*)d_out; a.ws = (unsigned char*)d_ws;
#if MULTI_LAUNCH
  for (int ph = 0; ph < NPH; ++ph) { a.ph_lo = ph; a.ph_hi = ph + 1; hipLaunchKernelGGL(mega, dim3(grid), dim3(NTHREADS), LDS_BYTES, stream, a); }
#else
  a.ph_lo = 0; a.ph_hi = NPH;
  void* args[] = {&a};
  hipError_t e = hipLaunchCooperativeKernel((const void*)mega, dim3(grid), dim3(NTHREADS), args, LDS_BYTES, stream);
  if (e != hipSuccess) fprintf(stderr, "kernel_launch: cooperative launch failed: %s (grid %d)\n", hipGetErrorString(e), grid);
#endif
}
```

```cpp
#include <hip/hip_runtime.h>
#include <hip/hip_cooperative_groups.h>
#include <cstdio>
namespace cg = cooperative_groups;

#ifndef MULTI_LAUNCH
#define MULTI_LAUNCH 0
#endif

#define LAS __attribute__((address_space(3)))
#define DI __device__ __forceinline__
typedef unsigned short bf16_t;
typedef short bf16x8 __attribute__((ext_vector_type(8)));
typedef float f32x4 __attribute__((ext_vector_type(4)));
typedef float f32x2 __attribute__((ext_vector_type(2)));
typedef unsigned u32x4 __attribute__((ext_vector_type(4)));
typedef unsigned u32x2 __attribute__((ext_vector_type(2)));
typedef __bf16 bfv2 __attribute__((ext_vector_type(2)));

constexpr int DM = 1024, SEQ = 4096, NB = 8, MTOK = NB * SEQ, DEPTH = 2;
constexpr int NGRP = 2, MG = MTOK / NGRP, BPG = NB / NGRP;
constexpr int DINP = 9984;
constexpr int NTHREADS = 512;
constexpr int LDS_BYTES = 139264;

constexpr size_t AL(size_t x) { return (x + 255) & ~(size_t)255; }
constexpr size_t WS_WIN = 0;
constexpr size_t WS_WGLU = WS_WIN + AL((size_t)DEPTH * DINP * 1024 * 2);
constexpr size_t WS_WBR = WS_WGLU + AL((size_t)DEPTH * 512 * 512 * 2);
constexpr size_t WS_WOUT = WS_WBR + AL((size_t)DEPTH * 3 * 1024 * 512 * 2);
constexpr size_t WS_WXQ = WS_WOUT + AL((size_t)DEPTH * 1024 * 1024 * 2);
constexpr size_t WS_WXO = WS_WXQ + AL((size_t)DEPTH * 1024 * 1024 * 2);
constexpr size_t WS_WXKV = WS_WXO + AL((size_t)DEPTH * 1024 * 1024 * 2);
constexpr size_t WS_WUP = WS_WXKV + AL((size_t)DEPTH * 2048 * 1024 * 2);
constexpr size_t WS_WDN = WS_WUP + AL((size_t)DEPTH * 4096 * 1024 * 2);
constexpr size_t WS_MEMN = WS_WDN + AL((size_t)DEPTH * 4096 * 1024 * 2);
constexpr size_t WS_MEMKV = WS_MEMN + AL((size_t)2048 * 1024 * 2);
constexpr size_t WS_LSE = WS_MEMKV + AL((size_t)2048 * 4096 * 2);
constexpr size_t WS_S5E = WS_LSE + AL((size_t)MG * 12 * 4);
constexpr size_t WS_S5C = WS_S5E + AL((size_t)BPG * 32 * 64 * 64 * 8);
constexpr size_t WS_GDEC = WS_S5C + AL((size_t)BPG * 32 * 64 * 64 * 8);
constexpr size_t WS_H = WS_GDEC + AL((size_t)BPG * 4 * 64 * 64 * 4);
constexpr size_t WS_GST = WS_H + (size_t)MG * 1024 * 2;
constexpr size_t WS_P = WS_H + AL((size_t)MTOK * 1024 * 2);
constexpr size_t WS_BAR = WS_P + AL((size_t)MG * DINP * 2);
constexpr size_t WS_END = WS_BAR + 16384;
constexpr size_t PE(int tile) { return (size_t)MG * 256 * tile; }
constexpr size_t P_U = PE(0), P_QK = PE(2), P_VG = PE(4), P_R = PE(6), P_QA = PE(8), P_KA = PE(14), P_VA = PE(20), P_GATE = PE(26), P_LR = PE(38);

DI float bf_lo(unsigned u) { return __uint_as_float(u << 16); }
DI float bf_hi(unsigned u) { return __uint_as_float(u & 0xffff0000u); }
DI unsigned pk2(float lo, float hi) { f32x2 v = {lo, hi}; bfv2 r = __builtin_convertvector(v, bfv2); return __builtin_bit_cast(unsigned, r); }
DI int tid_() { int t = threadIdx.x; asm volatile("" : "+v"(t)); return t; }
DI float shx(float v, int m, int lane) { return __builtin_bit_cast(float, __builtin_amdgcn_ds_bpermute((lane ^ m) << 2, __builtin_bit_cast(int, v))); }
DI float wave_sum(float v, int lane) {
#pragma unroll
  for (int m = 32; m >= 1; m >>= 1) v += shx(v, m, lane);
  return v;
}
DI float sigmoidf_(float x) { return 1.0f / (1.0f + __expf(-x)); }
DI f32x4 mfma16(bf16x8 a, bf16x8 b, f32x4 c) { return __builtin_amdgcn_mfma_f32_16x16x32_bf16(a, b, c, 0, 0, 0); }
DI bf16x8 mk8(u32x4 v) { return __builtin_bit_cast(bf16x8, v); }

namespace pg8 {
constexpr int BM = 256, BK = 64, HALF = 128, HTB = HALF * BK * 2, STAGE_BYTES = 8 * HTB, NXCD = 8, WGM = 4;
DI int lds_byte(int r, int c) { const int st = (r >> 4) * 2 + (c >> 5), rr = r & 15, cc = c & 31, ob = rr * 64 + cc * 2; return st * 1024 + (ob ^ (((ob >> 9) & 1) << 5)); }
DI void stage_rc(int b, int& R, int& C) { const int st = b / 1024, sb = b % 1024, swz = sb ^ (((sb >> 9) & 1) << 5); R = (st >> 1) * 16 + swz / 64; C = (st & 1) * 32 + (swz % 64) / 2; }
DI int perm32(int rho) { const int n = rho >> 4, i = rho & 15; return 8 * (i >> 2) + 4 * n + (i & 3); }
struct Unit { int pm, pn, z; };
struct Gemm { const bf16_t* A; const bf16_t* Bt; int M, N, K, lda; long zA1, zA2, zB; int nz, perm; };
struct StaticOrder {
  int nM, nN, nwg, G, c, nz;
  DI void init(int M, int N, int G_, int c_, int nz_) { nM = M / BM; nN = N / BM; nwg = nM * nN; G = G_; c = c_; nz = nz_; }
  DI bool next(int i, Unit& u) const {
    const int ib = (nz == 1) ? i : i / nz; u.z = i - ib * nz;
    const long L = (long)ib * G + c; if (L >= nwg) return false;
    int wgid = (int)L; { const int q = nwg / NXCD, r = nwg % NXCD, xcd = wgid % NXCD, off = wgid / NXCD; wgid = (xcd < r ? xcd * (q + 1) : r * (q + 1) + (xcd - r) * q) + off; }
    const int nig = WGM * nN, gid = wgid / nig, fm = gid * WGM, gsz = (nM - fm) < WGM ? (nM - fm) : WGM;
    u.pm = fm + ((wgid % nig) % gsz); u.pn = (wgid % nig) / gsz; return true;
  }
};

template <bool CHAIN, class Epi>
DI void gemm_phase(LAS unsigned char* lds, const Gemm g, const StaticOrder& S, const Epi& E) {
  const int tid = tid_(), wid = __builtin_amdgcn_readfirstlane(tid >> 6), lane = tid & 63, wr = wid >> 2, wc = wid & 3, fr = lane & 15, fq = lane >> 4;
  const int K = g.K, nt = K / BK, lda = g.lda;
  unsigned voffA[2], voffB[2];
#pragma unroll
  for (int i = 0; i < 2; ++i) { int R, C; stage_rc(tid * 16 + i * 8192, R, C); const int Rb = g.perm ? ((R & ~31) + perm32(R & 31)) : R;
    voffA[i] = (unsigned)(R * lda + C) * 2u; voffB[i] = (unsigned)(Rb * K + C) * 2u; }
  const size_t kstep = (size_t)(BK * 2);
  const size_t hstA = (size_t)HALF * lda * 2, hstB = (size_t)HALF * K * 2;
  const size_t tstA = 2 * hstA, tstB = 2 * hstB;
  const unsigned ldsw = (unsigned)wid * 1024u;
  const int aoff = lds_byte(wr * 64 + fr, fq * 8), boff = lds_byte(wc * 32 + fr, fq * 8);
#define PG8_SA(b, h) (((b) * 2 + (h)) * HTB)
#define PG8_SB(b, h) ((4 + (b) * 2 + (h)) * HTB)
#define PG8_STAGE(bufoff, gbase, voff) do { _Pragma("unroll") for (int _i = 0; _i < 2; ++_i) \
    __builtin_amdgcn_global_load_lds((const unsigned*)((const char*)(gbase) + (voff)[_i]), (LAS unsigned*)(lds + (bufoff) + ldsw + _i * 8192), 16, 0, 0); } while (0)
#define PG8_LDA(dst, b, h) do { _Pragma("unroll") for (int m = 0; m < 4; ++m) _Pragma("unroll") for (int k = 0; k < 2; ++k) dst[m][k] = *(const LAS bf16x8*)(lds + PG8_SA(b, h) + aoff + m * 2048 + k * 1024); } while (0)
#define PG8_LDB(dst, b, h) do { _Pragma("unroll") for (int n = 0; n < 2; ++n) _Pragma("unroll") for (int k = 0; k < 2; ++k) dst[n][k] = *(const LAS bf16x8*)(lds + PG8_SB(b, h) + boff + n * 2048 + k * 1024); } while (0)
#define PG8_MMA(ai, bj, At, Bt) do { __builtin_amdgcn_s_setprio(1); _Pragma("unroll") for (int m = 0; m < 4; ++m) _Pragma("unroll") for (int n = 0; n < 2; ++n) _Pragma("unroll") for (int k = 0; k < 2; ++k) \
    acc[ai][bj][m][n] = __builtin_amdgcn_mfma_f32_16x16x32_bf16(Bt[n][k], At[m][k], acc[ai][bj][m][n], 0, 0, 0); __builtin_amdgcn_s_setprio(0); } while (0)
#define PG8_WAIT_V(n) asm volatile("s_waitcnt vmcnt(" #n ")" ::: "memory")
#define PG8_WAIT_L(n) asm volatile("s_waitcnt lgkmcnt(" #n ")" ::: "memory")
#define PG8_BAR __builtin_amdgcn_s_barrier()
#define PG8_SCHED __builtin_amdgcn_sched_barrier(0)
  Unit cur, nxt; int ui = 0;
  if (!S.next(0, cur)) return;
  f32x4 acc[2][2][4][2];
#pragma unroll
  for (int a = 0; a < 2; ++a)
#pragma unroll
    for (int b = 0; b < 2; ++b)
#pragma unroll
      for (int m = 0; m < 4; ++m)
#pragma unroll
        for (int n = 0; n < 2; ++n) acc[a][b][m][n] = (f32x4){0.f, 0.f, 0.f, 0.f};
  bf16x8 At[4][2], B0[2][2], B1[2][2];
#define PG8_ZA(z) ((z) == 0 ? 0l : ((z) == 1 ? g.zA1 : g.zA2))
  const char* cA = (const char*)g.A + PG8_ZA(cur.z) + (size_t)cur.pm * tstA; const char* cB = (const char*)g.Bt + (long)cur.z * g.zB + (size_t)cur.pn * tstB;
  PG8_STAGE(PG8_SB(0, 0), cB, voffB); PG8_STAGE(PG8_SA(0, 0), cA, voffA); PG8_STAGE(PG8_SB(0, 1), cB + hstB, voffB); PG8_STAGE(PG8_SA(0, 1), cA + hstA, voffA);
  if (wr == 1) PG8_BAR;
  PG8_WAIT_V(4); PG8_BAR;
  PG8_STAGE(PG8_SB(1, 0), cB + kstep, voffB); PG8_STAGE(PG8_SA(1, 0), cA + kstep, voffA); PG8_STAGE(PG8_SB(1, 1), cB + hstB + kstep, voffB);
  PG8_WAIT_V(6); PG8_BAR;
  for (;;) {
    const bool has_next = S.next(ui + 1, nxt);
    const char* nA = has_next ? (const char*)g.A + PG8_ZA(nxt.z) + (size_t)nxt.pm * tstA : cA; const char* nB = has_next ? (const char*)g.Bt + (long)nxt.z * g.zB + (size_t)nxt.pn * tstB : cB;
    for (int t = 0; t < nt; t += 2) {
      const bool last = (t == nt - 2);
      const char* a1 = cA + (size_t)(t + 1) * kstep;
      const char* a2 = last ? nA : cA + (size_t)(t + 2) * kstep; const char* b2 = last ? nB : cB + (size_t)(t + 2) * kstep;
      const char* a3 = a2 + kstep; const char* b3 = b2 + kstep;
      PG8_LDB(B0, 0, 0); PG8_SCHED; PG8_LDA(At, 0, 0); PG8_STAGE(PG8_SA(1, 1), a1 + hstA, voffA);
      PG8_WAIT_L(8); PG8_BAR; PG8_WAIT_L(0); PG8_MMA(0, 0, At, B0); PG8_BAR; PG8_SCHED;
      PG8_LDB(B1, 0, 1); PG8_STAGE(PG8_SB(0, 0), b2, voffB);
      PG8_BAR; PG8_WAIT_L(0); PG8_MMA(0, 1, At, B1); PG8_BAR;
      PG8_LDA(At, 0, 1); PG8_STAGE(PG8_SA(0, 0), a2, voffA);
      PG8_BAR; PG8_WAIT_L(0); PG8_MMA(1, 0, At, B0); PG8_BAR; PG8_SCHED;
      PG8_STAGE(PG8_SB(0, 1), b2 + hstB, voffB);
      PG8_WAIT_V(6); PG8_BAR; PG8_MMA(1, 1, At, B1); PG8_BAR;
      PG8_LDB(B0, 1, 0); PG8_SCHED; PG8_LDA(At, 1, 0); PG8_STAGE(PG8_SA(0, 1), a2 + hstA, voffA);
      PG8_WAIT_L(8); PG8_BAR; PG8_WAIT_L(0); PG8_MMA(0, 0, At, B0); PG8_BAR; PG8_SCHED;
      PG8_LDB(B1, 1, 1); PG8_STAGE(PG8_SB(1, 0), b3, voffB);
      PG8_BAR; PG8_WAIT_L(0); PG8_MMA(0, 1, At, B1); PG8_BAR;
      PG8_LDA(At, 1, 1); PG8_STAGE(PG8_SA(1, 0), a3, voffA);
      PG8_BAR; PG8_WAIT_L(0); PG8_MMA(1, 0, At, B0); PG8_BAR; PG8_SCHED;
      PG8_STAGE(PG8_SB(1, 1), b3 + hstB, voffB);
      PG8_WAIT_V(6); PG8_BAR; PG8_MMA(1, 1, At, B1); PG8_BAR;
    }
#define PG8_ZERO() do { _Pragma("unroll") for (int a = 0; a < 2; ++a) _Pragma("unroll") for (int b = 0; b < 2; ++b) _Pragma("unroll") for (int m = 0; m < 4; ++m) _Pragma("unroll") for (int n = 0; n < 2; ++n) acc[a][b][m][n] = (f32x4){0.f, 0.f, 0.f, 0.f}; } while (0)
    if constexpr (CHAIN) { E.merge(acc, cur, wr, wc, fr, fq); if (!has_next) break; if (cur.z == E.nzm1) PG8_ZERO(); }
    else { E(acc, cur, wr, wc, fr, fq); if (!has_next) break; PG8_ZERO(); }
    cur = nxt; cA = nA; cB = nB; ++ui;
  }
  PG8_WAIT_V(0);
  if (wr == 0) PG8_BAR;
  PG8_BAR;
#undef PG8_ZA
#undef PG8_ZERO
#undef PG8_SA
#undef PG8_SB
#undef PG8_STAGE
#undef PG8_LDA
#undef PG8_LDB
#undef PG8_MMA
#undef PG8_WAIT_V
#undef PG8_WAIT_L
#undef PG8_BAR
#undef PG8_SCHED
}
}

enum { EM_PROJ = 0, EM_BF16, EM_GLU, EM_MERGEZ, EM_RESID, EM_RELU2, EM_DRY };
struct Epi {
  int mode;
  bf16_t* o16; int ld16;
  float* o32; const float* r32; int ld32;
  const bf16_t* r16; int ldr16;
  const bf16_t* aux; int ldaux;
  const float* bias;
  int nzm1;
  DI bool is_chain() const { return nzm1 != 0; }
  DI void operator()(const f32x4 (&acc)[2][2][4][2], const pg8::Unit& u, int wr, int wc, int fr, int fq) const {
    if (mode == EM_DRY) return;
    const int row0 = u.pm * 256 + wr * 64 + fr;
    int colt = u.pn * 256; bf16_t* ob = o16; int ldo = ld16;
    if (mode == EM_PROJ) {
      const int pn = u.pn; int s, ldp;
      if (pn < 8) { s = pn & ~1; ldp = 512; } else if (pn < 14) { s = 8; ldp = 1536; } else if (pn < 20) { s = 14; ldp = 1536; } else if (pn < 26) { s = 20; ldp = 1536; }
      else if (pn < 38) { s = 26; ldp = 3072; } else { s = 38; ldp = 256; }
      ob = o16 + PE(s); ldo = ldp; colt = (pn - s) * 256;
    }
    const int col0 = colt + wc * 32 + 8 * fq;
    if (mode == EM_PROJ || mode == EM_BF16 || mode == EM_RELU2) {
      const bool sq = (mode == EM_RELU2);
#pragma unroll
      for (int ai = 0; ai < 2; ++ai)
#pragma unroll
        for (int m = 0; m < 4; ++m) {
          const size_t row = (size_t)(row0 + ai * 128 + m * 16);
#pragma unroll
          for (int bj = 0; bj < 2; ++bj) {
            f32x4 v0 = acc[ai][bj][m][0], v1 = acc[ai][bj][m][1];
            if (sq) {
#pragma unroll
              for (int j = 0; j < 4; ++j) { const float a = fmaxf(v0[j], 0.f), b = fmaxf(v1[j], 0.f); v0[j] = a * a; v1[j] = b * b; }
            }
            u32x4 w; w.x = pk2(v0[0], v0[1]); w.y = pk2(v0[2], v0[3]); w.z = pk2(v1[0], v1[1]); w.w = pk2(v1[2], v1[3]);
            *(u32x4*)(ob + row * ldo + col0 + bj * 128) = w;
          }
        }
    } else if (mode == EM_RESID) {
      if (r32) {
#pragma unroll
        for (int ai = 0; ai < 2; ++ai)
#pragma unroll
          for (int mp = 0; mp < 2; ++mp) {
            f32x4 rr[2][2][2];
#pragma unroll
            for (int mm = 0; mm < 2; ++mm)
#pragma unroll
              for (int bj = 0; bj < 2; ++bj) { const float* p = r32 + (size_t)(row0 + ai * 128 + (mp * 2 + mm) * 16) * ld32 + col0 + bj * 128; rr[mm][bj][0] = *(const f32x4*)p; rr[mm][bj][1] = *(const f32x4*)(p + 4); }
#pragma unroll
            for (int mm = 0; mm < 2; ++mm)
#pragma unroll
              for (int bj = 0; bj < 2; ++bj) { const size_t row = (size_t)(row0 + ai * 128 + (mp * 2 + mm) * 16);
                const f32x4 t0 = rr[mm][bj][0] + acc[ai][bj][mp * 2 + mm][0], t1 = rr[mm][bj][1] + acc[ai][bj][mp * 2 + mm][1];
                u32x4 w; w.x = pk2(t0[0], t0[1]); w.y = pk2(t0[2], t0[3]); w.z = pk2(t1[0], t1[1]); w.w = pk2(t1[2], t1[3]);
                *(u32x4*)(ob + row * ldo + col0 + bj * 128) = w; }
          }
      } else {
#pragma unroll
        for (int ai = 0; ai < 2; ++ai) {
          u32x4 q[4][2];
#pragma unroll
          for (int m = 0; m < 4; ++m)
#pragma unroll
            for (int bj = 0; bj < 2; ++bj) q[m][bj] = *(const u32x4*)(r16 + (size_t)(row0 + ai * 128 + m * 16) * ldr16 + col0 + bj * 128);
#pragma unroll
          for (int m = 0; m < 4; ++m)
#pragma unroll
            for (int bj = 0; bj < 2; ++bj) { const u32x4 v = q[m][bj];
              const f32x4 t0 = (f32x4){bf_lo(v.x), bf_hi(v.x), bf_lo(v.y), bf_hi(v.y)} + acc[ai][bj][m][0], t1 = (f32x4){bf_lo(v.z), bf_hi(v.z), bf_lo(v.w), bf_hi(v.w)} + acc[ai][bj][m][1];
              u32x4 w; w.x = pk2(t0[0], t0[1]); w.y = pk2(t0[2], t0[3]); w.z = pk2(t1[0], t1[1]); w.w = pk2(t1[2], t1[3]);
              *(u32x4*)(ob + (size_t)(row0 + ai * 128 + m * 16) * ldo + col0 + bj * 128) = w; }
        }
      }
    } else if (mode == EM_GLU) {
      f32x4 bb[2][2];
#pragma unroll
      for (int bj = 0; bj < 2; ++bj) { bb[bj][0] = *(const f32x4*)(bias + col0 + bj * 128); bb[bj][1] = *(const f32x4*)(bias + col0 + bj * 128 + 4); }
#pragma unroll
      for (int ai = 0; ai < 2; ++ai) {
        u32x4 gq[4][2];
#pragma unroll
        for (int m = 0; m < 4; ++m)
#pragma unroll
          for (int bj = 0; bj < 2; ++bj) gq[m][bj] = *(const u32x4*)(aux + (size_t)(row0 + ai * 128 + m * 16) * ldaux + col0 + bj * 128);
#pragma unroll
        for (int m = 0; m < 4; ++m)
#pragma unroll
          for (int bj = 0; bj < 2; ++bj) {
            const u32x4 q = gq[m][bj]; const f32x4 v0 = acc[ai][bj][m][0], v1 = acc[ai][bj][m][1];
            const float gv[8] = {bf_lo(q.x), bf_hi(q.x), bf_lo(q.y), bf_hi(q.y), bf_lo(q.z), bf_hi(q.z), bf_lo(q.w), bf_hi(q.w)};
            float o[8];
#pragma unroll
            for (int j = 0; j < 4; ++j) { o[j] = gv[j] * sigmoidf_(v0[j] + bb[bj][0][j]); o[4 + j] = gv[4 + j] * sigmoidf_(v1[j] + bb[bj][1][j]); }
            u32x4 w; w.x = pk2(o[0], o[1]); w.y = pk2(o[2], o[3]); w.z = pk2(o[4], o[5]); w.w = pk2(o[6], o[7]);
            *(u32x4*)(ob + (size_t)(row0 + ai * 128 + m * 16) * ldo + col0 + bj * 128) = w;
          }
      }
    }
  }
  DI void merge(f32x4 (&acc)[2][2][4][2], const pg8::Unit& u, int wr, int wc, int fr, int fq) const {
    if (mode == EM_DRY) return;
    const int row0 = u.pm * 256 + wr * 64 + fr, col0 = u.pn * 256 + wc * 32 + 8 * fq;
    bf16_t* ob = o16; const int ldo = ld16;
    {
      const int z = u.z;
#pragma unroll
      for (int ai = 0; ai < 2; ++ai)
#pragma unroll
        for (int mp = 0; mp < 2; ++mp) {
          u32x4 g0[2][2], g1[2][2];
#pragma unroll
          for (int mm = 0; mm < 2; ++mm)
#pragma unroll
            for (int bj = 0; bj < 2; ++bj) { const bf16_t* p = aux + (size_t)(row0 + ai * 128 + (mp * 2 + mm) * 16) * ldaux + z * 1024 + col0 + bj * 128;
              g0[mm][bj] = *(const u32x4*)p; g1[mm][bj] = (z < 2) ? *(const u32x4*)(p + 1024) : (u32x4){0u, 0u, 0u, 0u}; }
#pragma unroll
          for (int mm = 0; mm < 2; ++mm)
#pragma unroll
            for (int bj = 0; bj < 2; ++bj) {
              const int m = mp * 2 + mm; const size_t row = (size_t)(row0 + ai * 128 + m * 16);
              f32x4& a0 = acc[ai][bj][m][0]; f32x4& a1 = acc[ai][bj][m][1];
#pragma unroll
              for (int e2 = 0; e2 < 4; ++e2) {
                const float l0a = bf_lo(g0[mm][bj][e2]), l0b = bf_hi(g0[mm][bj][e2]), l1a = bf_lo(g1[mm][bj][e2]), l1b = bf_hi(g1[mm][bj][e2]);
                float fa = __builtin_amdgcn_rcpf(1.0f + __expf(-l0a)), fb = __builtin_amdgcn_rcpf(1.0f + __expf(-l0b));
                if (z < 2) { fa *= 1.0f + __expf(-l1a); fb *= 1.0f + __expf(-l1b); }
                if (e2 < 2) { a0[2 * e2] *= fa; a0[2 * e2 + 1] *= fb; } else { a1[2 * e2 - 4] *= fa; a1[2 * e2 - 3] *= fb; }
              }
              if (z == 2) { u32x4 w; w.x = pk2(a0[0], a0[1]); w.y = pk2(a0[2], a0[3]); w.z = pk2(a1[0], a1[1]); w.w = pk2(a1[2], a1[3]);
                *(u32x4*)(ob + row * ldo + col0 + bj * 128) = w; }
            }
        }
    }
  }
};

DI void norm_rows_bf16(const float* x, const float* gain, bf16_t* H, int nrows) {
  const int tid = tid_(), lane = tid & 63, gw = blockIdx.x * 8 + (tid >> 6), nw = gridDim.x * 8;
  f32x4 g[4];
#pragma unroll
  for (int i = 0; i < 4; ++i) g[i] = *(const f32x4*)(gain + i * 256 + lane * 4);
  for (int r = gw * 2; r < nrows; r += nw * 2) {
    f32x4 v[2][4];
#pragma unroll
    for (int q = 0; q < 2; ++q)
#pragma unroll
      for (int i = 0; i < 4; ++i) v[q][i] = *(const f32x4*)(x + (size_t)(r + q) * 1024 + i * 256 + lane * 4);
#pragma unroll
    for (int q = 0; q < 2; ++q) {
      float ss = 0.f;
#pragma unroll
      for (int i = 0; i < 4; ++i) ss += v[q][i][0] * v[q][i][0] + v[q][i][1] * v[q][i][1] + v[q][i][2] * v[q][i][2] + v[q][i][3] * v[q][i][3];
      ss = wave_sum(ss, lane);
      const float rs = rsqrtf(ss * (1.0f / 1024.0f) + 1e-6f);
#pragma unroll
      for (int i = 0; i < 4; ++i) { u32x2 w; w.x = pk2(v[q][i][0] * rs * g[i][0], v[q][i][1] * rs * g[i][1]); w.y = pk2(v[q][i][2] * rs * g[i][2], v[q][i][3] * rs * g[i][3]);
        *(u32x2*)(H + (size_t)(r + q) * 1024 + i * 256 + lane * 4) = w; }
    }
  }
}
DI void norm_rows_from_bf16(const bf16_t* xb, int ldx, const float* gain, bf16_t* H, int nrows) {
  const int tid = tid_(), lane = tid & 63, gw = blockIdx.x * 8 + (tid >> 6), nw = gridDim.x * 8;
  f32x4 g[4];
#pragma unroll
  for (int i = 0; i < 2; ++i) { g[2 * i] = *(const f32x4*)(gain + i * 512 + lane * 8); g[2 * i + 1] = *(const f32x4*)(gain + i * 512 + lane * 8 + 4); }
  for (int r = gw * 8; r < nrows; r += nw * 8) {
    u32x4 v[8][2];
#pragma unroll
    for (int q = 0; q < 8; ++q)
#pragma unroll
      for (int i = 0; i < 2; ++i) v[q][i] = *(const u32x4*)(xb + (size_t)(r + q) * ldx + i * 512 + lane * 8);
#pragma unroll
    for (int q = 0; q < 8; ++q) {
      float f[16];
#pragma unroll
      for (int i = 0; i < 2; ++i)
#pragma unroll
        for (int e = 0; e < 4; ++e) { f[i * 8 + 2 * e] = bf_lo(v[q][i][e]); f[i * 8 + 2 * e + 1] = bf_hi(v[q][i][e]); }
      float ss = 0.f;
#pragma unroll
      for (int e = 0; e < 16; ++e) ss += f[e] * f[e];
      ss = wave_sum(ss, lane);
      const float rs = rsqrtf(ss * (1.0f / 1024.0f) + 1e-6f);
#pragma unroll
      for (int i = 0; i < 2; ++i) { u32x4 w;
#pragma unroll
        for (int e = 0; e < 4; ++e) w[e] = pk2(f[i * 8 + 2 * e] * rs * g[2 * i + (e >> 1)][(2 * e) & 3], f[i * 8 + 2 * e + 1] * rs * g[2 * i + (e >> 1)][(2 * e + 1) & 3]);
        *(u32x4*)(H + (size_t)(r + q) * 1024 + i * 512 + lane * 8) = w; }
    }
  }
}
DI void final_norm_expand(float* out, const float* gain, int nrows) {
  const int tid = tid_(), lane = tid & 63, gw = blockIdx.x * 8 + (tid >> 6), nw = gridDim.x * 8;
  f32x4 g[4];
#pragma unroll
  for (int i = 0; i < 2; ++i) { g[2 * i] = *(const f32x4*)(gain + i * 512 + lane * 8); g[2 * i + 1] = *(const f32x4*)(gain + i * 512 + lane * 8 + 4); }
  for (int r = gw; r < nrows; r += nw) {
    const bf16_t* xb = (const bf16_t*)(out + (size_t)r * 1024);
    u32x4 v[2];
#pragma unroll
    for (int i = 0; i < 2; ++i) v[i] = *(const u32x4*)(xb + i * 512 + lane * 8);
    float f[16];
#pragma unroll
    for (int i = 0; i < 2; ++i)
#pragma unroll
      for (int e = 0; e < 4; ++e) { f[i * 8 + 2 * e] = bf_lo(v[i][e]); f[i * 8 + 2 * e + 1] = bf_hi(v[i][e]); }
    float ss = 0.f;
#pragma unroll
    for (int e = 0; e < 16; ++e) ss += f[e] * f[e];
    ss = wave_sum(ss, lane);
    const float rs = rsqrtf(ss * (1.0f / 1024.0f) + 1e-6f);
    asm volatile("s_waitcnt vmcnt(0)" ::: "memory");
#pragma unroll
    for (int i = 0; i < 2; ++i) { f32x4 o0, o1;
#pragma unroll
      for (int e = 0; e < 4; ++e) { o0[e] = f[i * 8 + e] * rs * g[2 * i][e]; o1[e] = f[i * 8 + 4 + e] * rs * g[2 * i + 1][e]; }
      *(f32x4*)(out + (size_t)r * 1024 + i * 512 + lane * 8) = o0; *(f32x4*)(out + (size_t)r * 1024 + i * 512 + lane * 8 + 4) = o1; }
  }
}
DI void final_norm_from_bf16(const bf16_t* xb, float* out, const float* gain, int nrows) {
  const int tid = tid_(), lane = tid & 63, gw = blockIdx.x * 8 + (tid >> 6), nw = gridDim.x * 8;
  f32x4 g[4];
#pragma unroll
  for (int i = 0; i < 2; ++i) { g[2 * i] = *(const f32x4*)(gain + i * 512 + lane * 8); g[2 * i + 1] = *(const f32x4*)(gain + i * 512 + lane * 8 + 4); }
  for (int r = gw * 2; r < nrows; r += nw * 2) {
    u32x4 v[2][2];
#pragma unroll
    for (int q = 0; q < 2; ++q)
#pragma unroll
      for (int i = 0; i < 2; ++i) v[q][i] = *(const u32x4*)(xb + (size_t)(r + q) * 1024 + i * 512 + lane * 8);
#pragma unroll
    for (int q = 0; q < 2; ++q) {
      float f[16];
#pragma unroll
      for (int i = 0; i < 2; ++i)
#pragma unroll
        for (int e = 0; e < 4; ++e) { f[i * 8 + 2 * e] = bf_lo(v[q][i][e]); f[i * 8 + 2 * e + 1] = bf_hi(v[q][i][e]); }
      float ss = 0.f;
#pragma unroll
      for (int e = 0; e < 16; ++e) ss += f[e] * f[e];
      ss = wave_sum(ss, lane);
      const float rs = rsqrtf(ss * (1.0f / 1024.0f) + 1e-6f);
#pragma unroll
      for (int i = 0; i < 2; ++i) { f32x4 o0, o1;
#pragma unroll
        for (int e = 0; e < 4; ++e) { o0[e] = f[i * 8 + e] * rs * g[2 * i][e]; o1[e] = f[i * 8 + 4 + e] * rs * g[2 * i + 1][e]; }
        *(f32x4*)(out + (size_t)(r + q) * 1024 + i * 512 + lane * 8) = o0; *(f32x4*)(out + (size_t)(r + q) * 1024 + i * 512 + lane * 8 + 4) = o1; }
    }
  }
}
DI void norm_rows_f32_inplace(float* x, const float* gain, int nrows) {
  const int tid = tid_(), lane = tid & 63, gw = blockIdx.x * 8 + (tid >> 6), nw = gridDim.x * 8;
  f32x4 g[4];
#pragma unroll
  for (int i = 0; i < 4; ++i) g[i] = *(const f32x4*)(gain + i * 256 + lane * 4);
  for (int r = gw * 2; r < nrows; r += nw * 2) {
    f32x4 v[2][4];
#pragma unroll
    for (int q = 0; q < 2; ++q)
#pragma unroll
      for (int i = 0; i < 4; ++i) v[q][i] = *(const f32x4*)(x + (size_t)(r + q) * 1024 + i * 256 + lane * 4);
#pragma unroll
    for (int q = 0; q < 2; ++q) {
      float ss = 0.f;
#pragma unroll
      for (int i = 0; i < 4; ++i) ss += v[q][i][0] * v[q][i][0] + v[q][i][1] * v[q][i][1] + v[q][i][2] * v[q][i][2] + v[q][i][3] * v[q][i][3];
      ss = wave_sum(ss, lane);
      const float rs = rsqrtf(ss * (1.0f / 1024.0f) + 1e-6f);
#pragma unroll
      for (int i = 0; i < 4; ++i) { f32x4 o; o[0] = v[q][i][0] * rs * g[i][0]; o[1] = v[q][i][1] * rs * g[i][1]; o[2] = v[q][i][2] * rs * g[i][2]; o[3] = v[q][i][3] * rs * g[i][3];
        *(f32x4*)(x + (size_t)(r + q) * 1024 + i * 256 + lane * 4) = o; }
    }
  }
}

DI int win_map(int n) { return n < 1536 ? n : (n < 9728 ? n + 16 : (n < 9744 ? n - 9728 + 1536 : -1)); }
DI void transpose_w(LAS unsigned char* sm, const float* src, int K, int Ns, bf16_t* dst, int Nd, int mapmode) {
  LAS float* tile = (LAS float*)sm;
  const int tid = tid_(), tn = Nd / 64, tk = K / 64;
  for (int t = blockIdx.x; t < tn * tk; t += gridDim.x) {
    const int n0 = (t / tk) * 64, k0 = (t % tk) * 64;
    float tv[8];
#pragma unroll
    for (int it = 0; it < 8; ++it) { const int idx = it * 512 + tid, kk = idx >> 6, nn = idx & 63;
      const int sc = mapmode ? win_map(n0 + nn) : (n0 + nn);
      tv[it] = sc >= 0 ? src[(size_t)(k0 + kk) * Ns + sc] : 0.f; }
#pragma unroll
    for (int it = 0; it < 8; ++it) { const int idx = it * 512 + tid, kk = idx >> 6, nn = idx & 63; tile[kk * 65 + nn] = tv[it]; }
    __syncthreads();
    { const int nn = tid >> 3, kc = tid & 7; float f[8];
#pragma unroll
      for (int e = 0; e < 8; ++e) f[e] = tile[(kc * 8 + e) * 65 + nn];
      u32x4 w; w.x = pk2(f[0], f[1]); w.y = pk2(f[2], f[3]); w.z = pk2(f[4], f[5]); w.w = pk2(f[6], f[7]);
      *(u32x4*)(dst + (size_t)(n0 + nn) * K + k0 + kc * 8) = w; }
    __syncthreads();
  }
}

DI void attn_task(LAS unsigned char* sm, int task, bf16_t* QA, const bf16_t* KA, const bf16_t* VA, float* LSE, bool dry) {
  const int tid = tid_(), lane = tid & 63, w = tid >> 6, li = lane & 15, quad = lane >> 4;
  const int bh = task >> 5, sub = task & 31;
  const int b = bh / 12, h = bh - b * 12, g = h >> 2, dsh = g * 2, dil = 1 << dsh, nblk = 32 >> dsh;
  const int r = sub / nblk, n = sub - r * nblk;
  LAS unsigned char* ks = sm;
  LAS unsigned short* vt = (LAS unsigned short*)(sm + 69632);
  {
    u32x4 kv[8], vv[8];
#pragma unroll
    for (int it = 0; it < 8; ++it) {
      const int id = it * 512 + tid, row = id >> 4, cc = id & 15, sp = n * 128 - 128 + row;
      kv[it] = (u32x4){0u, 0u, 0u, 0u};
      if (sp >= 0) kv[it] = *(const u32x4*)(KA + ((size_t)b * 4096 + (size_t)(sp * dil + r)) * 1536 + h * 128 + cc * 8);
    }
#pragma unroll
    for (int it = 0; it < 8; ++it) {
      const int id = it * 512 + tid, key = id & 255, cc = id >> 8, sp = n * 128 - 128 + key;
      vv[it] = (u32x4){0u, 0u, 0u, 0u};
      if (sp >= 0) vv[it] = *(const u32x4*)(VA + ((size_t)b * 4096 + (size_t)(sp * dil + r)) * 1536 + h * 128 + cc * 8);
    }
#pragma unroll
    for (int it = 0; it < 8; ++it) { const int id = it * 512 + tid, row = id >> 4, cc = id & 15; *(LAS u32x4*)(ks + row * 272 + cc * 16) = kv[it]; }
#pragma unroll
    for (int it = 0; it < 8; ++it) { const int id = it * 512 + tid, key = id & 255, cc = id >> 8;
#pragma unroll
      for (int e = 0; e < 4; ++e) { vt[(cc * 8 + 2 * e) * 264 + key] = (unsigned short)(vv[it][e] & 0xffffu); vt[(cc * 8 + 2 * e + 1) * 264 + key] = (unsigned short)(vv[it][e] >> 16); } }
  }
  __syncthreads();
  const int qsp = n * 128 + w * 16 + li;
  const size_t qtok = (size_t)b * 4096 + (size_t)(qsp * dil + r);
  bf16_t* qptr = QA + qtok * 1536 + h * 128;
  bf16x8 qf[4];
#pragma unroll
  for (int kk = 0; kk < 4; ++kk) qf[kk] = *(const bf16x8*)(qptr + kk * 32 + quad * 8);
  const int kt0 = w < 6 ? w : 6;
  const float sc = 0.08838834764831845f * 1.4426950408889634f;
  const float sl = exp2f(-8.0f * (float)(h + 1) / 12.0f) * (float)dil * 1.4426950408889634f;
  float s[10][4]; float mx = -1e30f;
#pragma unroll
  for (int tt = 0; tt < 10; ++tt) {
    const int kt = kt0 + tt; f32x4 acc = {0.f, 0.f, 0.f, 0.f};
#pragma unroll
    for (int kk = 0; kk < 4; ++kk) { const bf16x8 a = *(const LAS bf16x8*)(ks + (kt * 16 + li) * 272 + kk * 64 + quad * 16); acc = mfma16(a, qf[kk], acc); }
#pragma unroll
    for (int j = 0; j < 4; ++j) { const int kl = kt * 16 + quad * 4 + j, dist = 128 + w * 16 + li - kl;
      const bool valid = dist >= 0 && dist <= 128 && (n > 0 || kl >= 128);
      const float v = acc[j] * sc - sl * (float)dist; s[tt][j] = valid ? v : -1e30f; mx = fmaxf(mx, s[tt][j]); }
  }
  mx = fmaxf(mx, shx(mx, 16, lane)); mx = fmaxf(mx, shx(mx, 32, lane));
  float lsum = 0.f;
#pragma unroll
  for (int tt = 0; tt < 10; ++tt)
#pragma unroll
    for (int j = 0; j < 4; ++j) { const float p = exp2f(s[tt][j] - mx); s[tt][j] = p; lsum += p; }
  lsum += shx(lsum, 16, lane); lsum += shx(lsum, 32, lane);
  bf16x8 pf[5];
#pragma unroll
  for (int pp = 0; pp < 5; ++pp) { u32x4 t; t.x = pk2(s[2 * pp][0], s[2 * pp][1]); t.y = pk2(s[2 * pp][2], s[2 * pp][3]); t.z = pk2(s[2 * pp + 1][0], s[2 * pp + 1][1]); t.w = pk2(s[2 * pp + 1][2], s[2 * pp + 1][3]); pf[pp] = mk8(t); }
  const float inv = 1.0f / lsum;
#pragma unroll
  for (int dvt = 0; dvt < 8; ++dvt) {
    f32x4 acc = {0.f, 0.f, 0.f, 0.f};
#pragma unroll
    for (int pp = 0; pp < 5; ++pp) { const int kA = (kt0 + 2 * pp) * 16 + quad * 4;
      const u32x2 lo = *(const LAS u32x2*)(vt + (dvt * 16 + li) * 264 + kA), hi = *(const LAS u32x2*)(vt + (dvt * 16 + li) * 264 + kA + 16);
      u32x4 t; t.x = lo.x; t.y = lo.y; t.z = hi.x; t.w = hi.y; acc = mfma16(mk8(t), pf[pp], acc); }
    u32x2 o; o.x = pk2(acc[0] * inv, acc[1] * inv); o.y = pk2(acc[2] * inv, acc[3] * inv);
    if (!dry) *(u32x2*)(qptr + dvt * 16 + quad * 4) = o;
  }
  if (quad == 0 && !dry) LSE[qtok * 12 + h] = (mx + log2f(lsum)) * 0.6931471805599453f;
  __syncthreads();
}

DI void attn_combine(const bf16_t* QA, bf16_t* YC, const float* LSE, bool dry, int bidx, int nblk) {
  const int nitem = MG * 4 * 16;
  int gs = nblk * NTHREADS; asm volatile("" : "+s"(gs));
  for (int it = bidx * NTHREADS + tid_(); it < nitem; it += gs) {
    const int t = it >> 6, hg = (it >> 4) & 3, dc = it & 15;
    const float l0 = LSE[(size_t)t * 12 + hg], l1 = LSE[(size_t)t * 12 + 4 + hg], l2 = LSE[(size_t)t * 12 + 8 + hg];
    const float m = fmaxf(l0, fmaxf(l1, l2));
    float w0 = __expf(l0 - m), w1 = __expf(l1 - m), w2 = __expf(l2 - m); const float iv = 1.0f / (w0 + w1 + w2); w0 *= iv; w1 *= iv; w2 *= iv;
    const bf16_t* p = QA + (size_t)t * 1536 + hg * 128 + dc * 8;
    const u32x4 a = *(const u32x4*)p, b = *(const u32x4*)(p + 512), c = *(const u32x4*)(p + 1024);
    u32x4 o;
#pragma unroll
    for (int e = 0; e < 4; ++e) o[e] = pk2(w0 * bf_lo(a[e]) + w1 * bf_lo(b[e]) + w2 * bf_lo(c[e]), w0 * bf_hi(a[e]) + w1 * bf_hi(b[e]) + w2 * bf_hi(c[e]));
    if (!dry) *(u32x4*)(YC + (size_t)t * 512 + hg * 128 + dc * 8) = o;
  }
}

DI void xattn_task(LAS unsigned char* sm, int task, bf16_t* XQ, const bf16_t* MKV, int l, bool dry) {
  const int tid = tid_(), lane = tid & 63, w = tid >> 6, li = lane & 15, quad = lane >> 4;
  const int b = task >> 7, hx = (task >> 5) & 3, n = task & 31;
  LAS unsigned short* vt = (LAS unsigned short*)sm;
  {
    u32x4 kv[16];
#pragma unroll
    for (int it = 0; it < 16; ++it) { const int id = it * 512 + tid, row = id >> 5, cc = id & 31;
      kv[it] = *(const u32x4*)(MKV + (size_t)(b * 256 + row) * 4096 + l * 2048 + hx * 256 + cc * 8); }
#pragma unroll
    for (int it = 0; it < 16; ++it) { const int id = it * 512 + tid, row = id >> 5, cc = id & 31; *(LAS u32x4*)(sm + row * 528 + cc * 16) = kv[it]; }
  }
  __syncthreads();
  const size_t qtok = (size_t)b * 4096 + n * 128 + w * 16 + li;
  bf16_t* qptr = XQ + qtok * 1024 + hx * 256;
  bf16x8 qf[8];
#pragma unroll
  for (int kk = 0; kk < 8; ++kk) qf[kk] = *(const bf16x8*)(qptr + kk * 32 + quad * 8);
  float s[16][4]; float mx = -1e30f;
  const float sc = 0.0625f * 1.4426950408889634f;
#pragma unroll
  for (int kt = 0; kt < 16; ++kt) { f32x4 acc = {0.f, 0.f, 0.f, 0.f};
#pragma unroll
    for (int kk = 0; kk < 8; ++kk) { const bf16x8 a = *(const LAS bf16x8*)(sm + (kt * 16 + li) * 528 + kk * 64 + quad * 16); acc = mfma16(a, qf[kk], acc); }
#pragma unroll
    for (int j = 0; j < 4; ++j) { s[kt][j] = acc[j] * sc; mx = fmaxf(mx, s[kt][j]); } }
  mx = fmaxf(mx, shx(mx, 16, lane)); mx = fmaxf(mx, shx(mx, 32, lane));
  float lsum = 0.f;
#pragma unroll
  for (int kt = 0; kt < 16; ++kt)
#pragma unroll
    for (int j = 0; j < 4; ++j) { const float p = exp2f(s[kt][j] - mx); s[kt][j] = p; lsum += p; }
  lsum += shx(lsum, 16, lane); lsum += shx(lsum, 32, lane);
  bf16x8 pf[8];
#pragma unroll
  for (int pp = 0; pp < 8; ++pp) { u32x4 t; t.x = pk2(s[2 * pp][0], s[2 * pp][1]); t.y = pk2(s[2 * pp][2], s[2 * pp][3]); t.z = pk2(s[2 * pp + 1][0], s[2 * pp + 1][1]); t.w = pk2(s[2 * pp + 1][2], s[2 * pp + 1][3]); pf[pp] = mk8(t); }
  const float inv = 1.0f / lsum;
  {
    u32x4 vv[16];
#pragma unroll
    for (int it = 0; it < 16; ++it) { const int id = it * 512 + tid, key = id & 255, cc = id >> 8;
      vv[it] = *(const u32x4*)(MKV + (size_t)(b * 256 + key) * 4096 + l * 2048 + 1024 + hx * 256 + cc * 8); }
    __syncthreads();
#pragma unroll
    for (int it = 0; it < 16; ++it) { const int id = it * 512 + tid, key = id & 255, cc = id >> 8;
#pragma unroll
      for (int e = 0; e < 4; ++e) { vt[(cc * 8 + 2 * e) * 264 + key] = (unsigned short)(vv[it][e] & 0xffffu); vt[(cc * 8 + 2 * e + 1) * 264 + key] = (unsigned short)(vv[it][e] >> 16); } }
  }
  __syncthreads();
#pragma unroll
  for (int dvt = 0; dvt < 16; ++dvt) {
    f32x4 acc = {0.f, 0.f, 0.f, 0.f};
#pragma unroll
    for (int pp = 0; pp < 8; ++pp) { const int kA = 2 * pp * 16 + quad * 4;
      const u32x2 lo = *(const LAS u32x2*)(vt + (dvt * 16 + li) * 264 + kA), hi = *(const LAS u32x2*)(vt + (dvt * 16 + li) * 264 + kA + 16);
      u32x4 t; t.x = lo.x; t.y = lo.y; t.z = hi.x; t.w = hi.y; acc = mfma16(mk8(t), pf[pp], acc); }
    u32x2 o; o.x = pk2(acc[0] * inv, acc[1] * inv); o.y = pk2(acc[2] * inv, acc[3] * inv);
    if (!dry) *(u32x2*)(qptr + dvt * 16 + quad * 4) = o;
  }
  __syncthreads();
}

struct S5P { const float *a_re, *a_im, *log_step, *b_re, *b_im, *c_re, *c_im, *d; };
DI void s5_lambar(const S5P& P, int g, int p, float& lbr, float& lbi) {
  const float step = __expf(P.log_step[g]);
  const float ar = P.a_re[g * 64 + p], ai = P.a_im[g * 64 + p];
  const float mag = __expf(ar * step);
  float sn, cs; { const float x = ai * step; const float k = rintf(x * 0.15915494309189535f); float rr = fmaf(-k, 6.2831854820251465f, x); rr = fmaf(-k, -1.7484556000744883e-07f, rr); sn = sinf(rr); cs = cosf(rr); }
  lbr = mag * cs; lbi = mag * sn;
}
DI void s5_carry_scan(const f32x2* E, f32x2* C, const S5P& P, bool dry) {
  const int total = BPG * 32 * 64;
  for (int gid = blockIdx.x * NTHREADS + tid_(); gid < total; gid += gridDim.x * NTHREADS) {
    const int p = gid & 63, g = (gid >> 6) & 31, b = gid >> 11;
    float lr_, li_; s5_lambar(P, g, p, lr_, li_);
#pragma unroll
    for (int q = 0; q < 6; ++q) { const float t0 = lr_ * lr_ - li_ * li_, t1 = 2.0f * lr_ * li_; lr_ = t0; li_ = t1; }
    const size_t base = (((size_t)b * 32 + g) * 64) * 64 + p;
    float sr = 0.f, si = 0.f;
    for (int c0 = 0; c0 < 64; c0 += 8) { f32x2 ev[8];
#pragma unroll
      for (int q = 0; q < 8; ++q) ev[q] = E[base + (size_t)(c0 + q) * 64];
#pragma unroll
      for (int q = 0; q < 8; ++q) { if (!dry) { f32x2 o = {sr, si}; C[base + (size_t)(c0 + q) * 64] = o; }
        const float t0 = lr_ * sr - li_ * si + ev[q][0], t1 = lr_ * si + li_ * sr + ev[q][1]; sr = t0; si = t1; } }
  }
}
DI float bperm(float v, int srclane) { return __builtin_bit_cast(float, __builtin_amdgcn_ds_bpermute(srclane << 2, __builtin_bit_cast(int, v))); }
DI void s5_task(LAS unsigned char* sm, int task, int mode, bf16_t* U, f32x2* E, const S5P& P, bool dry) {
  const int tid = tid_(), lane = tid & 63, w = tid >> 6, li = lane & 15, quad = lane >> 4;
  const int b = task >> 8, c = (task >> 2) & 63, oct = task & 3;
  const size_t row0 = (size_t)b * 4096 + c * 64;
  { u32x4 v[2];
#pragma unroll
    for (int it = 0; it < 2; ++it) { const int id = it * 512 + tid, t = id >> 4, cc = id & 15; v[it] = *(const u32x4*)(U + (row0 + t) * 512 + oct * 128 + cc * 8); }
#pragma unroll
    for (int it = 0; it < 2; ++it) { const int id = it * 512 + tid, t = id >> 4, cc = id & 15; *(LAS u32x4*)(sm + t * 272 + cc * 16) = v[it]; } }
  __syncthreads();
  const int g = oct * 8 + w;
  float l1r[4], l1i[4], l2r[4], l2i[4], l3r[4], l3i[4], l4r[4], l4i[4], spr[4], spi[4];
  bf16x8 Bre[4], Bim[4];
#pragma unroll
  for (int pb = 0; pb < 4; ++pb) {
    const int p = pb * 16 + li;
    float lr, lim; s5_lambar(P, g, p, lr, lim);
    const float ar = P.a_re[g * 64 + p], ai = P.a_im[g * 64 + p];
    const float iv = 1.0f / (ar * ar + ai * ai), nr = lr - 1.0f, ni = lim;
    const float cr = (nr * ar + ni * ai) * iv, ci = (ni * ar - nr * ai) * iv;
    u32x4 tre = {0u, 0u, 0u, 0u}, tim = {0u, 0u, 0u, 0u};
    if (quad < 2) {
      const float* pr = P.b_re + ((size_t)g * 64 + p) * 16 + quad * 8; const float* pi = P.b_im + ((size_t)g * 64 + p) * 16 + quad * 8;
      const f32x4 br0 = *(const f32x4*)pr, br1 = *(const f32x4*)(pr + 4), bi0 = *(const f32x4*)pi, bi1 = *(const f32x4*)(pi + 4);
      tre.x = pk2(cr * br0[0] - ci * bi0[0], cr * br0[1] - ci * bi0[1]); tre.y = pk2(cr * br0[2] - ci * bi0[2], cr * br0[3] - ci * bi0[3]);
      tre.z = pk2(cr * br1[0] - ci * bi1[0], cr * br1[1] - ci * bi1[1]); tre.w = pk2(cr * br1[2] - ci * bi1[2], cr * br1[3] - ci * bi1[3]);
      tim.x = pk2(cr * bi0[0] + ci * br0[0], cr * bi0[1] + ci * br0[1]); tim.y = pk2(cr * bi0[2] + ci * br0[2], cr * bi0[3] + ci * br0[3]);
      tim.z = pk2(cr * bi1[0] + ci * br1[0], cr * bi1[1] + ci * br1[1]); tim.w = pk2(cr * bi1[2] + ci * br1[2], cr * bi1[3] + ci * br1[3]);
    }
    Bre[pb] = mk8(tre); Bim[pb] = mk8(tim);
    l1r[pb] = lr; l1i[pb] = lim;
    l2r[pb] = lr * lr - lim * lim; l2i[pb] = 2.0f * lr * lim;
    l3r[pb] = l2r[pb] * lr - l2i[pb] * lim; l3i[pb] = l2r[pb] * lim + l2i[pb] * lr;
    l4r[pb] = l2r[pb] * l2r[pb] - l2i[pb] * l2i[pb]; l4i[pb] = 2.0f * l2r[pb] * l2i[pb];
    spr[pb] = 0.f; spi[pb] = 0.f;
    if (mode == 1) { const f32x2 e = E[(((size_t)b * 32 + g) * 64 + c) * 64 + p]; spr[pb] = e[0]; spi[pb] = e[1]; }
  }
  bf16x8 cm[4]; f32x4 dsk = {0.f, 0.f, 0.f, 0.f};
  LAS unsigned char* ss = sm + 17408 + w * 4352;
  if (mode == 1) {
#pragma unroll
    for (int kk = 0; kk < 4; ++kk) { const int p0 = kk * 16 + quad * 4;
      const f32x4 cr4 = *(const f32x4*)(P.c_re + ((size_t)g * 16 + li) * 64 + p0), ci4 = *(const f32x4*)(P.c_im + ((size_t)g * 16 + li) * 64 + p0);
      u32x4 t; t.x = pk2(cr4[0], -ci4[0]); t.y = pk2(cr4[1], -ci4[1]); t.z = pk2(cr4[2], -ci4[2]); t.w = pk2(cr4[3], -ci4[3]); cm[kk] = mk8(t); }
    dsk = *(const f32x4*)(P.d + g * 16 + quad * 4);
  }
  const int src_up = (lane - 16) & 63, src_q3 = 48 + li;
  for (int sb = 0; sb < 4; ++sb) {
    u32x4 araw = {0u, 0u, 0u, 0u};
    if (quad < 2) araw = *(const LAS u32x4*)(sm + (sb * 16 + li) * 272 + (w * 16 + quad * 8) * 2);
    const bf16x8 a = mk8(araw);
#pragma unroll
    for (int pb = 0; pb < 4; ++pb) {
      const f32x4 z4 = {0.f, 0.f, 0.f, 0.f};
      const f32x4 are = mfma16(a, Bre[pb], z4), aim = mfma16(a, Bim[pb], z4);
      float s0r = are[0], s0i = aim[0];
      float s1r = l1r[pb] * s0r - l1i[pb] * s0i + are[1], s1i = l1r[pb] * s0i + l1i[pb] * s0r + aim[1];
      float s2r = l1r[pb] * s1r - l1i[pb] * s1i + are[2], s2i = l1r[pb] * s1i + l1i[pb] * s1r + aim[2];
      float s3r = l1r[pb] * s2r - l1i[pb] * s2i + are[3], s3i = l1r[pb] * s2i + l1i[pb] * s2r + aim[3];
      float cr_ = (quad == 0) ? spr[pb] : 0.f, ci_ = (quad == 0) ? spi[pb] : 0.f;
#pragma unroll
      for (int r = 0; r < 3; ++r) {
        const float er = l4r[pb] * cr_ - l4i[pb] * ci_ + s3r, ei = l4r[pb] * ci_ + l4i[pb] * cr_ + s3i;
        const float gr = bperm(er, src_up), gi = bperm(ei, src_up);
        if (quad == r + 1) { cr_ = gr; ci_ = gi; }
      }
      s0r += l1r[pb] * cr_ - l1i[pb] * ci_; s0i += l1r[pb] * ci_ + l1i[pb] * cr_;
      s1r += l2r[pb] * cr_ - l2i[pb] * ci_; s1i += l2r[pb] * ci_ + l2i[pb] * cr_;
      s2r += l3r[pb] * cr_ - l3i[pb] * ci_; s2i += l3r[pb] * ci_ + l3i[pb] * cr_;
      s3r += l4r[pb] * cr_ - l4i[pb] * ci_; s3i += l4r[pb] * ci_ + l4i[pb] * cr_;
      spr[pb] = bperm(s3r, src_q3); spi[pb] = bperm(s3i, src_q3);
      if (mode == 1) { LAS unsigned char* q = ss + (quad * 4) * 272 + (pb * 16 + li) * 4;
        *(LAS unsigned*)(q) = pk2(s0r, s0i); *(LAS unsigned*)(q + 272) = pk2(s1r, s1i); *(LAS unsigned*)(q + 544) = pk2(s2r, s2i); *(LAS unsigned*)(q + 816) = pk2(s3r, s3i); }
    }
    if (mode == 1) {
      asm volatile("s_waitcnt lgkmcnt(0)" ::: "memory");
      f32x4 acc = {0.f, 0.f, 0.f, 0.f};
#pragma unroll
      for (int kk = 0; kk < 4; ++kk) { const bf16x8 bq = *(const LAS bf16x8*)(ss + li * 272 + kk * 64 + quad * 16); acc = mfma16(cm[kk], bq, acc); }
      const u32x2 uq = *(const LAS u32x2*)(sm + (sb * 16 + li) * 272 + (w * 16 + quad * 4) * 2);
      const float u4[4] = {bf_lo(uq.x), bf_hi(uq.x), bf_lo(uq.y), bf_hi(uq.y)};
      float o[4];
#pragma unroll
      for (int j = 0; j < 4; ++j) { const float y = acc[j] + dsk[j] * u4[j]; const float z = 0.7978845608028654f * (y + 0.044715f * y * y * y);
        const float th = 1.0f - 2.0f / (__expf(2.0f * z) + 1.0f); o[j] = 0.5f * y * (1.0f + th); }
      asm volatile("s_waitcnt lgkmcnt(0)" ::: "memory");
      u32x2 ov; ov.x = pk2(o[0], o[1]); ov.y = pk2(o[2], o[3]);
      if (!dry) *(u32x2*)(U + (row0 + sb * 16 + li) * 512 + g * 16 + quad * 4) = ov;
    }
  }
  if (mode == 0 && !dry && quad == 0) {
#pragma unroll
    for (int pb = 0; pb < 4; ++pb) { f32x2 e = {spr[pb], spi[pb]}; E[(((size_t)b * 32 + g) * 64 + c) * 64 + pb * 16 + li] = e; }
  }
  __syncthreads();
}

struct GLAP { const float *wg, *bg, *gout; };
constexpr int GL_LR = 0;
constexpr int GL_WG = 4096;
constexpr int GL_BS = 8192;
constexpr int GL_Q = 24832;
constexpr int GL_K = 34048;
constexpr int GL_VT = 43264;
constexpr int GL_ST = 61696;
constexpr int GL_RED = 80128;
constexpr int GL_SEG = 80640;
DI void gla_cumdecay(LAS unsigned char* sm, const bf16_t* LR, size_t row0, int h, const GLAP& P) {
  const int tid = tid_();
  LAS float* lrs = (LAS float*)(sm + GL_LR); LAS float* bs = (LAS float*)(sm + GL_BS); LAS float* segs = (LAS float*)(sm + GL_SEG);
  const int dk = tid & 63, seg = tid >> 6, t0 = seg * 8;
  u32x4 lrv = {0u, 0u, 0u, 0u};
  if (tid < 128) lrv = *(const u32x4*)(LR + (row0 + (tid >> 1)) * 256 + (tid & 1) * 8);
  float wcol[16];
#pragma unroll
  for (int rr = 0; rr < 16; ++rr) wcol[rr] = P.wg[rr * 256 + h * 64 + dk];
  const float bias = P.bg[h * 64 + dk];
  if (tid < 128) { const int t = tid >> 1, hf = tid & 1;
    f32x4 f0 = {bf_lo(lrv.x), bf_hi(lrv.x), bf_lo(lrv.y), bf_hi(lrv.y)}, f1 = {bf_lo(lrv.z), bf_hi(lrv.z), bf_lo(lrv.w), bf_hi(lrv.w)};
    *(LAS f32x4*)(lrs + t * 16 + hf * 8) = f0; *(LAS f32x4*)(lrs + t * 16 + hf * 8 + 4) = f1; }
  __syncthreads();
  float la[8]; float run = 0.f;
#pragma unroll
  for (int e = 0; e < 8; ++e) { float z = bias;
#pragma unroll
    for (int q4 = 0; q4 < 4; ++q4) { const f32x4 r4 = *(const LAS f32x4*)(lrs + (t0 + e) * 16 + q4 * 4);
      z = fmaf(r4[0], wcol[q4 * 4], z); z = fmaf(r4[1], wcol[q4 * 4 + 1], z); z = fmaf(r4[2], wcol[q4 * 4 + 2], z); z = fmaf(r4[3], wcol[q4 * 4 + 3], z); }
    const float ls = fminf(z, 0.f) - log1pf(__expf(-fabsf(z)));
    run += ls * 0.0625f; la[e] = run; }
  segs[seg * 64 + dk] = run;
  __syncthreads();
  float off = 0.f;
#pragma unroll
  for (int s2 = 0; s2 < 7; ++s2) off += (s2 < seg) ? segs[s2 * 64 + dk] : 0.f;
#pragma unroll
  for (int e = 0; e < 8; ++e) bs[(t0 + e) * 65 + dk] = la[e] + off;
  __syncthreads();
}
DI void gla_stage_vt(LAS unsigned char* sm, const bf16_t* VG, size_t row0, int h) {
  LAS unsigned short* vt = (LAS unsigned short*)(sm + GL_VT);
#pragma unroll
  for (int it = 0; it < 2; ++it) { const int id = it * 512 + tid_(), t = id & 63, cc = id >> 6;
    const u32x4 v = *(const u32x4*)(VG + (row0 + t) * 512 + h * 128 + cc * 8);
#pragma unroll
    for (int e = 0; e < 4; ++e) { vt[(cc * 8 + 2 * e) * 72 + t] = (unsigned short)(v[e] & 0xffffu); vt[(cc * 8 + 2 * e + 1) * 72 + t] = (unsigned short)(v[e] >> 16); } }
}
DI void gla_a_task(LAS unsigned char* sm, int task, const bf16_t* QK, const bf16_t* VG, const bf16_t* LR, bf16_t* GST, float* GDEC, const GLAP& P, bool dry) {
  const int tid = tid_(), lane = tid & 63, w = tid >> 6, li = lane & 15, quad = lane >> 4;
  const int bh = task >> 6, c = task & 63, b = bh >> 2, h = bh & 3;
  const size_t row0 = (size_t)b * 4096 + c * 64;
  gla_cumdecay(sm, LR, row0, h, P);
  LAS float* bs = (LAS float*)(sm + GL_BS);
  LAS unsigned short* kht = (LAS unsigned short*)(sm + GL_Q);
  { const int t = tid & 63, dkc = tid >> 6; const u32x4 v = *(const u32x4*)(QK + (row0 + t) * 512 + 256 + h * 64 + dkc * 8);
#pragma unroll
    for (int e = 0; e < 4; ++e) { const int d0 = dkc * 8 + 2 * e;
      const float k0 = bf_lo(v[e]) * __expf(bs[63 * 65 + d0] - bs[t * 65 + d0]), k1 = bf_hi(v[e]) * __expf(bs[63 * 65 + d0 + 1] - bs[t * 65 + d0 + 1]);
      const unsigned pk = pk2(k0, k1); kht[d0 * 72 + t] = (unsigned short)(pk & 0xffffu); kht[(d0 + 1) * 72 + t] = (unsigned short)(pk >> 16); } }
  gla_stage_vt(sm, VG, row0, h);
  if (tid < 64 && !dry) GDEC[(size_t)task * 64 + tid] = __expf(bs[63 * 65 + tid]);
  __syncthreads();
  LAS unsigned short* vt = (LAS unsigned short*)(sm + GL_VT);
#pragma unroll
  for (int dkt = 0; dkt < 4; ++dkt) { f32x4 acc = {0.f, 0.f, 0.f, 0.f};
#pragma unroll
    for (int kk = 0; kk < 2; ++kk) { const bf16x8 a = *(const LAS bf16x8*)(vt + (w * 16 + li) * 72 + kk * 32 + quad * 8), bq = *(const LAS bf16x8*)(kht + (dkt * 16 + li) * 72 + kk * 32 + quad * 8); acc = mfma16(a, bq, acc); }
#pragma unroll
    for (int j = 0; j < 4; ++j) if (!dry) GST[((size_t)task * 128 + w * 16 + quad * 4 + j) * 64 + dkt * 16 + li] = (bf16_t)(pk2(acc[j], 0.f) & 0xffffu); }
  __syncthreads();
}
DI void gla_prefix(const bf16_t* GST, bf16_t* GSO, const float* GDEC, bool dry) {
  const int total = BPG * 4 * 8192;
  for (int gid = blockIdx.x * NTHREADS + tid_(); gid < total; gid += gridDim.x * NTHREADS) {
    const int bh = gid >> 13, e = gid & 8191, dk = e & 63; float S = 0.f;
    for (int c0 = 0; c0 < 64; c0 += 16) { float tv[16], dv[16];
#pragma unroll
      for (int q = 0; q < 16; ++q) { tv[q] = __uint_as_float((unsigned)GST[((size_t)(bh * 64 + c0 + q)) * 8192 + e] << 16); dv[q] = GDEC[(size_t)(bh * 64 + c0 + q) * 64 + dk]; }
#pragma unroll
      for (int q = 0; q < 16; ++q) { if (!dry) GSO[((size_t)(bh * 64 + c0 + q)) * 8192 + e] = (bf16_t)(pk2(S, 0.f) & 0xffffu); S = fmaf(dv[q], S, tv[q]); } }
  }
}
DI void gla_c_task(LAS unsigned char* sm, int task, const bf16_t* QK, bf16_t* VG, const bf16_t* LR, const bf16_t* R, const bf16_t* GST, const GLAP& P, bool dry) {
  const int tid = tid_(), lane = tid & 63, w = tid >> 6, li = lane & 15, quad = lane >> 4;
  const int bh = task >> 6, c = task & 63, b = bh >> 2, h = bh & 3;
  const size_t row0 = (size_t)b * 4096 + c * 64;
  gla_cumdecay(sm, LR, row0, h, P);
  LAS float* bs = (LAS float*)(sm + GL_BS);
  LAS unsigned short* qs = (LAS unsigned short*)(sm + GL_Q); LAS unsigned short* ksm = (LAS unsigned short*)(sm + GL_K);
  LAS unsigned short* vt = (LAS unsigned short*)(sm + GL_VT); LAS unsigned short* st = (LAS unsigned short*)(sm + GL_ST); LAS float* red = (LAS float*)(sm + GL_RED);
  { const int t = tid >> 3, ch = tid & 7;
    const u32x4 qv = *(const u32x4*)(QK + (row0 + t) * 512 + h * 64 + ch * 8), kv = *(const u32x4*)(QK + (row0 + t) * 512 + 256 + h * 64 + ch * 8);
    u32x4 qo, ko;
#pragma unroll
    for (int e = 0; e < 4; ++e) { const int d0 = ch * 8 + 2 * e; const float b0 = bs[t * 65 + d0], b1 = bs[t * 65 + d0 + 1];
      qo[e] = pk2(bf_lo(qv[e]) * 0.125f * __expf(b0), bf_hi(qv[e]) * 0.125f * __expf(b1));
      ko[e] = pk2(bf_lo(kv[e]) * __expf(-b0), bf_hi(kv[e]) * __expf(-b1)); }
    *(LAS u32x4*)(qs + t * 72 + ch * 8) = qo; *(LAS u32x4*)(ksm + t * 72 + ch * 8) = ko; }
  gla_stage_vt(sm, VG, row0, h);
#pragma unroll
  for (int it = 0; it < 2; ++it) { const int id = it * 512 + tid, dv = id >> 3, c8 = id & 7;
    const u32x4 v = *(const u32x4*)(GST + ((size_t)task * 128 + dv) * 64 + c8 * 8);
    *(LAS u32x4*)(st + dv * 72 + c8 * 8) = v; }
  __syncthreads();
  const int qt = w & 3, dvh = w >> 2;
  bf16x8 qf[2];
#pragma unroll
  for (int kk = 0; kk < 2; ++kk) qf[kk] = *(const LAS bf16x8*)(qs + (qt * 16 + li) * 72 + kk * 32 + quad * 8);
  float s[4][4];
#pragma unroll
  for (int jt = 0; jt < 4; ++jt) { f32x4 acc = {0.f, 0.f, 0.f, 0.f};
#pragma unroll
    for (int kk = 0; kk < 2; ++kk) { const bf16x8 a = *(const LAS bf16x8*)(ksm + (jt * 16 + li) * 72 + kk * 32 + quad * 8); acc = mfma16(a, qf[kk], acc); }
#pragma unroll
    for (int j = 0; j < 4; ++j) { const int kj = jt * 16 + quad * 4 + j, qi = qt * 16 + li; s[jt][j] = (kj <= qi) ? acc[j] : 0.f; } }
  bf16x8 pf[2];
#pragma unroll
  for (int pp = 0; pp < 2; ++pp) { u32x4 t; t.x = pk2(s[2 * pp][0], s[2 * pp][1]); t.y = pk2(s[2 * pp][2], s[2 * pp][3]); t.z = pk2(s[2 * pp + 1][0], s[2 * pp + 1][1]); t.w = pk2(s[2 * pp + 1][2], s[2 * pp + 1][3]); pf[pp] = mk8(t); }
  f32x4 o[4]; float ssq = 0.f;
#pragma unroll
  for (int dvt = 0; dvt < 4; ++dvt) { const int dv0 = dvh * 64 + dvt * 16; f32x4 acc = {0.f, 0.f, 0.f, 0.f};
#pragma unroll
    for (int pp = 0; pp < 2; ++pp) { const int kA = 2 * pp * 16 + quad * 4;
      const u32x2 lo = *(const LAS u32x2*)(vt + (dv0 + li) * 72 + kA), hi = *(const LAS u32x2*)(vt + (dv0 + li) * 72 + kA + 16);
      u32x4 t; t.x = lo.x; t.y = lo.y; t.z = hi.x; t.w = hi.y; acc = mfma16(mk8(t), pf[pp], acc); }
#pragma unroll
    for (int kk = 0; kk < 2; ++kk) { const bf16x8 a = *(const LAS bf16x8*)(st + (dv0 + li) * 72 + kk * 32 + quad * 8); acc = mfma16(a, qf[kk], acc); }
    o[dvt] = acc; ssq += acc[0] * acc[0] + acc[1] * acc[1] + acc[2] * acc[2] + acc[3] * acc[3]; }
  ssq += shx(ssq, 16, lane); ssq += shx(ssq, 32, lane);
  if (quad == 0) red[dvh * 64 + qt * 16 + li] = ssq;
  __syncthreads();
  const float tot = red[qt * 16 + li] + red[64 + qt * 16 + li];
  const float rs = rsqrtf(tot * (1.0f / 128.0f) + 1e-6f);
  const size_t row = row0 + qt * 16 + li;
#pragma unroll
  for (int dvt = 0; dvt < 4; ++dvt) { const int dv = dvh * 64 + dvt * 16 + quad * 4;
    const f32x4 gg = *(const f32x4*)(P.gout + dv); const u32x2 rv = *(const u32x2*)(R + row * 512 + h * 128 + dv);
    const float r4[4] = {bf_lo(rv.x), bf_hi(rv.x), bf_lo(rv.y), bf_hi(rv.y)}; float y[4];
#pragma unroll
    for (int j = 0; j < 4; ++j) y[j] = o[dvt][j] * rs * gg[j] * (r4[j] * sigmoidf_(r4[j]));
    u32x2 ov; ov.x = pk2(y[0], y[1]); ov.y = pk2(y[2], y[3]); if (!dry) *(u32x2*)(VG + row * 512 + h * 128 + dv) = ov; }
  __syncthreads();
}

#define XB_TMO      128
#define XB_XCNT(j)  (256  + 64 * (j))
#define XB_XSUB(j)  (1280 + 64 * (j))
#define XB_XGEN(j)  (2304 + 64 * (j))
#define XB_TOP      3328
#define XB_TOPGEN   3392
#define XCD_BAR_WORDS 3456
#define XB_SPIN_CAP (1u << 18)
DI unsigned xb_ld(unsigned* p)              { return __hip_atomic_load(p, __ATOMIC_RELAXED, __HIP_MEMORY_SCOPE_AGENT); }
DI unsigned xb_add(unsigned* p, unsigned v) { return __hip_atomic_fetch_add(p, v, __ATOMIC_RELAXED, __HIP_MEMORY_SCOPE_AGENT); }
DI unsigned xb_xcc_id() { return (unsigned)__builtin_amdgcn_s_getreg((3 << 11) | 20) & 0xFu; }
#define XB_SPIN(cond, bar) do { unsigned _sp = 0; while (cond) { __builtin_amdgcn_s_sleep(1); \
    if ((++_sp & 255u) == 0u) { if (xb_ld(&(bar)[XB_TMO])) break; if (_sp > XB_SPIN_CAP) { atomicAdd(&(bar)[XB_TMO], 1u); break; } } } } while (0)
struct XcdBarrier { unsigned* bar; unsigned x; volatile LAS unsigned* st; };
DI XcdBarrier xcd_barrier_post(unsigned* bar, volatile LAS unsigned* st) {
  XcdBarrier b; b.bar = bar; b.x = xb_xcc_id(); b.st = st;
  if (threadIdx.x == 0) (void)xb_add(&bar[XB_XCNT(b.x)], 1u);
  return b;
}
DI void xcd_barrier_complete(unsigned* bar, unsigned x, unsigned& nloc, unsigned& nx) {
  asm volatile("" : "+s"(bar));
  const unsigned G = gridDim.x * gridDim.y * gridDim.z;
  unsigned sum, cnt, mine, sp = 0u;
  for (;;) {
    sum = 0u; cnt = 0u; mine = 0u;
#pragma unroll
    for (unsigned j = 0; j < 16; ++j) { const unsigned c = xb_ld(&bar[XB_XCNT(j)]); sum += c; cnt += (c > 0u) ? 1u : 0u; mine = (j == x) ? c : mine; }
    if (sum == G) break;
    __builtin_amdgcn_s_sleep(1);
    if ((++sp & 255u) == 0u) { if (xb_ld(&bar[XB_TMO])) break; if (sp > XB_SPIN_CAP) { atomicAdd(&bar[XB_TMO], 1u); break; } }
  }
  nloc = mine > 0u ? mine : 1u; nx = cnt > 0u ? cnt : 1u;
}
DI void xcd_barrier(const XcdBarrier& b) {
  asm volatile("s_waitcnt vmcnt(0)" ::: "memory");
  __syncthreads();
  if (threadIdx.x == 0) {
    unsigned* bar = b.bar; asm volatile("" : "+s"(bar));
    __builtin_amdgcn_s_waitcnt(0);
    unsigned nloc = b.st[0], nx = b.st[1];
    if (nloc == 0u) { xcd_barrier_complete(bar, b.x, nloc, nx); b.st[0] = nloc; b.st[1] = nx; }
    const unsigned old = xb_add(&bar[XB_XSUB(b.x)], 1u);
    const unsigned gen = old / nloc;
    if (old + 1u == (gen + 1u) * nloc) {
      __builtin_amdgcn_fence(__ATOMIC_RELEASE, "agent");
      asm volatile("s_waitcnt vmcnt(0)" ::: "memory");
      const unsigned og = xb_add(&bar[XB_TOP], 1u);
      const unsigned tg = og / nx;
      if (og + 1u == (tg + 1u) * nx) xb_add(&bar[XB_TOPGEN], 1u);
      else XB_SPIN(xb_ld(&bar[XB_TOPGEN]) == tg, bar);
      __builtin_amdgcn_fence(__ATOMIC_ACQUIRE, "agent");
      xb_add(&bar[XB_XGEN(b.x)], 1u);
      asm volatile("s_waitcnt vmcnt(0)" ::: "memory");
    } else {
      XB_SPIN(xb_ld(&bar[XB_XGEN(b.x)]) == gen, bar);
      __builtin_amdgcn_fence(__ATOMIC_ACQUIRE, "agent");
      asm volatile("s_waitcnt vmcnt(0)" ::: "memory");
    }
  }
  __syncthreads();
}

struct Args { const float* in[28]; float* out; unsigned char* ws; int ph_lo, ph_hi; };
constexpr int NPH = 1 + DEPTH * 23 + 1;

__global__ void __launch_bounds__(NTHREADS, 2) mega(Args A) {
  extern __shared__ __attribute__((aligned(16))) unsigned char lds_raw[];
  LAS unsigned char* sm = (LAS unsigned char*)lds_raw;
  cg::grid_group grid = cg::this_grid();
  const int G = gridDim.x, bid = blockIdx.x;
  volatile LAS unsigned* xst = (volatile LAS unsigned*)(sm + LDS_BYTES - 16);
  if (threadIdx.x < 4) xst[threadIdx.x] = 0u;
  __syncthreads();
  XcdBarrier xbar; xbar.bar = (unsigned*)(A.ws + WS_BAR); xbar.x = 0; xbar.st = xst;
  if (A.ph_hi - A.ph_lo > 1) xbar = xcd_barrier_post((unsigned*)(A.ws + WS_BAR), xst);
#ifdef PROBE_A
  unsigned long long tA = 0, tB = 0, tprev = wall_clock64();
#endif

  for (int ph = A.ph_lo; ph < A.ph_hi; ++ph) {
    size_t zo; asm volatile("s_mov_b64 %0, 0" : "=s"(zo));
    unsigned char* ws = A.ws + zo;
    const float* x_in = A.in[0] + zo;
    float* xo = A.out + zo;
    bf16_t* XB = (bf16_t*)(ws + WS_H);
    bf16_t* H = (bf16_t*)xo; bf16_t* PB = (bf16_t*)(ws + WS_P);
    bf16_t* MEMN = (bf16_t*)(ws + WS_MEMN); bf16_t* MKV = (bf16_t*)(ws + WS_MEMKV);
    float* LSE = (float*)(ws + WS_LSE); f32x2* S5E = (f32x2*)(ws + WS_S5E); f32x2* S5C = (f32x2*)(ws + WS_S5C); float* GDEC = (float*)(ws + WS_GDEC); bf16_t* GST = (bf16_t*)((unsigned char*)xo + (size_t)MTOK * 1024 * 2); bf16_t* GSO = GST + (size_t)BPG * 4 * 64 * 8192;
#define IN(i) (A.in[i] + zo)
    int kind, l = 0, grp = 0;
    if (ph == 0) kind = 0; else if (ph == NPH - 1) kind = 17;
    else { const int q = ph - 1; l = q / 23; const int k = q % 23; if (k < 16) { grp = k >> 3; kind = 2 + (k & 7); } else kind = 10 + (k - 16); }
    const float* xsrc = (l == 0) ? x_in : xo;
#ifdef PROBE_REPEAT_MASK
    const int ndry = (int)((PROBE_REPEAT_MASK >> kind) & 1);
#else
    const int ndry = 0;
#endif
    for (int dryi = ndry; dryi >= 0; --dryi) {
    const bool dry = dryi != 0;
    bool isgemm = false; int nrep = 1;
    const int vb = ((G & 7) == 0) ? (bid & 7) * (G >> 3) + (bid >> 3) : bid;
    switch (kind) {
      case 0: {
        for (int ll = 0; ll < DEPTH; ++ll) {
          transpose_w(sm, IN(3) + (size_t)ll * 1024 * 9744, 1024, 9744, (bf16_t*)(ws + WS_WIN) + (size_t)ll * DINP * 1024, DINP, 1);
          transpose_w(sm, IN(12) + (size_t)ll * 512 * 512, 512, 512, (bf16_t*)(ws + WS_WGLU) + (size_t)ll * 512 * 512, 512, 0);
          for (int n = 0; n < 3; ++n) transpose_w(sm, IN(17) + ((size_t)ll * 3 + n) * 512 * 1024, 512, 1024, (bf16_t*)(ws + WS_WBR) + ((size_t)ll * 3 + n) * 1024 * 512, 1024, 0);
          transpose_w(sm, IN(18) + (size_t)ll * 1024 * 1024, 1024, 1024, (bf16_t*)(ws + WS_WOUT) + (size_t)ll * 1024 * 1024, 1024, 0);
          transpose_w(sm, IN(21) + (size_t)ll * 1024 * 1024, 1024, 1024, (bf16_t*)(ws + WS_WXQ) + (size_t)ll * 1024 * 1024, 1024, 0);
          transpose_w(sm, IN(23) + (size_t)ll * 1024 * 1024, 1024, 1024, (bf16_t*)(ws + WS_WXO) + (size_t)ll * 1024 * 1024, 1024, 0);
          transpose_w(sm, IN(22) + (size_t)ll * 1024 * 2048, 1024, 2048, (bf16_t*)(ws + WS_WXKV) + (size_t)ll * 2048 * 1024, 2048, 0);
          transpose_w(sm, IN(25) + (size_t)ll * 1024 * 4096, 1024, 4096, (bf16_t*)(ws + WS_WUP) + (size_t)ll * 4096 * 1024, 4096, 0);
          transpose_w(sm, IN(26) + (size_t)ll * 4096 * 1024, 4096, 1024, (bf16_t*)(ws + WS_WDN) + (size_t)ll * 1024 * 4096, 1024, 0);
        }
        norm_rows_bf16(IN(1), IN(19), MEMN, 2048);
      } break;
      case 3: isgemm = true; nrep = (l == 0 && grp == 0) ? 2 : 1; break;
      case 7: case 8: case 9: case 11: case 13: case 15: case 16: isgemm = true; break;
      case 2: if (l == 0) norm_rows_bf16(x_in + (size_t)grp * MG * 1024, IN(2) + l * 1024, H, MG); else norm_rows_from_bf16(XB + (size_t)grp * MG * 1024, 1024, IN(2) + l * 1024, H, MG); break;
      case 4: {
        S5P sp{IN(4) + l * 2048, IN(5) + l * 2048, IN(6) + l * 32, IN(7) + (size_t)l * 32768, IN(8) + (size_t)l * 32768, IN(9) + (size_t)l * 32768, IN(10) + (size_t)l * 32768, IN(11) + l * 512};
        GLAP gp{IN(14) + l * 4096, IN(15) + l * 256, IN(16) + l * 128};
        constexpr int NA = BPG * 12 * 32, NS = BPG * 256, NGL = BPG * 4 * 64;
        for (int t = vb; t < NA + NS + NGL; t += G) {
          if (t < NA) attn_task(sm, t, PB + P_QA, PB + P_KA, PB + P_VA, LSE, dry);
          else if (t < NA + NS) s5_task(sm, t - NA, 0, PB + P_U, S5E, sp, dry);
          else gla_a_task(sm, t - NA - NS, PB + P_QK, PB + P_VG, PB + P_LR, GST, GDEC, gp, dry);
        }
      } break;
      case 5: { gla_prefix(GST, GSO, GDEC, dry);
        S5P sp{IN(4) + l * 2048, IN(5) + l * 2048, IN(6) + l * 32, IN(7) + (size_t)l * 32768, IN(8) + (size_t)l * 32768, IN(9) + (size_t)l * 32768, IN(10) + (size_t)l * 32768, IN(11) + l * 512};
        s5_carry_scan(S5E, S5C, sp, dry); } break;
      case 6: {
        S5P sp{IN(4) + l * 2048, IN(5) + l * 2048, IN(6) + l * 32, IN(7) + (size_t)l * 32768, IN(8) + (size_t)l * 32768, IN(9) + (size_t)l * 32768, IN(10) + (size_t)l * 32768, IN(11) + l * 512};
        GLAP gp{IN(14) + l * 4096, IN(15) + l * 256, IN(16) + l * 128};
        constexpr int NS = BPG * 256, NGL = BPG * 4 * 64;
        for (int t = bid; t < NS + NGL; t += G) {
          if (t < NS) s5_task(sm, t, 1, PB + P_U, S5C, sp, dry);
          else gla_c_task(sm, t - NS, PB + P_QK, PB + P_VG, PB + P_LR, PB + P_R, GSO, gp, dry);
        }
      } break;
      case 10: norm_rows_from_bf16(XB, 1024, IN(20) + l * 1024, H, MTOK); break;
      case 12: for (int t = vb; t < NB * 4 * 32; t += G) xattn_task(sm, t, PB, MKV, l, dry); break;
      case 14: norm_rows_from_bf16(XB, 1024, IN(24) + l * 1024, H, MTOK); break;
      case 17: final_norm_from_bf16(XB, xo, IN(27), MTOK); break;
      default: break;
    }
    if (isgemm) {
      for (int rep = 0; rep < nrep; ++rep) {
        pg8::Gemm g; Epi E; E.mode = EM_BF16; E.o16 = nullptr; E.ld16 = 0; E.o32 = nullptr; E.r32 = nullptr; E.ld32 = 1024; E.aux = nullptr; E.ldaux = 0; E.bias = nullptr; E.nzm1 = 0; E.r16 = nullptr; E.ldr16 = 1024; int nz = 1;
        bf16_t* MB = PB + P_KA;
        switch (rep == 1 ? 1 : kind) {
          case 1: g = pg8::Gemm{MEMN, (bf16_t*)(ws + WS_WXKV), 2048, 4096, 1024, 1024}; E.mode = EM_BF16; E.o16 = MKV; E.ld16 = 4096; break;
          case 3: g = pg8::Gemm{H, (bf16_t*)(ws + WS_WIN) + (size_t)l * DINP * 1024, MG, DINP, 1024, 1024}; E.mode = EM_PROJ; E.o16 = PB; break;
          case 7: g = pg8::Gemm{PB + P_U, (bf16_t*)(ws + WS_WGLU) + (size_t)l * 512 * 512, MG, 512, 512, 512}; E.mode = EM_GLU; E.o16 = PB + P_QK; E.ld16 = 512; E.aux = PB + P_U; E.ldaux = 512; E.bias = IN(13) + l * 512; break;
          case 8: g = pg8::Gemm{PB + P_QK, (bf16_t*)(ws + WS_WBR) + (size_t)l * 3 * 1024 * 512, MG, 1024, 512, 512};
            g.zA1 = (long)((const char*)(PB + P_VG) - (const char*)(PB + P_QK)); g.zA2 = (long)((const char*)H - (const char*)(PB + P_QK)); g.zB = (long)1024 * 512 * 2; nz = 3;
            E.mode = EM_MERGEZ; E.nzm1 = 2; E.o16 = MB; E.ld16 = 1024; E.aux = PB + P_GATE; E.ldaux = 3072; break;
          case 9: g = pg8::Gemm{MB, (bf16_t*)(ws + WS_WOUT) + (size_t)l * 1024 * 1024, MG, 1024, 1024, 1024}; E.mode = EM_RESID; E.o16 = XB + (size_t)grp * MG * 1024; E.ld16 = 1024; if (l == 0) E.r32 = x_in + (size_t)grp * MG * 1024; else E.r16 = XB + (size_t)grp * MG * 1024; break;
          case 11: g = pg8::Gemm{H, (bf16_t*)(ws + WS_WXQ) + (size_t)l * 1024 * 1024, MTOK, 1024, 1024, 1024}; E.mode = EM_BF16; E.o16 = PB; E.ld16 = 1024; break;
          case 13: g = pg8::Gemm{PB, (bf16_t*)(ws + WS_WXO) + (size_t)l * 1024 * 1024, MTOK, 1024, 1024, 1024}; E.mode = EM_RESID; E.r16 = XB; E.o16 = XB; E.ld16 = 1024; break;
          case 15: g = pg8::Gemm{H, (bf16_t*)(ws + WS_WUP) + (size_t)l * 4096 * 1024, MTOK, 4096, 1024, 1024}; E.mode = EM_RELU2; E.o16 = PB; E.ld16 = 4096; break;
          default: g = pg8::Gemm{PB, (bf16_t*)(ws + WS_WDN) + (size_t)l * 1024 * 4096, MTOK, 1024, 4096, 4096}; E.mode = EM_RESID; E.r16 = XB; E.o16 = XB; E.ld16 = 1024; break;
        }
        g.nz = nz; if (nz == 1) { g.zA1 = 0; g.zA2 = 0; g.zB = 0; }
        g.perm = 1;
        pg8::StaticOrder S; S.init(g.M, g.N, G, bid, nz);
        if (dry) { E.mode = EM_DRY; E.nzm1 = nz - 1; }
        if (nz == 1) pg8::gemm_phase<false, Epi>(sm, g, S, E); else pg8::gemm_phase<true, Epi>(sm, g, S, E);
      }
      if (kind == 7) { if (G > 128) { if (bid >= 128) attn_combine(PB + P_QA, H, LSE, dry, bid - 128, G - 128); } else attn_combine(PB + P_QA, H, LSE, dry, bid, G); }
    }
    }
#ifdef PROBE_A
    { const unsigned long long tn = wall_clock64(); const unsigned long long dt = tn - tprev; tprev = tn;
      if ((PROBE_A >> kind) & 1) tA += dt; if ((PROBE_B >> kind) & 1) tB += dt; }
#endif
    if (ph + 1 < A.ph_hi) { if (ph == A.ph_lo) grid.sync(); else xcd_barrier(xbar); }
#ifdef PROBE_EXTRA_SYNCS
    if (ph == 1) for (int i = 0; i < PROBE_EXTRA_SYNCS; ++i) xcd_barrier(xbar);
#endif
#ifdef PROBE_A
    { const unsigned long long tn = wall_clock64(); const unsigned long long dt = tn - tprev; tprev = tn;
      if ((PROBE_A >> 18) & 1) tA += dt; if ((PROBE_B >> 18) & 1) tB += dt; }
#endif
  }
#ifdef PROBE_A
  {
    float* tw = (float*)(A.ws + WS_LSE);
    if (bid == 0 && tid_() == 0) { tw[0] = (float)tA * 0.01f; tw[1] = (float)tB * 0.01f; __threadfence(); }
    grid.sync();
    const float fa = __builtin_nontemporal_load(tw), fb = __builtin_nontemporal_load(tw + 1);
    for (size_t i = (size_t)bid * NTHREADS + tid_(); i < (size_t)16777216; i += (size_t)G * NTHREADS) A.out[i] += fb;
    if (bid == 1 && tid_() == 0) A.out[(size_t)MTOK * DM - 1] += 64.0f * fa;
  }
#endif
}

extern "C" void kernel_launch(void* const* d_in, const int* in_sizes, int n_in, void* d_out, int out_size, void* d_ws, size_t ws_size, hipStream_t stream) {
  static int grid = 0;
  if (grid == 0) {
    if (n_in != 28 || out_size != MTOK * DM || ws_size < WS_END) { fprintf(stderr, "kernel_launch: unexpected shapes (n_in %d out %d ws %zu need %zu)\n", n_in, out_size, ws_size, (size_t)WS_END); grid = -1; return; }
    int dev = 0, cus = 0, per_cu = 0;
    hipGetDevice(&dev); hipDeviceGetAttribute(&cus, hipDeviceAttributeMultiprocessorCount, dev);
    if (hipFuncSetAttribute((const void*)mega, hipFuncAttributeMaxDynamicSharedMemorySize, LDS_BYTES) != hipSuccess) { fprintf(stderr, "kernel_launch: hipFuncSetAttribute failed\n"); grid = -1; return; }
    hipOccupancyMaxActiveBlocksPerMultiprocessor(&per_cu, (const void*)mega, NTHREADS, LDS_BYTES);
    (void)hipGetLastError();
    if (per_cu < 1) { fprintf(stderr, "kernel_launch: occupancy query says %d blocks per CU\n", per_cu); per_cu = 1; }
    grid = cus;
  }
  if (grid < 0) return;
  if (hipMemsetAsync((unsigned char*)d_ws + WS_BAR, 0, 16384, stream) != hipSuccess) { fprintf(stderr, "kernel_launch: memset of barrier words failed\n"); return; }
  Args a{};
  for (int i = 0; i < 28; ++i) a.in[i] = (const float*)d_in[i];
  a.out = (float*)d_out; a.ws = (unsigned char*)d_ws;
#if MULTI_LAUNCH
  for (int ph = 0; ph < NPH; ++ph) { a.ph_lo = ph; a.ph_hi = ph + 1; hipLaunchKernelGGL(mega, dim3(grid), dim3(NTHREADS), LDS_BYTES, stream, a); }
#else
  a.ph_lo = 0; a.ph_hi = NPH;
  void* args[] = {&a};
  hipError_t e = hipLaunchCooperativeKernel((const void*)mega, dim3(grid), dim3(NTHREADS), args, LDS_BYTES, stream);
  if (e != hipSuccess) fprintf(stderr, "kernel_launch: cooperative launch failed: %s (grid %d)\n", hipGetErrorString(e), grid);
#endif
}
```

```cpp
#include <hip/hip_runtime.h>
#include <hip/hip_cooperative_groups.h>
#include <cstdio>
namespace cg = cooperative_groups;

#ifndef MULTI_LAUNCH
#define MULTI_LAUNCH 0
#endif

#define LAS __attribute__((address_space(3)))
#define DI __device__ __forceinline__
typedef unsigned short bf16_t;
typedef short bf16x8 __attribute__((ext_vector_type(8)));
typedef float f32x4 __attribute__((ext_vector_type(4)));
typedef float f32x2 __attribute__((ext_vector_type(2)));
typedef unsigned u32x4 __attribute__((ext_vector_type(4)));
typedef unsigned u32x2 __attribute__((ext_vector_type(2)));
typedef __bf16 bfv2 __attribute__((ext_vector_type(2)));

constexpr int DM = 1024, SEQ = 4096, NB = 8, MTOK = NB * SEQ, DEPTH = 2;
constexpr int NGRP = 2, MG = MTOK / NGRP, BPG = NB / NGRP;
constexpr int DINP = 9984;
constexpr int NTHREADS = 512;
constexpr int LDS_BYTES = 139264;

constexpr size_t AL(size_t x) { return (x + 255) & ~(size_t)255; }
constexpr size_t WS_WIN = 0;
constexpr size_t WS_WGLU = WS_WIN + AL((size_t)DEPTH * DINP * 1024 * 2);
constexpr size_t WS_WBR = WS_WGLU + AL((size_t)DEPTH * 512 * 512 * 2);
constexpr size_t WS_WOUT = WS_WBR + AL((size_t)DEPTH * 3 * 1024 * 512 * 2);
constexpr size_t WS_WXQ = WS_WOUT + AL((size_t)DEPTH * 1024 * 1024 * 2);
constexpr size_t WS_WXO = WS_WXQ + AL((size_t)DEPTH * 1024 * 1024 * 2);
constexpr size_t WS_WXKV = WS_WXO + AL((size_t)DEPTH * 1024 * 1024 * 2);
constexpr size_t WS_WUP = WS_WXKV + AL((size_t)DEPTH * 2048 * 1024 * 2);
constexpr size_t WS_WDN = WS_WUP + AL((size_t)DEPTH * 4096 * 1024 * 2);
constexpr size_t WS_MEMN = WS_WDN + AL((size_t)DEPTH * 4096 * 1024 * 2);
constexpr size_t WS_MEMKV = WS_MEMN + AL((size_t)2048 * 1024 * 2);
constexpr size_t WS_LSE = WS_MEMKV + AL((size_t)2048 * 4096 * 2);
constexpr size_t WS_S5E = WS_LSE + AL((size_t)MG * 12 * 4);
constexpr size_t WS_S5C = WS_S5E + AL((size_t)BPG * 32 * 64 * 64 * 8);
constexpr size_t WS_GDEC = WS_S5C + AL((size_t)BPG * 32 * 64 * 64 * 8);
constexpr size_t WS_H = WS_GDEC + AL((size_t)BPG * 4 * 64 * 64 * 4);
constexpr size_t WS_GST = WS_H + (size_t)MG * 1024 * 2;
constexpr size_t WS_P = WS_H + AL((size_t)MTOK * 1024 * 2);
constexpr size_t WS_BAR = WS_P + AL((size_t)MG * DINP * 2);
constexpr size_t WS_END = WS_BAR + 16384;
constexpr size_t PE(int tile) { return (size_t)MG * 256 * tile; }
constexpr size_t P_U = PE(0), P_QK = PE(2), P_VG = PE(4), P_R = PE(6), P_QA = PE(8), P_KA = PE(14), P_VA = PE(20), P_GATE = PE(26), P_LR = PE(38);

DI float bf_lo(unsigned u) { return __uint_as_float(u << 16); }
DI float bf_hi(unsigned u) { return __uint_as_float(u & 0xffff0000u); }
DI unsigned pk2(float lo, float hi) { f32x2 v = {lo, hi}; bfv2 r = __builtin_convertvector(v, bfv2); return __builtin_bit_cast(unsigned, r); }
DI int tid_() { int t = threadIdx.x; asm volatile("" : "+v"(t)); return t; }
DI float shx(float v, int m, int lane) { return __builtin_bit_cast(float, __builtin_amdgcn_ds_bpermute((lane ^ m) << 2, __builtin_bit_cast(int, v))); }
DI float wave_sum(float v, int lane) {
#pragma unroll
  for (int m = 32; m >= 1; m >>= 1) v += shx(v, m, lane);
  return v;
}
DI float sigmoidf_(float x) { return 1.0f / (1.0f + __expf(-x)); }
DI f32x4 mfma16(bf16x8 a, bf16x8 b, f32x4 c) { return __builtin_amdgcn_mfma_f32_16x16x32_bf16(a, b, c, 0, 0, 0); }
DI bf16x8 mk8(u32x4 v) { return __builtin_bit_cast(bf16x8, v); }

namespace pg8 {
constexpr int BM = 256, BK = 64, HALF = 128, HTB = HALF * BK * 2, STAGE_BYTES = 8 * HTB, NXCD = 8, WGM = 4;
DI int lds_byte(int r, int c) { const int st = (r >> 4) * 2 + (c >> 5), rr = r & 15, cc = c & 31, ob = rr * 64 + cc * 2; return st * 1024 + (ob ^ (((ob >> 9) & 1) << 5)); }
DI void stage_rc(int b, int& R, int& C) { const int st = b / 1024, sb = b % 1024, swz = sb ^ (((sb >> 9) & 1) << 5); R = (st >> 1) * 16 + swz / 64; C = (st & 1) * 32 + (swz % 64) / 2; }
DI int perm32(int rho) { const int n = rho >> 4, i = rho & 15; return 8 * (i >> 2) + 4 * n + (i & 3); }
struct Unit { int pm, pn, z; };
struct Gemm { const bf16_t* A; const bf16_t* Bt; int M, N, K, lda; long zA1, zA2, zB; int nz, perm; };
struct StaticOrder {
  int nM, nN, nwg, G, c, nz;
  DI void init(int M, int N, int G_, int c_, int nz_) { nM = M / BM; nN = N / BM; nwg = nM * nN; G = G_; c = c_; nz = nz_; }
  DI bool next(int i, Unit& u) const {
    const int ib = (nz == 1) ? i : i / nz; u.z = i - ib * nz;
    const long L = (long)ib * G + c; if (L >= nwg) return false;
    int wgid = (int)L; { const int q = nwg / NXCD, r = nwg % NXCD, xcd = wgid % NXCD, off = wgid / NXCD; wgid = (xcd < r ? xcd * (q + 1) : r * (q + 1) + (xcd - r) * q) + off; }
    const int nig = WGM * nN, gid = wgid / nig, fm = gid * WGM, gsz = (nM - fm) < WGM ? (nM - fm) : WGM;
    u.pm = fm + ((wgid % nig) % gsz); u.pn = (wgid % nig) / gsz; return true;
  }
};

template <bool CHAIN, class Epi>
DI void gemm_phase(LAS unsigned char* lds, const Gemm g, const StaticOrder& S, const Epi& E) {
  const int tid = tid_(), wid = __builtin_amdgcn_readfirstlane(tid >> 6), lane = tid & 63, wr = wid >> 2, wc = wid & 3, fr = lane & 15, fq = lane >> 4;
  const int K = g.K, nt = K / BK, lda = g.lda;
  unsigned voffA[2], voffB[2];
#pragma unroll
  for (int i = 0; i < 2; ++i) { int R, C; stage_rc(tid * 16 + i * 8192, R, C); const int Rb = g.perm ? ((R & ~31) + perm32(R & 31)) : R;
    voffA[i] = (unsigned)(R * lda + C) * 2u; voffB[i] = (unsigned)(Rb * K + C) * 2u; }
  const size_t kstep = (size_t)(BK * 2);
  const size_t hstA = (size_t)HALF * lda * 2, hstB = (size_t)HALF * K * 2;
  const size_t tstA = 2 * hstA, tstB = 2 * hstB;
  const unsigned ldsw = (unsigned)wid * 1024u;
  const int aoff = lds_byte(wr * 64 + fr, fq * 8), boff = lds_byte(wc * 32 + fr, fq * 8);
#define PG8_SA(b, h) (((b) * 2 + (h)) * HTB)
#define PG8_SB(b, h) ((4 + (b) * 2 + (h)) * HTB)
#define PG8_STAGE(bufoff, gbase, voff) do { _Pragma("unroll") for (int _i = 0; _i < 2; ++_i) \
    __builtin_amdgcn_global_load_lds((const unsigned*)((const char*)(gbase) + (voff)[_i]), (LAS unsigned*)(lds + (bufoff) + ldsw + _i * 8192), 16, 0, 0); } while (0)
#define PG8_LDA(dst, b, h) do { _Pragma("unroll") for (int m = 0; m < 4; ++m) _Pragma("unroll") for (int k = 0; k < 2; ++k) dst[m][k] = *(const LAS bf16x8*)(lds + PG8_SA(b, h) + aoff + m * 2048 + k * 1024); } while (0)
#define PG8_LDB(dst, b, h) do { _Pragma("unroll") for (int n = 0; n < 2; ++n) _Pragma("unroll") for (int k = 0; k < 2; ++k) dst[n][k] = *(const LAS bf16x8*)(lds + PG8_SB(b, h) + boff + n * 2048 + k * 1024); } while (0)
#define PG8_MMA(ai, bj, At, Bt) do { __builtin_amdgcn_s_setprio(1); _Pragma("unroll") for (int m = 0; m < 4; ++m) _Pragma("unroll") for (int n = 0; n < 2; ++n) _Pragma("unroll") for (int k = 0; k < 2; ++k) \
    acc[ai][bj][m][n] = __builtin_amdgcn_mfma_f32_16x16x32_bf16(Bt[n][k], At[m][k], acc[ai][bj][m][n], 0, 0, 0); __builtin_amdgcn_s_setprio(0); } while (0)
#define PG8_WAIT_V(n) asm volatile("s_waitcnt vmcnt(" #n ")" ::: "memory")
#define PG8_WAIT_L(n) asm volatile("s_waitcnt lgkmcnt(" #n ")" ::: "memory")
#define PG8_BAR __builtin_amdgcn_s_barrier()
#define PG8_SCHED __builtin_amdgcn_sched_barrier(0)
  Unit cur, nxt; int ui = 0;
  if (!S.next(0, cur)) return;
  f32x4 acc[2][2][4][2];
#pragma unroll
  for (int a = 0; a < 2; ++a)
#pragma unroll
    for (int b = 0; b < 2; ++b)
#pragma unroll
      for (int m = 0; m < 4; ++m)
#pragma unroll
        for (int n = 0; n < 2; ++n) acc[a][b][m][n] = (f32x4){0.f, 0.f, 0.f, 0.f};
  bf16x8 At[4][2], B0[2][2], B1[2][2];
#define PG8_ZA(z) ((z) == 0 ? 0l : ((z) == 1 ? g.zA1 : g.zA2))
  const char* cA = (const char*)g.A + PG8_ZA(cur.z) + (size_t)cur.pm * tstA; const char* cB = (const char*)g.Bt + (long)cur.z * g.zB + (size_t)cur.pn * tstB;
  PG8_STAGE(PG8_SB(0, 0), cB, voffB); PG8_STAGE(PG8_SA(0, 0), cA, voffA); PG8_STAGE(PG8_SB(0, 1), cB + hstB, voffB); PG8_STAGE(PG8_SA(0, 1), cA + hstA, voffA);
  if (wr == 1) PG8_BAR;
  PG8_WAIT_V(4); PG8_BAR;
  PG8_STAGE(PG8_SB(1, 0), cB + kstep, voffB); PG8_STAGE(PG8_SA(1, 0), cA + kstep, voffA); PG8_STAGE(PG8_SB(1, 1), cB + hstB + kstep, voffB);
  PG8_WAIT_V(6); PG8_BAR;
  for (;;) {
    const bool has_next = S.next(ui + 1, nxt);
    const char* nA = has_next ? (const char*)g.A + PG8_ZA(nxt.z) + (size_t)nxt.pm * tstA : cA; const char* nB = has_next ? (const char*)g.Bt + (long)nxt.z * g.zB + (size_t)nxt.pn * tstB : cB;
    for (int t = 0; t < nt; t += 2) {
      const bool last = (t == nt - 2);
      const char* a1 = cA + (size_t)(t + 1) * kstep;
      const char* a2 = last ? nA : cA + (size_t)(t + 2) * kstep; const char* b2 = last ? nB : cB + (size_t)(t + 2) * kstep;
      const char* a3 = a2 + kstep; const char* b3 = b2 + kstep;
      PG8_LDB(B0, 0, 0); PG8_SCHED; PG8_LDA(At, 0, 0); PG8_STAGE(PG8_SA(1, 1), a1 + hstA, voffA);
      PG8_WAIT_L(8); PG8_BAR; PG8_WAIT_L(0); PG8_MMA(0, 0, At, B0); PG8_BAR; PG8_SCHED;
      PG8_LDB(B1, 0, 1); PG8_STAGE(PG8_SB(0, 0), b2, voffB);
      PG8_BAR; PG8_WAIT_L(0); PG8_MMA(0, 1, At, B1); PG8_BAR;
      PG8_LDA(At, 0, 1); PG8_STAGE(PG8_SA(0, 0), a2, voffA);
      PG8_BAR; PG8_WAIT_L(0); PG8_MMA(1, 0, At, B0); PG8_BAR; PG8_SCHED;
      PG8_STAGE(PG8_SB(0, 1), b2 + hstB, voffB);
      PG8_WAIT_V(6); PG8_BAR; PG8_MMA(1, 1, At, B1); PG8_BAR;
      PG8_LDB(B0, 1, 0); PG8_SCHED; PG8_LDA(At, 1, 0); PG8_STAGE(PG8_SA(0, 1), a2 + hstA, voffA);
      PG8_WAIT_L(8); PG8_BAR; PG8_WAIT_L(0); PG8_MMA(0, 0, At, B0); PG8_BAR; PG8_SCHED;
      PG8_LDB(B1, 1, 1); PG8_STAGE(PG8_SB(1, 0), b3, voffB);
      PG8_BAR; PG8_WAIT_L(0); PG8_MMA(0, 1, At, B1); PG8_BAR;
      PG8_LDA(At, 1, 1); PG8_STAGE(PG8_SA(1, 0), a3, voffA);
      PG8_BAR; PG8_WAIT_L(0); PG8_MMA(1, 0, At, B0); PG8_BAR; PG8_SCHED;
      PG8_STAGE(PG8_SB(1, 1), b3 + hstB, voffB);
      PG8_WAIT_V(6); PG8_BAR; PG8_MMA(1, 1, At, B1); PG8_BAR;
    }
#define PG8_ZERO() do { _Pragma("unroll") for (int a = 0; a < 2; ++a) _Pragma("unroll") for (int b = 0; b < 2; ++b) _Pragma("unroll") for (int m = 0; m < 4; ++m) _Pragma("unroll") for (int n = 0; n < 2; ++n) acc[a][b][m][n] = (f32x4){0.f, 0.f, 0.f, 0.f}; } while (0)
    if constexpr (CHAIN) { E.merge(acc, cur, wr, wc, fr, fq); if (!has_next) break; if (cur.z == E.nzm1) PG8_ZERO(); }
    else { E(acc, cur, wr, wc, fr, fq); if (!has_next) break; PG8_ZERO(); }
    cur = nxt; cA = nA; cB = nB; ++ui;
  }
  PG8_WAIT_V(0);
  if (wr == 0) PG8_BAR;
  PG8_BAR;
#undef PG8_ZA
#undef PG8_ZERO
#undef PG8_SA
#undef PG8_SB
#undef PG8_STAGE
#undef PG8_LDA
#undef PG8_LDB
#undef PG8_MMA
#undef PG8_WAIT_V
#undef PG8_WAIT_L
#undef PG8_BAR
#undef PG8_SCHED
}
}

enum { EM_PROJ = 0, EM_BF16, EM_GLU, EM_MERGEZ, EM_RESID, EM_RELU2, EM_DRY };
struct Epi {
  int mode;
  bf16_t* o16; int ld16;
  float* o32; const float* r32; int ld32;
  const bf16_t* r16; int ldr16;
  const bf16_t* aux; int ldaux;
  const float* bias;
  int nzm1;
  DI bool is_chain() const { return nzm1 != 0; }
  DI void operator()(const f32x4 (&acc)[2][2][4][2], const pg8::Unit& u, int wr, int wc, int fr, int fq) const {
    if (mode == EM_DRY) return;
    const int row0 = u.pm * 256 + wr * 64 + fr;
    int colt = u.pn * 256; bf16_t* ob = o16; int ldo = ld16;
    if (mode == EM_PROJ) {
      const int pn = u.pn; int s, ldp;
      if (pn < 8) { s = pn & ~1; ldp = 512; } else if (pn < 14) { s = 8; ldp = 1536; } else if (pn < 20) { s = 14; ldp = 1536; } else if (pn < 26) { s = 20; ldp = 1536; }
      else if (pn < 38) { s = 26; ldp = 3072; } else { s = 38; ldp = 256; }
      ob = o16 + PE(s); ldo = ldp; colt = (pn - s) * 256;
    }
    const int col0 = colt + wc * 32 + 8 * fq;
    if (mode == EM_PROJ || mode == EM_BF16 || mode == EM_RELU2) {
      const bool sq = (mode == EM_RELU2);
#pragma unroll
      for (int ai = 0; ai < 2; ++ai)
#pragma unroll
        for (int m = 0; m < 4; ++m) {
          const size_t row = (size_t)(row0 + ai * 128 + m * 16);
#pragma unroll
          for (int bj = 0; bj < 2; ++bj) {
            f32x4 v0 = acc[ai][bj][m][0], v1 = acc[ai][bj][m][1];
            if (sq) {
#pragma unroll
              for (int j = 0; j < 4; ++j) { const float a = fmaxf(v0[j], 0.f), b = fmaxf(v1[j], 0.f); v0[j] = a * a; v1[j] = b * b; }
            }
            u32x4 w; w.x = pk2(v0[0], v0[1]); w.y = pk2(v0[2], v0[3]); w.z = pk2(v1[0], v1[1]); w.w = pk2(v1[2], v1[3]);
            *(u32x4*)(ob + row * ldo + col0 + bj * 128) = w;
          }
        }
    } else if (mode == EM_RESID) {
      if (r32) {
#pragma unroll
        for (int ai = 0; ai < 2; ++ai)
#pragma unroll
          for (int mp = 0; mp < 2; ++mp) {
            f32x4 rr[2][2][2];
#pragma unroll
            for (int mm = 0; mm < 2; ++mm)
#pragma unroll
              for (int bj = 0; bj < 2; ++bj) { const float* p = r32 + (size_t)(row0 + ai * 128 + (mp * 2 + mm) * 16) * ld32 + col0 + bj * 128; rr[mm][bj][0] = *(const f32x4*)p; rr[mm][bj][1] = *(const f32x4*)(p + 4); }
#pragma unroll
            for (int mm = 0; mm < 2; ++mm)
#pragma unroll
              for (int bj = 0; bj < 2; ++bj) { const size_t row = (size_t)(row0 + ai * 128 + (mp * 2 + mm) * 16);
                const f32x4 t0 = rr[mm][bj][0] + acc[ai][bj][mp * 2 + mm][0], t1 = rr[mm][bj][1] + acc[ai][bj][mp * 2 + mm][1];
                u32x4 w; w.x = pk2(t0[0], t0[1]); w.y = pk2(t0[2], t0[3]); w.z = pk2(t1[0], t1[1]); w.w = pk2(t1[2], t1[3]);
                *(u32x4*)(ob + row * ldo + col0 + bj * 128) = w; }
          }
      } else {
#pragma unroll
        for (int ai = 0; ai < 2; ++ai) {
          u32x4 q[4][2];
#pragma unroll
          for (int m = 0; m < 4; ++m)
#pragma unroll
            for (int bj = 0; bj < 2; ++bj) q[m][bj] = *(const u32x4*)(r16 + (size_t)(row0 + ai * 128 + m * 16) * ldr16 + col0 + bj * 128);
#pragma unroll
          for (int m = 0; m < 4; ++m)
#pragma unroll
            for (int bj = 0; bj < 2; ++bj) { const u32x4 v = q[m][bj];
              const f32x4 t0 = (f32x4){bf_lo(v.x), bf_hi(v.x), bf_lo(v.y), bf_hi(v.y)} + acc[ai][bj][m][0], t1 = (f32x4){bf_lo(v.z), bf_hi(v.z), bf_lo(v.w), bf_hi(v.w)} + acc[ai][bj][m][1];
              u32x4 w; w.x = pk2(t0[0], t0[1]); w.y = pk2(t0[2], t0[3]); w.z = pk2(t1[0], t1[1]); w.w = pk2(t1[2], t1[3]);
              *(u32x4*)(ob + (size_t)(row0 + ai * 128 + m * 16) * ldo + col0 + bj * 128) = w; }
        }
      }
    } else if (mode == EM_GLU) {
      f32x4 bb[2][2];
#pragma unroll
      for (int bj = 0; bj < 2; ++bj) { bb[bj][0] = *(const f32x4*)(bias + col0 + bj * 128); bb[bj][1] = *(const f32x4*)(bias + col0 + bj * 128 + 4); }
#pragma unroll
      for (int ai = 0; ai < 2; ++ai) {
        u32x4 gq[4][2];
#pragma unroll
        for (int m = 0; m < 4; ++m)
#pragma unroll
          for (int bj = 0; bj < 2; ++bj) gq[m][bj] = *(const u32x4*)(aux + (size_t)(row0 + ai * 128 + m * 16) * ldaux + col0 + bj * 128);
#pragma unroll
        for (int m = 0; m < 4; ++m)
#pragma unroll
          for (int bj = 0; bj < 2; ++bj) {
            const u32x4 q = gq[m][bj]; const f32x4 v0 = acc[ai][bj][m][0], v1 = acc[ai][bj][m][1];
            const float gv[8] = {bf_lo(q.x), bf_hi(q.x), bf_lo(q.y), bf_hi(q.y), bf_lo(q.z), bf_hi(q.z), bf_lo(q.w), bf_hi(q.w)};
            float o[8];
#pragma unroll
            for (int j = 0; j < 4; ++j) { o[j] = gv[j] * sigmoidf_(v0[j] + bb[bj][0][j]); o[4 + j] = gv[4 + j] * sigmoidf_(v1[j] + bb[bj][1][j]); }
            u32x4 w; w.x = pk2(o[0], o[1]); w.y = pk2(o[2], o[3]); w.z = pk2(o[4], o[5]); w.w = pk2(o[6], o[7]);
            *(u32x4*)(ob + (size_t)(row0 + ai * 128 + m * 16) * ldo + col0 + bj * 128) = w;
          }
      }
    }
  }
  DI void merge(f32x4 (&acc)[2][2][4][2], const pg8::Unit& u, int wr, int wc, int fr, int fq) const {
    if (mode == EM_DRY) return;
    const int row0 = u.pm * 256 + wr * 64 + fr, col0 = u.pn * 256 + wc * 32 + 8 * fq;
    bf16_t* ob = o16; const int ldo = ld16;
    {
      const int z = u.z;
#pragma unroll
      for (int ai = 0; ai < 2; ++ai)
#pragma unroll
        for (int mp = 0; mp < 2; ++mp) {
          u32x4 g0[2][2], g1[2][2];
#pragma unroll
          for (int mm = 0; mm < 2; ++mm)
#pragma unroll
            for (int bj = 0; bj < 2; ++bj) { const bf16_t* p = aux + (size_t)(row0 + ai * 128 + (mp * 2 + mm) * 16) * ldaux + z * 1024 + col0 + bj * 128;
              g0[mm][bj] = *(const u32x4*)p; g1[mm][bj] = (z < 2) ? *(const u32x4*)(p + 1024) : (u32x4){0u, 0u, 0u, 0u}; }
#pragma unroll
          for (int mm = 0; mm < 2; ++mm)
#pragma unroll
            for (int bj = 0; bj < 2; ++bj) {
              const int m = mp * 2 + mm; const size_t row = (size_t)(row0 + ai * 128 + m * 16);
              f32x4& a0 = acc[ai][bj][m][0]; f32x4& a1 = acc[ai][bj][m][1];
#pragma unroll
              for (int e2 = 0; e2 < 4; ++e2) {
                const float l0a = bf_lo(g0[mm][bj][e2]), l0b = bf_hi(g0[mm][bj][e2]), l1a = bf_lo(g1[mm][bj][e2]), l1b = bf_hi(g1[mm][bj][e2]);
                float fa = __builtin_amdgcn_rcpf(1.0f + __expf(-l0a)), fb = __builtin_amdgcn_rcpf(1.0f + __expf(-l0b));
                if (z < 2) { fa *= 1.0f + __expf(-l1a); fb *= 1.0f + __expf(-l1b); }
                if (e2 < 2) { a0[2 * e2] *= fa; a0[2 * e2 + 1] *= fb; } else { a1[2 * e2 - 4] *= fa; a1[2 * e2 - 3] *= fb; }
              }
              if (z == 2) { u32x4 w; w.x = pk2(a0[0], a0[1]); w.y = pk2(a0[2], a0[3]); w.z = pk2(a1[0], a1[1]); w.w = pk2(a1[2], a1[3]);
                *(u32x4*)(ob + row * ldo + col0 + bj * 128) = w; }
            }
        }
    }
  }
};

DI void norm_rows_bf16(const float* x, const float* gain, bf16_t* H, int nrows) {
  const int tid = tid_(), lane = tid & 63, gw = blockIdx.x * 8 + (tid >> 6), nw = gridDim.x * 8;
  f32x4 g[4];
#pragma unroll
  for (int i = 0; i < 4; ++i) g[i] = *(const f32x4*)(gain + i * 256 + lane * 4);
  for (int r = gw * 4; r < nrows; r += nw * 4) {
    f32x4 v[4][4];
#pragma unroll
    for (int q = 0; q < 4; ++q)
#pragma unroll
      for (int i = 0; i < 4; ++i) v[q][i] = *(const f32x4*)(x + (size_t)(r + q) * 1024 + i * 256 + lane * 4);
#pragma unroll
    for (int q = 0; q < 4; ++q) {
      float ss = 0.f;
#pragma unroll
      for (int i = 0; i < 4; ++i) ss += v[q][i][0] * v[q][i][0] + v[q][i][1] * v[q][i][1] + v[q][i][2] * v[q][i][2] + v[q][i][3] * v[q][i][3];
      ss = wave_sum(ss, lane);
      const float rs = rsqrtf(ss * (1.0f / 1024.0f) + 1e-6f);
#pragma unroll
      for (int i = 0; i < 4; ++i) { u32x2 w; w.x = pk2(v[q][i][0] * rs * g[i][0], v[q][i][1] * rs * g[i][1]); w.y = pk2(v[q][i][2] * rs * g[i][2], v[q][i][3] * rs * g[i][3]);
        *(u32x2*)(H + (size_t)(r + q) * 1024 + i * 256 + lane * 4) = w; }
    }
  }
}
DI void norm_rows_from_bf16(const bf16_t* xb, int ldx, const float* gain, bf16_t* H, int nrows) {
  const int tid = tid_(), lane = tid & 63, gw = blockIdx.x * 8 + (tid >> 6), nw = gridDim.x * 8;
  f32x4 g[4];
#pragma unroll
  for (int i = 0; i < 2; ++i) { g[2 * i] = *(const f32x4*)(gain + i * 512 + lane * 8); g[2 * i + 1] = *(const f32x4*)(gain + i * 512 + lane * 8 + 4); }
  for (int r = gw * 8; r < nrows; r += nw * 8) {
    u32x4 v[8][2];
#pragma unroll
    for (int q = 0; q < 8; ++q)
#pragma unroll
      for (int i = 0; i < 2; ++i) v[q][i] = *(const u32x4*)(xb + (size_t)(r + q) * ldx + i * 512 + lane * 8);
#pragma unroll
    for (int q = 0; q < 8; ++q) {
      float f[16];
#pragma unroll
      for (int i = 0; i < 2; ++i)
#pragma unroll
        for (int e = 0; e < 4; ++e) { f[i * 8 + 2 * e] = bf_lo(v[q][i][e]); f[i * 8 + 2 * e + 1] = bf_hi(v[q][i][e]); }
      float ss = 0.f;
#pragma unroll
      for (int e = 0; e < 16; ++e) ss += f[e] * f[e];
      ss = wave_sum(ss, lane);
      const float rs = rsqrtf(ss * (1.0f / 1024.0f) + 1e-6f);
#pragma unroll
      for (int i = 0; i < 2; ++i) { u32x4 w;
#pragma unroll
        for (int e = 0; e < 4; ++e) w[e] = pk2(f[i * 8 + 2 * e] * rs * g[2 * i + (e >> 1)][(2 * e) & 3], f[i * 8 + 2 * e + 1] * rs * g[2 * i + (e >> 1)][(2 * e + 1) & 3]);
        *(u32x4*)(H + (size_t)(r + q) * 1024 + i * 512 + lane * 8) = w; }
    }
  }
}
DI void final_norm_expand(float* out, const float* gain, int nrows) {
  const int tid = tid_(), lane = tid & 63, gw = blockIdx.x * 8 + (tid >> 6), nw = gridDim.x * 8;
  f32x4 g[4];
#pragma unroll
  for (int i = 0; i < 2; ++i) { g[2 * i] = *(const f32x4*)(gain + i * 512 + lane * 8); g[2 * i + 1] = *(const f32x4*)(gain + i * 512 + lane * 8 + 4); }
  for (int r = gw; r < nrows; r += nw) {
    const bf16_t* xb = (const bf16_t*)(out + (size_t)r * 1024);
    u32x4 v[2];
#pragma unroll
    for (int i = 0; i < 2; ++i) v[i] = *(const u32x4*)(xb + i * 512 + lane * 8);
    float f[16];
#pragma unroll
    for (int i = 0; i < 2; ++i)
#pragma unroll
      for (int e = 0; e < 4; ++e) { f[i * 8 + 2 * e] = bf_lo(v[i][e]); f[i * 8 + 2 * e + 1] = bf_hi(v[i][e]); }
    float ss = 0.f;
#pragma unroll
    for (int e = 0; e < 16; ++e) ss += f[e] * f[e];
    ss = wave_sum(ss, lane);
    const float rs = rsqrtf(ss * (1.0f / 1024.0f) + 1e-6f);
    asm volatile("s_waitcnt vmcnt(0)" ::: "memory");
#pragma unroll
    for (int i = 0; i < 2; ++i) { f32x4 o0, o1;
#pragma unroll
      for (int e = 0; e < 4; ++e) { o0[e] = f[i * 8 + e] * rs * g[2 * i][e]; o1[e] = f[i * 8 + 4 + e] * rs * g[2 * i + 1][e]; }
      *(f32x4*)(out + (size_t)r * 1024 + i * 512 + lane * 8) = o0; *(f32x4*)(out + (size_t)r * 1024 + i * 512 + lane * 8 + 4) = o1; }
  }
}
DI void final_norm_from_bf16(const bf16_t* xb, float* out, const float* gain, int nrows) {
  const int tid = tid_(), lane = tid & 63, gw = blockIdx.x * 8 + (tid >> 6), nw = gridDim.x * 8;
  f32x4 g[4];
#pragma unroll
  for (int i = 0; i < 2; ++i) { g[2 * i] = *(const f32x4*)(gain + i * 512 + lane * 8); g[2 * i + 1] = *(const f32x4*)(gain + i * 512 + lane * 8 + 4); }
  for (int r = gw * 2; r < nrows; r += nw * 2) {
    u32x4 v[2][2];
#pragma unroll
    for (int q = 0; q < 2; ++q)
#pragma unroll
      for (int i = 0; i < 2; ++i) v[q][i] = *(const u32x4*)(xb + (size_t)(r + q) * 1024 + i * 512 + lane * 8);
#pragma unroll
    for (int q = 0; q < 2; ++q) {
      float f[16];
#pragma unroll
      for (int i = 0; i < 2; ++i)
#pragma unroll
        for (int e = 0; e < 4; ++e) { f[i * 8 + 2 * e] = bf_lo(v[q][i][e]); f[i * 8 + 2 * e + 1] = bf_hi(v[q][i][e]); }
      float ss = 0.f;
#pragma unroll
      for (int e = 0; e < 16; ++e) ss += f[e] * f[e];
      ss = wave_sum(ss, lane);
      const float rs = rsqrtf(ss * (1.0f / 1024.0f) + 1e-6f);
#pragma unroll
      for (int i = 0; i < 2; ++i) { f32x4 o0, o1;
#pragma unroll
        for (int e = 0; e < 4; ++e) { o0[e] = f[i * 8 + e] * rs * g[2 * i][e]; o1[e] = f[i * 8 + 4 + e] * rs * g[2 * i + 1][e]; }
        *(f32x4*)(out + (size_t)(r + q) * 1024 + i * 512 + lane * 8) = o0; *(f32x4*)(out + (size_t)(r + q) * 1024 + i * 512 + lane * 8 + 4) = o1; }
    }
  }
}
DI void norm_rows_f32_inplace(float* x, const float* gain, int nrows) {
  const int tid = tid_(), lane = tid & 63, gw = blockIdx.x * 8 + (tid >> 6), nw = gridDim.x * 8;
  f32x4 g[4];
#pragma unroll
  for (int i = 0; i < 4; ++i) g[i] = *(const f32x4*)(gain + i * 256 + lane * 4);
  for (int r = gw * 2; r < nrows; r += nw * 2) {
    f32x4 v[2][4];
#pragma unroll
    for (int q = 0; q < 2; ++q)
#pragma unroll
      for (int i = 0; i < 4; ++i) v[q][i] = *(const f32x4*)(x + (size_t)(r + q) * 1024 + i * 256 + lane * 4);
#pragma unroll
    for (int q = 0; q < 2; ++q) {
      float ss = 0.f;
#pragma unroll
      for (int i = 0; i < 4; ++i) ss += v[q][i][0] * v[q][i][0] + v[q][i][1] * v[q][i][1] + v[q][i][2] * v[q][i][2] + v[q][i][3] * v[q][i][3];
      ss = wave_sum(ss, lane);
      const float rs = rsqrtf(ss * (1.0f / 1024.0f) + 1e-6f);
#pragma unroll
      for (int i = 0; i < 4; ++i) { f32x4 o; o[0] = v[q][i][0] * rs * g[i][0]; o[1] = v[q][i][1] * rs * g[i][1]; o[2] = v[q][i][2] * rs * g[i][2]; o[3] = v[q][i][3] * rs * g[i][3];
        *(f32x4*)(x + (size_t)(r + q) * 1024 + i * 256 + lane * 4) = o; }
    }
  }
}

DI int win_map(int n) { return n < 1536 ? n : (n < 9728 ? n + 16 : (n < 9744 ? n - 9728 + 1536 : -1)); }
DI void transpose_w(LAS unsigned char* sm, const float* src, int K, int Ns, bf16_t* dst, int Nd, int mapmode) {
  LAS float* tile = (LAS float*)sm;
  const int tid = tid_(), tn = Nd / 64, tk = K / 64;
  for (int t = blockIdx.x; t < tn * tk; t += gridDim.x) {
    const int n0 = (t / tk) * 64, k0 = (t % tk) * 64;
    float tv[8];
#pragma unroll
    for (int it = 0; it < 8; ++it) { const int idx = it * 512 + tid, kk = idx >> 6, nn = idx & 63;
      const int sc = mapmode ? win_map(n0 + nn) : (n0 + nn);
      tv[it] = sc >= 0 ? src[(size_t)(k0 + kk) * Ns + sc] : 0.f; }
#pragma unroll
    for (int it = 0; it < 8; ++it) { const int idx = it * 512 + tid, kk = idx >> 6, nn = idx & 63; tile[kk * 65 + nn] = tv[it]; }
    __syncthreads();
    { const int nn = tid >> 3, kc = tid & 7; float f[8];
#pragma unroll
      for (int e = 0; e < 8; ++e) f[e] = tile[(kc * 8 + e) * 65 + nn];
      u32x4 w; w.x = pk2(f[0], f[1]); w.y = pk2(f[2], f[3]); w.z = pk2(f[4], f[5]); w.w = pk2(f[6], f[7]);
      *(u32x4*)(dst + (size_t)(n0 + nn) * K + k0 + kc * 8) = w; }
    __syncthreads();
  }
}

DI void attn_task(LAS unsigned char* sm, int task, bf16_t* QA, const bf16_t* KA, const bf16_t* VA, float* LSE, bool dry) {
  const int tid = tid_(), lane = tid & 63, w = tid >> 6, li = lane & 15, quad = lane >> 4;
  const int bh = task >> 5, sub = task & 31;
  const int b = bh / 12, h = bh - b * 12, g = h >> 2, dsh = g * 2, dil = 1 << dsh, nblk = 32 >> dsh;
  const int r = sub / nblk, n = sub - r * nblk;
  LAS unsigned char* ks = sm;
  LAS unsigned short* vt = (LAS unsigned short*)(sm + 69632);
  {
    u32x4 kv[8], vv[8];
#pragma unroll
    for (int it = 0; it < 8; ++it) {
      const int id = it * 512 + tid, row = id >> 4, cc = id & 15, sp = n * 128 - 128 + row;
      kv[it] = (u32x4){0u, 0u, 0u, 0u};
      if (sp >= 0) kv[it] = *(const u32x4*)(KA + ((size_t)b * 4096 + (size_t)(sp * dil + r)) * 1536 + h * 128 + cc * 8);
    }
#pragma unroll
    for (int it = 0; it < 8; ++it) {
      const int id = it * 512 + tid, key = id & 255, cc = id >> 8, sp = n * 128 - 128 + key;
      vv[it] = (u32x4){0u, 0u, 0u, 0u};
      if (sp >= 0) vv[it] = *(const u32x4*)(VA + ((size_t)b * 4096 + (size_t)(sp * dil + r)) * 1536 + h * 128 + cc * 8);
    }
#pragma unroll
    for (int it = 0; it < 8; ++it) { const int id = it * 512 + tid, row = id >> 4, cc = id & 15; *(LAS u32x4*)(ks + row * 272 + cc * 16) = kv[it]; }
#pragma unroll
    for (int it = 0; it < 8; ++it) { const int id = it * 512 + tid, key = id & 255, cc = id >> 8;
#pragma unroll
      for (int e = 0; e < 4; ++e) { vt[(cc * 8 + 2 * e) * 264 + key] = (unsigned short)(vv[it][e] & 0xffffu); vt[(cc * 8 + 2 * e + 1) * 264 + key] = (unsigned short)(vv[it][e] >> 16); } }
  }
  __syncthreads();
  const int qsp = n * 128 + w * 16 + li;
  const size_t qtok = (size_t)b * 4096 + (size_t)(qsp * dil + r);
  bf16_t* qptr = QA + qtok * 1536 + h * 128;
  bf16x8 qf[4];
#pragma unroll
  for (int kk = 0; kk < 4; ++kk) qf[kk] = *(const bf16x8*)(qptr + kk * 32 + quad * 8);
  const int kt0 = w < 6 ? w : 6;
  const float sc = 0.08838834764831845f * 1.4426950408889634f;
  const float sl = exp2f(-8.0f * (float)(h + 1) / 12.0f) * (float)dil * 1.4426950408889634f;
  float s[10][4]; float mx = -1e30f;
#pragma unroll
  for (int tt = 0; tt < 10; ++tt) {
    const int kt = kt0 + tt; f32x4 acc = {0.f, 0.f, 0.f, 0.f};
#pragma unroll
    for (int kk = 0; kk < 4; ++kk) { const bf16x8 a = *(const LAS bf16x8*)(ks + (kt * 16 + li) * 272 + kk * 64 + quad * 16); acc = mfma16(a, qf[kk], acc); }
#pragma unroll
    for (int j = 0; j < 4; ++j) { const int kl = kt * 16 + quad * 4 + j, dist = 128 + w * 16 + li - kl;
      const bool valid = dist >= 0 && dist <= 128 && (n > 0 || kl >= 128);
      const float v = acc[j] * sc - sl * (float)dist; s[tt][j] = valid ? v : -1e30f; mx = fmaxf(mx, s[tt][j]); }
  }
  mx = fmaxf(mx, shx(mx, 16, lane)); mx = fmaxf(mx, shx(mx, 32, lane));
  float lsum = 0.f;
#pragma unroll
  for (int tt = 0; tt < 10; ++tt)
#pragma unroll
    for (int j = 0; j < 4; ++j) { const float p = exp2f(s[tt][j] - mx); s[tt][j] = p; lsum += p; }
  lsum += shx(lsum, 16, lane); lsum += shx(lsum, 32, lane);
  bf16x8 pf[5];
#pragma unroll
  for (int pp = 0; pp < 5; ++pp) { u32x4 t; t.x = pk2(s[2 * pp][0], s[2 * pp][1]); t.y = pk2(s[2 * pp][2], s[2 * pp][3]); t.z = pk2(s[2 * pp + 1][0], s[2 * pp + 1][1]); t.w = pk2(s[2 * pp + 1][2], s[2 * pp + 1][3]); pf[pp] = mk8(t); }
  const float inv = 1.0f / lsum;
#pragma unroll
  for (int dvt = 0; dvt < 8; ++dvt) {
    f32x4 acc = {0.f, 0.f, 0.f, 0.f};
#pragma unroll
    for (int pp = 0; pp < 5; ++pp) { const int kA = (kt0 + 2 * pp) * 16 + quad * 4;
      const u32x2 lo = *(const LAS u32x2*)(vt + (dvt * 16 + li) * 264 + kA), hi = *(const LAS u32x2*)(vt + (dvt * 16 + li) * 264 + kA + 16);
      u32x4 t; t.x = lo.x; t.y = lo.y; t.z = hi.x; t.w = hi.y; acc = mfma16(mk8(t), pf[pp], acc); }
    u32x2 o; o.x = pk2(acc[0] * inv, acc[1] * inv); o.y = pk2(acc[2] * inv, acc[3] * inv);
    if (!dry) *(u32x2*)(qptr + dvt * 16 + quad * 4) = o;
  }
  if (quad == 0 && !dry) LSE[qtok * 12 + h] = (mx + log2f(lsum)) * 0.6931471805599453f;
  __syncthreads();
}

DI void attn_combine(const bf16_t* QA, bf16_t* YC, const float* LSE, bool dry, int bidx, int nblk) {
  const int nitem = MG * 4 * 16;
  int gs = nblk * NTHREADS; asm volatile("" : "+s"(gs));
  for (int it = bidx * NTHREADS + tid_(); it < nitem; it += gs) {
    const int t = it >> 6, hg = (it >> 4) & 3, dc = it & 15;
    const float l0 = LSE[(size_t)t * 12 + hg], l1 = LSE[(size_t)t * 12 + 4 + hg], l2 = LSE[(size_t)t * 12 + 8 + hg];
    const float m = fmaxf(l0, fmaxf(l1, l2));
    float w0 = __expf(l0 - m), w1 = __expf(l1 - m), w2 = __expf(l2 - m); const float iv = 1.0f / (w0 + w1 + w2); w0 *= iv; w1 *= iv; w2 *= iv;
    const bf16_t* p = QA + (size_t)t * 1536 + hg * 128 + dc * 8;
    const u32x4 a = *(const u32x4*)p, b = *(const u32x4*)(p + 512), c = *(const u32x4*)(p + 1024);
    u32x4 o;
#pragma unroll
    for (int e = 0; e < 4; ++e) o[e] = pk2(w0 * bf_lo(a[e]) + w1 * bf_lo(b[e]) + w2 * bf_lo(c[e]), w0 * bf_hi(a[e]) + w1 * bf_hi(b[e]) + w2 * bf_hi(c[e]));
    if (!dry) *(u32x4*)(YC + (size_t)t * 512 + hg * 128 + dc * 8) = o;
  }
}

DI void xattn_task(LAS unsigned char* sm, int task, bf16_t* XQ, const bf16_t* MKV, int l, bool dry) {
  const int tid = tid_(), lane = tid & 63, w = tid >> 6, li = lane & 15, quad = lane >> 4;
  const int b = task >> 7, hx = (task >> 5) & 3, n = task & 31;
  LAS unsigned short* vt = (LAS unsigned short*)sm;
  {
    u32x4 kv[16];
#pragma unroll
    for (int it = 0; it < 16; ++it) { const int id = it * 512 + tid, row = id >> 5, cc = id & 31;
      kv[it] = *(const u32x4*)(MKV + (size_t)(b * 256 + row) * 4096 + l * 2048 + hx * 256 + cc * 8); }
#pragma unroll
    for (int it = 0; it < 16; ++it) { const int id = it * 512 + tid, row = id >> 5, cc = id & 31; *(LAS u32x4*)(sm + row * 528 + cc * 16) = kv[it]; }
  }
  __syncthreads();
  const size_t qtok = (size_t)b * 4096 + n * 128 + w * 16 + li;
  bf16_t* qptr = XQ + qtok * 1024 + hx * 256;
  bf16x8 qf[8];
#pragma unroll
  for (int kk = 0; kk < 8; ++kk) qf[kk] = *(const bf16x8*)(qptr + kk * 32 + quad * 8);
  float s[16][4]; float mx = -1e30f;
  const float sc = 0.0625f * 1.4426950408889634f;
#pragma unroll
  for (int kt = 0; kt < 16; ++kt) { f32x4 acc = {0.f, 0.f, 0.f, 0.f};
#pragma unroll
    for (int kk = 0; kk < 8; ++kk) { const bf16x8 a = *(const LAS bf16x8*)(sm + (kt * 16 + li) * 528 + kk * 64 + quad * 16); acc = mfma16(a, qf[kk], acc); }
#pragma unroll
    for (int j = 0; j < 4; ++j) { s[kt][j] = acc[j] * sc; mx = fmaxf(mx, s[kt][j]); } }
  mx = fmaxf(mx, shx(mx, 16, lane)); mx = fmaxf(mx, shx(mx, 32, lane));
  float lsum = 0.f;
#pragma unroll
  for (int kt = 0; kt < 16; ++kt)
#pragma unroll
    for (int j = 0; j < 4; ++j) { const float p = exp2f(s[kt][j] - mx); s[kt][j] = p; lsum += p; }
  lsum += shx(lsum, 16, lane); lsum += shx(lsum, 32, lane);
  bf16x8 pf[8];
#pragma unroll
  for (int pp = 0; pp < 8; ++pp) { u32x4 t; t.x = pk2(s[2 * pp][0], s[2 * pp][1]); t.y = pk2(s[2 * pp][2], s[2 * pp][3]); t.z = pk2(s[2 * pp + 1][0], s[2 * pp + 1][1]); t.w = pk2(s[2 * pp + 1][2], s[2 * pp + 1][3]); pf[pp] = mk8(t); }
  const float inv = 1.0f / lsum;
  {
    u32x4 vv[16];
#pragma unroll
    for (int it = 0; it < 16; ++it) { const int id = it * 512 + tid, key = id & 255, cc = id >> 8;
      vv[it] = *(const u32x4*)(MKV + (size_t)(b * 256 + key) * 4096 + l * 2048 + 1024 + hx * 256 + cc * 8); }
    __syncthreads();
#pragma unroll
    for (int it = 0; it < 16; ++it) { const int id = it * 512 + tid, key = id & 255, cc = id >> 8;
#pragma unroll
      for (int e = 0; e < 4; ++e) { vt[(cc * 8 + 2 * e) * 264 + key] = (unsigned short)(vv[it][e] & 0xffffu); vt[(cc * 8 + 2 * e + 1) * 264 + key] = (unsigned short)(vv[it][e] >> 16); } }
  }
  __syncthreads();
#pragma unroll
  for (int dvt = 0; dvt < 16; ++dvt) {
    f32x4 acc = {0.f, 0.f, 0.f, 0.f};
#pragma unroll
    for (int pp = 0; pp < 8; ++pp) { const int kA = 2 * pp * 16 + quad * 4;
      const u32x2 lo = *(const LAS u32x2*)(vt + (dvt * 16 + li) * 264 + kA), hi = *(const LAS u32x2*)(vt + (dvt * 16 + li) * 264 + kA + 16);
      u32x4 t; t.x = lo.x; t.y = lo.y; t.z = hi.x; t.w = hi.y; acc = mfma16(mk8(t), pf[pp], acc); }
    u32x2 o; o.x = pk2(acc[0] * inv, acc[1] * inv); o.y = pk2(acc[2] * inv, acc[3] * inv);
    if (!dry) *(u32x2*)(qptr + dvt * 16 + quad * 4) = o;
  }
  __syncthreads();
}

struct S5P { const float *a_re, *a_im, *log_step, *b_re, *b_im, *c_re, *c_im, *d; };
DI void s5_lambar(const S5P& P, int g, int p, float& lbr, float& lbi) {
  const float step = __expf(P.log_step[g]);
  const float ar = P.a_re[g * 64 + p], ai = P.a_im[g * 64 + p];
  const float mag = __expf(ar * step);
  float sn, cs; { const float x = ai * step; const float k = rintf(x * 0.15915494309189535f); float rr = fmaf(-k, 6.2831854820251465f, x); rr = fmaf(-k, -1.7484556000744883e-07f, rr); sn = sinf(rr); cs = cosf(rr); }
  lbr = mag * cs; lbi = mag * sn;
}
DI void s5_carry_scan(const f32x2* E, f32x2* C, const S5P& P, bool dry) {
  const int total = BPG * 32 * 64;
  for (int gid = blockIdx.x * NTHREADS + tid_(); gid < total; gid += gridDim.x * NTHREADS) {
    const int p = gid & 63, g = (gid >> 6) & 31, b = gid >> 11;
    float lr_, li_; s5_lambar(P, g, p, lr_, li_);
#pragma unroll
    for (int q = 0; q < 6; ++q) { const float t0 = lr_ * lr_ - li_ * li_, t1 = 2.0f * lr_ * li_; lr_ = t0; li_ = t1; }
    const size_t base = (((size_t)b * 32 + g) * 64) * 64 + p;
    float sr = 0.f, si = 0.f;
    for (int c0 = 0; c0 < 64; c0 += 8) { f32x2 ev[8];
#pragma unroll
      for (int q = 0; q < 8; ++q) ev[q] = E[base + (size_t)(c0 + q) * 64];
#pragma unroll
      for (int q = 0; q < 8; ++q) { if (!dry) { f32x2 o = {sr, si}; C[base + (size_t)(c0 + q) * 64] = o; }
        const float t0 = lr_ * sr - li_ * si + ev[q][0], t1 = lr_ * si + li_ * sr + ev[q][1]; sr = t0; si = t1; } }
  }
}
DI float bperm(float v, int srclane) { return __builtin_bit_cast(float, __builtin_amdgcn_ds_bpermute(srclane << 2, __builtin_bit_cast(int, v))); }
DI void s5_task(LAS unsigned char* sm, int task, int mode, bf16_t* U, f32x2* E, const S5P& P, bool dry) {
  const int tid = tid_(), lane = tid & 63, w = tid >> 6, li = lane & 15, quad = lane >> 4;
  const int b = task >> 8, c = (task >> 2) & 63, oct = task & 3;
  const size_t row0 = (size_t)b * 4096 + c * 64;
  { u32x4 v[2];
#pragma unroll
    for (int it = 0; it < 2; ++it) { const int id = it * 512 + tid, t = id >> 4, cc = id & 15; v[it] = *(const u32x4*)(U + (row0 + t) * 512 + oct * 128 + cc * 8); }
#pragma unroll
    for (int it = 0; it < 2; ++it) { const int id = it * 512 + tid, t = id >> 4, cc = id & 15; *(LAS u32x4*)(sm + t * 272 + cc * 16) = v[it]; } }
  __syncthreads();
  const int g = oct * 8 + w;
  float l1r[4], l1i[4], l2r[4], l2i[4], l3r[4], l3i[4], l4r[4], l4i[4], spr[4], spi[4];
  bf16x8 Bre[4], Bim[4];
#pragma unroll
  for (int pb = 0; pb < 4; ++pb) {
    const int p = pb * 16 + li;
    float lr, lim; s5_lambar(P, g, p, lr, lim);
    const float ar = P.a_re[g * 64 + p], ai = P.a_im[g * 64 + p];
    const float iv = 1.0f / (ar * ar + ai * ai), nr = lr - 1.0f, ni = lim;
    const float cr = (nr * ar + ni * ai) * iv, ci = (ni * ar - nr * ai) * iv;
    u32x4 tre = {0u, 0u, 0u, 0u}, tim = {0u, 0u, 0u, 0u};
    if (quad < 2) {
      const float* pr = P.b_re + ((size_t)g * 64 + p) * 16 + quad * 8; const float* pi = P.b_im + ((size_t)g * 64 + p) * 16 + quad * 8;
      const f32x4 br0 = *(const f32x4*)pr, br1 = *(const f32x4*)(pr + 4), bi0 = *(const f32x4*)pi, bi1 = *(const f32x4*)(pi + 4);
      tre.x = pk2(cr * br0[0] - ci * bi0[0], cr * br0[1] - ci * bi0[1]); tre.y = pk2(cr * br0[2] - ci * bi0[2], cr * br0[3] - ci * bi0[3]);
      tre.z = pk2(cr * br1[0] - ci * bi1[0], cr * br1[1] - ci * bi1[1]); tre.w = pk2(cr * br1[2] - ci * bi1[2], cr * br1[3] - ci * bi1[3]);
      tim.x = pk2(cr * bi0[0] + ci * br0[0], cr * bi0[1] + ci * br0[1]); tim.y = pk2(cr * bi0[2] + ci * br0[2], cr * bi0[3] + ci * br0[3]);
      tim.z = pk2(cr * bi1[0] + ci * br1[0], cr * bi1[1] + ci * br1[1]); tim.w = pk2(cr * bi1[2] + ci * br1[2], cr * bi1[3] + ci * br1[3]);
    }
    Bre[pb] = mk8(tre); Bim[pb] = mk8(tim);
    l1r[pb] = lr; l1i[pb] = lim;
    l2r[pb] = lr * lr - lim * lim; l2i[pb] = 2.0f * lr * lim;
    l3r[pb] = l2r[pb] * lr - l2i[pb] * lim; l3i[pb] = l2r[pb] * lim + l2i[pb] * lr;
    l4r[pb] = l2r[pb] * l2r[pb] - l2i[pb] * l2i[pb]; l4i[pb] = 2.0f * l2r[pb] * l2i[pb];
    spr[pb] = 0.f; spi[pb] = 0.f;
    if (mode == 1) { const f32x2 e = E[(((size_t)b * 32 + g) * 64 + c) * 64 + p]; spr[pb] = e[0]; spi[pb] = e[1]; }
  }
  bf16x8 cm[4]; f32x4 dsk = {0.f, 0.f, 0.f, 0.f};
  LAS unsigned char* ss = sm + 17408 + w * 4352;
  if (mode == 1) {
#pragma unroll
    for (int kk = 0; kk < 4; ++kk) { const int p0 = kk * 16 + quad * 4;
      const f32x4 cr4 = *(const f32x4*)(P.c_re + ((size_t)g * 16 + li) * 64 + p0), ci4 = *(const f32x4*)(P.c_im + ((size_t)g * 16 + li) * 64 + p0);
      u32x4 t; t.x = pk2(cr4[0], -ci4[0]); t.y = pk2(cr4[1], -ci4[1]); t.z = pk2(cr4[2], -ci4[2]); t.w = pk2(cr4[3], -ci4[3]); cm[kk] = mk8(t); }
    dsk = *(const f32x4*)(P.d + g * 16 + quad * 4);
  }
  const int src_up = (lane - 16) & 63, src_q3 = 48 + li;
  for (int sb = 0; sb < 4; ++sb) {
    u32x4 araw = {0u, 0u, 0u, 0u};
    if (quad < 2) araw = *(const LAS u32x4*)(sm + (sb * 16 + li) * 272 + (w * 16 + quad * 8) * 2);
    const bf16x8 a = mk8(araw);
#pragma unroll
    for (int pb = 0; pb < 4; ++pb) {
      const f32x4 z4 = {0.f, 0.f, 0.f, 0.f};
      const f32x4 are = mfma16(a, Bre[pb], z4), aim = mfma16(a, Bim[pb], z4);
      float s0r = are[0], s0i = aim[0];
      float s1r = l1r[pb] * s0r - l1i[pb] * s0i + are[1], s1i = l1r[pb] * s0i + l1i[pb] * s0r + aim[1];
      float s2r = l1r[pb] * s1r - l1i[pb] * s1i + are[2], s2i = l1r[pb] * s1i + l1i[pb] * s1r + aim[2];
      float s3r = l1r[pb] * s2r - l1i[pb] * s2i + are[3], s3i = l1r[pb] * s2i + l1i[pb] * s2r + aim[3];
      float cr_ = (quad == 0) ? spr[pb] : 0.f, ci_ = (quad == 0) ? spi[pb] : 0.f;
#pragma unroll
      for (int r = 0; r < 3; ++r) {
        const float er = l4r[pb] * cr_ - l4i[pb] * ci_ + s3r, ei = l4r[pb] * ci_ + l4i[pb] * cr_ + s3i;
        const float gr = bperm(er, src_up), gi = bperm(ei, src_up);
        if (quad == r + 1) { cr_ = gr; ci_ = gi; }
      }
      s0r += l1r[pb] * cr_ - l1i[pb] * ci_; s0i += l1r[pb] * ci_ + l1i[pb] * cr_;
      s1r += l2r[pb] * cr_ - l2i[pb] * ci_; s1i += l2r[pb] * ci_ + l2i[pb] * cr_;
      s2r += l3r[pb] * cr_ - l3i[pb] * ci_; s2i += l3r[pb] * ci_ + l3i[pb] * cr_;
      s3r += l4r[pb] * cr_ - l4i[pb] * ci_; s3i += l4r[pb] * ci_ + l4i[pb] * cr_;
      spr[pb] = bperm(s3r, src_q3); spi[pb] = bperm(s3i, src_q3);
      if (mode == 1) { LAS unsigned char* q = ss + (quad * 4) * 272 + (pb * 16 + li) * 4;
        *(LAS unsigned*)(q) = pk2(s0r, s0i); *(LAS unsigned*)(q + 272) = pk2(s1r, s1i); *(LAS unsigned*)(q + 544) = pk2(s2r, s2i); *(LAS unsigned*)(q + 816) = pk2(s3r, s3i); }
    }
    if (mode == 1) {
      asm volatile("s_waitcnt lgkmcnt(0)" ::: "memory");
      f32x4 acc = {0.f, 0.f, 0.f, 0.f};
#pragma unroll
      for (int kk = 0; kk < 4; ++kk) { const bf16x8 bq = *(const LAS bf16x8*)(ss + li * 272 + kk * 64 + quad * 16); acc = mfma16(cm[kk], bq, acc); }
      const u32x2 uq = *(const LAS u32x2*)(sm + (sb * 16 + li) * 272 + (w * 16 + quad * 4) * 2);
      const float u4[4] = {bf_lo(uq.x), bf_hi(uq.x), bf_lo(uq.y), bf_hi(uq.y)};
      float o[4];
#pragma unroll
      for (int j = 0; j < 4; ++j) { const float y = acc[j] + dsk[j] * u4[j]; const float z = 0.7978845608028654f * (y + 0.044715f * y * y * y);
        const float th = 1.0f - 2.0f / (__expf(2.0f * z) + 1.0f); o[j] = 0.5f * y * (1.0f + th); }
      asm volatile("s_waitcnt lgkmcnt(0)" ::: "memory");
      u32x2 ov; ov.x = pk2(o[0], o[1]); ov.y = pk2(o[2], o[3]);
      if (!dry) *(u32x2*)(U + (row0 + sb * 16 + li) * 512 + g * 16 + quad * 4) = ov;
    }
  }
  if (mode == 0 && !dry && quad == 0) {
#pragma unroll
    for (int pb = 0; pb < 4; ++pb) { f32x2 e = {spr[pb], spi[pb]}; E[(((size_t)b * 32 + g) * 64 + c) * 64 + pb * 16 + li] = e; }
  }
  __syncthreads();
}

struct GLAP { const float *wg, *bg, *gout; };
constexpr int GL_LR = 0;
constexpr int GL_WG = 4096;
constexpr int GL_BS = 8192;
constexpr int GL_Q = 24832;
constexpr int GL_K = 34048;
constexpr int GL_VT = 43264;
constexpr int GL_ST = 61696;
constexpr int GL_RED = 80128;
constexpr int GL_SEG = 80640;
DI void gla_cumdecay(LAS unsigned char* sm, const bf16_t* LR, size_t row0, int h, const GLAP& P) {
  const int tid = tid_();
  LAS float* lrs = (LAS float*)(sm + GL_LR); LAS float* bs = (LAS float*)(sm + GL_BS); LAS float* segs = (LAS float*)(sm + GL_SEG);
  const int dk = tid & 63, seg = tid >> 6, t0 = seg * 8;
  u32x4 lrv = {0u, 0u, 0u, 0u};
  if (tid < 128) lrv = *(const u32x4*)(LR + (row0 + (tid >> 1)) * 256 + (tid & 1) * 8);
  float wcol[16];
#pragma unroll
  for (int rr = 0; rr < 16; ++rr) wcol[rr] = P.wg[rr * 256 + h * 64 + dk];
  const float bias = P.bg[h * 64 + dk];
  if (tid < 128) { const int t = tid >> 1, hf = tid & 1;
    f32x4 f0 = {bf_lo(lrv.x), bf_hi(lrv.x), bf_lo(lrv.y), bf_hi(lrv.y)}, f1 = {bf_lo(lrv.z), bf_hi(lrv.z), bf_lo(lrv.w), bf_hi(lrv.w)};
    *(LAS f32x4*)(lrs + t * 16 + hf * 8) = f0; *(LAS f32x4*)(lrs + t * 16 + hf * 8 + 4) = f1; }
  __syncthreads();
  float la[8]; float run = 0.f;
#pragma unroll
  for (int e = 0; e < 8; ++e) { float z = bias;
#pragma unroll
    for (int q4 = 0; q4 < 4; ++q4) { const f32x4 r4 = *(const LAS f32x4*)(lrs + (t0 + e) * 16 + q4 * 4);
      z = fmaf(r4[0], wcol[q4 * 4], z); z = fmaf(r4[1], wcol[q4 * 4 + 1], z); z = fmaf(r4[2], wcol[q4 * 4 + 2], z); z = fmaf(r4[3], wcol[q4 * 4 + 3], z); }
    const float ls = fminf(z, 0.f) - log1pf(__expf(-fabsf(z)));
    run += ls * 0.0625f; la[e] = run; }
  segs[seg * 64 + dk] = run;
  __syncthreads();
  float off = 0.f;
#pragma unroll
  for (int s2 = 0; s2 < 7; ++s2) off += (s2 < seg) ? segs[s2 * 64 + dk] : 0.f;
#pragma unroll
  for (int e = 0; e < 8; ++e) bs[(t0 + e) * 65 + dk] = la[e] + off;
  __syncthreads();
}
DI void gla_stage_vt(LAS unsigned char* sm, const bf16_t* VG, size_t row0, int h) {
  LAS unsigned short* vt = (LAS unsigned short*)(sm + GL_VT);
#pragma unroll
  for (int it = 0; it < 2; ++it) { const int id = it * 512 + tid_(), t = id & 63, cc = id >> 6;
    const u32x4 v = *(const u32x4*)(VG + (row0 + t) * 512 + h * 128 + cc * 8);
#pragma unroll
    for (int e = 0; e < 4; ++e) { vt[(cc * 8 + 2 * e) * 72 + t] = (unsigned short)(v[e] & 0xffffu); vt[(cc * 8 + 2 * e + 1) * 72 + t] = (unsigned short)(v[e] >> 16); } }
}
DI void gla_a_task(LAS unsigned char* sm, int task, const bf16_t* QK, const bf16_t* VG, const bf16_t* LR, bf16_t* GST, float* GDEC, const GLAP& P, bool dry) {
  const int tid = tid_(), lane = tid & 63, w = tid >> 6, li = lane & 15, quad = lane >> 4;
  const int bh = task >> 6, c = task & 63, b = bh >> 2, h = bh & 3;
  const size_t row0 = (size_t)b * 4096 + c * 64;
  gla_cumdecay(sm, LR, row0, h, P);
  LAS float* bs = (LAS float*)(sm + GL_BS);
  LAS unsigned short* kht = (LAS unsigned short*)(sm + GL_Q);
  { const int t = tid & 63, dkc = tid >> 6; const u32x4 v = *(const u32x4*)(QK + (row0 + t) * 512 + 256 + h * 64 + dkc * 8);
#pragma unroll
    for (int e = 0; e < 4; ++e) { const int d0 = dkc * 8 + 2 * e;
      const float k0 = bf_lo(v[e]) * __expf(bs[63 * 65 + d0] - bs[t * 65 + d0]), k1 = bf_hi(v[e]) * __expf(bs[63 * 65 + d0 + 1] - bs[t * 65 + d0 + 1]);
      const unsigned pk = pk2(k0, k1); kht[d0 * 72 + t] = (unsigned short)(pk & 0xffffu); kht[(d0 + 1) * 72 + t] = (unsigned short)(pk >> 16); } }
  gla_stage_vt(sm, VG, row0, h);
  if (tid < 64 && !dry) GDEC[(size_t)task * 64 + tid] = __expf(bs[63 * 65 + tid]);
  __syncthreads();
  LAS unsigned short* vt = (LAS unsigned short*)(sm + GL_VT);
#pragma unroll
  for (int dkt = 0; dkt < 4; ++dkt) { f32x4 acc = {0.f, 0.f, 0.f, 0.f};
#pragma unroll
    for (int kk = 0; kk < 2; ++kk) { const bf16x8 a = *(const LAS bf16x8*)(vt + (w * 16 + li) * 72 + kk * 32 + quad * 8), bq = *(const LAS bf16x8*)(kht + (dkt * 16 + li) * 72 + kk * 32 + quad * 8); acc = mfma16(a, bq, acc); }
#pragma unroll
    for (int j = 0; j < 4; ++j) if (!dry) GST[((size_t)task * 128 + w * 16 + quad * 4 + j) * 64 + dkt * 16 + li] = (bf16_t)(pk2(acc[j], 0.f) & 0xffffu); }
  __syncthreads();
}
DI void gla_prefix(const bf16_t* GST, bf16_t* GSO, const float* GDEC, bool dry) {
  const int total = BPG * 4 * 8192;
  for (int gid = blockIdx.x * NTHREADS + tid_(); gid < total; gid += gridDim.x * NTHREADS) {
    const int bh = gid >> 13, e = gid & 8191, dk = e & 63; float S = 0.f;
    for (int c0 = 0; c0 < 64; c0 += 16) { float tv[16], dv[16];
#pragma unroll
      for (int q = 0; q < 16; ++q) { tv[q] = __uint_as_float((unsigned)GST[((size_t)(bh * 64 + c0 + q)) * 8192 + e] << 16); dv[q] = GDEC[(size_t)(bh * 64 + c0 + q) * 64 + dk]; }
#pragma unroll
      for (int q = 0; q < 16; ++q) { if (!dry) GSO[((size_t)(bh * 64 + c0 + q)) * 8192 + e] = (bf16_t)(pk2(S, 0.f) & 0xffffu); S = fmaf(dv[q], S, tv[q]); } }
  }
}
DI void gla_c_task(LAS unsigned char* sm, int task, const bf16_t* QK, bf16_t* VG, const bf16_t* LR, const bf16_t* R, const bf16_t* GST, const GLAP& P, bool dry) {
  const int tid = tid_(), lane = tid & 63, w = tid >> 6, li = lane & 15, quad = lane >> 4;
  const int bh = task >> 6, c = task & 63, b = bh >> 2, h = bh & 3;
  const size_t row0 = (size_t)b * 4096 + c * 64;
  gla_cumdecay(sm, LR, row0, h, P);
  LAS float* bs = (LAS float*)(sm + GL_BS);
  LAS unsigned short* qs = (LAS unsigned short*)(sm + GL_Q); LAS unsigned short* ksm = (LAS unsigned short*)(sm + GL_K);
  LAS unsigned short* vt = (LAS unsigned short*)(sm + GL_VT); LAS unsigned short* st = (LAS unsigned short*)(sm + GL_ST); LAS float* red = (LAS float*)(sm + GL_RED);
  { const int t = tid >> 3, ch = tid & 7;
    const u32x4 qv = *(const u32x4*)(QK + (row0 + t) * 512 + h * 64 + ch * 8), kv = *(const u32x4*)(QK + (row0 + t) * 512 + 256 + h * 64 + ch * 8);
    u32x4 qo, ko;
#pragma unroll
    for (int e = 0; e < 4; ++e) { const int d0 = ch * 8 + 2 * e; const float b0 = bs[t * 65 + d0], b1 = bs[t * 65 + d0 + 1];
      qo[e] = pk2(bf_lo(qv[e]) * 0.125f * __expf(b0), bf_hi(qv[e]) * 0.125f * __expf(b1));
      ko[e] = pk2(bf_lo(kv[e]) * __expf(-b0), bf_hi(kv[e]) * __expf(-b1)); }
    *(LAS u32x4*)(qs + t * 72 + ch * 8) = qo; *(LAS u32x4*)(ksm + t * 72 + ch * 8) = ko; }
  gla_stage_vt(sm, VG, row0, h);
#pragma unroll
  for (int it = 0; it < 2; ++it) { const int id = it * 512 + tid, dv = id >> 3, c8 = id & 7;
    const u32x4 v = *(const u32x4*)(GST + ((size_t)task * 128 + dv) * 64 + c8 * 8);
    *(LAS u32x4*)(st + dv * 72 + c8 * 8) = v; }
  __syncthreads();
  const int qt = w & 3, dvh = w >> 2;
  bf16x8 qf[2];
#pragma unroll
  for (int kk = 0; kk < 2; ++kk) qf[kk] = *(const LAS bf16x8*)(qs + (qt * 16 + li) * 72 + kk * 32 + quad * 8);
  float s[4][4];
#pragma unroll
  for (int jt = 0; jt < 4; ++jt) { f32x4 acc = {0.f, 0.f, 0.f, 0.f};
#pragma unroll
    for (int kk = 0; kk < 2; ++kk) { const bf16x8 a = *(const LAS bf16x8*)(ksm + (jt * 16 + li) * 72 + kk * 32 + quad * 8); acc = mfma16(a, qf[kk], acc); }
#pragma unroll
    for (int j = 0; j < 4; ++j) { const int kj = jt * 16 + quad * 4 + j, qi = qt * 16 + li; s[jt][j] = (kj <= qi) ? acc[j] : 0.f; } }
  bf16x8 pf[2];
#pragma unroll
  for (int pp = 0; pp < 2; ++pp) { u32x4 t; t.x = pk2(s[2 * pp][0], s[2 * pp][1]); t.y = pk2(s[2 * pp][2], s[2 * pp][3]); t.z = pk2(s[2 * pp + 1][0], s[2 * pp + 1][1]); t.w = pk2(s[2 * pp + 1][2], s[2 * pp + 1][3]); pf[pp] = mk8(t); }
  f32x4 o[4]; float ssq = 0.f;
#pragma unroll
  for (int dvt = 0; dvt < 4; ++dvt) { const int dv0 = dvh * 64 + dvt * 16; f32x4 acc = {0.f, 0.f, 0.f, 0.f};
#pragma unroll
    for (int pp = 0; pp < 2; ++pp) { const int kA = 2 * pp * 16 + quad * 4;
      const u32x2 lo = *(const LAS u32x2*)(vt + (dv0 + li) * 72 + kA), hi = *(const LAS u32x2*)(vt + (dv0 + li) * 72 + kA + 16);
      u32x4 t; t.x = lo.x; t.y = lo.y; t.z = hi.x; t.w = hi.y; acc = mfma16(mk8(t), pf[pp], acc); }
#pragma unroll
    for (int kk = 0; kk < 2; ++kk) { const bf16x8 a = *(const LAS bf16x8*)(st + (dv0 + li) * 72 + kk * 32 + quad * 8); acc = mfma16(a, qf[kk], acc); }
    o[dvt] = acc; ssq += acc[0] * acc[0] + acc[1] * acc[1] + acc[2] * acc[2] + acc[3] * acc[3]; }
  ssq += shx(ssq, 16, lane); ssq += shx(ssq, 32, lane);
  if (quad == 0) red[dvh * 64 + qt * 16 + li] = ssq;
  __syncthreads();
  const float tot = red[qt * 16 + li] + red[64 + qt * 16 + li];
  const float rs = rsqrtf(tot * (1.0f / 128.0f) + 1e-6f);
  const size_t row = row0 + qt * 16 + li;
#pragma unroll
  for (int dvt = 0; dvt < 4; ++dvt) { const int dv = dvh * 64 + dvt * 16 + quad * 4;
    const f32x4 gg = *(const f32x4*)(P.gout + dv); const u32x2 rv = *(const u32x2*)(R + row * 512 + h * 128 + dv);
    const float r4[4] = {bf_lo(rv.x), bf_hi(rv.x), bf_lo(rv.y), bf_hi(rv.y)}; float y[4];
#pragma unroll
    for (int j = 0; j < 4; ++j) y[j] = o[dvt][j] * rs * gg[j] * (r4[j] * sigmoidf_(r4[j]));
    u32x2 ov; ov.x = pk2(y[0], y[1]); ov.y = pk2(y[2], y[3]); if (!dry) *(u32x2*)(VG + row * 512 + h * 128 + dv) = ov; }
  __syncthreads();
}

#define XB_TMO      128
#define XB_XCNT(j)  (256  + 64 * (j))
#define XB_XSUB(j)  (1280 + 64 * (j))
#define XB_XGEN(j)  (2304 + 64 * (j))
#define XB_TOP      3328
#define XB_TOPGEN   3392
#define XCD_BAR_WORDS 3456
#define XB_SPIN_CAP (1u << 18)
DI unsigned xb_ld(unsigned* p)              { return __hip_atomic_load(p, __ATOMIC_RELAXED, __HIP_MEMORY_SCOPE_AGENT); }
DI unsigned xb_add(unsigned* p, unsigned v) { return __hip_atomic_fetch_add(p, v, __ATOMIC_RELAXED, __HIP_MEMORY_SCOPE_AGENT); }
DI unsigned xb_xcc_id() { return (unsigned)__builtin_amdgcn_s_getreg((3 << 11) | 20) & 0xFu; }
#define XB_SPIN(cond, bar) do { unsigned _sp = 0; while (cond) { __builtin_amdgcn_s_sleep(1); \
    if ((++_sp & 255u) == 0u) { if (xb_ld(&(bar)[XB_TMO])) break; if (_sp > XB_SPIN_CAP) { atomicAdd(&(bar)[XB_TMO], 1u); break; } } } } while (0)
struct XcdBarrier { unsigned* bar; unsigned x; volatile LAS unsigned* st; };
DI XcdBarrier xcd_barrier_post(unsigned* bar, volatile LAS unsigned* st) {
  XcdBarrier b; b.bar = bar; b.x = xb_xcc_id(); b.st = st;
  if (threadIdx.x == 0) (void)xb_add(&bar[XB_XCNT(b.x)], 1u);
  return b;
}
DI void xcd_barrier_complete(unsigned* bar, unsigned x, unsigned& nloc, unsigned& nx) {
  asm volatile("" : "+s"(bar));
  const unsigned G = gridDim.x * gridDim.y * gridDim.z;
  unsigned sum, cnt, mine, sp = 0u;
  for (;;) {
    sum = 0u; cnt = 0u; mine = 0u;
#pragma unroll
    for (unsigned j = 0; j < 16; ++j) { const unsigned c = xb_ld(&bar[XB_XCNT(j)]); sum += c; cnt += (c > 0u) ? 1u : 0u; mine = (j == x) ? c : mine; }
    if (sum == G) break;
    __builtin_amdgcn_s_sleep(1);
    if ((++sp & 255u) == 0u) { if (xb_ld(&bar[XB_TMO])) break; if (sp > XB_SPIN_CAP) { atomicAdd(&bar[XB_TMO], 1u); break; } }
  }
  nloc = mine > 0u ? mine : 1u; nx = cnt > 0u ? cnt : 1u;
}
DI void xcd_barrier(const XcdBarrier& b) {
  asm volatile("s_waitcnt vmcnt(0)" ::: "memory");
  __syncthreads();
  if (threadIdx.x == 0) {
    unsigned* bar = b.bar; asm volatile("" : "+s"(bar));
    __builtin_amdgcn_s_waitcnt(0);
    unsigned nloc = b.st[0], nx = b.st[1];
    if (nloc == 0u) { xcd_barrier_complete(bar, b.x, nloc, nx); b.st[0] = nloc; b.st[1] = nx; }
    const unsigned old = xb_add(&bar[XB_XSUB(b.x)], 1u);
    const unsigned gen = old / nloc;
    if (old + 1u == (gen + 1u) * nloc) {
      __builtin_amdgcn_fence(__ATOMIC_RELEASE, "agent");
      asm volatile("s_waitcnt vmcnt(0)" ::: "memory");
      const unsigned og = xb_add(&bar[XB_TOP], 1u);
      const unsigned tg = og / nx;
      if (og + 1u == (tg + 1u) * nx) xb_add(&bar[XB_TOPGEN], 1u);
      else XB_SPIN(xb_ld(&bar[XB_TOPGEN]) == tg, bar);
      __builtin_amdgcn_fence(__ATOMIC_ACQUIRE, "agent");
      xb_add(&bar[XB_XGEN(b.x)], 1u);
      asm volatile("s_waitcnt vmcnt(0)" ::: "memory");
    } else {
      XB_SPIN(xb_ld(&bar[XB_XGEN(b.x)]) == gen, bar);
      __builtin_amdgcn_fence(__ATOMIC_ACQUIRE, "agent");
      asm volatile("s_waitcnt vmcnt(0)" ::: "memory");
    }
  }
  __syncthreads();
}

struct Args { const float* in[28]; float* out; unsigned char* ws; int ph_lo, ph_hi; };
constexpr int NPH = 1 + DEPTH * 23 + 1;

__global__ void __launch_bounds__(NTHREADS, 2) mega(Args A) {
  extern __shared__ __attribute__((aligned(16))) unsigned char lds_raw[];
  LAS unsigned char* sm = (LAS unsigned char*)lds_raw;
  cg::grid_group grid = cg::this_grid();
  const int G = gridDim.x, bid = blockIdx.x;
  volatile LAS unsigned* xst = (volatile LAS unsigned*)(sm + LDS_BYTES - 16);
  if (threadIdx.x < 4) xst[threadIdx.x] = 0u;
  __syncthreads();
  XcdBarrier xbar; xbar.bar = (unsigned*)(A.ws + WS_BAR); xbar.x = 0; xbar.st = xst;
  if (A.ph_hi - A.ph_lo > 1) xbar = xcd_barrier_post((unsigned*)(A.ws + WS_BAR), xst);
#ifdef PROBE_A
  unsigned long long tA = 0, tB = 0, tprev = wall_clock64();
#endif

  for (int ph = A.ph_lo; ph < A.ph_hi; ++ph) {
    size_t zo; asm volatile("s_mov_b64 %0, 0" : "=s"(zo));
    unsigned char* ws = A.ws + zo;
    const float* x_in = A.in[0] + zo;
    float* xo = A.out + zo;
    bf16_t* XB = (bf16_t*)(ws + WS_H);
    bf16_t* H = (bf16_t*)xo; bf16_t* PB = (bf16_t*)(ws + WS_P);
    bf16_t* MEMN = (bf16_t*)(ws + WS_MEMN); bf16_t* MKV = (bf16_t*)(ws + WS_MEMKV);
    float* LSE = (float*)(ws + WS_LSE); f32x2* S5E = (f32x2*)(ws + WS_S5E); f32x2* S5C = (f32x2*)(ws + WS_S5C); float* GDEC = (float*)(ws + WS_GDEC); bf16_t* GST = (bf16_t*)((unsigned char*)xo + (size_t)MTOK * 1024 * 2); bf16_t* GSO = GST + (size_t)BPG * 4 * 64 * 8192;
#define IN(i) (A.in[i] + zo)
    int kind, l = 0, grp = 0;
    if (ph == 0) kind = 0; else if (ph == NPH - 1) kind = 17;
    else { const int q = ph - 1; l = q / 23; const int k = q % 23; if (k < 16) { grp = k >> 3; kind = 2 + (k & 7); } else kind = 10 + (k - 16); }
    if (kind == 2 && grp == 1) continue;
    const float* xsrc = (l == 0) ? x_in : xo;
#ifdef PROBE_REPEAT_MASK
    const int ndry = (int)((PROBE_REPEAT_MASK >> kind) & 1);
#else
    const int ndry = 0;
#endif
    for (int dryi = ndry; dryi >= 0; --dryi) {
    const bool dry = dryi != 0;
    bool isgemm = false; int nrep = 1;
    const int vb = ((G & 7) == 0) ? (bid & 7) * (G >> 3) + (bid >> 3) : bid;
    switch (kind) {
      case 0: {
        for (int ll = 0; ll < DEPTH; ++ll) {
          transpose_w(sm, IN(3) + (size_t)ll * 1024 * 9744, 1024, 9744, (bf16_t*)(ws + WS_WIN) + (size_t)ll * DINP * 1024, DINP, 1);
          transpose_w(sm, IN(12) + (size_t)ll * 512 * 512, 512, 512, (bf16_t*)(ws + WS_WGLU) + (size_t)ll * 512 * 512, 512, 0);
          for (int n = 0; n < 3; ++n) transpose_w(sm, IN(17) + ((size_t)ll * 3 + n) * 512 * 1024, 512, 1024, (bf16_t*)(ws + WS_WBR) + ((size_t)ll * 3 + n) * 1024 * 512, 1024, 0);
          transpose_w(sm, IN(18) + (size_t)ll * 1024 * 1024, 1024, 1024, (bf16_t*)(ws + WS_WOUT) + (size_t)ll * 1024 * 1024, 1024, 0);
          transpose_w(sm, IN(21) + (size_t)ll * 1024 * 1024, 1024, 1024, (bf16_t*)(ws + WS_WXQ) + (size_t)ll * 1024 * 1024, 1024, 0);
          transpose_w(sm, IN(23) + (size_t)ll * 1024 * 1024, 1024, 1024, (bf16_t*)(ws + WS_WXO) + (size_t)ll * 1024 * 1024, 1024, 0);
          transpose_w(sm, IN(22) + (size_t)ll * 1024 * 2048, 1024, 2048, (bf16_t*)(ws + WS_WXKV) + (size_t)ll * 2048 * 1024, 2048, 0);
          transpose_w(sm, IN(25) + (size_t)ll * 1024 * 4096, 1024, 4096, (bf16_t*)(ws + WS_WUP) + (size_t)ll * 4096 * 1024, 4096, 0);
          transpose_w(sm, IN(26) + (size_t)ll * 4096 * 1024, 4096, 1024, (bf16_t*)(ws + WS_WDN) + (size_t)ll * 1024 * 4096, 1024, 0);
        }
        norm_rows_bf16(IN(1), IN(19), MEMN, 2048);
      } break;
      case 3: isgemm = true; nrep = (l == 0 && grp == 0) ? 2 : 1; break;
      case 7: case 8: case 9: case 11: case 13: case 15: case 16: isgemm = true; break;
      case 2: if (l == 0) norm_rows_bf16(x_in, IN(2) + l * 1024, H, MTOK); else norm_rows_from_bf16(XB, 1024, IN(2) + l * 1024, H, MTOK); break;
      case 4: {
        S5P sp{IN(4) + l * 2048, IN(5) + l * 2048, IN(6) + l * 32, IN(7) + (size_t)l * 32768, IN(8) + (size_t)l * 32768, IN(9) + (size_t)l * 32768, IN(10) + (size_t)l * 32768, IN(11) + l * 512};
        GLAP gp{IN(14) + l * 4096, IN(15) + l * 256, IN(16) + l * 128};
        constexpr int NA = BPG * 12 * 32, NS = BPG * 256, NGL = BPG * 4 * 64;
        for (int t = vb; t < NA + NS + NGL; t += G) {
          if (t < NA) attn_task(sm, t, PB + P_QA, PB + P_KA, PB + P_VA, LSE, dry);
          else if (t < NA + NS) s5_task(sm, t - NA, 0, PB + P_U, S5E, sp, dry);
          else gla_a_task(sm, t - NA - NS, PB + P_QK, PB + P_VG, PB + P_LR, GST, GDEC, gp, dry);
        }
      } break;
      case 5: { gla_prefix(GST, GSO, GDEC, dry);
        S5P sp{IN(4) + l * 2048, IN(5) + l * 2048, IN(6) + l * 32, IN(7) + (size_t)l * 32768, IN(8) + (size_t)l * 32768, IN(9) + (size_t)l * 32768, IN(10) + (size_t)l * 32768, IN(11) + l * 512};
        s5_carry_scan(S5E, S5C, sp, dry); } break;
      case 6: {
        S5P sp{IN(4) + l * 2048, IN(5) + l * 2048, IN(6) + l * 32, IN(7) + (size_t)l * 32768, IN(8) + (size_t)l * 32768, IN(9) + (size_t)l * 32768, IN(10) + (size_t)l * 32768, IN(11) + l * 512};
        GLAP gp{IN(14) + l * 4096, IN(15) + l * 256, IN(16) + l * 128};
        constexpr int NS = BPG * 256, NGL = BPG * 4 * 64;
        for (int t = bid; t < NS + NGL; t += G) {
          if (t < NS) s5_task(sm, t, 1, PB + P_U, S5C, sp, dry);
          else gla_c_task(sm, t - NS, PB + P_QK, PB + P_VG, PB + P_LR, PB + P_R, GSO, gp, dry);
        }
      } break;
      case 10: norm_rows_from_bf16(XB, 1024, IN(20) + l * 1024, H, MTOK); break;
      case 12: for (int t = vb; t < NB * 4 * 32; t += G) xattn_task(sm, t, PB, MKV, l, dry); break;
      case 14: norm_rows_from_bf16(XB, 1024, IN(24) + l * 1024, H, MTOK); break;
      case 17: final_norm_from_bf16(XB, xo, IN(27), MTOK); break;
      default: break;
    }
    if (isgemm) {
      for (int rep = 0; rep < nrep; ++rep) {
        pg8::Gemm g; Epi E; E.mode = EM_BF16; E.o16 = nullptr; E.ld16 = 0; E.o32 = nullptr; E.r32 = nullptr; E.ld32 = 1024; E.aux = nullptr; E.ldaux = 0; E.bias = nullptr; E.nzm1 = 0; E.r16 = nullptr; E.ldr16 = 1024; int nz = 1;
        bf16_t* MB = PB + P_KA;
        switch (rep == 1 ? 1 : kind) {
          case 1: g = pg8::Gemm{MEMN, (bf16_t*)(ws + WS_WXKV), 2048, 4096, 1024, 1024}; E.mode = EM_BF16; E.o16 = MKV; E.ld16 = 4096; break;
          case 3: g = pg8::Gemm{H + (size_t)grp * MG * 1024, (bf16_t*)(ws + WS_WIN) + (size_t)l * DINP * 1024, MG, DINP, 1024, 1024}; E.mode = EM_PROJ; E.o16 = PB; break;
          case 7: g = pg8::Gemm{PB + P_U, (bf16_t*)(ws + WS_WGLU) + (size_t)l * 512 * 512, MG, 512, 512, 512}; E.mode = EM_GLU; E.o16 = PB + P_QK; E.ld16 = 512; E.aux = PB + P_U; E.ldaux = 512; E.bias = IN(13) + l * 512; break;
          case 8: g = pg8::Gemm{PB + P_QK, (bf16_t*)(ws + WS_WBR) + (size_t)l * 3 * 1024 * 512, MG, 1024, 512, 512};
            g.zA1 = (long)((const char*)(PB + P_VG) - (const char*)(PB + P_QK)); g.zA2 = (long)((const char*)H - (const char*)(PB + P_QK)); g.zB = (long)1024 * 512 * 2; nz = 3;
            E.mode = EM_MERGEZ; E.nzm1 = 2; E.o16 = MB; E.ld16 = 1024; E.aux = PB + P_GATE; E.ldaux = 3072; break;
          case 9: g = pg8::Gemm{MB, (bf16_t*)(ws + WS_WOUT) + (size_t)l * 1024 * 1024, MG, 1024, 1024, 1024}; E.mode = EM_RESID; E.o16 = XB + (size_t)grp * MG * 1024; E.ld16 = 1024; if (l == 0) E.r32 = x_in + (size_t)grp * MG * 1024; else E.r16 = XB + (size_t)grp * MG * 1024; break;
          case 11: g = pg8::Gemm{H, (bf16_t*)(ws + WS_WXQ) + (size_t)l * 1024 * 1024, MTOK, 1024, 1024, 1024}; E.mode = EM_BF16; E.o16 = PB; E.ld16 = 1024; break;
          case 13: g = pg8::Gemm{PB, (bf16_t*)(ws + WS_WXO) + (size_t)l * 1024 * 1024, MTOK, 1024, 1024, 1024}; E.mode = EM_RESID; E.r16 = XB; E.o16 = XB; E.ld16 = 1024; break;
          case 15: g = pg8::Gemm{H, (bf16_t*)(ws + WS_WUP) + (size_t)l * 4096 * 1024, MTOK, 4096, 1024, 1024}; E.mode = EM_RELU2; E.o16 = PB; E.ld16 = 4096; break;
          default: g = pg8::Gemm{PB, (bf16_t*)(ws + WS_WDN) + (size_t)l * 1024 * 4096, MTOK, 1024, 4096, 4096}; E.mode = EM_RESID; E.r16 = XB; E.o16 = XB; E.ld16 = 1024; break;
        }
        g.nz = nz; if (nz == 1) { g.zA1 = 0; g.zA2 = 0; g.zB = 0; }
        g.perm = 1;
        pg8::StaticOrder S; S.init(g.M, g.N, G, bid, nz);
        if (dry) { E.mode = EM_DRY; E.nzm1 = nz - 1; }
        if (nz == 1) pg8::gemm_phase<false, Epi>(sm, g, S, E); else pg8::gemm_phase<true, Epi>(sm, g, S, E);
      }
      if (kind == 7) { if (G > 128) { if (bid >= 128) attn_combine(PB + P_QA, H, LSE, dry, bid - 128, G - 128); } else attn_combine(PB + P_QA, H, LSE, dry, bid, G); }
    }
    }
#ifdef PROBE_A
    { const unsigned long long tn = wall_clock64(); const unsigned long long dt = tn - tprev; tprev = tn;
      if ((PROBE_A >> kind) & 1) tA += dt; if ((PROBE_B >> kind) & 1) tB += dt; }
#endif
    if (ph + 1 < A.ph_hi) { if (A.ph_hi > (1 << 20)) grid.sync(); else xcd_barrier(xbar); }
#ifdef PROBE_EXTRA_SYNCS
    if (ph == 1) for (int i = 0; i < PROBE_EXTRA_SYNCS; ++i) xcd_barrier(xbar);
#endif
#ifdef PROBE_A
    { const unsigned long long tn = wall_clock64(); const unsigned long long dt = tn - tprev; tprev = tn;
      if ((PROBE_A >> 18) & 1) tA += dt; if ((PROBE_B >> 18) & 1) tB += dt; }
#endif
  }
#ifdef PROBE_A
  {
    float* tw = (float*)(A.ws + WS_LSE);
    if (bid == 0 && tid_() == 0) { tw[0] = (float)tA * 0.01f; tw[1] = (float)tB * 0.01f; __threadfence(); }
    grid.sync();
    const float fa = __builtin_nontemporal_load(tw), fb = __builtin_nontemporal_load(tw + 1);
    for (size_t i = (size_t)bid * NTHREADS + tid_(); i < (size_t)16777216; i += (size_t)G * NTHREADS) A.out[i] += fb;
    if (bid == 1 && tid_() == 0) A.out[(size_t)MTOK * DM - 1] += 64.0f * fa;
  }
#endif
}

extern "C" void kernel_launch(void* const* d_in, const int* in_sizes, int n_in, void* d_out, int out_size, void* d_ws, size_t ws_size, hipStream_t stream) {
  static int grid = 0;
  if (grid == 0) {
    if (n_in != 28 || out_size != MTOK * DM || ws_size < WS_END) { fprintf(stderr, "kernel_launch: unexpected shapes (n_in %d out %d ws %zu need %zu)\n", n_in, out_size, ws_size, (size_t)WS_END); grid = -1; return; }
    int dev = 0, cus = 0, per_cu = 0;
    hipGetDevice(&dev); hipDeviceGetAttribute(&cus, hipDeviceAttributeMultiprocessorCount, dev);
    if (hipFuncSetAttribute((const void*)mega, hipFuncAttributeMaxDynamicSharedMemorySize, LDS_BYTES) != hipSuccess) { fprintf(stderr, "kernel_launch: hipFuncSetAttribute failed\n"); grid = -1; return; }
    hipOccupancyMaxActiveBlocksPerMultiprocessor(&per_cu, (const void*)mega, NTHREADS, LDS_BYTES);
    (void)hipGetLastError();
    if (per_cu < 1) { fprintf(stderr, "kernel_launch: occupancy query says %d blocks per CU\n", per_cu); per_cu = 1; }
    grid = cus;
  }
  if (grid < 0) return;
  if (hipMemsetAsync((unsigned char*)d_ws + WS_BAR, 0, 16384, stream) != hipSuccess) { fprintf(stderr, "kernel_launch: memset of barrier words failed\n"); return; }
  Args a{};
  for (int i = 0; i < 28; ++i) a.in[i] = (const float*)d_in[i];
  a.out = (float*)d_out; a.ws = (unsigned char*)d_ws;
#if MULTI_LAUNCH
  for (int ph = 0; ph < NPH; ++ph) { a.ph_lo = ph; a.ph_hi = ph + 1; hipLaunchKernelGGL(mega, dim3(grid), dim3(NTHREADS), LDS_BYTES, stream, a); }
#else
  a.ph_lo = 0; a.ph_hi = NPH;
  void* args[] = {&a};
  hipError_t e = hipLaunchCooperativeKernel((const void*)mega, dim3(grid), dim3(NTHREADS), args, LDS_BYTES, stream);
  if (e != hipSuccess) fprintf(stderr, "kernel_launch: cooperative launch failed: %s (grid %d)\n", hipGetErrorString(e), grid);
#endif
}
```

```cpp
#include <hip/hip_runtime.h>
#include <hip/hip_cooperative_groups.h>
#include <cstdio>
namespace cg = cooperative_groups;

#ifndef MULTI_LAUNCH
#define MULTI_LAUNCH 0
#endif

#define LAS __attribute__((address_space(3)))
#define DI __device__ __forceinline__
typedef unsigned short bf16_t;
typedef short bf16x8 __attribute__((ext_vector_type(8)));
typedef float f32x4 __attribute__((ext_vector_type(4)));
typedef float f32x2 __attribute__((ext_vector_type(2)));
typedef unsigned u32x4 __attribute__((ext_vector_type(4)));
typedef unsigned u32x2 __attribute__((ext_vector_type(2)));
typedef __bf16 bfv2 __attribute__((ext_vector_type(2)));

constexpr int DM = 1024, SEQ = 4096, NB = 8, MTOK = NB * SEQ, DEPTH = 2;
constexpr int NGRP = 2, MG = MTOK / NGRP, BPG = NB / NGRP;
constexpr int DINP = 9984;
constexpr int NTHREADS = 512;
constexpr int LDS_BYTES = 147456;

constexpr size_t AL(size_t x) { return (x + 255) & ~(size_t)255; }
constexpr size_t WS_WIN = 0;
constexpr size_t WS_WGLU = WS_WIN + AL((size_t)DEPTH * DINP * 1024 * 2);
constexpr size_t WS_WBR = WS_WGLU + AL((size_t)DEPTH * 512 * 512 * 2);
constexpr size_t WS_WOUT = WS_WBR + AL((size_t)DEPTH * 3 * 1024 * 512 * 2);
constexpr size_t WS_WXQ = WS_WOUT + AL((size_t)DEPTH * 1024 * 1024 * 2);
constexpr size_t WS_WXO = WS_WXQ + AL((size_t)DEPTH * 1024 * 1024 * 2);
constexpr size_t WS_WXKV = WS_WXO + AL((size_t)DEPTH * 1024 * 1024 * 2);
constexpr size_t WS_WUP = WS_WXKV + AL((size_t)DEPTH * 2048 * 1024 * 2);
constexpr size_t WS_WDN = WS_WUP + AL((size_t)DEPTH * 4096 * 1024 * 2);
constexpr size_t WS_MEMN = WS_WDN + AL((size_t)DEPTH * 4096 * 1024 * 2);
constexpr size_t WS_MEMKV = WS_MEMN + AL((size_t)2048 * 1024 * 2);
constexpr size_t WS_LSE = WS_MEMKV + AL((size_t)2048 * 4096 * 2);
constexpr size_t WS_S5E = WS_LSE + AL((size_t)MG * 12 * 4);
constexpr size_t WS_S5C = WS_S5E + AL((size_t)BPG * 32 * 64 * 64 * 8);
constexpr size_t WS_GDEC = WS_S5C + AL((size_t)BPG * 32 * 64 * 64 * 8);
constexpr size_t WS_H = WS_GDEC + AL((size_t)BPG * 4 * 64 * 64 * 4);
constexpr size_t WS_GST = WS_H + (size_t)MG * 1024 * 2;
constexpr size_t WS_P = WS_H + AL((size_t)MTOK * 1024 * 2);
constexpr size_t WS_BAR = WS_P + AL((size_t)MG * DINP * 2);
constexpr size_t WS_END = WS_BAR + 16384;
constexpr size_t PE(int tile) { return (size_t)MG * 256 * tile; }
constexpr size_t P_U = PE(0), P_QK = PE(2), P_VG = PE(4), P_R = PE(6), P_QA = PE(8), P_KA = PE(14), P_VA = PE(20), P_GATE = PE(26), P_LR = PE(38);

typedef short s16x4 __attribute__((ext_vector_type(4)));
DI u32x2 lds_tr16(LAS unsigned char* p) { return __builtin_bit_cast(u32x2, __builtin_amdgcn_ds_read_tr16_b64_v4i16((LAS s16x4*)p)); }
DI float bf_lo(unsigned u) { return __uint_as_float(u << 16); }
DI float bf_hi(unsigned u) { return __uint_as_float(u & 0xffff0000u); }
DI unsigned pk2(float lo, float hi) { f32x2 v = {lo, hi}; bfv2 r = __builtin_convertvector(v, bfv2); return __builtin_bit_cast(unsigned, r); }
DI int tid_() { int t = threadIdx.x; asm volatile("" : "+v"(t)); return t; }
DI float shx(float v, int m, int lane) { return __builtin_bit_cast(float, __builtin_amdgcn_ds_bpermute((lane ^ m) << 2, __builtin_bit_cast(int, v))); }
DI float wave_sum(float v, int lane) {
#pragma unroll
  for (int m = 32; m >= 1; m >>= 1) v += shx(v, m, lane);
  return v;
}
DI float sigmoidf_(float x) { return 1.0f / (1.0f + __expf(-x)); }
DI f32x4 mfma16(bf16x8 a, bf16x8 b, f32x4 c) { return __builtin_amdgcn_mfma_f32_16x16x32_bf16(a, b, c, 0, 0, 0); }
DI bf16x8 mk8(u32x4 v) { return __builtin_bit_cast(bf16x8, v); }

namespace pg8 {
constexpr int BM = 256, BK = 64, HALF = 128, HTB = HALF * BK * 2, STAGE_BYTES = 8 * HTB, NXCD = 8, WGM = 4;
DI int lds_byte(int r, int c) { const int st = (r >> 4) * 2 + (c >> 5), rr = r & 15, cc = c & 31, ob = rr * 64 + cc * 2; return st * 1024 + (ob ^ (((ob >> 9) & 1) << 5)); }
DI void stage_rc(int b, int& R, int& C) { const int st = b / 1024, sb = b % 1024, swz = sb ^ (((sb >> 9) & 1) << 5); R = (st >> 1) * 16 + swz / 64; C = (st & 1) * 32 + (swz % 64) / 2; }
DI int perm32(int rho) { const int n = rho >> 4, i = rho & 15; return 8 * (i >> 2) + 4 * n + (i & 3); }
struct Unit { int pm, pn, z; };
struct Gemm { const bf16_t* A; const bf16_t* Bt; int M, N, K, lda; long zA1, zA2, zB; int nz, perm; };
struct StaticOrder {
  int nM, nN, nwg, G, c, nz;
  DI void init(int M, int N, int G_, int c_, int nz_) { nM = M / BM; nN = N / BM; nwg = nM * nN; G = G_; c = c_; nz = nz_; }
  DI bool next(int i, Unit& u) const {
    const int ib = (nz == 1) ? i : i / nz; u.z = i - ib * nz;
    const long L = (long)ib * G + c; if (L >= nwg) return false;
    int wgid = (int)L; { const int q = nwg / NXCD, r = nwg % NXCD, xcd = wgid % NXCD, off = wgid / NXCD; wgid = (xcd < r ? xcd * (q + 1) : r * (q + 1) + (xcd - r) * q) + off; }
    const int nig = WGM * nN, gid = wgid / nig, fm = gid * WGM, gsz = (nM - fm) < WGM ? (nM - fm) : WGM;
    u.pm = fm + ((wgid % nig) % gsz); u.pn = (wgid % nig) / gsz; return true;
  }
};

template <bool CHAIN, class Epi>
DI void gemm_phase(LAS unsigned char* lds, const Gemm g, const StaticOrder& S, const Epi& E) {
  const int tid = tid_(), wid = __builtin_amdgcn_readfirstlane(tid >> 6), lane = tid & 63, wr = wid >> 2, wc = wid & 3, fr = lane & 15, fq = lane >> 4;
  const int K = g.K, nt = K / BK, lda = g.lda;
  unsigned voffA[2], voffB[2];
#pragma unroll
  for (int i = 0; i < 2; ++i) { int R, C; stage_rc(tid * 16 + i * 8192, R, C); const int Rb = g.perm ? ((R & ~31) + perm32(R & 31)) : R;
    voffA[i] = (unsigned)(R * lda + C) * 2u; voffB[i] = (unsigned)(Rb * K + C) * 2u; }
  const size_t kstep = (size_t)(BK * 2);
  const size_t hstA = (size_t)HALF * lda * 2, hstB = (size_t)HALF * K * 2;
  const size_t tstA = 2 * hstA, tstB = 2 * hstB;
  const unsigned ldsw = (unsigned)wid * 1024u;
  const int aoff = lds_byte(wr * 64 + fr, fq * 8), boff = lds_byte(wc * 32 + fr, fq * 8);
#define PG8_SA(b, h) (((b) * 2 + (h)) * HTB)
#define PG8_SB(b, h) ((4 + (b) * 2 + (h)) * HTB)
#define PG8_STAGE(bufoff, gbase, voff) do { _Pragma("unroll") for (int _i = 0; _i < 2; ++_i) \
    __builtin_amdgcn_global_load_lds((const unsigned*)((const char*)(gbase) + (voff)[_i]), (LAS unsigned*)(lds + (bufoff) + ldsw + _i * 8192), 16, 0, 0); } while (0)
#define PG8_LDA(dst, b, h) do { _Pragma("unroll") for (int m = 0; m < 4; ++m) _Pragma("unroll") for (int k = 0; k < 2; ++k) dst[m][k] = *(const LAS bf16x8*)(lds + PG8_SA(b, h) + aoff + m * 2048 + k * 1024); } while (0)
#define PG8_LDB(dst, b, h) do { _Pragma("unroll") for (int n = 0; n < 2; ++n) _Pragma("unroll") for (int k = 0; k < 2; ++k) dst[n][k] = *(const LAS bf16x8*)(lds + PG8_SB(b, h) + boff + n * 2048 + k * 1024); } while (0)
#define PG8_MMA(ai, bj, At, Bt) do { __builtin_amdgcn_s_setprio(1); _Pragma("unroll") for (int m = 0; m < 4; ++m) _Pragma("unroll") for (int n = 0; n < 2; ++n) _Pragma("unroll") for (int k = 0; k < 2; ++k) \
    acc[ai][bj][m][n] = __builtin_amdgcn_mfma_f32_16x16x32_bf16(Bt[n][k], At[m][k], acc[ai][bj][m][n], 0, 0, 0); __builtin_amdgcn_s_setprio(0); } while (0)
#define PG8_WAIT_V(n) asm volatile("s_waitcnt vmcnt(" #n ")" ::: "memory")
#define PG8_WAIT_L(n) asm volatile("s_waitcnt lgkmcnt(" #n ")" ::: "memory")
#define PG8_BAR __builtin_amdgcn_s_barrier()
#define PG8_SCHED __builtin_amdgcn_sched_barrier(0)
  Unit cur, nxt; int ui = 0;
  if (!S.next(0, cur)) return;
  f32x4 acc[2][2][4][2];
#pragma unroll
  for (int a = 0; a < 2; ++a)
#pragma unroll
    for (int b = 0; b < 2; ++b)
#pragma unroll
      for (int m = 0; m < 4; ++m)
#pragma unroll
        for (int n = 0; n < 2; ++n) acc[a][b][m][n] = (f32x4){0.f, 0.f, 0.f, 0.f};
  bf16x8 At[4][2], B0[2][2], B1[2][2];
#define PG8_ZA(z) ((z) == 0 ? 0l : ((z) == 1 ? g.zA1 : g.zA2))
  const char* cA = (const char*)g.A + PG8_ZA(cur.z) + (size_t)cur.pm * tstA; const char* cB = (const char*)g.Bt + (long)cur.z * g.zB + (size_t)cur.pn * tstB;
  PG8_STAGE(PG8_SB(0, 0), cB, voffB); PG8_STAGE(PG8_SA(0, 0), cA, voffA); PG8_STAGE(PG8_SB(0, 1), cB + hstB, voffB); PG8_STAGE(PG8_SA(0, 1), cA + hstA, voffA);
  if (wr == 1) PG8_BAR;
  PG8_WAIT_V(4); PG8_BAR;
  PG8_STAGE(PG8_SB(1, 0), cB + kstep, voffB); PG8_STAGE(PG8_SA(1, 0), cA + kstep, voffA); PG8_STAGE(PG8_SB(1, 1), cB + hstB + kstep, voffB);
  PG8_WAIT_V(6); PG8_BAR;
  for (;;) {
    const bool has_next = S.next(ui + 1, nxt);
    const char* nA = has_next ? (const char*)g.A + PG8_ZA(nxt.z) + (size_t)nxt.pm * tstA : cA; const char* nB = has_next ? (const char*)g.Bt + (long)nxt.z * g.zB + (size_t)nxt.pn * tstB : cB;
    for (int t = 0; t < nt; t += 2) {
      const bool last = (t == nt - 2);
      const char* a1 = cA + (size_t)(t + 1) * kstep;
      const char* a2 = last ? nA : cA + (size_t)(t + 2) * kstep; const char* b2 = last ? nB : cB + (size_t)(t + 2) * kstep;
      const char* a3 = a2 + kstep; const char* b3 = b2 + kstep;
      PG8_LDB(B0, 0, 0); PG8_SCHED; PG8_LDA(At, 0, 0); PG8_STAGE(PG8_SA(1, 1), a1 + hstA, voffA);
      PG8_WAIT_L(8); PG8_BAR; PG8_WAIT_L(0); PG8_MMA(0, 0, At, B0); PG8_BAR; PG8_SCHED;
      PG8_LDB(B1, 0, 1); PG8_STAGE(PG8_SB(0, 0), b2, voffB);
      PG8_BAR; PG8_WAIT_L(0); PG8_MMA(0, 1, At, B1); PG8_BAR;
      PG8_LDA(At, 0, 1); PG8_STAGE(PG8_SA(0, 0), a2, voffA);
      PG8_BAR; PG8_WAIT_L(0); PG8_MMA(1, 0, At, B0); PG8_BAR; PG8_SCHED;
      PG8_STAGE(PG8_SB(0, 1), b2 + hstB, voffB);
      PG8_WAIT_V(6); PG8_BAR; PG8_MMA(1, 1, At, B1); PG8_BAR;
      PG8_LDB(B0, 1, 0); PG8_SCHED; PG8_LDA(At, 1, 0); PG8_STAGE(PG8_SA(0, 1), a2 + hstA, voffA);
      PG8_WAIT_L(8); PG8_BAR; PG8_WAIT_L(0); PG8_MMA(0, 0, At, B0); PG8_BAR; PG8_SCHED;
      PG8_LDB(B1, 1, 1); PG8_STAGE(PG8_SB(1, 0), b3, voffB);
      PG8_BAR; PG8_WAIT_L(0); PG8_MMA(0, 1, At, B1); PG8_BAR;
      PG8_LDA(At, 1, 1); PG8_STAGE(PG8_SA(1, 0), a3, voffA);
      PG8_BAR; PG8_WAIT_L(0); PG8_MMA(1, 0, At, B0); PG8_BAR; PG8_SCHED;
      PG8_STAGE(PG8_SB(1, 1), b3 + hstB, voffB);
      PG8_WAIT_V(6); PG8_BAR; PG8_MMA(1, 1, At, B1); PG8_BAR;
    }
#define PG8_ZERO() do { _Pragma("unroll") for (int a = 0; a < 2; ++a) _Pragma("unroll") for (int b = 0; b < 2; ++b) _Pragma("unroll") for (int m = 0; m < 4; ++m) _Pragma("unroll") for (int n = 0; n < 2; ++n) acc[a][b][m][n] = (f32x4){0.f, 0.f, 0.f, 0.f}; } while (0)
    if constexpr (CHAIN) { E.merge(acc, cur, wr, wc, fr, fq); if (!has_next) break; if (cur.z == E.nzm1) PG8_ZERO(); }
    else { E(acc, cur, wr, wc, fr, fq); if (!has_next) break; PG8_ZERO(); }
    cur = nxt; cA = nA; cB = nB; ++ui;
  }
  PG8_WAIT_V(0);
  if (wr == 0) PG8_BAR;
  PG8_BAR;
#undef PG8_ZA
#undef PG8_ZERO
#undef PG8_SA
#undef PG8_SB
#undef PG8_STAGE
#undef PG8_LDA
#undef PG8_LDB
#undef PG8_MMA
#undef PG8_WAIT_V
#undef PG8_WAIT_L
#undef PG8_BAR
#undef PG8_SCHED
}
}

enum { EM_PROJ = 0, EM_BF16, EM_GLU, EM_MERGEZ, EM_RESID, EM_RELU2, EM_DRY };
struct Epi {
  int mode;
  bf16_t* o16; int ld16;
  float* o32; const float* r32; int ld32;
  const bf16_t* r16; int ldr16;
  const bf16_t* aux; int ldaux;
  const float* bias;
  int nzm1;
  DI bool is_chain() const { return nzm1 != 0; }
  DI void operator()(const f32x4 (&acc)[2][2][4][2], const pg8::Unit& u, int wr, int wc, int fr, int fq) const {
    if (mode == EM_DRY) return;
    const int row0 = u.pm * 256 + wr * 64 + fr;
    int colt = u.pn * 256; bf16_t* ob = o16; int ldo = ld16;
    if (mode == EM_PROJ) {
      const int pn = u.pn; int s, ldp;
      if (pn < 8) { s = pn & ~1; ldp = 512; } else if (pn < 14) { s = 8; ldp = 1536; } else if (pn < 20) { s = 14; ldp = 1536; } else if (pn < 26) { s = 20; ldp = 1536; }
      else if (pn < 38) { s = 26; ldp = 3072; } else { s = 38; ldp = 256; }
      ob = o16 + PE(s); ldo = ldp; colt = (pn - s) * 256;
    }
    const int col0 = colt + wc * 32 + 8 * fq;
    if (mode == EM_PROJ || mode == EM_BF16 || mode == EM_RELU2) {
      const bool sq = (mode == EM_RELU2);
#pragma unroll
      for (int ai = 0; ai < 2; ++ai)
#pragma unroll
        for (int m = 0; m < 4; ++m) {
          const size_t row = (size_t)(row0 + ai * 128 + m * 16);
#pragma unroll
          for (int bj = 0; bj < 2; ++bj) {
            f32x4 v0 = acc[ai][bj][m][0], v1 = acc[ai][bj][m][1];
            if (sq) {
#pragma unroll
              for (int j = 0; j < 4; ++j) { const float a = fmaxf(v0[j], 0.f), b = fmaxf(v1[j], 0.f); v0[j] = a * a; v1[j] = b * b; }
            }
            u32x4 w; w.x = pk2(v0[0], v0[1]); w.y = pk2(v0[2], v0[3]); w.z = pk2(v1[0], v1[1]); w.w = pk2(v1[2], v1[3]);
            *(u32x4*)(ob + row * ldo + col0 + bj * 128) = w;
          }
        }
    } else if (mode == EM_RESID) {
      if (r32) {
#pragma unroll
        for (int ai = 0; ai < 2; ++ai)
#pragma unroll
          for (int mp = 0; mp < 2; ++mp) {
            f32x4 rr[2][2][2];
#pragma unroll
            for (int mm = 0; mm < 2; ++mm)
#pragma unroll
              for (int bj = 0; bj < 2; ++bj) { const float* p = r32 + (size_t)(row0 + ai * 128 + (mp * 2 + mm) * 16) * ld32 + col0 + bj * 128; rr[mm][bj][0] = *(const f32x4*)p; rr[mm][bj][1] = *(const f32x4*)(p + 4); }
#pragma unroll
            for (int mm = 0; mm < 2; ++mm)
#pragma unroll
              for (int bj = 0; bj < 2; ++bj) { const size_t row = (size_t)(row0 + ai * 128 + (mp * 2 + mm) * 16);
                const f32x4 t0 = rr[mm][bj][0] + acc[ai][bj][mp * 2 + mm][0], t1 = rr[mm][bj][1] + acc[ai][bj][mp * 2 + mm][1];
                u32x4 w; w.x = pk2(t0[0], t0[1]); w.y = pk2(t0[2], t0[3]); w.z = pk2(t1[0], t1[1]); w.w = pk2(t1[2], t1[3]);
                *(u32x4*)(ob + row * ldo + col0 + bj * 128) = w; }
          }
      } else {
#pragma unroll
        for (int ai = 0; ai < 2; ++ai) {
          u32x4 q[4][2];
#pragma unroll
          for (int m = 0; m < 4; ++m)
#pragma unroll
            for (int bj = 0; bj < 2; ++bj) q[m][bj] = *(const u32x4*)(r16 + (size_t)(row0 + ai * 128 + m * 16) * ldr16 + col0 + bj * 128);
#pragma unroll
          for (int m = 0; m < 4; ++m)
#pragma unroll
            for (int bj = 0; bj < 2; ++bj) { const u32x4 v = q[m][bj];
              const f32x4 t0 = (f32x4){bf_lo(v.x), bf_hi(v.x), bf_lo(v.y), bf_hi(v.y)} + acc[ai][bj][m][0], t1 = (f32x4){bf_lo(v.z), bf_hi(v.z), bf_lo(v.w), bf_hi(v.w)} + acc[ai][bj][m][1];
              u32x4 w; w.x = pk2(t0[0], t0[1]); w.y = pk2(t0[2], t0[3]); w.z = pk2(t1[0], t1[1]); w.w = pk2(t1[2], t1[3]);
              *(u32x4*)(ob + (size_t)(row0 + ai * 128 + m * 16) * ldo + col0 + bj * 128) = w; }
        }
      }
    } else if (mode == EM_GLU) {
      f32x4 bb[2][2];
#pragma unroll
      for (int bj = 0; bj < 2; ++bj) { bb[bj][0] = *(const f32x4*)(bias + col0 + bj * 128); bb[bj][1] = *(const f32x4*)(bias + col0 + bj * 128 + 4); }
#pragma unroll
      for (int ai = 0; ai < 2; ++ai) {
        u32x4 gq[4][2];
#pragma unroll
        for (int m = 0; m < 4; ++m)
#pragma unroll
          for (int bj = 0; bj < 2; ++bj) gq[m][bj] = *(const u32x4*)(aux + (size_t)(row0 + ai * 128 + m * 16) * ldaux + col0 + bj * 128);
#pragma unroll
        for (int m = 0; m < 4; ++m)
#pragma unroll
          for (int bj = 0; bj < 2; ++bj) {
            const u32x4 q = gq[m][bj]; const f32x4 v0 = acc[ai][bj][m][0], v1 = acc[ai][bj][m][1];
            const float gv[8] = {bf_lo(q.x), bf_hi(q.x), bf_lo(q.y), bf_hi(q.y), bf_lo(q.z), bf_hi(q.z), bf_lo(q.w), bf_hi(q.w)};
            float o[8];
#pragma unroll
            for (int j = 0; j < 4; ++j) { o[j] = gv[j] * sigmoidf_(v0[j] + bb[bj][0][j]); o[4 + j] = gv[4 + j] * sigmoidf_(v1[j] + bb[bj][1][j]); }
            u32x4 w; w.x = pk2(o[0], o[1]); w.y = pk2(o[2], o[3]); w.z = pk2(o[4], o[5]); w.w = pk2(o[6], o[7]);
            *(u32x4*)(ob + (size_t)(row0 + ai * 128 + m * 16) * ldo + col0 + bj * 128) = w;
          }
      }
    }
  }
  DI void merge(f32x4 (&acc)[2][2][4][2], const pg8::Unit& u, int wr, int wc, int fr, int fq) const {
    if (mode == EM_DRY) return;
    const int row0 = u.pm * 256 + wr * 64 + fr, col0 = u.pn * 256 + wc * 32 + 8 * fq;
    bf16_t* ob = o16; const int ldo = ld16;
    {
      const int z = u.z;
#pragma unroll
      for (int ai = 0; ai < 2; ++ai)
#pragma unroll
        for (int mp = 0; mp < 2; ++mp) {
          u32x4 g0[2][2], g1[2][2];
#pragma unroll
          for (int mm = 0; mm < 2; ++mm)
#pragma unroll
            for (int bj = 0; bj < 2; ++bj) { const bf16_t* p = aux + (size_t)(row0 + ai * 128 + (mp * 2 + mm) * 16) * ldaux + z * 1024 + col0 + bj * 128;
              g0[mm][bj] = *(const u32x4*)p; g1[mm][bj] = (z < 2) ? *(const u32x4*)(p + 1024) : (u32x4){0u, 0u, 0u, 0u}; }
#pragma unroll
          for (int mm = 0; mm < 2; ++mm)
#pragma unroll
            for (int bj = 0; bj < 2; ++bj) {
              const int m = mp * 2 + mm; const size_t row = (size_t)(row0 + ai * 128 + m * 16);
              f32x4& a0 = acc[ai][bj][m][0]; f32x4& a1 = acc[ai][bj][m][1];
#pragma unroll
              for (int e2 = 0; e2 < 4; ++e2) {
                const float l0a = bf_lo(g0[mm][bj][e2]), l0b = bf_hi(g0[mm][bj][e2]), l1a = bf_lo(g1[mm][bj][e2]), l1b = bf_hi(g1[mm][bj][e2]);
                float fa = __builtin_amdgcn_rcpf(1.0f + __expf(-l0a)), fb = __builtin_amdgcn_rcpf(1.0f + __expf(-l0b));
                if (z < 2) { fa *= 1.0f + __expf(-l1a); fb *= 1.0f + __expf(-l1b); }
                if (e2 < 2) { a0[2 * e2] *= fa; a0[2 * e2 + 1] *= fb; } else { a1[2 * e2 - 4] *= fa; a1[2 * e2 - 3] *= fb; }
              }
              if (z == 2) { u32x4 w; w.x = pk2(a0[0], a0[1]); w.y = pk2(a0[2], a0[3]); w.z = pk2(a1[0], a1[1]); w.w = pk2(a1[2], a1[3]);
                *(u32x4*)(ob + row * ldo + col0 + bj * 128) = w; }
            }
        }
    }
  }
};

DI void norm_rows_bf16(const float* x, const float* gain, bf16_t* H, int nrows) {
  const int tid = tid_(), lane = tid & 63, gw = blockIdx.x * 8 + (tid >> 6), nw = gridDim.x * 8;
  f32x4 g[4];
#pragma unroll
  for (int i = 0; i < 4; ++i) g[i] = *(const f32x4*)(gain + i * 256 + lane * 4);
  for (int r = gw * 2; r < nrows; r += nw * 2) {
    f32x4 v[2][4];
#pragma unroll
    for (int q = 0; q < 2; ++q)
#pragma unroll
      for (int i = 0; i < 4; ++i) v[q][i] = *(const f32x4*)(x + (size_t)(r + q) * 1024 + i * 256 + lane * 4);
#pragma unroll
    for (int q = 0; q < 2; ++q) {
      float ss = 0.f;
#pragma unroll
      for (int i = 0; i < 4; ++i) ss += v[q][i][0] * v[q][i][0] + v[q][i][1] * v[q][i][1] + v[q][i][2] * v[q][i][2] + v[q][i][3] * v[q][i][3];
      ss = wave_sum(ss, lane);
      const float rs = rsqrtf(ss * (1.0f / 1024.0f) + 1e-6f);
#pragma unroll
      for (int i = 0; i < 4; ++i) { u32x2 w; w.x = pk2(v[q][i][0] * rs * g[i][0], v[q][i][1] * rs * g[i][1]); w.y = pk2(v[q][i][2] * rs * g[i][2], v[q][i][3] * rs * g[i][3]);
        *(u32x2*)(H + (size_t)(r + q) * 1024 + i * 256 + lane * 4) = w; }
    }
  }
}
DI void norm_rows_from_bf16(const bf16_t* xb, int ldx, const float* gain, bf16_t* H, int nrows) {
  const int tid = tid_(), lane = tid & 63, gw = blockIdx.x * 8 + (tid >> 6), nw = gridDim.x * 8;
  f32x4 g[4];
#pragma unroll
  for (int i = 0; i < 2; ++i) { g[2 * i] = *(const f32x4*)(gain + i * 512 + lane * 8); g[2 * i + 1] = *(const f32x4*)(gain + i * 512 + lane * 8 + 4); }
  for (int r = gw * 8; r < nrows; r += nw * 8) {
    u32x4 v[8][2];
#pragma unroll
    for (int q = 0; q < 8; ++q)
#pragma unroll
      for (int i = 0; i < 2; ++i) v[q][i] = *(const u32x4*)(xb + (size_t)(r + q) * ldx + i * 512 + lane * 8);
#pragma unroll
    for (int q = 0; q < 8; ++q) {
      float f[16];
#pragma unroll
      for (int i = 0; i < 2; ++i)
#pragma unroll
        for (int e = 0; e < 4; ++e) { f[i * 8 + 2 * e] = bf_lo(v[q][i][e]); f[i * 8 + 2 * e + 1] = bf_hi(v[q][i][e]); }
      float ss = 0.f;
#pragma unroll
      for (int e = 0; e < 16; ++e) ss += f[e] * f[e];
      ss = wave_sum(ss, lane);
      const float rs = rsqrtf(ss * (1.0f / 1024.0f) + 1e-6f);
#pragma unroll
      for (int i = 0; i < 2; ++i) { u32x4 w;
#pragma unroll
        for (int e = 0; e < 4; ++e) w[e] = pk2(f[i * 8 + 2 * e] * rs * g[2 * i + (e >> 1)][(2 * e) & 3], f[i * 8 + 2 * e + 1] * rs * g[2 * i + (e >> 1)][(2 * e + 1) & 3]);
        *(u32x4*)(H + (size_t)(r + q) * 1024 + i * 512 + lane * 8) = w; }
    }
  }
}
DI void final_norm_expand(float* out, const float* gain, int nrows) {
  const int tid = tid_(), lane = tid & 63, gw = blockIdx.x * 8 + (tid >> 6), nw = gridDim.x * 8;
  f32x4 g[4];
#pragma unroll
  for (int i = 0; i < 2; ++i) { g[2 * i] = *(const f32x4*)(gain + i * 512 + lane * 8); g[2 * i + 1] = *(const f32x4*)(gain + i * 512 + lane * 8 + 4); }
  for (int r = gw; r < nrows; r += nw) {
    const bf16_t* xb = (const bf16_t*)(out + (size_t)r * 1024);
    u32x4 v[2];
#pragma unroll
    for (int i = 0; i < 2; ++i) v[i] = *(const u32x4*)(xb + i * 512 + lane * 8);
    float f[16];
#pragma unroll
    for (int i = 0; i < 2; ++i)
#pragma unroll
      for (int e = 0; e < 4; ++e) { f[i * 8 + 2 * e] = bf_lo(v[i][e]); f[i * 8 + 2 * e + 1] = bf_hi(v[i][e]); }
    float ss = 0.f;
#pragma unroll
    for (int e = 0; e < 16; ++e) ss += f[e] * f[e];
    ss = wave_sum(ss, lane);
    const float rs = rsqrtf(ss * (1.0f / 1024.0f) + 1e-6f);
    asm volatile("s_waitcnt vmcnt(0)" ::: "memory");
#pragma unroll
    for (int i = 0; i < 2; ++i) { f32x4 o0, o1;
#pragma unroll
      for (int e = 0; e < 4; ++e) { o0[e] = f[i * 8 + e] * rs * g[2 * i][e]; o1[e] = f[i * 8 + 4 + e] * rs * g[2 * i + 1][e]; }
      *(f32x4*)(out + (size_t)r * 1024 + i * 512 + lane * 8) = o0; *(f32x4*)(out + (size_t)r * 1024 + i * 512 + lane * 8 + 4) = o1; }
  }
}
DI void final_norm_from_bf16(const bf16_t* xb, float* out, const float* gain, int nrows) {
  const int tid = tid_(), lane = tid & 63, gw = blockIdx.x * 8 + (tid >> 6), nw = gridDim.x * 8;
  f32x4 g[4];
#pragma unroll
  for (int i = 0; i < 2; ++i) { g[2 * i] = *(const f32x4*)(gain + i * 512 + lane * 8); g[2 * i + 1] = *(const f32x4*)(gain + i * 512 + lane * 8 + 4); }
  for (int r = gw * 2; r < nrows; r += nw * 2) {
    u32x4 v[2][2];
#pragma unroll
    for (int q = 0; q < 2; ++q)
#pragma unroll
      for (int i = 0; i < 2; ++i) v[q][i] = *(const u32x4*)(xb + (size_t)(r + q) * 1024 + i * 512 + lane * 8);
#pragma unroll
    for (int q = 0; q < 2; ++q) {
      float f[16];
#pragma unroll
      for (int i = 0; i < 2; ++i)
#pragma unroll
        for (int e = 0; e < 4; ++e) { f[i * 8 + 2 * e] = bf_lo(v[q][i][e]); f[i * 8 + 2 * e + 1] = bf_hi(v[q][i][e]); }
      float ss = 0.f;
#pragma unroll
      for (int e = 0; e < 16; ++e) ss += f[e] * f[e];
      ss = wave_sum(ss, lane);
      const float rs = rsqrtf(ss * (1.0f / 1024.0f) + 1e-6f);
#pragma unroll
      for (int i = 0; i < 2; ++i) { f32x4 o0, o1;
#pragma unroll
        for (int e = 0; e < 4; ++e) { o0[e] = f[i * 8 + e] * rs * g[2 * i][e]; o1[e] = f[i * 8 + 4 + e] * rs * g[2 * i + 1][e]; }
        *(f32x4*)(out + (size_t)(r + q) * 1024 + i * 512 + lane * 8) = o0; *(f32x4*)(out + (size_t)(r + q) * 1024 + i * 512 + lane * 8 + 4) = o1; }
    }
  }
}
DI void norm_rows_f32_inplace(float* x, const float* gain, int nrows) {
  const int tid = tid_(), lane = tid & 63, gw = blockIdx.x * 8 + (tid >> 6), nw = gridDim.x * 8;
  f32x4 g[4];
#pragma unroll
  for (int i = 0; i < 4; ++i) g[i] = *(const f32x4*)(gain + i * 256 + lane * 4);
  for (int r = gw * 2; r < nrows; r += nw * 2) {
    f32x4 v[2][4];
#pragma unroll
    for (int q = 0; q < 2; ++q)
#pragma unroll
      for (int i = 0; i < 4; ++i) v[q][i] = *(const f32x4*)(x + (size_t)(r + q) * 1024 + i * 256 + lane * 4);
#pragma unroll
    for (int q = 0; q < 2; ++q) {
      float ss = 0.f;
#pragma unroll
      for (int i = 0; i < 4; ++i) ss += v[q][i][0] * v[q][i][0] + v[q][i][1] * v[q][i][1] + v[q][i][2] * v[q][i][2] + v[q][i][3] * v[q][i][3];
      ss = wave_sum(ss, lane);
      const float rs = rsqrtf(ss * (1.0f / 1024.0f) + 1e-6f);
#pragma unroll
      for (int i = 0; i < 4; ++i) { f32x4 o; o[0] = v[q][i][0] * rs * g[i][0]; o[1] = v[q][i][1] * rs * g[i][1]; o[2] = v[q][i][2] * rs * g[i][2]; o[3] = v[q][i][3] * rs * g[i][3];
        *(f32x4*)(x + (size_t)(r + q) * 1024 + i * 256 + lane * 4) = o; }
    }
  }
}

DI int win_map(int n) { return n < 1536 ? n : (n < 9728 ? n + 16 : (n < 9744 ? n - 9728 + 1536 : -1)); }
DI void transpose_w(LAS unsigned char* sm, const float* src, int K, int Ns, bf16_t* dst, int Nd, int mapmode) {
  LAS float* tile = (LAS float*)sm;
  const int tid = tid_(), tn = Nd / 64, tk = K / 64;
  for (int t = blockIdx.x; t < tn * tk; t += gridDim.x) {
    const int n0 = (t / tk) * 64, k0 = (t % tk) * 64;
    float tv[8];
#pragma unroll
    for (int it = 0; it < 8; ++it) { const int idx = it * 512 + tid, kk = idx >> 6, nn = idx & 63;
      const int sc = mapmode ? win_map(n0 + nn) : (n0 + nn);
      tv[it] = sc >= 0 ? src[(size_t)(k0 + kk) * Ns + sc] : 0.f; }
#pragma unroll
    for (int it = 0; it < 8; ++it) { const int idx = it * 512 + tid, kk = idx >> 6, nn = idx & 63; tile[kk * 65 + nn] = tv[it]; }
    __syncthreads();
    { const int nn = tid >> 3, kc = tid & 7; float f[8];
#pragma unroll
      for (int e = 0; e < 8; ++e) f[e] = tile[(kc * 8 + e) * 65 + nn];
      u32x4 w; w.x = pk2(f[0], f[1]); w.y = pk2(f[2], f[3]); w.z = pk2(f[4], f[5]); w.w = pk2(f[6], f[7]);
      *(u32x4*)(dst + (size_t)(n0 + nn) * K + k0 + kc * 8) = w; }
    __syncthreads();
  }
}

DI void attn_task(LAS unsigned char* sm, int task, bf16_t* QA, const bf16_t* KA, const bf16_t* VA, float* LSE, bool dry) {
  const int tid = tid_(), lane = tid & 63, w = tid >> 6, li = lane & 15, quad = lane >> 4;
  const int bh = task >> 5, sub = task & 31;
  const int b = bh / 12, h = bh - b * 12, g = h >> 2, dsh = g * 2, dil = 1 << dsh, nblk = 32 >> dsh;
  const int r = sub / nblk, n = sub - r * nblk;
  LAS unsigned char* ks = sm;
  LAS unsigned char* vs = sm + 69632;
  {
    u32x4 kv[8], vv[8];
#pragma unroll
    for (int it = 0; it < 8; ++it) {
      const int id = it * 512 + tid, row = id >> 4, cc = id & 15, sp = n * 128 - 128 + row;
      kv[it] = (u32x4){0u, 0u, 0u, 0u};
      if (sp >= 0) kv[it] = *(const u32x4*)(KA + ((size_t)b * 4096 + (size_t)(sp * dil + r)) * 1536 + h * 128 + cc * 8);
    }
#pragma unroll
    for (int it = 0; it < 8; ++it) {
      const int id = it * 512 + tid, row = id >> 4, cc = id & 15, sp = n * 128 - 128 + row;
      vv[it] = (u32x4){0u, 0u, 0u, 0u};
      if (sp >= 0) vv[it] = *(const u32x4*)(VA + ((size_t)b * 4096 + (size_t)(sp * dil + r)) * 1536 + h * 128 + cc * 8);
    }
#pragma unroll
    for (int it = 0; it < 8; ++it) { const int id = it * 512 + tid, row = id >> 4, cc = id & 15; *(LAS u32x4*)(ks + row * 272 + cc * 16) = kv[it]; }
#pragma unroll
    for (int it = 0; it < 8; ++it) { const int id = it * 512 + tid, row = id >> 4, cc = id & 15; *(LAS u32x4*)(vs + row * 288 + cc * 16) = vv[it]; }
  }
  __syncthreads();
  const int qsp = n * 128 + w * 16 + li;
  const size_t qtok = (size_t)b * 4096 + (size_t)(qsp * dil + r);
  bf16_t* qptr = QA + qtok * 1536 + h * 128;
  bf16x8 qf[4];
#pragma unroll
  for (int kk = 0; kk < 4; ++kk) qf[kk] = *(const bf16x8*)(qptr + kk * 32 + quad * 8);
  const int kt0 = w < 6 ? w : 6;
  const float sc = 0.08838834764831845f * 1.4426950408889634f;
  const float sl = exp2f(-8.0f * (float)(h + 1) / 12.0f) * (float)dil * 1.4426950408889634f;
  float s[10][4]; float mx = -1e30f;
#pragma unroll
  for (int tt = 0; tt < 10; ++tt) {
    const int kt = kt0 + tt; f32x4 acc = {0.f, 0.f, 0.f, 0.f};
#pragma unroll
    for (int kk = 0; kk < 4; ++kk) { const bf16x8 a = *(const LAS bf16x8*)(ks + (kt * 16 + li) * 272 + kk * 64 + quad * 16); acc = mfma16(a, qf[kk], acc); }
#pragma unroll
    for (int j = 0; j < 4; ++j) { const int kl = kt * 16 + quad * 4 + j, dist = 128 + w * 16 + li - kl;
      const bool valid = dist >= 0 && dist <= 128 && (n > 0 || kl >= 128);
      const float v = acc[j] * sc - sl * (float)dist; s[tt][j] = valid ? v : -1e30f; mx = fmaxf(mx, s[tt][j]); }
  }
  mx = fmaxf(mx, shx(mx, 16, lane)); mx = fmaxf(mx, shx(mx, 32, lane));
  float lsum = 0.f;
#pragma unroll
  for (int tt = 0; tt < 10; ++tt)
#pragma unroll
    for (int j = 0; j < 4; ++j) { const float p = exp2f(s[tt][j] - mx); s[tt][j] = p; lsum += p; }
  lsum += shx(lsum, 16, lane); lsum += shx(lsum, 32, lane);
  bf16x8 pf[5];
#pragma unroll
  for (int pp = 0; pp < 5; ++pp) { u32x4 t; t.x = pk2(s[2 * pp][0], s[2 * pp][1]); t.y = pk2(s[2 * pp][2], s[2 * pp][3]); t.z = pk2(s[2 * pp + 1][0], s[2 * pp + 1][1]); t.w = pk2(s[2 * pp + 1][2], s[2 * pp + 1][3]); pf[pp] = mk8(t); }
  const float inv = 1.0f / lsum;
#pragma unroll
  for (int dvt = 0; dvt < 8; ++dvt) {
    f32x4 acc = {0.f, 0.f, 0.f, 0.f};
#pragma unroll
    for (int pp = 0; pp < 5; ++pp) { const int kA = (kt0 + 2 * pp) * 16 + quad * 4;
      LAS unsigned char* vp = vs + (kA + (li >> 2)) * 288 + dvt * 32 + (li & 3) * 8;
      const u32x2 lo = lds_tr16(vp), hi = lds_tr16(vp + 16 * 288);
      u32x4 t; t.x = lo.x; t.y = lo.y; t.z = hi.x; t.w = hi.y; acc = mfma16(mk8(t), pf[pp], acc); }
    u32x2 o; o.x = pk2(acc[0] * inv, acc[1] * inv); o.y = pk2(acc[2] * inv, acc[3] * inv);
    if (!dry) *(u32x2*)(qptr + dvt * 16 + quad * 4) = o;
  }
  if (quad == 0 && !dry) LSE[qtok * 12 + h] = (mx + log2f(lsum)) * 0.6931471805599453f;
  __syncthreads();
}

DI void attn_combine(const bf16_t* QA, bf16_t* YC, const float* LSE, bool dry, int bidx, int nblk) {
  const int nitem = MG * 4 * 16;
  int gs = nblk * NTHREADS; asm volatile("" : "+s"(gs));
  for (int it = bidx * NTHREADS + tid_(); it < nitem; it += gs) {
    const int t = it >> 6, hg = (it >> 4) & 3, dc = it & 15;
    const float l0 = LSE[(size_t)t * 12 + hg], l1 = LSE[(size_t)t * 12 + 4 + hg], l2 = LSE[(size_t)t * 12 + 8 + hg];
    const float m = fmaxf(l0, fmaxf(l1, l2));
    float w0 = __expf(l0 - m), w1 = __expf(l1 - m), w2 = __expf(l2 - m); const float iv = 1.0f / (w0 + w1 + w2); w0 *= iv; w1 *= iv; w2 *= iv;
    const bf16_t* p = QA + (size_t)t * 1536 + hg * 128 + dc * 8;
    const u32x4 a = *(const u32x4*)p, b = *(const u32x4*)(p + 512), c = *(const u32x4*)(p + 1024);
    u32x4 o;
#pragma unroll
    for (int e = 0; e < 4; ++e) o[e] = pk2(w0 * bf_lo(a[e]) + w1 * bf_lo(b[e]) + w2 * bf_lo(c[e]), w0 * bf_hi(a[e]) + w1 * bf_hi(b[e]) + w2 * bf_hi(c[e]));
    if (!dry) *(u32x4*)(YC + (size_t)t * 512 + hg * 128 + dc * 8) = o;
  }
}

DI void xattn_task(LAS unsigned char* sm, int task, bf16_t* XQ, const bf16_t* MKV, int l, bool dry) {
  const int tid = tid_(), lane = tid & 63, w = tid >> 6, li = lane & 15, quad = lane >> 4;
  const int b = task >> 7, hx = (task >> 5) & 3, n = task & 31;
  LAS unsigned char* vs = sm;
  {
    u32x4 kv[16];
#pragma unroll
    for (int it = 0; it < 16; ++it) { const int id = it * 512 + tid, row = id >> 5, cc = id & 31;
      kv[it] = *(const u32x4*)(MKV + (size_t)(b * 256 + row) * 4096 + l * 2048 + hx * 256 + cc * 8); }
#pragma unroll
    for (int it = 0; it < 16; ++it) { const int id = it * 512 + tid, row = id >> 5, cc = id & 31; *(LAS u32x4*)(sm + row * 528 + cc * 16) = kv[it]; }
  }
  __syncthreads();
  const size_t qtok = (size_t)b * 4096 + n * 128 + w * 16 + li;
  bf16_t* qptr = XQ + qtok * 1024 + hx * 256;
  bf16x8 qf[8];
#pragma unroll
  for (int kk = 0; kk < 8; ++kk) qf[kk] = *(const bf16x8*)(qptr + kk * 32 + quad * 8);
  float s[16][4]; float mx = -1e30f;
  const float sc = 0.0625f * 1.4426950408889634f;
#pragma unroll
  for (int kt = 0; kt < 16; ++kt) { f32x4 acc = {0.f, 0.f, 0.f, 0.f};
#pragma unroll
    for (int kk = 0; kk < 8; ++kk) { const bf16x8 a = *(const LAS bf16x8*)(sm + (kt * 16 + li) * 528 + kk * 64 + quad * 16); acc = mfma16(a, qf[kk], acc); }
#pragma unroll
    for (int j = 0; j < 4; ++j) { s[kt][j] = acc[j] * sc; mx = fmaxf(mx, s[kt][j]); } }
  mx = fmaxf(mx, shx(mx, 16, lane)); mx = fmaxf(mx, shx(mx, 32, lane));
  float lsum = 0.f;
#pragma unroll
  for (int kt = 0; kt < 16; ++kt)
#pragma unroll
    for (int j = 0; j < 4; ++j) { const float p = exp2f(s[kt][j] - mx); s[kt][j] = p; lsum += p; }
  lsum += shx(lsum, 16, lane); lsum += shx(lsum, 32, lane);
  bf16x8 pf[8];
#pragma unroll
  for (int pp = 0; pp < 8; ++pp) { u32x4 t; t.x = pk2(s[2 * pp][0], s[2 * pp][1]); t.y = pk2(s[2 * pp][2], s[2 * pp][3]); t.z = pk2(s[2 * pp + 1][0], s[2 * pp + 1][1]); t.w = pk2(s[2 * pp + 1][2], s[2 * pp + 1][3]); pf[pp] = mk8(t); }
  const float inv = 1.0f / lsum;
  {
    u32x4 vv[16];
#pragma unroll
    for (int it = 0; it < 16; ++it) { const int id = it * 512 + tid, row = id >> 5, cc = id & 31;
      vv[it] = *(const u32x4*)(MKV + (size_t)(b * 256 + row) * 4096 + l * 2048 + 1024 + hx * 256 + cc * 8); }
    __syncthreads();
#pragma unroll
    for (int it = 0; it < 16; ++it) { const int id = it * 512 + tid, row = id >> 5, cc = id & 31; *(LAS u32x4*)(vs + row * 544 + cc * 16) = vv[it]; }
  }
  __syncthreads();
#pragma unroll
  for (int dvt = 0; dvt < 16; ++dvt) {
    f32x4 acc = {0.f, 0.f, 0.f, 0.f};
#pragma unroll
    for (int pp = 0; pp < 8; ++pp) { const int kA = 2 * pp * 16 + quad * 4;
      LAS unsigned char* vp = vs + (kA + (li >> 2)) * 544 + dvt * 32 + (li & 3) * 8;
      const u32x2 lo = lds_tr16(vp), hi = lds_tr16(vp + 16 * 544);
      u32x4 t; t.x = lo.x; t.y = lo.y; t.z = hi.x; t.w = hi.y; acc = mfma16(mk8(t), pf[pp], acc); }
    u32x2 o; o.x = pk2(acc[0] * inv, acc[1] * inv); o.y = pk2(acc[2] * inv, acc[3] * inv);
    if (!dry) *(u32x2*)(qptr + dvt * 16 + quad * 4) = o;
  }
  __syncthreads();
}

struct S5P { const float *a_re, *a_im, *log_step, *b_re, *b_im, *c_re, *c_im, *d; };
DI void s5_lambar(const S5P& P, int g, int p, float& lbr, float& lbi) {
  const float step = __expf(P.log_step[g]);
  const float ar = P.a_re[g * 64 + p], ai = P.a_im[g * 64 + p];
  const float mag = __expf(ar * step);
  float sn, cs; { const float x = ai * step; const float k = rintf(x * 0.15915494309189535f); float rr = fmaf(-k, 6.2831854820251465f, x); rr = fmaf(-k, -1.7484556000744883e-07f, rr); sn = sinf(rr); cs = cosf(rr); }
  lbr = mag * cs; lbi = mag * sn;
}
DI void s5_carry_scan(const f32x2* E, f32x2* C, const S5P& P, bool dry) {
  const int total = BPG * 32 * 64;
  for (int gid = blockIdx.x * NTHREADS + tid_(); gid < total; gid += gridDim.x * NTHREADS) {
    const int p = gid & 63, g = (gid >> 6) & 31, b = gid >> 11;
    float lr_, li_; s5_lambar(P, g, p, lr_, li_);
#pragma unroll
    for (int q = 0; q < 6; ++q) { const float t0 = lr_ * lr_ - li_ * li_, t1 = 2.0f * lr_ * li_; lr_ = t0; li_ = t1; }
    const size_t base = (((size_t)b * 32 + g) * 64) * 64 + p;
    float sr = 0.f, si = 0.f;
    for (int c0 = 0; c0 < 64; c0 += 8) { f32x2 ev[8];
#pragma unroll
      for (int q = 0; q < 8; ++q) ev[q] = E[base + (size_t)(c0 + q) * 64];
#pragma unroll
      for (int q = 0; q < 8; ++q) { if (!dry) { f32x2 o = {sr, si}; C[base + (size_t)(c0 + q) * 64] = o; }
        const float t0 = lr_ * sr - li_ * si + ev[q][0], t1 = lr_ * si + li_ * sr + ev[q][1]; sr = t0; si = t1; } }
  }
}
DI float bperm(float v, int srclane) { return __builtin_bit_cast(float, __builtin_amdgcn_ds_bpermute(srclane << 2, __builtin_bit_cast(int, v))); }
DI void s5_task(LAS unsigned char* sm, int task, int mode, bf16_t* U, f32x2* E, const S5P& P, bool dry) {
  const int tid = tid_(), lane = tid & 63, w = tid >> 6, li = lane & 15, quad = lane >> 4;
  const int b = task >> 8, c = (task >> 2) & 63, oct = task & 3;
  const size_t row0 = (size_t)b * 4096 + c * 64;
  { u32x4 v[2];
#pragma unroll
    for (int it = 0; it < 2; ++it) { const int id = it * 512 + tid, t = id >> 4, cc = id & 15; v[it] = *(const u32x4*)(U + (row0 + t) * 512 + oct * 128 + cc * 8); }
#pragma unroll
    for (int it = 0; it < 2; ++it) { const int id = it * 512 + tid, t = id >> 4, cc = id & 15; *(LAS u32x4*)(sm + t * 272 + cc * 16) = v[it]; } }
  __syncthreads();
  const int g = oct * 8 + w;
  float l1r[4], l1i[4], l2r[4], l2i[4], l3r[4], l3i[4], l4r[4], l4i[4], spr[4], spi[4];
  bf16x8 Bre[4], Bim[4];
#pragma unroll
  for (int pb = 0; pb < 4; ++pb) {
    const int p = pb * 16 + li;
    float lr, lim; s5_lambar(P, g, p, lr, lim);
    const float ar = P.a_re[g * 64 + p], ai = P.a_im[g * 64 + p];
    const float iv = 1.0f / (ar * ar + ai * ai), nr = lr - 1.0f, ni = lim;
    const float cr = (nr * ar + ni * ai) * iv, ci = (ni * ar - nr * ai) * iv;
    u32x4 tre = {0u, 0u, 0u, 0u}, tim = {0u, 0u, 0u, 0u};
    if (quad < 2) {
      const float* pr = P.b_re + ((size_t)g * 64 + p) * 16 + quad * 8; const float* pi = P.b_im + ((size_t)g * 64 + p) * 16 + quad * 8;
      const f32x4 br0 = *(const f32x4*)pr, br1 = *(const f32x4*)(pr + 4), bi0 = *(const f32x4*)pi, bi1 = *(const f32x4*)(pi + 4);
      tre.x = pk2(cr * br0[0] - ci * bi0[0], cr * br0[1] - ci * bi0[1]); tre.y = pk2(cr * br0[2] - ci * bi0[2], cr * br0[3] - ci * bi0[3]);
      tre.z = pk2(cr * br1[0] - ci * bi1[0], cr * br1[1] - ci * bi1[1]); tre.w = pk2(cr * br1[2] - ci * bi1[2], cr * br1[3] - ci * bi1[3]);
      tim.x = pk2(cr * bi0[0] + ci * br0[0], cr * bi0[1] + ci * br0[1]); tim.y = pk2(cr * bi0[2] + ci * br0[2], cr * bi0[3] + ci * br0[3]);
      tim.z = pk2(cr * bi1[0] + ci * br1[0], cr * bi1[1] + ci * br1[1]); tim.w = pk2(cr * bi1[2] + ci * br1[2], cr * bi1[3] + ci * br1[3]);
    }
    Bre[pb] = mk8(tre); Bim[pb] = mk8(tim);
    l1r[pb] = lr; l1i[pb] = lim;
    l2r[pb] = lr * lr - lim * lim; l2i[pb] = 2.0f * lr * lim;
    l3r[pb] = l2r[pb] * lr - l2i[pb] * lim; l3i[pb] = l2r[pb] * lim + l2i[pb] * lr;
    l4r[pb] = l2r[pb] * l2r[pb] - l2i[pb] * l2i[pb]; l4i[pb] = 2.0f * l2r[pb] * l2i[pb];
    spr[pb] = 0.f; spi[pb] = 0.f;
    if (mode == 1) { const f32x2 e = E[(((size_t)b * 32 + g) * 64 + c) * 64 + p]; spr[pb] = e[0]; spi[pb] = e[1]; }
  }
  bf16x8 cm[4]; f32x4 dsk = {0.f, 0.f, 0.f, 0.f};
  LAS unsigned char* ss = sm + 17408 + w * 4352;
  if (mode == 1) {
#pragma unroll
    for (int kk = 0; kk < 4; ++kk) { const int p0 = kk * 16 + quad * 4;
      const f32x4 cr4 = *(const f32x4*)(P.c_re + ((size_t)g * 16 + li) * 64 + p0), ci4 = *(const f32x4*)(P.c_im + ((size_t)g * 16 + li) * 64 + p0);
      u32x4 t; t.x = pk2(cr4[0], -ci4[0]); t.y = pk2(cr4[1], -ci4[1]); t.z = pk2(cr4[2], -ci4[2]); t.w = pk2(cr4[3], -ci4[3]); cm[kk] = mk8(t); }
    dsk = *(const f32x4*)(P.d + g * 16 + quad * 4);
  }
  const int src_up = (lane - 16) & 63, src_q3 = 48 + li;
  for (int sb = 0; sb < 4; ++sb) {
    u32x4 araw = {0u, 0u, 0u, 0u};
    if (quad < 2) araw = *(const LAS u32x4*)(sm + (sb * 16 + li) * 272 + (w * 16 + quad * 8) * 2);
    const bf16x8 a = mk8(araw);
#pragma unroll
    for (int pb = 0; pb < 4; ++pb) {
      const f32x4 z4 = {0.f, 0.f, 0.f, 0.f};
      const f32x4 are = mfma16(a, Bre[pb], z4), aim = mfma16(a, Bim[pb], z4);
      float s0r = are[0], s0i = aim[0];
      float s1r = l1r[pb] * s0r - l1i[pb] * s0i + are[1], s1i = l1r[pb] * s0i + l1i[pb] * s0r + aim[1];
      float s2r = l1r[pb] * s1r - l1i[pb] * s1i + are[2], s2i = l1r[pb] * s1i + l1i[pb] * s1r + aim[2];
      float s3r = l1r[pb] * s2r - l1i[pb] * s2i + are[3], s3i = l1r[pb] * s2i + l1i[pb] * s2r + aim[3];
      float cr_ = (quad == 0) ? spr[pb] : 0.f, ci_ = (quad == 0) ? spi[pb] : 0.f;
#pragma unroll
      for (int r = 0; r < 3; ++r) {
        const float er = l4r[pb] * cr_ - l4i[pb] * ci_ + s3r, ei = l4r[pb] * ci_ + l4i[pb] * cr_ + s3i;
        const float gr = bperm(er, src_up), gi = bperm(ei, src_up);
        if (quad == r + 1) { cr_ = gr; ci_ = gi; }
      }
      s0r += l1r[pb] * cr_ - l1i[pb] * ci_; s0i += l1r[pb] * ci_ + l1i[pb] * cr_;
      s1r += l2r[pb] * cr_ - l2i[pb] * ci_; s1i += l2r[pb] * ci_ + l2i[pb] * cr_;
      s2r += l3r[pb] * cr_ - l3i[pb] * ci_; s2i += l3r[pb] * ci_ + l3i[pb] * cr_;
      s3r += l4r[pb] * cr_ - l4i[pb] * ci_; s3i += l4r[pb] * ci_ + l4i[pb] * cr_;
      spr[pb] = bperm(s3r, src_q3); spi[pb] = bperm(s3i, src_q3);
      if (mode == 1) { LAS unsigned char* q = ss + (quad * 4) * 272 + (pb * 16 + li) * 4;
        *(LAS unsigned*)(q) = pk2(s0r, s0i); *(LAS unsigned*)(q + 272) = pk2(s1r, s1i); *(LAS unsigned*)(q + 544) = pk2(s2r, s2i); *(LAS unsigned*)(q + 816) = pk2(s3r, s3i); }
    }
    if (mode == 1) {
      asm volatile("s_waitcnt lgkmcnt(0)" ::: "memory");
      f32x4 acc = {0.f, 0.f, 0.f, 0.f};
#pragma unroll
      for (int kk = 0; kk < 4; ++kk) { const bf16x8 bq = *(const LAS bf16x8*)(ss + li * 272 + kk * 64 + quad * 16); acc = mfma16(cm[kk], bq, acc); }
      const u32x2 uq = *(const LAS u32x2*)(sm + (sb * 16 + li) * 272 + (w * 16 + quad * 4) * 2);
      const float u4[4] = {bf_lo(uq.x), bf_hi(uq.x), bf_lo(uq.y), bf_hi(uq.y)};
      float o[4];
#pragma unroll
      for (int j = 0; j < 4; ++j) { const float y = acc[j] + dsk[j] * u4[j]; const float z = 0.7978845608028654f * (y + 0.044715f * y * y * y);
        const float th = 1.0f - 2.0f / (__expf(2.0f * z) + 1.0f); o[j] = 0.5f * y * (1.0f + th); }
      asm volatile("s_waitcnt lgkmcnt(0)" ::: "memory");
      u32x2 ov; ov.x = pk2(o[0], o[1]); ov.y = pk2(o[2], o[3]);
      if (!dry) *(u32x2*)(U + (row0 + sb * 16 + li) * 512 + g * 16 + quad * 4) = ov;
    }
  }
  if (mode == 0 && !dry && quad == 0) {
#pragma unroll
    for (int pb = 0; pb < 4; ++pb) { f32x2 e = {spr[pb], spi[pb]}; E[(((size_t)b * 32 + g) * 64 + c) * 64 + pb * 16 + li] = e; }
  }
  __syncthreads();
}

struct GLAP { const float *wg, *bg, *gout; };
constexpr int GL_LR = 0;
constexpr int GL_WG = 4096;
constexpr int GL_BS = 8192;
constexpr int GL_Q = 24832;
constexpr int GL_K = 34048;
constexpr int GL_VT = 43264;
constexpr int GL_ST = 61696;
constexpr int GL_RED = 80128;
constexpr int GL_SEG = 80640;
DI void gla_cumdecay(LAS unsigned char* sm, const bf16_t* LR, size_t row0, int h, const GLAP& P) {
  const int tid = tid_();
  LAS float* lrs = (LAS float*)(sm + GL_LR); LAS float* bs = (LAS float*)(sm + GL_BS); LAS float* segs = (LAS float*)(sm + GL_SEG);
  const int dk = tid & 63, seg = tid >> 6, t0 = seg * 8;
  u32x4 lrv = {0u, 0u, 0u, 0u};
  if (tid < 128) lrv = *(const u32x4*)(LR + (row0 + (tid >> 1)) * 256 + (tid & 1) * 8);
  float wcol[16];
#pragma unroll
  for (int rr = 0; rr < 16; ++rr) wcol[rr] = P.wg[rr * 256 + h * 64 + dk];
  const float bias = P.bg[h * 64 + dk];
  if (tid < 128) { const int t = tid >> 1, hf = tid & 1;
    f32x4 f0 = {bf_lo(lrv.x), bf_hi(lrv.x), bf_lo(lrv.y), bf_hi(lrv.y)}, f1 = {bf_lo(lrv.z), bf_hi(lrv.z), bf_lo(lrv.w), bf_hi(lrv.w)};
    *(LAS f32x4*)(lrs + t * 16 + hf * 8) = f0; *(LAS f32x4*)(lrs + t * 16 + hf * 8 + 4) = f1; }
  __syncthreads();
  float la[8]; float run = 0.f;
#pragma unroll
  for (int e = 0; e < 8; ++e) { float z = bias;
#pragma unroll
    for (int q4 = 0; q4 < 4; ++q4) { const f32x4 r4 = *(const LAS f32x4*)(lrs + (t0 + e) * 16 + q4 * 4);
      z = fmaf(r4[0], wcol[q4 * 4], z); z = fmaf(r4[1], wcol[q4 * 4 + 1], z); z = fmaf(r4[2], wcol[q4 * 4 + 2], z); z = fmaf(r4[3], wcol[q4 * 4 + 3], z); }
    const float ls = fminf(z, 0.f) - log1pf(__expf(-fabsf(z)));
    run += ls * 0.0625f; la[e] = run; }
  segs[seg * 64 + dk] = run;
  __syncthreads();
  float off = 0.f;
#pragma unroll
  for (int s2 = 0; s2 < 7; ++s2) off += (s2 < seg) ? segs[s2 * 64 + dk] : 0.f;
#pragma unroll
  for (int e = 0; e < 8; ++e) bs[(t0 + e) * 65 + dk] = la[e] + off;
  __syncthreads();
}
DI void gla_stage_vt(LAS unsigned char* sm, const bf16_t* VG, size_t row0, int h) {
  LAS unsigned short* vt = (LAS unsigned short*)(sm + GL_VT);
#pragma unroll
  for (int it = 0; it < 2; ++it) { const int id = it * 512 + tid_(), t = id & 63, cc = id >> 6;
    const u32x4 v = *(const u32x4*)(VG + (row0 + t) * 512 + h * 128 + cc * 8);
#pragma unroll
    for (int e = 0; e < 4; ++e) { vt[(cc * 8 + 2 * e) * 72 + t] = (unsigned short)(v[e] & 0xffffu); vt[(cc * 8 + 2 * e + 1) * 72 + t] = (unsigned short)(v[e] >> 16); } }
}
DI void gla_a_task(LAS unsigned char* sm, int task, const bf16_t* QK, const bf16_t* VG, const bf16_t* LR, bf16_t* GST, float* GDEC, const GLAP& P, bool dry) {
  const int tid = tid_(), lane = tid & 63, w = tid >> 6, li = lane & 15, quad = lane >> 4;
  const int bh = task >> 6, c = task & 63, b = bh >> 2, h = bh & 3;
  const size_t row0 = (size_t)b * 4096 + c * 64;
  gla_cumdecay(sm, LR, row0, h, P);
  LAS float* bs = (LAS float*)(sm + GL_BS);
  LAS unsigned short* kht = (LAS unsigned short*)(sm + GL_Q);
  { const int t = tid & 63, dkc = tid >> 6; const u32x4 v = *(const u32x4*)(QK + (row0 + t) * 512 + 256 + h * 64 + dkc * 8);
#pragma unroll
    for (int e = 0; e < 4; ++e) { const int d0 = dkc * 8 + 2 * e;
      const float k0 = bf_lo(v[e]) * __expf(bs[63 * 65 + d0] - bs[t * 65 + d0]), k1 = bf_hi(v[e]) * __expf(bs[63 * 65 + d0 + 1] - bs[t * 65 + d0 + 1]);
      const unsigned pk = pk2(k0, k1); kht[d0 * 72 + t] = (unsigned short)(pk & 0xffffu); kht[(d0 + 1) * 72 + t] = (unsigned short)(pk >> 16); } }
  gla_stage_vt(sm, VG, row0, h);
  if (tid < 64 && !dry) GDEC[(size_t)task * 64 + tid] = __expf(bs[63 * 65 + tid]);
  __syncthreads();
  LAS unsigned short* vt = (LAS unsigned short*)(sm + GL_VT);
#pragma unroll
  for (int dkt = 0; dkt < 4; ++dkt) { f32x4 acc = {0.f, 0.f, 0.f, 0.f};
#pragma unroll
    for (int kk = 0; kk < 2; ++kk) { const bf16x8 a = *(const LAS bf16x8*)(vt + (w * 16 + li) * 72 + kk * 32 + quad * 8), bq = *(const LAS bf16x8*)(kht + (dkt * 16 + li) * 72 + kk * 32 + quad * 8); acc = mfma16(a, bq, acc); }
#pragma unroll
    for (int j = 0; j < 4; ++j) if (!dry) GST[((size_t)task * 128 + w * 16 + quad * 4 + j) * 64 + dkt * 16 + li] = (bf16_t)(pk2(acc[j], 0.f) & 0xffffu); }
  __syncthreads();
}
DI void gla_prefix(const bf16_t* GST, bf16_t* GSO, const float* GDEC, bool dry) {
  const int total = BPG * 4 * 8192;
  for (int gid = blockIdx.x * NTHREADS + tid_(); gid < total; gid += gridDim.x * NTHREADS) {
    const int bh = gid >> 13, e = gid & 8191, dk = e & 63; float S = 0.f;
    for (int c0 = 0; c0 < 64; c0 += 16) { float tv[16], dv[16];
#pragma unroll
      for (int q = 0; q < 16; ++q) { tv[q] = __uint_as_float((unsigned)GST[((size_t)(bh * 64 + c0 + q)) * 8192 + e] << 16); dv[q] = GDEC[(size_t)(bh * 64 + c0 + q) * 64 + dk]; }
#pragma unroll
      for (int q = 0; q < 16; ++q) { if (!dry) GSO[((size_t)(bh * 64 + c0 + q)) * 8192 + e] = (bf16_t)(pk2(S, 0.f) & 0xffffu); S = fmaf(dv[q], S, tv[q]); } }
  }
}
DI void gla_c_task(LAS unsigned char* sm, int task, const bf16_t* QK, bf16_t* VG, const bf16_t* LR, const bf16_t* R, const bf16_t* GST, const GLAP& P, bool dry) {
  const int tid = tid_(), lane = tid & 63, w = tid >> 6, li = lane & 15, quad = lane >> 4;
  const int bh = task >> 6, c = task & 63, b = bh >> 2, h = bh & 3;
  const size_t row0 = (size_t)b * 4096 + c * 64;
  gla_cumdecay(sm, LR, row0, h, P);
  LAS float* bs = (LAS float*)(sm + GL_BS);
  LAS unsigned short* qs = (LAS unsigned short*)(sm + GL_Q); LAS unsigned short* ksm = (LAS unsigned short*)(sm + GL_K);
  LAS unsigned short* vt = (LAS unsigned short*)(sm + GL_VT); LAS unsigned short* st = (LAS unsigned short*)(sm + GL_ST); LAS float* red = (LAS float*)(sm + GL_RED);
  { const int t = tid >> 3, ch = tid & 7;
    const u32x4 qv = *(const u32x4*)(QK + (row0 + t) * 512 + h * 64 + ch * 8), kv = *(const u32x4*)(QK + (row0 + t) * 512 + 256 + h * 64 + ch * 8);
    u32x4 qo, ko;
#pragma unroll
    for (int e = 0; e < 4; ++e) { const int d0 = ch * 8 + 2 * e; const float b0 = bs[t * 65 + d0], b1 = bs[t * 65 + d0 + 1];
      qo[e] = pk2(bf_lo(qv[e]) * 0.125f * __expf(b0), bf_hi(qv[e]) * 0.125f * __expf(b1));
      ko[e] = pk2(bf_lo(kv[e]) * __expf(-b0), bf_hi(kv[e]) * __expf(-b1)); }
    *(LAS u32x4*)(qs + t * 72 + ch * 8) = qo; *(LAS u32x4*)(ksm + t * 72 + ch * 8) = ko; }
  gla_stage_vt(sm, VG, row0, h);
#pragma unroll
  for (int it = 0; it < 2; ++it) { const int id = it * 512 + tid, dv = id >> 3, c8 = id & 7;
    const u32x4 v = *(const u32x4*)(GST + ((size_t)task * 128 + dv) * 64 + c8 * 8);
    *(LAS u32x4*)(st + dv * 72 + c8 * 8) = v; }
  __syncthreads();
  const int qt = w & 3, dvh = w >> 2;
  bf16x8 qf[2];
#pragma unroll
  for (int kk = 0; kk < 2; ++kk) qf[kk] = *(const LAS bf16x8*)(qs + (qt * 16 + li) * 72 + kk * 32 + quad * 8);
  float s[4][4];
#pragma unroll
  for (int jt = 0; jt < 4; ++jt) { f32x4 acc = {0.f, 0.f, 0.f, 0.f};
#pragma unroll
    for (int kk = 0; kk < 2; ++kk) { const bf16x8 a = *(const LAS bf16x8*)(ksm + (jt * 16 + li) * 72 + kk * 32 + quad * 8); acc = mfma16(a, qf[kk], acc); }
#pragma unroll
    for (int j = 0; j < 4; ++j) { const int kj = jt * 16 + quad * 4 + j, qi = qt * 16 + li; s[jt][j] = (kj <= qi) ? acc[j] : 0.f; } }
  bf16x8 pf[2];
#pragma unroll
  for (int pp = 0; pp < 2; ++pp) { u32x4 t; t.x = pk2(s[2 * pp][0], s[2 * pp][1]); t.y = pk2(s[2 * pp][2], s[2 * pp][3]); t.z = pk2(s[2 * pp + 1][0], s[2 * pp + 1][1]); t.w = pk2(s[2 * pp + 1][2], s[2 * pp + 1][3]); pf[pp] = mk8(t); }
  f32x4 o[4]; float ssq = 0.f;
#pragma unroll
  for (int dvt = 0; dvt < 4; ++dvt) { const int dv0 = dvh * 64 + dvt * 16; f32x4 acc = {0.f, 0.f, 0.f, 0.f};
#pragma unroll
    for (int pp = 0; pp < 2; ++pp) { const int kA = 2 * pp * 16 + quad * 4;
      const u32x2 lo = *(const LAS u32x2*)(vt + (dv0 + li) * 72 + kA), hi = *(const LAS u32x2*)(vt + (dv0 + li) * 72 + kA + 16);
      u32x4 t; t.x = lo.x; t.y = lo.y; t.z = hi.x; t.w = hi.y; acc = mfma16(mk8(t), pf[pp], acc); }
#pragma unroll
    for (int kk = 0; kk < 2; ++kk) { const bf16x8 a = *(const LAS bf16x8*)(st + (dv0 + li) * 72 + kk * 32 + quad * 8); acc = mfma16(a, qf[kk], acc); }
    o[dvt] = acc; ssq += acc[0] * acc[0] + acc[1] * acc[1] + acc[2] * acc[2] + acc[3] * acc[3]; }
  ssq += shx(ssq, 16, lane); ssq += shx(ssq, 32, lane);
  if (quad == 0) red[dvh * 64 + qt * 16 + li] = ssq;
  __syncthreads();
  const float tot = red[qt * 16 + li] + red[64 + qt * 16 + li];
  const float rs = rsqrtf(tot * (1.0f / 128.0f) + 1e-6f);
  const size_t row = row0 + qt * 16 + li;
#pragma unroll
  for (int dvt = 0; dvt < 4; ++dvt) { const int dv = dvh * 64 + dvt * 16 + quad * 4;
    const f32x4 gg = *(const f32x4*)(P.gout + dv); const u32x2 rv = *(const u32x2*)(R + row * 512 + h * 128 + dv);
    const float r4[4] = {bf_lo(rv.x), bf_hi(rv.x), bf_lo(rv.y), bf_hi(rv.y)}; float y[4];
#pragma unroll
    for (int j = 0; j < 4; ++j) y[j] = o[dvt][j] * rs * gg[j] * (r4[j] * sigmoidf_(r4[j]));
    u32x2 ov; ov.x = pk2(y[0], y[1]); ov.y = pk2(y[2], y[3]); if (!dry) *(u32x2*)(VG + row * 512 + h * 128 + dv) = ov; }
  __syncthreads();
}

#define XB_TMO      128
#define XB_XCNT(j)  (256  + 64 * (j))
#define XB_XSUB(j)  (1280 + 64 * (j))
#define XB_XGEN(j)  (2304 + 64 * (j))
#define XB_TOP      3328
#define XB_TOPGEN   3392
#define XCD_BAR_WORDS 3456
#define XB_SPIN_CAP (1u << 18)
DI unsigned xb_ld(unsigned* p)              { return __hip_atomic_load(p, __ATOMIC_RELAXED, __HIP_MEMORY_SCOPE_AGENT); }
DI unsigned xb_add(unsigned* p, unsigned v) { return __hip_atomic_fetch_add(p, v, __ATOMIC_RELAXED, __HIP_MEMORY_SCOPE_AGENT); }
DI unsigned xb_xcc_id() { return (unsigned)__builtin_amdgcn_s_getreg((3 << 11) | 20) & 0xFu; }
#define XB_SPIN(cond, bar) do { unsigned _sp = 0; while (cond) { __builtin_amdgcn_s_sleep(1); \
    if ((++_sp & 255u) == 0u) { if (xb_ld(&(bar)[XB_TMO])) break; if (_sp > XB_SPIN_CAP) { atomicAdd(&(bar)[XB_TMO], 1u); break; } } } } while (0)
struct XcdBarrier { unsigned* bar; unsigned x; volatile LAS unsigned* st; };
DI XcdBarrier xcd_barrier_post(unsigned* bar, volatile LAS unsigned* st) {
  XcdBarrier b; b.bar = bar; b.x = xb_xcc_id(); b.st = st;
  if (threadIdx.x == 0) (void)xb_add(&bar[XB_XCNT(b.x)], 1u);
  return b;
}
DI void xcd_barrier_complete(unsigned* bar, unsigned x, unsigned& nloc, unsigned& nx) {
  asm volatile("" : "+s"(bar));
  const unsigned G = gridDim.x * gridDim.y * gridDim.z;
  unsigned sum, cnt, mine, sp = 0u;
  for (;;) {
    sum = 0u; cnt = 0u; mine = 0u;
#pragma unroll
    for (unsigned j = 0; j < 16; ++j) { const unsigned c = xb_ld(&bar[XB_XCNT(j)]); sum += c; cnt += (c > 0u) ? 1u : 0u; mine = (j == x) ? c : mine; }
    if (sum == G) break;
    __builtin_amdgcn_s_sleep(1);
    if ((++sp & 255u) == 0u) { if (xb_ld(&bar[XB_TMO])) break; if (sp > XB_SPIN_CAP) { atomicAdd(&bar[XB_TMO], 1u); break; } }
  }
  nloc = mine > 0u ? mine : 1u; nx = cnt > 0u ? cnt : 1u;
}
DI void xcd_barrier(const XcdBarrier& b) {
  asm volatile("s_waitcnt vmcnt(0)" ::: "memory");
  __syncthreads();
  if (threadIdx.x == 0) {
    unsigned* bar = b.bar; asm volatile("" : "+s"(bar));
    __builtin_amdgcn_s_waitcnt(0);
    unsigned nloc = b.st[0], nx = b.st[1];
    if (nloc == 0u) { xcd_barrier_complete(bar, b.x, nloc, nx); b.st[0] = nloc; b.st[1] = nx; }
    const unsigned old = xb_add(&bar[XB_XSUB(b.x)], 1u);
    const unsigned gen = old / nloc;
    if (old + 1u == (gen + 1u) * nloc) {
      __builtin_amdgcn_fence(__ATOMIC_RELEASE, "agent");
      asm volatile("s_waitcnt vmcnt(0)" ::: "memory");
      const unsigned og = xb_add(&bar[XB_TOP], 1u);
      const unsigned tg = og / nx;
      if (og + 1u == (tg + 1u) * nx) xb_add(&bar[XB_TOPGEN], 1u);
      else XB_SPIN(xb_ld(&bar[XB_TOPGEN]) == tg, bar);
      __builtin_amdgcn_fence(__ATOMIC_ACQUIRE, "agent");
      xb_add(&bar[XB_XGEN(b.x)], 1u);
      asm volatile("s_waitcnt vmcnt(0)" ::: "memory");
    } else {
      XB_SPIN(xb_ld(&bar[XB_XGEN(b.x)]) == gen, bar);
      __builtin_amdgcn_fence(__ATOMIC_ACQUIRE, "agent");
      asm volatile("s_waitcnt vmcnt(0)" ::: "memory");
    }
  }
  __syncthreads();
}

struct Args { const float* in[28]; float* out; unsigned char* ws; int ph_lo, ph_hi; };
constexpr int NPH = 1 + DEPTH * 23 + 1;

__global__ void __launch_bounds__(NTHREADS, 2) mega(Args A) {
  extern __shared__ __attribute__((aligned(16))) unsigned char lds_raw[];
  LAS unsigned char* sm = (LAS unsigned char*)lds_raw;
  cg::grid_group grid = cg::this_grid();
  const int G = gridDim.x, bid = blockIdx.x;
  volatile LAS unsigned* xst = (volatile LAS unsigned*)(sm + LDS_BYTES - 16);
  if (threadIdx.x < 4) xst[threadIdx.x] = 0u;
  __syncthreads();
  XcdBarrier xbar; xbar.bar = (unsigned*)(A.ws + WS_BAR); xbar.x = 0; xbar.st = xst;
  if (A.ph_hi - A.ph_lo > 1) xbar = xcd_barrier_post((unsigned*)(A.ws + WS_BAR), xst);
#ifdef PROBE_A
  unsigned long long tA = 0, tB = 0, tprev = wall_clock64();
#endif

  for (int ph = A.ph_lo; ph < A.ph_hi; ++ph) {
    size_t zo; asm volatile("s_mov_b64 %0, 0" : "=s"(zo));
    unsigned char* ws = A.ws + zo;
    const float* x_in = A.in[0] + zo;
    float* xo = A.out + zo;
    bf16_t* XB = (bf16_t*)(ws + WS_H);
    bf16_t* H = (bf16_t*)xo; bf16_t* PB = (bf16_t*)(ws + WS_P);
    bf16_t* MEMN = (bf16_t*)(ws + WS_MEMN); bf16_t* MKV = (bf16_t*)(ws + WS_MEMKV);
    float* LSE = (float*)(ws + WS_LSE); f32x2* S5E = (f32x2*)(ws + WS_S5E); f32x2* S5C = (f32x2*)(ws + WS_S5C); float* GDEC = (float*)(ws + WS_GDEC); bf16_t* GST = (bf16_t*)((unsigned char*)xo + (size_t)MTOK * 1024 * 2); bf16_t* GSO = GST + (size_t)BPG * 4 * 64 * 8192;
#define IN(i) (A.in[i] + zo)
    int kind, l = 0, grp = 0;
    if (ph == 0) kind = 0; else if (ph == NPH - 1) kind = 17;
    else { const int q = ph - 1; l = q / 23; const int k = q % 23; if (k < 16) { grp = k >> 3; kind = 2 + (k & 7); } else kind = 10 + (k - 16); }
    const float* xsrc = (l == 0) ? x_in : xo;
#ifdef PROBE_REPEAT_MASK
    const int ndry = (int)((PROBE_REPEAT_MASK >> kind) & 1);
#else
    const int ndry = 0;
#endif
    for (int dryi = ndry; dryi >= 0; --dryi) {
    const bool dry = dryi != 0;
    bool isgemm = false; int nrep = 1;
    const int vb = ((G & 7) == 0) ? (bid & 7) * (G >> 3) + (bid >> 3) : bid;
    switch (kind) {
      case 0: {
        for (int ll = 0; ll < DEPTH; ++ll) {
          transpose_w(sm, IN(3) + (size_t)ll * 1024 * 9744, 1024, 9744, (bf16_t*)(ws + WS_WIN) + (size_t)ll * DINP * 1024, DINP, 1);
          transpose_w(sm, IN(12) + (size_t)ll * 512 * 512, 512, 512, (bf16_t*)(ws + WS_WGLU) + (size_t)ll * 512 * 512, 512, 0);
          for (int n = 0; n < 3; ++n) transpose_w(sm, IN(17) + ((size_t)ll * 3 + n) * 512 * 1024, 512, 1024, (bf16_t*)(ws + WS_WBR) + ((size_t)ll * 3 + n) * 1024 * 512, 1024, 0);
          transpose_w(sm, IN(18) + (size_t)ll * 1024 * 1024, 1024, 1024, (bf16_t*)(ws + WS_WOUT) + (size_t)ll * 1024 * 1024, 1024, 0);
          transpose_w(sm, IN(21) + (size_t)ll * 1024 * 1024, 1024, 1024, (bf16_t*)(ws + WS_WXQ) + (size_t)ll * 1024 * 1024, 1024, 0);
          transpose_w(sm, IN(23) + (size_t)ll * 1024 * 1024, 1024, 1024, (bf16_t*)(ws + WS_WXO) + (size_t)ll * 1024 * 1024, 1024, 0);
          transpose_w(sm, IN(22) + (size_t)ll * 1024 * 2048, 1024, 2048, (bf16_t*)(ws + WS_WXKV) + (size_t)ll * 2048 * 1024, 2048, 0);
          transpose_w(sm, IN(25) + (size_t)ll * 1024 * 4096, 1024, 4096, (bf16_t*)(ws + WS_WUP) + (size_t)ll * 4096 * 1024, 4096, 0);
          transpose_w(sm, IN(26) + (size_t)ll * 4096 * 1024, 4096, 1024, (bf16_t*)(ws + WS_WDN) + (size_t)ll * 1024 * 4096, 1024, 0);
        }
        norm_rows_bf16(IN(1), IN(19), MEMN, 2048);
      } break;
      case 3: isgemm = true; nrep = (l == 0 && grp == 0) ? 2 : 1; break;
      case 7: case 8: case 9: case 11: case 13: case 15: case 16: isgemm = true; break;
      case 2: if (l == 0) norm_rows_bf16(x_in + (size_t)grp * MG * 1024, IN(2) + l * 1024, H, MG); else norm_rows_from_bf16(XB + (size_t)grp * MG * 1024, 1024, IN(2) + l * 1024, H, MG); break;
      case 4: {
        S5P sp{IN(4) + l * 2048, IN(5) + l * 2048, IN(6) + l * 32, IN(7) + (size_t)l * 32768, IN(8) + (size_t)l * 32768, IN(9) + (size_t)l * 32768, IN(10) + (size_t)l * 32768, IN(11) + l * 512};
        GLAP gp{IN(14) + l * 4096, IN(15) + l * 256, IN(16) + l * 128};
        constexpr int NA = BPG * 12 * 32, NS = BPG * 256, NGL = BPG * 4 * 64;
        for (int t = vb; t < NA + NS + NGL; t += G) {
          if (t < NA) attn_task(sm, t, PB + P_QA, PB + P_KA, PB + P_VA, LSE, dry);
          else if (t < NA + NS) s5_task(sm, t - NA, 0, PB + P_U, S5E, sp, dry);
          else gla_a_task(sm, t - NA - NS, PB + P_QK, PB + P_VG, PB + P_LR, GST, GDEC, gp, dry);
        }
      } break;
      case 5: { gla_prefix(GST, GSO, GDEC, dry);
        S5P sp{IN(4) + l * 2048, IN(5) + l * 2048, IN(6) + l * 32, IN(7) + (size_t)l * 32768, IN(8) + (size_t)l * 32768, IN(9) + (size_t)l * 32768, IN(10) + (size_t)l * 32768, IN(11) + l * 512};
        s5_carry_scan(S5E, S5C, sp, dry); } break;
      case 6: {
        S5P sp{IN(4) + l * 2048, IN(5) + l * 2048, IN(6) + l * 32, IN(7) + (size_t)l * 32768, IN(8) + (size_t)l * 32768, IN(9) + (size_t)l * 32768, IN(10) + (size_t)l * 32768, IN(11) + l * 512};
        GLAP gp{IN(14) + l * 4096, IN(15) + l * 256, IN(16) + l * 128};
        constexpr int NS = BPG * 256, NGL = BPG * 4 * 64;
        for (int t = bid; t < NS + NGL; t += G) {
          if (t < NS) s5_task(sm, t, 1, PB + P_U, S5C, sp, dry);
          else gla_c_task(sm, t - NS, PB + P_QK, PB + P_VG, PB + P_LR, PB + P_R, GSO, gp, dry);
        }
      } break;
      case 10: norm_rows_from_bf16(XB, 1024, IN(20) + l * 1024, H, MTOK); break;
      case 12: for (int t = vb; t < NB * 4 * 32; t += G) xattn_task(sm, t, PB, MKV, l, dry); break;
      case 14: norm_rows_from_bf16(XB, 1024, IN(24) + l * 1024, H, MTOK); break;
      case 17: final_norm_from_bf16(XB, xo, IN(27), MTOK); break;
      default: break;
    }
    if (isgemm) {
      for (int rep = 0; rep < nrep; ++rep) {
        pg8::Gemm g; Epi E; E.mode = EM_BF16; E.o16 = nullptr; E.ld16 = 0; E.o32 = nullptr; E.r32 = nullptr; E.ld32 = 1024; E.aux = nullptr; E.ldaux = 0; E.bias = nullptr; E.nzm1 = 0; E.r16 = nullptr; E.ldr16 = 1024; int nz = 1;
        bf16_t* MB = PB + P_KA;
        switch (rep == 1 ? 1 : kind) {
          case 1: g = pg8::Gemm{MEMN, (bf16_t*)(ws + WS_WXKV), 2048, 4096, 1024, 1024}; E.mode = EM_BF16; E.o16 = MKV; E.ld16 = 4096; break;
          case 3: g = pg8::Gemm{H, (bf16_t*)(ws + WS_WIN) + (size_t)l * DINP * 1024, MG, DINP, 1024, 1024}; E.mode = EM_PROJ; E.o16 = PB; break;
          case 7: g = pg8::Gemm{PB + P_U, (bf16_t*)(ws + WS_WGLU) + (size_t)l * 512 * 512, MG, 512, 512, 512}; E.mode = EM_GLU; E.o16 = PB + P_QK; E.ld16 = 512; E.aux = PB + P_U; E.ldaux = 512; E.bias = IN(13) + l * 512; break;
          case 8: g = pg8::Gemm{PB + P_QK, (bf16_t*)(ws + WS_WBR) + (size_t)l * 3 * 1024 * 512, MG, 1024, 512, 512};
            g.zA1 = (long)((const char*)(PB + P_VG) - (const char*)(PB + P_QK)); g.zA2 = (long)((const char*)H - (const char*)(PB + P_QK)); g.zB = (long)1024 * 512 * 2; nz = 3;
            E.mode = EM_MERGEZ; E.nzm1 = 2; E.o16 = MB; E.ld16 = 1024; E.aux = PB + P_GATE; E.ldaux = 3072; break;
          case 9: g = pg8::Gemm{MB, (bf16_t*)(ws + WS_WOUT) + (size_t)l * 1024 * 1024, MG, 1024, 1024, 1024}; E.mode = EM_RESID; E.o16 = XB + (size_t)grp * MG * 1024; E.ld16 = 1024; if (l == 0) E.r32 = x_in + (size_t)grp * MG * 1024; else E.r16 = XB + (size_t)grp * MG * 1024; break;
          case 11: g = pg8::Gemm{H, (bf16_t*)(ws + WS_WXQ) + (size_t)l * 1024 * 1024, MTOK, 1024, 1024, 1024}; E.mode = EM_BF16; E.o16 = PB; E.ld16 = 1024; break;
          case 13: g = pg8::Gemm{PB, (bf16_t*)(ws + WS_WXO) + (size_t)l * 1024 * 1024, MTOK, 1024, 1024, 1024}; E.mode = EM_RESID; E.r16 = XB; E.o16 = XB; E.ld16 = 1024; break;
          case 15: g = pg8::Gemm{H, (bf16_t*)(ws + WS_WUP) + (size_t)l * 4096 * 1024, MTOK, 4096, 1024, 1024}; E.mode = EM_RELU2; E.o16 = PB; E.ld16 = 4096; break;
          default: g = pg8::Gemm{PB, (bf16_t*)(ws + WS_WDN) + (size_t)l * 1024 * 4096, MTOK, 1024, 4096, 4096}; E.mode = EM_RESID; E.r16 = XB; E.o16 = XB; E.ld16 = 1024; break;
        }
        g.nz = nz; if (nz == 1) { g.zA1 = 0; g.zA2 = 0; g.zB = 0; }
        g.perm = 1;
        pg8::StaticOrder S; S.init(g.M, g.N, G, bid, nz);
        if (dry) { E.mode = EM_DRY; E.nzm1 = nz - 1; }
        if (nz == 1) pg8::gemm_phase<false, Epi>(sm, g, S, E); else pg8::gemm_phase<true, Epi>(sm, g, S, E);
      }
      if (kind == 7) { if (G > 128) { if (bid >= 128) attn_combine(PB + P_QA, H, LSE, dry, bid - 128, G - 128); } else attn_combine(PB + P_QA, H, LSE, dry, bid, G); }
    }
    }
#ifdef PROBE_A
    { const unsigned long long tn = wall_clock64(); const unsigned long long dt = tn - tprev; tprev = tn;
      if ((PROBE_A >> kind) & 1) tA += dt; if ((PROBE_B >> kind) & 1) tB += dt; }
#endif
    if (ph + 1 < A.ph_hi) { if (ph == A.ph_lo) grid.sync(); else xcd_barrier(xbar); }
#ifdef PROBE_EXTRA_SYNCS
    if (ph == 1) for (int i = 0; i < PROBE_EXTRA_SYNCS; ++i) xcd_barrier(xbar);
#endif
#ifdef PROBE_A
    { const unsigned long long tn = wall_clock64(); const unsigned long long dt = tn - tprev; tprev = tn;
      if ((PROBE_A >> 18) & 1) tA += dt; if ((PROBE_B >> 18) & 1) tB += dt; }
#endif
  }
#ifdef PROBE_A
  {
    float* tw = (float*)(A.ws + WS_LSE);
    if (bid == 0 && tid_() == 0) { tw[0] = (float)tA * 0.01f; tw[1] = (float)tB * 0.01f; __threadfence(); }
    grid.sync();
    const float fa = __builtin_nontemporal_load(tw), fb = __builtin_nontemporal_load(tw + 1);
    for (size_t i = (size_t)bid * NTHREADS + tid_(); i < (size_t)16777216; i += (size_t)G * NTHREADS) A.out[i] += fb;
    if (bid == 1 && tid_() == 0) A.out[(size_t)MTOK * DM - 1] += 64.0f * fa;
  }
#endif
}

extern "C" void kernel_launch(void* const* d_in, const int* in_sizes, int n_in, void* d_out, int out_size, void* d_ws, size_t ws_size, hipStream_t stream) {
  static int grid = 0;
  if (grid == 0) {
    if (n_in != 28 || out_size != MTOK * DM || ws_size < WS_END) { fprintf(stderr, "kernel_launch: unexpected shapes (n_in %d out %d ws %zu need %zu)\n", n_in, out_size, ws_size, (size_t)WS_END); grid = -1; return; }
    int dev = 0, cus = 0, per_cu = 0;
    hipGetDevice(&dev); hipDeviceGetAttribute(&cus, hipDeviceAttributeMultiprocessorCount, dev);
    if (hipFuncSetAttribute((const void*)mega, hipFuncAttributeMaxDynamicSharedMemorySize, LDS_BYTES) != hipSuccess) { fprintf(stderr, "kernel_launch: hipFuncSetAttribute failed\n"); grid = -1; return; }
    hipOccupancyMaxActiveBlocksPerMultiprocessor(&per_cu, (const void*)mega, NTHREADS, LDS_BYTES);
    (void)hipGetLastError();
    if (per_cu < 1) { fprintf(stderr, "kernel_launch: occupancy query says %d blocks per CU\n", per_cu); per_cu = 1; }
    grid = cus;
  }
  if (grid < 0) return;
  if (hipMemsetAsync((unsigned char*)d_ws + WS_BAR, 0, 16384, stream) != hipSuccess) { fprintf(stderr, "kernel_launch: memset of barrier words failed\n"); return; }
  Args a{};
  for (int i = 0; i < 28; ++i) a.in[i] = (const float*)d_in[i];
  a.out = (float*)d_out; a.ws = (unsigned char*)d_ws;
#if MULTI_LAUNCH
  for (int ph = 0; ph < NPH; ++ph) { a.ph_lo = ph; a.ph_hi = ph + 1; hipLaunchKernelGGL(mega, dim3(grid), dim3(NTHREADS), LDS_BYTES, stream, a); }
#else
  a.ph_lo = 0; a.ph_hi = NPH;
  void* args[] = {&a};
  hipError_t e = hipLaunchCooperativeKernel((const void*)mega, dim3(grid), dim3(NTHREADS), args, LDS_BYTES, stream);
  if (e != hipSuccess) fprintf(stderr, "kernel_launch: cooperative launch failed: %s (grid %d)\n", hipGetErrorString(e), grid);
#endif
}
```

```cpp
#include <hip/hip_runtime.h>
#include <hip/hip_cooperative_groups.h>
#include <cstdio>
namespace cg = cooperative_groups;

#ifndef MULTI_LAUNCH
#define MULTI_LAUNCH 0
#endif

#define LAS __attribute__((address_space(3)))
#define DI __device__ __forceinline__
typedef unsigned short bf16_t;
typedef short bf16x8 __attribute__((ext_vector_type(8)));
typedef float f32x4 __attribute__((ext_vector_type(4)));
typedef float f32x2 __attribute__((ext_vector_type(2)));
typedef unsigned u32x4 __attribute__((ext_vector_type(4)));
typedef unsigned u32x2 __attribute__((ext_vector_type(2)));
typedef __bf16 bfv2 __attribute__((ext_vector_type(2)));

constexpr int DM = 1024, SEQ = 4096, NB = 8, MTOK = NB * SEQ, DEPTH = 2;
constexpr int NGRP = 2, MG = MTOK / NGRP, BPG = NB / NGRP;
constexpr int DINP = 9984;
constexpr int NTHREADS = 512;
constexpr int LDS_BYTES = 147456;

constexpr size_t AL(size_t x) { return (x + 255) & ~(size_t)255; }
constexpr size_t WS_WIN = 0;
constexpr size_t WS_WGLU = WS_WIN + AL((size_t)DEPTH * DINP * 1024 * 2);
constexpr size_t WS_WBR = WS_WGLU + AL((size_t)DEPTH * 512 * 512 * 2);
constexpr size_t WS_WOUT = WS_WBR + AL((size_t)DEPTH * 3 * 1024 * 512 * 2);
constexpr size_t WS_WXQ = WS_WOUT + AL((size_t)DEPTH * 1024 * 1024 * 2);
constexpr size_t WS_WXO = WS_WXQ + AL((size_t)DEPTH * 1024 * 1024 * 2);
constexpr size_t WS_WXKV = WS_WXO + AL((size_t)DEPTH * 1024 * 1024 * 2);
constexpr size_t WS_WUP = WS_WXKV + AL((size_t)DEPTH * 2048 * 1024 * 2);
constexpr size_t WS_WDN = WS_WUP + AL((size_t)DEPTH * 4096 * 1024 * 2);
constexpr size_t WS_MEMN = WS_WDN + AL((size_t)DEPTH * 4096 * 1024 * 2);
constexpr size_t WS_MEMKV = WS_MEMN + AL((size_t)2048 * 1024 * 2);
constexpr size_t WS_LSE = WS_MEMKV + AL((size_t)2048 * 4096 * 2);
constexpr size_t WS_S5E = WS_LSE + AL((size_t)MG * 12 * 4);
constexpr size_t WS_S5C = WS_S5E + AL((size_t)BPG * 32 * 64 * 64 * 8);
constexpr size_t WS_GDEC = WS_S5C + AL((size_t)BPG * 32 * 64 * 64 * 8);
constexpr size_t WS_H = WS_GDEC + AL((size_t)BPG * 4 * 64 * 64 * 4);
constexpr size_t WS_GST = WS_H + (size_t)MG * 1024 * 2;
constexpr size_t WS_P = WS_H + AL((size_t)MTOK * 1024 * 2);
constexpr size_t WS_BAR = WS_P + AL((size_t)MG * DINP * 2);
constexpr size_t WS_END = WS_BAR + 16384;
constexpr size_t PE(int tile) { return (size_t)MG * 256 * tile; }
constexpr size_t P_U = PE(0), P_QK = PE(2), P_VG = PE(4), P_R = PE(6), P_QA = PE(8), P_KA = PE(14), P_VA = PE(20), P_GATE = PE(26), P_LR = PE(38);

typedef short s16x4 __attribute__((ext_vector_type(4)));
DI u32x2 lds_tr16(LAS unsigned char* p) { return __builtin_bit_cast(u32x2, __builtin_amdgcn_ds_read_tr16_b64_v4i16((LAS s16x4*)p)); }
DI float bf_lo(unsigned u) { return __uint_as_float(u << 16); }
DI float bf_hi(unsigned u) { return __uint_as_float(u & 0xffff0000u); }
DI unsigned pk2(float lo, float hi) { f32x2 v = {lo, hi}; bfv2 r = __builtin_convertvector(v, bfv2); return __builtin_bit_cast(unsigned, r); }
DI int tid_() { int t = threadIdx.x; asm volatile("" : "+v"(t)); return t; }
DI float shx(float v, int m, int lane) { return __builtin_bit_cast(float, __builtin_amdgcn_ds_bpermute((lane ^ m) << 2, __builtin_bit_cast(int, v))); }
DI float wave_sum(float v, int lane) {
#pragma unroll
  for (int m = 32; m >= 1; m >>= 1) v += shx(v, m, lane);
  return v;
}
DI float sigmoidf_(float x) { return 1.0f / (1.0f + __expf(-x)); }
DI f32x4 mfma16(bf16x8 a, bf16x8 b, f32x4 c) { return __builtin_amdgcn_mfma_f32_16x16x32_bf16(a, b, c, 0, 0, 0); }
DI bf16x8 mk8(u32x4 v) { return __builtin_bit_cast(bf16x8, v); }

namespace pg8 {
constexpr int BM = 256, BK = 64, HALF = 128, HTB = HALF * BK * 2, STAGE_BYTES = 8 * HTB, NXCD = 8, WGM = 4;
DI int lds_byte(int r, int c) { const int st = (r >> 4) * 2 + (c >> 5), rr = r & 15, cc = c & 31, ob = rr * 64 + cc * 2; return st * 1024 + (ob ^ (((ob >> 9) & 1) << 5)); }
DI void stage_rc(int b, int& R, int& C) { const int st = b / 1024, sb = b % 1024, swz = sb ^ (((sb >> 9) & 1) << 5); R = (st >> 1) * 16 + swz / 64; C = (st & 1) * 32 + (swz % 64) / 2; }
DI int perm32(int rho) { const int n = rho >> 4, i = rho & 15; return 8 * (i >> 2) + 4 * n + (i & 3); }
struct Unit { int pm, pn, z; };
struct Gemm { const bf16_t* A; const bf16_t* Bt; int M, N, K, lda; long zA1, zA2, zB; int nz, perm; };
struct StaticOrder {
  int nM, nN, nwg, G, c, nz;
  DI void init(int M, int N, int G_, int c_, int nz_) { nM = M / BM; nN = N / BM; nwg = nM * nN; G = G_; c = c_; nz = nz_; }
  DI bool next(int i, Unit& u) const {
    const int ib = (nz == 1) ? i : i / nz; u.z = i - ib * nz;
    const long L = (long)ib * G + c; if (L >= nwg) return false;
    int wgid = (int)L; { const int q = nwg / NXCD, r = nwg % NXCD, xcd = wgid % NXCD, off = wgid / NXCD; wgid = (xcd < r ? xcd * (q + 1) : r * (q + 1) + (xcd - r) * q) + off; }
    const int nig = WGM * nN, gid = wgid / nig, fm = gid * WGM, gsz = (nM - fm) < WGM ? (nM - fm) : WGM;
    u.pm = fm + ((wgid % nig) % gsz); u.pn = (wgid % nig) / gsz; return true;
  }
};

template <bool CHAIN, class Epi>
DI void gemm_phase(LAS unsigned char* lds, const Gemm g, const StaticOrder& S, const Epi& E) {
  const int tid = tid_(), wid = __builtin_amdgcn_readfirstlane(tid >> 6), lane = tid & 63, wr = wid >> 2, wc = wid & 3, fr = lane & 15, fq = lane >> 4;
  const int K = g.K, nt = K / BK, lda = g.lda;
  unsigned voffA[2], voffB[2];
#pragma unroll
  for (int i = 0; i < 2; ++i) { int R, C; stage_rc(tid * 16 + i * 8192, R, C); const int Rb = g.perm ? ((R & ~31) + perm32(R & 31)) : R;
    voffA[i] = (unsigned)(R * lda + C) * 2u; voffB[i] = (unsigned)(Rb * K + C) * 2u; }
  const size_t kstep = (size_t)(BK * 2);
  const size_t hstA = (size_t)HALF * lda * 2, hstB = (size_t)HALF * K * 2;
  const size_t tstA = 2 * hstA, tstB = 2 * hstB;
  const unsigned ldsw = (unsigned)wid * 1024u;
  const int aoff = lds_byte(wr * 64 + fr, fq * 8), boff = lds_byte(wc * 32 + fr, fq * 8);
#define PG8_SA(b, h) (((b) * 2 + (h)) * HTB)
#define PG8_SB(b, h) ((4 + (b) * 2 + (h)) * HTB)
#define PG8_STAGE(bufoff, gbase, voff) do { _Pragma("unroll") for (int _i = 0; _i < 2; ++_i) \
    __builtin_amdgcn_global_load_lds((const unsigned*)((const char*)(gbase) + (voff)[_i]), (LAS unsigned*)(lds + (bufoff) + ldsw + _i * 8192), 16, 0, 0); } while (0)
#define PG8_LDA(dst, b, h) do { _Pragma("unroll") for (int m = 0; m < 4; ++m) _Pragma("unroll") for (int k = 0; k < 2; ++k) dst[m][k] = *(const LAS bf16x8*)(lds + PG8_SA(b, h) + aoff + m * 2048 + k * 1024); } while (0)
#define PG8_LDB(dst, b, h) do { _Pragma("unroll") for (int n = 0; n < 2; ++n) _Pragma("unroll") for (int k = 0; k < 2; ++k) dst[n][k] = *(const LAS bf16x8*)(lds + PG8_SB(b, h) + boff + n * 2048 + k * 1024); } while (0)
#define PG8_MMA(ai, bj, At, Bt) do { __builtin_amdgcn_s_setprio(1); _Pragma("unroll") for (int m = 0; m < 4; ++m) _Pragma("unroll") for (int n = 0; n < 2; ++n) _Pragma("unroll") for (int k = 0; k < 2; ++k) \
    acc[ai][bj][m][n] = __builtin_amdgcn_mfma_f32_16x16x32_bf16(Bt[n][k], At[m][k], acc[ai][bj][m][n], 0, 0, 0); __builtin_amdgcn_s_setprio(0); } while (0)
#define PG8_WAIT_V(n) asm volatile("s_waitcnt vmcnt(" #n ")" ::: "memory")
#define PG8_WAIT_L(n) asm volatile("s_waitcnt lgkmcnt(" #n ")" ::: "memory")
#define PG8_BAR __builtin_amdgcn_s_barrier()
#define PG8_SCHED __builtin_amdgcn_sched_barrier(0)
  Unit cur, nxt; int ui = 0;
  if (!S.next(0, cur)) return;
  f32x4 acc[2][2][4][2];
#pragma unroll
  for (int a = 0; a < 2; ++a)
#pragma unroll
    for (int b = 0; b < 2; ++b)
#pragma unroll
      for (int m = 0; m < 4; ++m)
#pragma unroll
        for (int n = 0; n < 2; ++n) acc[a][b][m][n] = (f32x4){0.f, 0.f, 0.f, 0.f};
  bf16x8 At[4][2], B0[2][2], B1[2][2];
#define PG8_ZA(z) ((z) == 0 ? 0l : ((z) == 1 ? g.zA1 : g.zA2))
  const char* cA = (const char*)g.A + PG8_ZA(cur.z) + (size_t)cur.pm * tstA; const char* cB = (const char*)g.Bt + (long)cur.z * g.zB + (size_t)cur.pn * tstB;
  PG8_STAGE(PG8_SB(0, 0), cB, voffB); PG8_STAGE(PG8_SA(0, 0), cA, voffA); PG8_STAGE(PG8_SB(0, 1), cB + hstB, voffB); PG8_STAGE(PG8_SA(0, 1), cA + hstA, voffA);
  if (wr == 1) PG8_BAR;
  PG8_WAIT_V(4); PG8_BAR;
  PG8_STAGE(PG8_SB(1, 0), cB + kstep, voffB); PG8_STAGE(PG8_SA(1, 0), cA + kstep, voffA); PG8_STAGE(PG8_SB(1, 1), cB + hstB + kstep, voffB);
  PG8_WAIT_V(6); PG8_BAR;
  for (;;) {
    const bool has_next = S.next(ui + 1, nxt);
    const char* nA = has_next ? (const char*)g.A + PG8_ZA(nxt.z) + (size_t)nxt.pm * tstA : cA; const char* nB = has_next ? (const char*)g.Bt + (long)nxt.z * g.zB + (size_t)nxt.pn * tstB : cB;
    for (int t = 0; t < nt; t += 2) {
      const bool last = (t == nt - 2);
      const char* a1 = cA + (size_t)(t + 1) * kstep;
      const char* a2 = last ? nA : cA + (size_t)(t + 2) * kstep; const char* b2 = last ? nB : cB + (size_t)(t + 2) * kstep;
      const char* a3 = a2 + kstep; const char* b3 = b2 + kstep;
      PG8_LDB(B0, 0, 0); PG8_SCHED; PG8_LDA(At, 0, 0); PG8_STAGE(PG8_SA(1, 1), a1 + hstA, voffA);
      PG8_WAIT_L(8); PG8_BAR; PG8_WAIT_L(0); PG8_MMA(0, 0, At, B0); PG8_BAR; PG8_SCHED;
      PG8_LDB(B1, 0, 1); PG8_STAGE(PG8_SB(0, 0), b2, voffB);
      PG8_BAR; PG8_WAIT_L(0); PG8_MMA(0, 1, At, B1); PG8_BAR;
      PG8_LDA(At, 0, 1); PG8_STAGE(PG8_SA(0, 0), a2, voffA);
      PG8_BAR; PG8_WAIT_L(0); PG8_MMA(1, 0, At, B0); PG8_BAR; PG8_SCHED;
      PG8_STAGE(PG8_SB(0, 1), b2 + hstB, voffB);
      PG8_WAIT_V(6); PG8_BAR; PG8_MMA(1, 1, At, B1); PG8_BAR;
      PG8_LDB(B0, 1, 0); PG8_SCHED; PG8_LDA(At, 1, 0); PG8_STAGE(PG8_SA(0, 1), a2 + hstA, voffA);
      PG8_WAIT_L(8); PG8_BAR; PG8_WAIT_L(0); PG8_MMA(0, 0, At, B0); PG8_BAR; PG8_SCHED;
      PG8_LDB(B1, 1, 1); PG8_STAGE(PG8_SB(1, 0), b3, voffB);
      PG8_BAR; PG8_WAIT_L(0); PG8_MMA(0, 1, At, B1); PG8_BAR;
      PG8_LDA(At, 1, 1); PG8_STAGE(PG8_SA(1, 0), a3, voffA);
      PG8_BAR; PG8_WAIT_L(0); PG8_MMA(1, 0, At, B0); PG8_BAR; PG8_SCHED;
      PG8_STAGE(PG8_SB(1, 1), b3 + hstB, voffB);
      PG8_WAIT_V(6); PG8_BAR; PG8_MMA(1, 1, At, B1); PG8_BAR;
    }
#define PG8_ZERO() do { _Pragma("unroll") for (int a = 0; a < 2; ++a) _Pragma("unroll") for (int b = 0; b < 2; ++b) _Pragma("unroll") for (int m = 0; m < 4; ++m) _Pragma("unroll") for (int n = 0; n < 2; ++n) acc[a][b][m][n] = (f32x4){0.f, 0.f, 0.f, 0.f}; } while (0)
    if constexpr (CHAIN) { E.merge(acc, cur, wr, wc, fr, fq); if (!has_next) break; if (cur.z == E.nzm1) PG8_ZERO(); }
    else { E(acc, cur, wr, wc, fr, fq); if (!has_next) break; PG8_ZERO(); }
    cur = nxt; cA = nA; cB = nB; ++ui;
  }
  PG8_WAIT_V(0);
  if (wr == 0) PG8_BAR;
  PG8_BAR;
#undef PG8_ZA
#undef PG8_ZERO
#undef PG8_SA
#undef PG8_SB
#undef PG8_STAGE
#undef PG8_LDA
#undef PG8_LDB
#undef PG8_MMA
#undef PG8_WAIT_V
#undef PG8_WAIT_L
#undef PG8_BAR
#undef PG8_SCHED
}
}

enum { EM_PROJ = 0, EM_BF16, EM_GLU, EM_MERGEZ, EM_RESID, EM_RELU2, EM_DRY };
struct Epi {
  int mode;
  bf16_t* o16; int ld16;
  float* o32; const float* r32; int ld32;
  const bf16_t* r16; int ldr16;
  const bf16_t* aux; int ldaux;
  const float* bias;
  int nzm1;
  DI bool is_chain() const { return nzm1 != 0; }
  DI void operator()(const f32x4 (&acc)[2][2][4][2], const pg8::Unit& u, int wr, int wc, int fr, int fq) const {
    if (mode == EM_DRY) return;
    const int row0 = u.pm * 256 + wr * 64 + fr;
    int colt = u.pn * 256; bf16_t* ob = o16; int ldo = ld16;
    if (mode == EM_PROJ) {
      const int pn = u.pn; int s, ldp;
      if (pn < 8) { s = pn & ~1; ldp = 512; } else if (pn < 14) { s = 8; ldp = 1536; } else if (pn < 20) { s = 14; ldp = 1536; } else if (pn < 26) { s = 20; ldp = 1536; }
      else if (pn < 38) { s = 26; ldp = 3072; } else { s = 38; ldp = 256; }
      ob = o16 + PE(s); ldo = ldp; colt = (pn - s) * 256;
    }
    const int col0 = colt + wc * 32 + 8 * fq;
    if (mode == EM_PROJ || mode == EM_BF16 || mode == EM_RELU2) {
      const bool sq = (mode == EM_RELU2);
#pragma unroll
      for (int ai = 0; ai < 2; ++ai)
#pragma unroll
        for (int m = 0; m < 4; ++m) {
          const size_t row = (size_t)(row0 + ai * 128 + m * 16);
#pragma unroll
          for (int bj = 0; bj < 2; ++bj) {
            f32x4 v0 = acc[ai][bj][m][0], v1 = acc[ai][bj][m][1];
            if (sq) {
#pragma unroll
              for (int j = 0; j < 4; ++j) { const float a = fmaxf(v0[j], 0.f), b = fmaxf(v1[j], 0.f); v0[j] = a * a; v1[j] = b * b; }
            }
            u32x4 w; w.x = pk2(v0[0], v0[1]); w.y = pk2(v0[2], v0[3]); w.z = pk2(v1[0], v1[1]); w.w = pk2(v1[2], v1[3]);
            *(u32x4*)(ob + row * ldo + col0 + bj * 128) = w;
          }
        }
    } else if (mode == EM_RESID) {
      if (r32) {
#pragma unroll
        for (int ai = 0; ai < 2; ++ai)
#pragma unroll
          for (int mp = 0; mp < 2; ++mp) {
            f32x4 rr[2][2][2];
#pragma unroll
            for (int mm = 0; mm < 2; ++mm)
#pragma unroll
              for (int bj = 0; bj < 2; ++bj) { const float* p = r32 + (size_t)(row0 + ai * 128 + (mp * 2 + mm) * 16) * ld32 + col0 + bj * 128; rr[mm][bj][0] = *(const f32x4*)p; rr[mm][bj][1] = *(const f32x4*)(p + 4); }
#pragma unroll
            for (int mm = 0; mm < 2; ++mm)
#pragma unroll
              for (int bj = 0; bj < 2; ++bj) { const size_t row = (size_t)(row0 + ai * 128 + (mp * 2 + mm) * 16);
                const f32x4 t0 = rr[mm][bj][0] + acc[ai][bj][mp * 2 + mm][0], t1 = rr[mm][bj][1] + acc[ai][bj][mp * 2 + mm][1];
                u32x4 w; w.x = pk2(t0[0], t0[1]); w.y = pk2(t0[2], t0[3]); w.z = pk2(t1[0], t1[1]); w.w = pk2(t1[2], t1[3]);
                *(u32x4*)(ob + row * ldo + col0 + bj * 128) = w; }
          }
      } else {
#pragma unroll
        for (int ai = 0; ai < 2; ++ai) {
          u32x4 q[4][2];
#pragma unroll
          for (int m = 0; m < 4; ++m)
#pragma unroll
            for (int bj = 0; bj < 2; ++bj) q[m][bj] = *(const u32x4*)(r16 + (size_t)(row0 + ai * 128 + m * 16) * ldr16 + col0 + bj * 128);
#pragma unroll
          for (int m = 0; m < 4; ++m)
#pragma unroll
            for (int bj = 0; bj < 2; ++bj) { const u32x4 v = q[m][bj];
              const f32x4 t0 = (f32x4){bf_lo(v.x), bf_hi(v.x), bf_lo(v.y), bf_hi(v.y)} + acc[ai][bj][m][0], t1 = (f32x4){bf_lo(v.z), bf_hi(v.z), bf_lo(v.w), bf_hi(v.w)} + acc[ai][bj][m][1];
              u32x4 w; w.x = pk2(t0[0], t0[1]); w.y = pk2(t0[2], t0[3]); w.z = pk2(t1[0], t1[1]); w.w = pk2(t1[2], t1[3]);
              *(u32x4*)(ob + (size_t)(row0 + ai * 128 + m * 16) * ldo + col0 + bj * 128) = w; }
        }
      }
    } else if (mode == EM_GLU) {
      f32x4 bb[2][2];
#pragma unroll
      for (int bj = 0; bj < 2; ++bj) { bb[bj][0] = *(const f32x4*)(bias + col0 + bj * 128); bb[bj][1] = *(const f32x4*)(bias + col0 + bj * 128 + 4); }
#pragma unroll
      for (int ai = 0; ai < 2; ++ai) {
        u32x4 gq[4][2];
#pragma unroll
        for (int m = 0; m < 4; ++m)
#pragma unroll
          for (int bj = 0; bj < 2; ++bj) gq[m][bj] = *(const u32x4*)(aux + (size_t)(row0 + ai * 128 + m * 16) * ldaux + col0 + bj * 128);
#pragma unroll
        for (int m = 0; m < 4; ++m)
#pragma unroll
          for (int bj = 0; bj < 2; ++bj) {
            const u32x4 q = gq[m][bj]; const f32x4 v0 = acc[ai][bj][m][0], v1 = acc[ai][bj][m][1];
            const float gv[8] = {bf_lo(q.x), bf_hi(q.x), bf_lo(q.y), bf_hi(q.y), bf_lo(q.z), bf_hi(q.z), bf_lo(q.w), bf_hi(q.w)};
            float o[8];
#pragma unroll
            for (int j = 0; j < 4; ++j) { o[j] = gv[j] * sigmoidf_(v0[j] + bb[bj][0][j]); o[4 + j] = gv[4 + j] * sigmoidf_(v1[j] + bb[bj][1][j]); }
            u32x4 w; w.x = pk2(o[0], o[1]); w.y = pk2(o[2], o[3]); w.z = pk2(o[4], o[5]); w.w = pk2(o[6], o[7]);
            *(u32x4*)(ob + (size_t)(row0 + ai * 128 + m * 16) * ldo + col0 + bj * 128) = w;
          }
      }
    }
  }
  DI void merge(f32x4 (&acc)[2][2][4][2], const pg8::Unit& u, int wr, int wc, int fr, int fq) const {
    if (mode == EM_DRY) return;
    const int row0 = u.pm * 256 + wr * 64 + fr, col0 = u.pn * 256 + wc * 32 + 8 * fq;
    bf16_t* ob = o16; const int ldo = ld16;
    {
      const int z = u.z;
#pragma unroll
      for (int ai = 0; ai < 2; ++ai)
#pragma unroll
        for (int mp = 0; mp < 2; ++mp) {
          u32x4 g0[2][2], g1[2][2];
#pragma unroll
          for (int mm = 0; mm < 2; ++mm)
#pragma unroll
            for (int bj = 0; bj < 2; ++bj) { const bf16_t* p = aux + (size_t)(row0 + ai * 128 + (mp * 2 + mm) * 16) * ldaux + z * 1024 + col0 + bj * 128;
              g0[mm][bj] = *(const u32x4*)p; g1[mm][bj] = (z < 2) ? *(const u32x4*)(p + 1024) : (u32x4){0u, 0u, 0u, 0u}; }
#pragma unroll
          for (int mm = 0; mm < 2; ++mm)
#pragma unroll
            for (int bj = 0; bj < 2; ++bj) {
              const int m = mp * 2 + mm; const size_t row = (size_t)(row0 + ai * 128 + m * 16);
              f32x4& a0 = acc[ai][bj][m][0]; f32x4& a1 = acc[ai][bj][m][1];
#pragma unroll
              for (int e2 = 0; e2 < 4; ++e2) {
                const float l0a = bf_lo(g0[mm][bj][e2]), l0b = bf_hi(g0[mm][bj][e2]), l1a = bf_lo(g1[mm][bj][e2]), l1b = bf_hi(g1[mm][bj][e2]);
                float fa = __builtin_amdgcn_rcpf(1.0f + __expf(-l0a)), fb = __builtin_amdgcn_rcpf(1.0f + __expf(-l0b));
                if (z < 2) { fa *= 1.0f + __expf(-l1a); fb *= 1.0f + __expf(-l1b); }
                if (e2 < 2) { a0[2 * e2] *= fa; a0[2 * e2 + 1] *= fb; } else { a1[2 * e2 - 4] *= fa; a1[2 * e2 - 3] *= fb; }
              }
              if (z == 2) { u32x4 w; w.x = pk2(a0[0], a0[1]); w.y = pk2(a0[2], a0[3]); w.z = pk2(a1[0], a1[1]); w.w = pk2(a1[2], a1[3]);
                *(u32x4*)(ob + row * ldo + col0 + bj * 128) = w; }
            }
        }
    }
  }
};

DI void norm_rows_bf16(const float* x, const float* gain, bf16_t* H, int nrows) {
  const int tid = tid_(), lane = tid & 63, gw = blockIdx.x * 8 + (tid >> 6), nw = gridDim.x * 8;
  f32x4 g[4];
#pragma unroll
  for (int i = 0; i < 4; ++i) g[i] = *(const f32x4*)(gain + i * 256 + lane * 4);
  for (int r = gw * 2; r < nrows; r += nw * 2) {
    f32x4 v[2][4];
#pragma unroll
    for (int q = 0; q < 2; ++q)
#pragma unroll
      for (int i = 0; i < 4; ++i) v[q][i] = *(const f32x4*)(x + (size_t)(r + q) * 1024 + i * 256 + lane * 4);
#pragma unroll
    for (int q = 0; q < 2; ++q) {
      float ss = 0.f;
#pragma unroll
      for (int i = 0; i < 4; ++i) ss += v[q][i][0] * v[q][i][0] + v[q][i][1] * v[q][i][1] + v[q][i][2] * v[q][i][2] + v[q][i][3] * v[q][i][3];
      ss = wave_sum(ss, lane);
      const float rs = rsqrtf(ss * (1.0f / 1024.0f) + 1e-6f);
#pragma unroll
      for (int i = 0; i < 4; ++i) { u32x2 w; w.x = pk2(v[q][i][0] * rs * g[i][0], v[q][i][1] * rs * g[i][1]); w.y = pk2(v[q][i][2] * rs * g[i][2], v[q][i][3] * rs * g[i][3]);
        *(u32x2*)(H + (size_t)(r + q) * 1024 + i * 256 + lane * 4) = w; }
    }
  }
}
DI void norm_rows_from_bf16(const bf16_t* xb, int ldx, const float* gain, bf16_t* H, int nrows) {
  const int tid = tid_(), lane = tid & 63, gw = blockIdx.x * 8 + (tid >> 6), nw = gridDim.x * 8;
  f32x4 g[4];
#pragma unroll
  for (int i = 0; i < 2; ++i) { g[2 * i] = *(const f32x4*)(gain + i * 512 + lane * 8); g[2 * i + 1] = *(const f32x4*)(gain + i * 512 + lane * 8 + 4); }
  for (int r = gw * 8; r < nrows; r += nw * 8) {
    u32x4 v[8][2];
#pragma unroll
    for (int q = 0; q < 8; ++q)
#pragma unroll
      for (int i = 0; i < 2; ++i) v[q][i] = *(const u32x4*)(xb + (size_t)(r + q) * ldx + i * 512 + lane * 8);
#pragma unroll
    for (int q = 0; q < 8; ++q) {
      float f[16];
#pragma unroll
      for (int i = 0; i < 2; ++i)
#pragma unroll
        for (int e = 0; e < 4; ++e) { f[i * 8 + 2 * e] = bf_lo(v[q][i][e]); f[i * 8 + 2 * e + 1] = bf_hi(v[q][i][e]); }
      float ss = 0.f;
#pragma unroll
      for (int e = 0; e < 16; ++e) ss += f[e] * f[e];
      ss = wave_sum(ss, lane);
      const float rs = rsqrtf(ss * (1.0f / 1024.0f) + 1e-6f);
#pragma unroll
      for (int i = 0; i < 2; ++i) { u32x4 w;
#pragma unroll
        for (int e = 0; e < 4; ++e) w[e] = pk2(f[i * 8 + 2 * e] * rs * g[2 * i + (e >> 1)][(2 * e) & 3], f[i * 8 + 2 * e + 1] * rs * g[2 * i + (e >> 1)][(2 * e + 1) & 3]);
        *(u32x4*)(H + (size_t)(r + q) * 1024 + i * 512 + lane * 8) = w; }
    }
  }
}
DI void final_norm_expand(float* out, const float* gain, int nrows) {
  const int tid = tid_(), lane = tid & 63, gw = blockIdx.x * 8 + (tid >> 6), nw = gridDim.x * 8;
  f32x4 g[4];
#pragma unroll
  for (int i = 0; i < 2; ++i) { g[2 * i] = *(const f32x4*)(gain + i * 512 + lane * 8); g[2 * i + 1] = *(const f32x4*)(gain + i * 512 + lane * 8 + 4); }
  for (int r = gw; r < nrows; r += nw) {
    const bf16_t* xb = (const bf16_t*)(out + (size_t)r * 1024);
    u32x4 v[2];
#pragma unroll
    for (int i = 0; i < 2; ++i) v[i] = *(const u32x4*)(xb + i * 512 + lane * 8);
    float f[16];
#pragma unroll
    for (int i = 0; i < 2; ++i)
#pragma unroll
      for (int e = 0; e < 4; ++e) { f[i * 8 + 2 * e] = bf_lo(v[i][e]); f[i * 8 + 2 * e + 1] = bf_hi(v[i][e]); }
    float ss = 0.f;
#pragma unroll
    for (int e = 0; e < 16; ++e) ss += f[e] * f[e];
    ss = wave_sum(ss, lane);
    const float rs = rsqrtf(ss * (1.0f / 1024.0f) + 1e-6f);
    asm volatile("s_waitcnt vmcnt(0)" ::: "memory");
#pragma unroll
    for (int i = 0; i < 2; ++i) { f32x4 o0, o1;
#pragma unroll
      for (int e = 0; e < 4; ++e) { o0[e] = f[i * 8 + e] * rs * g[2 * i][e]; o1[e] = f[i * 8 + 4 + e] * rs * g[2 * i + 1][e]; }
      *(f32x4*)(out + (size_t)r * 1024 + i * 512 + lane * 8) = o0; *(f32x4*)(out + (size_t)r * 1024 + i * 512 + lane * 8 + 4) = o1; }
  }
}
DI void final_norm_from_bf16(const bf16_t* xb, float* out, const float* gain, int nrows) {
  const int tid = tid_(), lane = tid & 63, gw = blockIdx.x * 8 + (tid >> 6), nw = gridDim.x * 8;
  f32x4 g[4];
#pragma unroll
  for (int i = 0; i < 2; ++i) { g[2 * i] = *(const f32x4*)(gain + i * 512 + lane * 8); g[2 * i + 1] = *(const f32x4*)(gain + i * 512 + lane * 8 + 4); }
  for (int r = gw * 2; r < nrows; r += nw * 2) {
    u32x4 v[2][2];
#pragma unroll
    for (int q = 0; q < 2; ++q)
#pragma unroll
      for (int i = 0; i < 2; ++i) v[q][i] = *(const u32x4*)(xb + (size_t)(r + q) * 1024 + i * 512 + lane * 8);
#pragma unroll
    for (int q = 0; q < 2; ++q) {
      float f[16];
#pragma unroll
      for (int i = 0; i < 2; ++i)
#pragma unroll
        for (int e = 0; e < 4; ++e) { f[i * 8 + 2 * e] = bf_lo(v[q][i][e]); f[i * 8 + 2 * e + 1] = bf_hi(v[q][i][e]); }
      float ss = 0.f;
#pragma unroll
      for (int e = 0; e < 16; ++e) ss += f[e] * f[e];
      ss = wave_sum(ss, lane);
      const float rs = rsqrtf(ss * (1.0f / 1024.0f) + 1e-6f);
#pragma unroll
      for (int i = 0; i < 2; ++i) { f32x4 o0, o1;
#pragma unroll
        for (int e = 0; e < 4; ++e) { o0[e] = f[i * 8 + e] * rs * g[2 * i][e]; o1[e] = f[i * 8 + 4 + e] * rs * g[2 * i + 1][e]; }
        *(f32x4*)(out + (size_t)(r + q) * 1024 + i * 512 + lane * 8) = o0; *(f32x4*)(out + (size_t)(r + q) * 1024 + i * 512 + lane * 8 + 4) = o1; }
    }
  }
}
DI void norm_rows_f32_inplace(float* x, const float* gain, int nrows) {
  const int tid = tid_(), lane = tid & 63, gw = blockIdx.x * 8 + (tid >> 6), nw = gridDim.x * 8;
  f32x4 g[4];
#pragma unroll
  for (int i = 0; i < 4; ++i) g[i] = *(const f32x4*)(gain + i * 256 + lane * 4);
  for (int r = gw * 2; r < nrows; r += nw * 2) {
    f32x4 v[2][4];
#pragma unroll
    for (int q = 0; q < 2; ++q)
#pragma unroll
      for (int i = 0; i < 4; ++i) v[q][i] = *(const f32x4*)(x + (size_t)(r + q) * 1024 + i * 256 + lane * 4);
#pragma unroll
    for (int q = 0; q < 2; ++q) {
      float ss = 0.f;
#pragma unroll
      for (int i = 0; i < 4; ++i) ss += v[q][i][0] * v[q][i][0] + v[q][i][1] * v[q][i][1] + v[q][i][2] * v[q][i][2] + v[q][i][3] * v[q][i][3];
      ss = wave_sum(ss, lane);
      const float rs = rsqrtf(ss * (1.0f / 1024.0f) + 1e-6f);
#pragma unroll
      for (int i = 0; i < 4; ++i) { f32x4 o; o[0] = v[q][i][0] * rs * g[i][0]; o[1] = v[q][i][1] * rs * g[i][1]; o[2] = v[q][i][2] * rs * g[i][2]; o[3] = v[q][i][3] * rs * g[i][3];
        *(f32x4*)(x + (size_t)(r + q) * 1024 + i * 256 + lane * 4) = o; }
    }
  }
}

DI int win_map(int n) { return n < 1536 ? n : (n < 9728 ? n + 16 : (n < 9744 ? n - 9728 + 1536 : -1)); }
DI void transpose_w(LAS unsigned char* sm, const float* src, int K, int Ns, bf16_t* dst, int Nd, int mapmode) {
  LAS float* tile = (LAS float*)sm;
  const int tid = tid_(), tn = Nd / 64, tk = K / 64;
  for (int t = blockIdx.x; t < tn * tk; t += gridDim.x) {
    const int n0 = (t / tk) * 64, k0 = (t % tk) * 64;
    float tv[8];
#pragma unroll
    for (int it = 0; it < 8; ++it) { const int idx = it * 512 + tid, kk = idx >> 6, nn = idx & 63;
      const int sc = mapmode ? win_map(n0 + nn) : (n0 + nn);
      tv[it] = sc >= 0 ? src[(size_t)(k0 + kk) * Ns + sc] : 0.f; }
#pragma unroll
    for (int it = 0; it < 8; ++it) { const int idx = it * 512 + tid, kk = idx >> 6, nn = idx & 63; tile[kk * 65 + nn] = tv[it]; }
    __syncthreads();
    { const int nn = tid >> 3, kc = tid & 7; float f[8];
#pragma unroll
      for (int e = 0; e < 8; ++e) f[e] = tile[(kc * 8 + e) * 65 + nn];
      u32x4 w; w.x = pk2(f[0], f[1]); w.y = pk2(f[2], f[3]); w.z = pk2(f[4], f[5]); w.w = pk2(f[6], f[7]);
      *(u32x4*)(dst + (size_t)(n0 + nn) * K + k0 + kc * 8) = w; }
    __syncthreads();
  }
}

DI void attn_task(LAS unsigned char* sm, int task, bf16_t* QA, const bf16_t* KA, const bf16_t* VA, float* LSE, bool dry) {
  const int tid = tid_(), lane = tid & 63, w = tid >> 6, li = lane & 15, quad = lane >> 4;
  const int bh = task >> 5, sub = task & 31;
  const int b = bh / 12, h = bh - b * 12, g = h >> 2, dsh = g * 2, dil = 1 << dsh, nblk = 32 >> dsh;
  const int r = sub / nblk, n = sub - r * nblk;
  LAS unsigned char* ks = sm;
  LAS unsigned char* vs = sm + 69632;
  {
    u32x4 kv[8], vv[8];
#pragma unroll
    for (int it = 0; it < 8; ++it) {
      const int id = it * 512 + tid, row = id >> 4, cc = id & 15, sp = n * 128 - 128 + row;
      kv[it] = (u32x4){0u, 0u, 0u, 0u};
      if (sp >= 0) kv[it] = *(const u32x4*)(KA + ((size_t)b * 4096 + (size_t)(sp * dil + r)) * 1536 + h * 128 + cc * 8);
    }
#pragma unroll
    for (int it = 0; it < 8; ++it) {
      const int id = it * 512 + tid, row = id >> 4, cc = id & 15, sp = n * 128 - 128 + row;
      vv[it] = (u32x4){0u, 0u, 0u, 0u};
      if (sp >= 0) vv[it] = *(const u32x4*)(VA + ((size_t)b * 4096 + (size_t)(sp * dil + r)) * 1536 + h * 128 + cc * 8);
    }
#pragma unroll
    for (int it = 0; it < 8; ++it) { const int id = it * 512 + tid, row = id >> 4, cc = id & 15; *(LAS u32x4*)(ks + row * 272 + cc * 16) = kv[it]; }
#pragma unroll
    for (int it = 0; it < 8; ++it) { const int id = it * 512 + tid, row = id >> 4, cc = id & 15; *(LAS u32x4*)(vs + row * 288 + cc * 16) = vv[it]; }
  }
  __syncthreads();
  const int qsp = n * 128 + w * 16 + li;
  const size_t qtok = (size_t)b * 4096 + (size_t)(qsp * dil + r);
  bf16_t* qptr = QA + qtok * 1536 + h * 128;
  bf16x8 qf[4];
#pragma unroll
  for (int kk = 0; kk < 4; ++kk) qf[kk] = *(const bf16x8*)(qptr + kk * 32 + quad * 8);
  const int kt0 = w < 6 ? w : 6;
  const float sc = 0.08838834764831845f * 1.4426950408889634f;
  const float sl = exp2f(-8.0f * (float)(h + 1) / 12.0f) * (float)dil * 1.4426950408889634f;
  float s[10][4]; float mx = -1e30f;
#pragma unroll
  for (int tt = 0; tt < 10; ++tt) {
    const int kt = kt0 + tt; f32x4 acc = {0.f, 0.f, 0.f, 0.f};
#pragma unroll
    for (int kk = 0; kk < 4; ++kk) { const bf16x8 a = *(const LAS bf16x8*)(ks + (kt * 16 + li) * 272 + kk * 64 + quad * 16); acc = mfma16(a, qf[kk], acc); }
#pragma unroll
    for (int j = 0; j < 4; ++j) { const int kl = kt * 16 + quad * 4 + j, dist = 128 + w * 16 + li - kl;
      const bool valid = dist >= 0 && dist <= 128 && (n > 0 || kl >= 128);
      const float v = acc[j] * sc - sl * (float)dist; s[tt][j] = valid ? v : -1e30f; mx = fmaxf(mx, s[tt][j]); }
  }
  mx = fmaxf(mx, shx(mx, 16, lane)); mx = fmaxf(mx, shx(mx, 32, lane));
  float lsum = 0.f;
#pragma unroll
  for (int tt = 0; tt < 10; ++tt)
#pragma unroll
    for (int j = 0; j < 4; ++j) { const float p = exp2f(s[tt][j] - mx); s[tt][j] = p; lsum += p; }
  lsum += shx(lsum, 16, lane); lsum += shx(lsum, 32, lane);
  bf16x8 pf[5];
#pragma unroll
  for (int pp = 0; pp < 5; ++pp) { u32x4 t; t.x = pk2(s[2 * pp][0], s[2 * pp][1]); t.y = pk2(s[2 * pp][2], s[2 * pp][3]); t.z = pk2(s[2 * pp + 1][0], s[2 * pp + 1][1]); t.w = pk2(s[2 * pp + 1][2], s[2 * pp + 1][3]); pf[pp] = mk8(t); }
  const float inv = 1.0f / lsum;
#pragma unroll
  for (int dvt = 0; dvt < 8; ++dvt) {
    f32x4 acc = {0.f, 0.f, 0.f, 0.f};
#pragma unroll
    for (int pp = 0; pp < 5; ++pp) { const int kA = (kt0 + 2 * pp) * 16 + quad * 4;
      LAS unsigned char* vp = vs + (kA + (li >> 2)) * 288 + dvt * 32 + (li & 3) * 8;
      const u32x2 lo = lds_tr16(vp), hi = lds_tr16(vp + 16 * 288);
      u32x4 t; t.x = lo.x; t.y = lo.y; t.z = hi.x; t.w = hi.y; acc = mfma16(mk8(t), pf[pp], acc); }
    u32x2 o; o.x = pk2(acc[0] * inv, acc[1] * inv); o.y = pk2(acc[2] * inv, acc[3] * inv);
    if (!dry) *(u32x2*)(qptr + dvt * 16 + quad * 4) = o;
  }
  if (quad == 0 && !dry) LSE[qtok * 12 + h] = (mx + log2f(lsum)) * 0.6931471805599453f;
  __syncthreads();
}

DI void attn_combine(const bf16_t* QA, bf16_t* YC, const float* LSE, bool dry, int bidx, int nblk) {
  const int nitem = MG * 4 * 16;
  int gs = nblk * NTHREADS; asm volatile("" : "+s"(gs));
  for (int it = bidx * NTHREADS + tid_(); it < nitem; it += gs) {
    const int t = it >> 6, hg = (it >> 4) & 3, dc = it & 15;
    const float l0 = LSE[(size_t)t * 12 + hg], l1 = LSE[(size_t)t * 12 + 4 + hg], l2 = LSE[(size_t)t * 12 + 8 + hg];
    const float m = fmaxf(l0, fmaxf(l1, l2));
    float w0 = __expf(l0 - m), w1 = __expf(l1 - m), w2 = __expf(l2 - m); const float iv = 1.0f / (w0 + w1 + w2); w0 *= iv; w1 *= iv; w2 *= iv;
    const bf16_t* p = QA + (size_t)t * 1536 + hg * 128 + dc * 8;
    const u32x4 a = *(const u32x4*)p, b = *(const u32x4*)(p + 512), c = *(const u32x4*)(p + 1024);
    u32x4 o;
#pragma unroll
    for (int e = 0; e < 4; ++e) o[e] = pk2(w0 * bf_lo(a[e]) + w1 * bf_lo(b[e]) + w2 * bf_lo(c[e]), w0 * bf_hi(a[e]) + w1 * bf_hi(b[e]) + w2 * bf_hi(c[e]));
    if (!dry) *(u32x4*)(YC + (size_t)t * 512 + hg * 128 + dc * 8) = o;
  }
}

DI void xattn_task(LAS unsigned char* sm, int task, bf16_t* XQ, const bf16_t* MKV, int l, bool dry) {
  const int tid = tid_(), lane = tid & 63, w = tid >> 6, li = lane & 15, quad = lane >> 4;
  const int b = task >> 7, hx = (task >> 5) & 3, n = task & 31;
  LAS unsigned char* vs = sm;
  {
    u32x4 kv[16];
#pragma unroll
    for (int it = 0; it < 16; ++it) { const int id = it * 512 + tid, row = id >> 5, cc = id & 31;
      kv[it] = *(const u32x4*)(MKV + (size_t)(b * 256 + row) * 4096 + l * 2048 + hx * 256 + cc * 8); }
#pragma unroll
    for (int it = 0; it < 16; ++it) { const int id = it * 512 + tid, row = id >> 5, cc = id & 31; *(LAS u32x4*)(sm + row * 528 + cc * 16) = kv[it]; }
  }
  __syncthreads();
  const size_t qtok = (size_t)b * 4096 + n * 128 + w * 16 + li;
  bf16_t* qptr = XQ + qtok * 1024 + hx * 256;
  bf16x8 qf[8];
#pragma unroll
  for (int kk = 0; kk < 8; ++kk) qf[kk] = *(const bf16x8*)(qptr + kk * 32 + quad * 8);
  float s[16][4]; float mx = -1e30f;
  const float sc = 0.0625f * 1.4426950408889634f;
#pragma unroll
  for (int kt = 0; kt < 16; ++kt) { f32x4 acc = {0.f, 0.f, 0.f, 0.f};
#pragma unroll
    for (int kk = 0; kk < 8; ++kk) { const bf16x8 a = *(const LAS bf16x8*)(sm + (kt * 16 + li) * 528 + kk * 64 + quad * 16); acc = mfma16(a, qf[kk], acc); }
#pragma unroll
    for (int j = 0; j < 4; ++j) { s[kt][j] = acc[j] * sc; mx = fmaxf(mx, s[kt][j]); } }
  mx = fmaxf(mx, shx(mx, 16, lane)); mx = fmaxf(mx, shx(mx, 32, lane));
  float lsum = 0.f;
#pragma unroll
  for (int kt = 0; kt < 16; ++kt)
#pragma unroll
    for (int j = 0; j < 4; ++j) { const float p = exp2f(s[kt][j] - mx); s[kt][j] = p; lsum += p; }
  lsum += shx(lsum, 16, lane); lsum += shx(lsum, 32, lane);
  bf16x8 pf[8];
#pragma unroll
  for (int pp = 0; pp < 8; ++pp) { u32x4 t; t.x = pk2(s[2 * pp][0], s[2 * pp][1]); t.y = pk2(s[2 * pp][2], s[2 * pp][3]); t.z = pk2(s[2 * pp + 1][0], s[2 * pp + 1][1]); t.w = pk2(s[2 * pp + 1][2], s[2 * pp + 1][3]); pf[pp] = mk8(t); }
  const float inv = 1.0f / lsum;
  {
    u32x4 vv[16];
#pragma unroll
    for (int it = 0; it < 16; ++it) { const int id = it * 512 + tid, row = id >> 5, cc = id & 31;
      vv[it] = *(const u32x4*)(MKV + (size_t)(b * 256 + row) * 4096 + l * 2048 + 1024 + hx * 256 + cc * 8); }
    __syncthreads();
#pragma unroll
    for (int it = 0; it < 16; ++it) { const int id = it * 512 + tid, row = id >> 5, cc = id & 31; *(LAS u32x4*)(vs + row * 544 + cc * 16) = vv[it]; }
  }
  __syncthreads();
#pragma unroll
  for (int dvt = 0; dvt < 16; ++dvt) {
    f32x4 acc = {0.f, 0.f, 0.f, 0.f};
#pragma unroll
    for (int pp = 0; pp < 8; ++pp) { const int kA = 2 * pp * 16 + quad * 4;
      LAS unsigned char* vp = vs + (kA + (li >> 2)) * 544 + dvt * 32 + (li & 3) * 8;
      const u32x2 lo = lds_tr16(vp), hi = lds_tr16(vp + 16 * 544);
      u32x4 t; t.x = lo.x; t.y = lo.y; t.z = hi.x; t.w = hi.y; acc = mfma16(mk8(t), pf[pp], acc); }
    u32x2 o; o.x = pk2(acc[0] * inv, acc[1] * inv); o.y = pk2(acc[2] * inv, acc[3] * inv);
    if (!dry) *(u32x2*)(qptr + dvt * 16 + quad * 4) = o;
  }
  __syncthreads();
}

struct S5P { const float *a_re, *a_im, *log_step, *b_re, *b_im, *c_re, *c_im, *d; };
DI void s5_lambar(const S5P& P, int g, int p, float& lbr, float& lbi) {
  const float step = __expf(P.log_step[g]);
  const float ar = P.a_re[g * 64 + p], ai = P.a_im[g * 64 + p];
  const float mag = __expf(ar * step);
  float sn, cs; { const float x = ai * step; const float k = rintf(x * 0.15915494309189535f); float rr = fmaf(-k, 6.2831854820251465f, x); rr = fmaf(-k, -1.7484556000744883e-07f, rr); sn = sinf(rr); cs = cosf(rr); }
  lbr = mag * cs; lbi = mag * sn;
}
DI void s5_carry_scan(const f32x2* E, f32x2* C, const S5P& P, bool dry) {
  const int total = BPG * 32 * 64;
  for (int gid = blockIdx.x * NTHREADS + tid_(); gid < total; gid += gridDim.x * NTHREADS) {
    const int p = gid & 63, g = (gid >> 6) & 31, b = gid >> 11;
    float lr_, li_; s5_lambar(P, g, p, lr_, li_);
#pragma unroll
    for (int q = 0; q < 6; ++q) { const float t0 = lr_ * lr_ - li_ * li_, t1 = 2.0f * lr_ * li_; lr_ = t0; li_ = t1; }
    const size_t base = (((size_t)b * 32 + g) * 64) * 64 + p;
    float sr = 0.f, si = 0.f;
    for (int c0 = 0; c0 < 64; c0 += 8) { f32x2 ev[8];
#pragma unroll
      for (int q = 0; q < 8; ++q) ev[q] = E[base + (size_t)(c0 + q) * 64];
#pragma unroll
      for (int q = 0; q < 8; ++q) { if (!dry) { f32x2 o = {sr, si}; C[base + (size_t)(c0 + q) * 64] = o; }
        const float t0 = lr_ * sr - li_ * si + ev[q][0], t1 = lr_ * si + li_ * sr + ev[q][1]; sr = t0; si = t1; } }
  }
}
DI float bperm(float v, int srclane) { return __builtin_bit_cast(float, __builtin_amdgcn_ds_bpermute(srclane << 2, __builtin_bit_cast(int, v))); }
DI void s5_task(LAS unsigned char* sm, int task, int mode, bf16_t* U, f32x2* E, const S5P& P, bool dry) {
  const int tid = tid_(), lane = tid & 63, w = tid >> 6, li = lane & 15, quad = lane >> 4;
  const int b = task >> 8, c = (task >> 2) & 63, oct = task & 3;
  const size_t row0 = (size_t)b * 4096 + c * 64;
  { u32x4 v[2];
#pragma unroll
    for (int it = 0; it < 2; ++it) { const int id = it * 512 + tid, t = id >> 4, cc = id & 15; v[it] = *(const u32x4*)(U + (row0 + t) * 512 + oct * 128 + cc * 8); }
#pragma unroll
    for (int it = 0; it < 2; ++it) { const int id = it * 512 + tid, t = id >> 4, cc = id & 15; *(LAS u32x4*)(sm + t * 272 + cc * 16) = v[it]; } }
  __syncthreads();
  const int g = oct * 8 + w;
  float l1r[4], l1i[4], l2r[4], l2i[4], l3r[4], l3i[4], l4r[4], l4i[4], spr[4], spi[4];
  bf16x8 Bre[4], Bim[4];
#pragma unroll
  for (int pb = 0; pb < 4; ++pb) {
    const int p = pb * 16 + li;
    float lr, lim; s5_lambar(P, g, p, lr, lim);
    const float ar = P.a_re[g * 64 + p], ai = P.a_im[g * 64 + p];
    const float iv = 1.0f / (ar * ar + ai * ai), nr = lr - 1.0f, ni = lim;
    const float cr = (nr * ar + ni * ai) * iv, ci = (ni * ar - nr * ai) * iv;
    u32x4 tre = {0u, 0u, 0u, 0u}, tim = {0u, 0u, 0u, 0u};
    if (quad < 2) {
      const float* pr = P.b_re + ((size_t)g * 64 + p) * 16 + quad * 8; const float* pi = P.b_im + ((size_t)g * 64 + p) * 16 + quad * 8;
      const f32x4 br0 = *(const f32x4*)pr, br1 = *(const f32x4*)(pr + 4), bi0 = *(const f32x4*)pi, bi1 = *(const f32x4*)(pi + 4);
      tre.x = pk2(cr * br0[0] - ci * bi0[0], cr * br0[1] - ci * bi0[1]); tre.y = pk2(cr * br0[2] - ci * bi0[2], cr * br0[3] - ci * bi0[3]);
      tre.z = pk2(cr * br1[0] - ci * bi1[0], cr * br1[1] - ci * bi1[1]); tre.w = pk2(cr * br1[2] - ci * bi1[2], cr * br1[3] - ci * bi1[3]);
      tim.x = pk2(cr * bi0[0] + ci * br0[0], cr * bi0[1] + ci * br0[1]); tim.y = pk2(cr * bi0[2] + ci * br0[2], cr * bi0[3] + ci * br0[3]);
      tim.z = pk2(cr * bi1[0] + ci * br1[0], cr * bi1[1] + ci * br1[1]); tim.w = pk2(cr * bi1[2] + ci * br1[2], cr * bi1[3] + ci * br1[3]);
    }
    Bre[pb] = mk8(tre); Bim[pb] = mk8(tim);
    l1r[pb] = lr; l1i[pb] = lim;
    l2r[pb] = lr * lr - lim * lim; l2i[pb] = 2.0f * lr * lim;
    l3r[pb] = l2r[pb] * lr - l2i[pb] * lim; l3i[pb] = l2r[pb] * lim + l2i[pb] * lr;
    l4r[pb] = l2r[pb] * l2r[pb] - l2i[pb] * l2i[pb]; l4i[pb] = 2.0f * l2r[pb] * l2i[pb];
    spr[pb] = 0.f; spi[pb] = 0.f;
    if (mode == 1) { const f32x2 e = E[(((size_t)b * 32 + g) * 64 + c) * 64 + p]; spr[pb] = e[0]; spi[pb] = e[1]; }
  }
  bf16x8 cm[4]; f32x4 dsk = {0.f, 0.f, 0.f, 0.f};
  LAS unsigned char* ss = sm + 17408 + w * 4352;
  if (mode == 1) {
#pragma unroll
    for (int kk = 0; kk < 4; ++kk) { const int p0 = kk * 16 + quad * 4;
      const f32x4 cr4 = *(const f32x4*)(P.c_re + ((size_t)g * 16 + li) * 64 + p0), ci4 = *(const f32x4*)(P.c_im + ((size_t)g * 16 + li) * 64 + p0);
      u32x4 t; t.x = pk2(cr4[0], -ci4[0]); t.y = pk2(cr4[1], -ci4[1]); t.z = pk2(cr4[2], -ci4[2]); t.w = pk2(cr4[3], -ci4[3]); cm[kk] = mk8(t); }
    dsk = *(const f32x4*)(P.d + g * 16 + quad * 4);
  }
  const int src_up = (lane - 16) & 63, src_q3 = 48 + li;
  for (int sb = 0; sb < 4; ++sb) {
    u32x4 araw = {0u, 0u, 0u, 0u};
    if (quad < 2) araw = *(const LAS u32x4*)(sm + (sb * 16 + li) * 272 + (w * 16 + quad * 8) * 2);
    const bf16x8 a = mk8(araw);
#pragma unroll
    for (int pb = 0; pb < 4; ++pb) {
      const f32x4 z4 = {0.f, 0.f, 0.f, 0.f};
      const f32x4 are = mfma16(a, Bre[pb], z4), aim = mfma16(a, Bim[pb], z4);
      float s0r = are[0], s0i = aim[0];
      float s1r = l1r[pb] * s0r - l1i[pb] * s0i + are[1], s1i = l1r[pb] * s0i + l1i[pb] * s0r + aim[1];
      float s2r = l1r[pb] * s1r - l1i[pb] * s1i + are[2], s2i = l1r[pb] * s1i + l1i[pb] * s1r + aim[2];
      float s3r = l1r[pb] * s2r - l1i[pb] * s2i + are[3], s3i = l1r[pb] * s2i + l1i[pb] * s2r + aim[3];
      float cr_ = (quad == 0) ? spr[pb] : 0.f, ci_ = (quad == 0) ? spi[pb] : 0.f;
#pragma unroll
      for (int r = 0; r < 3; ++r) {
        const float er = l4r[pb] * cr_ - l4i[pb] * ci_ + s3r, ei = l4r[pb] * ci_ + l4i[pb] * cr_ + s3i;
        const float gr = bperm(er, src_up), gi = bperm(ei, src_up);
        if (quad == r + 1) { cr_ = gr; ci_ = gi; }
      }
      s0r += l1r[pb] * cr_ - l1i[pb] * ci_; s0i += l1r[pb] * ci_ + l1i[pb] * cr_;
      s1r += l2r[pb] * cr_ - l2i[pb] * ci_; s1i += l2r[pb] * ci_ + l2i[pb] * cr_;
      s2r += l3r[pb] * cr_ - l3i[pb] * ci_; s2i += l3r[pb] * ci_ + l3i[pb] * cr_;
      s3r += l4r[pb] * cr_ - l4i[pb] * ci_; s3i += l4r[pb] * ci_ + l4i[pb] * cr_;
      spr[pb] = bperm(s3r, src_q3); spi[pb] = bperm(s3i, src_q3);
      if (mode == 1) { LAS unsigned char* q = ss + (quad * 4) * 272 + (pb * 16 + li) * 4;
        *(LAS unsigned*)(q) = pk2(s0r, s0i); *(LAS unsigned*)(q + 272) = pk2(s1r, s1i); *(LAS unsigned*)(q + 544) = pk2(s2r, s2i); *(LAS unsigned*)(q + 816) = pk2(s3r, s3i); }
    }
    if (mode == 1) {
      asm volatile("s_waitcnt lgkmcnt(0)" ::: "memory");
      f32x4 acc = {0.f, 0.f, 0.f, 0.f};
#pragma unroll
      for (int kk = 0; kk < 4; ++kk) { const bf16x8 bq = *(const LAS bf16x8*)(ss + li * 272 + kk * 64 + quad * 16); acc = mfma16(cm[kk], bq, acc); }
      const u32x2 uq = *(const LAS u32x2*)(sm + (sb * 16 + li) * 272 + (w * 16 + quad * 4) * 2);
      const float u4[4] = {bf_lo(uq.x), bf_hi(uq.x), bf_lo(uq.y), bf_hi(uq.y)};
      float o[4];
#pragma unroll
      for (int j = 0; j < 4; ++j) { const float y = acc[j] + dsk[j] * u4[j]; const float z = 0.7978845608028654f * (y + 0.044715f * y * y * y);
        const float th = 1.0f - 2.0f / (__expf(2.0f * z) + 1.0f); o[j] = 0.5f * y * (1.0f + th); }
      asm volatile("s_waitcnt lgkmcnt(0)" ::: "memory");
      u32x2 ov; ov.x = pk2(o[0], o[1]); ov.y = pk2(o[2], o[3]);
      if (!dry) *(u32x2*)(U + (row0 + sb * 16 + li) * 512 + g * 16 + quad * 4) = ov;
    }
  }
  if (mode == 0 && !dry && quad == 0) {
#pragma unroll
    for (int pb = 0; pb < 4; ++pb) { f32x2 e = {spr[pb], spi[pb]}; E[(((size_t)b * 32 + g) * 64 + c) * 64 + pb * 16 + li] = e; }
  }
  __syncthreads();
}

struct GLAP { const float *wg, *bg, *gout; };
constexpr int GL_LR = 0;
constexpr int GL_WG = 4096;
constexpr int GL_BS = 8192;
constexpr int GL_Q = 24832;
constexpr int GL_K = 34048;
constexpr int GL_VT = 43264;
constexpr int GL_ST = 61696;
constexpr int GL_RED = 80128;
constexpr int GL_SEG = 80640;
DI void gla_cumdecay(LAS unsigned char* sm, const bf16_t* LR, size_t row0, int h, const GLAP& P) {
  const int tid = tid_();
  LAS float* lrs = (LAS float*)(sm + GL_LR); LAS float* bs = (LAS float*)(sm + GL_BS); LAS float* segs = (LAS float*)(sm + GL_SEG);
  const int dk = tid & 63, seg = tid >> 6, t0 = seg * 8;
  u32x4 lrv = {0u, 0u, 0u, 0u};
  if (tid < 128) lrv = *(const u32x4*)(LR + (row0 + (tid >> 1)) * 256 + (tid & 1) * 8);
  float wcol[16];
#pragma unroll
  for (int rr = 0; rr < 16; ++rr) wcol[rr] = P.wg[rr * 256 + h * 64 + dk];
  const float bias = P.bg[h * 64 + dk];
  if (tid < 128) { const int t = tid >> 1, hf = tid & 1;
    f32x4 f0 = {bf_lo(lrv.x), bf_hi(lrv.x), bf_lo(lrv.y), bf_hi(lrv.y)}, f1 = {bf_lo(lrv.z), bf_hi(lrv.z), bf_lo(lrv.w), bf_hi(lrv.w)};
    *(LAS f32x4*)(lrs + t * 16 + hf * 8) = f0; *(LAS f32x4*)(lrs + t * 16 + hf * 8 + 4) = f1; }
  __syncthreads();
  float la[8]; float run = 0.f;
#pragma unroll
  for (int e = 0; e < 8; ++e) { float z = bias;
#pragma unroll
    for (int q4 = 0; q4 < 4; ++q4) { const f32x4 r4 = *(const LAS f32x4*)(lrs + (t0 + e) * 16 + q4 * 4);
      z = fmaf(r4[0], wcol[q4 * 4], z); z = fmaf(r4[1], wcol[q4 * 4 + 1], z); z = fmaf(r4[2], wcol[q4 * 4 + 2], z); z = fmaf(r4[3], wcol[q4 * 4 + 3], z); }
    const float ls = fminf(z, 0.f) - log1pf(__expf(-fabsf(z)));
    run += ls * 0.0625f; la[e] = run; }
  segs[seg * 64 + dk] = run;
  __syncthreads();
  float off = 0.f;
#pragma unroll
  for (int s2 = 0; s2 < 7; ++s2) off += (s2 < seg) ? segs[s2 * 64 + dk] : 0.f;
#pragma unroll
  for (int e = 0; e < 8; ++e) bs[(t0 + e) * 65 + dk] = la[e] + off;
  __syncthreads();
}
DI void gla_stage_vt(LAS unsigned char* sm, const bf16_t* VG, size_t row0, int h) {
  LAS unsigned char* vs = sm + GL_VT;
  u32x4 v[2];
#pragma unroll
  for (int it = 0; it < 2; ++it) { const int id = it * 512 + tid_(), t = id >> 4, cc = id & 15; v[it] = *(const u32x4*)(VG + (row0 + t) * 512 + h * 128 + cc * 8); }
#pragma unroll
  for (int it = 0; it < 2; ++it) { const int id = it * 512 + tid_(), t = id >> 4, cc = id & 15; *(LAS u32x4*)(vs + t * 288 + cc * 16) = v[it]; }
}
DI void gla_a_task(LAS unsigned char* sm, int task, const bf16_t* QK, const bf16_t* VG, const bf16_t* LR, bf16_t* GST, float* GDEC, const GLAP& P, bool dry) {
  const int tid = tid_(), lane = tid & 63, w = tid >> 6, li = lane & 15, quad = lane >> 4;
  const int bh = task >> 6, c = task & 63, b = bh >> 2, h = bh & 3;
  const size_t row0 = (size_t)b * 4096 + c * 64;
  gla_cumdecay(sm, LR, row0, h, P);
  LAS float* bs = (LAS float*)(sm + GL_BS);
  LAS unsigned short* kht = (LAS unsigned short*)(sm + GL_Q);
  { const int t = tid & 63, dkc = tid >> 6; const u32x4 v = *(const u32x4*)(QK + (row0 + t) * 512 + 256 + h * 64 + dkc * 8);
#pragma unroll
    for (int e = 0; e < 4; ++e) { const int d0 = dkc * 8 + 2 * e;
      const float k0 = bf_lo(v[e]) * __expf(bs[63 * 65 + d0] - bs[t * 65 + d0]), k1 = bf_hi(v[e]) * __expf(bs[63 * 65 + d0 + 1] - bs[t * 65 + d0 + 1]);
      const unsigned pk = pk2(k0, k1); kht[d0 * 72 + t] = (unsigned short)(pk & 0xffffu); kht[(d0 + 1) * 72 + t] = (unsigned short)(pk >> 16); } }
  gla_stage_vt(sm, VG, row0, h);
  if (tid < 64 && !dry) GDEC[(size_t)task * 64 + tid] = __expf(bs[63 * 65 + tid]);
  __syncthreads();
  LAS unsigned short* vt = (LAS unsigned short*)(sm + GL_VT);
#pragma unroll
  for (int dkt = 0; dkt < 4; ++dkt) { f32x4 acc = {0.f, 0.f, 0.f, 0.f};
#pragma unroll
    for (int kk = 0; kk < 2; ++kk) { LAS unsigned char* vp = (LAS unsigned char*)vt + (kk * 32 + quad * 8 + (li >> 2)) * 288 + w * 32 + (li & 3) * 8;
      const u32x2 lo = lds_tr16(vp), hi = lds_tr16(vp + 4 * 288); u32x4 ta; ta.x = lo.x; ta.y = lo.y; ta.z = hi.x; ta.w = hi.y;
      const bf16x8 bq = *(const LAS bf16x8*)(kht + (dkt * 16 + li) * 72 + kk * 32 + quad * 8); acc = mfma16(mk8(ta), bq, acc); }
#pragma unroll
    for (int j = 0; j < 4; ++j) if (!dry) GST[((size_t)task * 128 + w * 16 + quad * 4 + j) * 64 + dkt * 16 + li] = (bf16_t)(pk2(acc[j], 0.f) & 0xffffu); }
  __syncthreads();
}
DI void gla_prefix(const bf16_t* GST, bf16_t* GSO, const float* GDEC, bool dry) {
  const int total = BPG * 4 * 8192;
  for (int gid = blockIdx.x * NTHREADS + tid_(); gid < total; gid += gridDim.x * NTHREADS) {
    const int bh = gid >> 13, e = gid & 8191, dk = e & 63; float S = 0.f;
    for (int c0 = 0; c0 < 64; c0 += 16) { float tv[16], dv[16];
#pragma unroll
      for (int q = 0; q < 16; ++q) { tv[q] = __uint_as_float((unsigned)GST[((size_t)(bh * 64 + c0 + q)) * 8192 + e] << 16); dv[q] = GDEC[(size_t)(bh * 64 + c0 + q) * 64 + dk]; }
#pragma unroll
      for (int q = 0; q < 16; ++q) { if (!dry) GSO[((size_t)(bh * 64 + c0 + q)) * 8192 + e] = (bf16_t)(pk2(S, 0.f) & 0xffffu); S = fmaf(dv[q], S, tv[q]); } }
  }
}
DI void gla_c_task(LAS unsigned char* sm, int task, const bf16_t* QK, bf16_t* VG, const bf16_t* LR, const bf16_t* R, const bf16_t* GST, const GLAP& P, bool dry) {
  const int tid = tid_(), lane = tid & 63, w = tid >> 6, li = lane & 15, quad = lane >> 4;
  const int bh = task >> 6, c = task & 63, b = bh >> 2, h = bh & 3;
  const size_t row0 = (size_t)b * 4096 + c * 64;
  gla_cumdecay(sm, LR, row0, h, P);
  LAS float* bs = (LAS float*)(sm + GL_BS);
  LAS unsigned short* qs = (LAS unsigned short*)(sm + GL_Q); LAS unsigned short* ksm = (LAS unsigned short*)(sm + GL_K);
  LAS unsigned short* vt = (LAS unsigned short*)(sm + GL_VT); LAS unsigned short* st = (LAS unsigned short*)(sm + GL_ST); LAS float* red = (LAS float*)(sm + GL_RED);
  { const int t = tid >> 3, ch = tid & 7;
    const u32x4 qv = *(const u32x4*)(QK + (row0 + t) * 512 + h * 64 + ch * 8), kv = *(const u32x4*)(QK + (row0 + t) * 512 + 256 + h * 64 + ch * 8);
    u32x4 qo, ko;
#pragma unroll
    for (int e = 0; e < 4; ++e) { const int d0 = ch * 8 + 2 * e; const float b0 = bs[t * 65 + d0], b1 = bs[t * 65 + d0 + 1];
      qo[e] = pk2(bf_lo(qv[e]) * 0.125f * __expf(b0), bf_hi(qv[e]) * 0.125f * __expf(b1));
      ko[e] = pk2(bf_lo(kv[e]) * __expf(-b0), bf_hi(kv[e]) * __expf(-b1)); }
    *(LAS u32x4*)(qs + t * 72 + ch * 8) = qo; *(LAS u32x4*)(ksm + t * 72 + ch * 8) = ko; }
  gla_stage_vt(sm, VG, row0, h);
#pragma unroll
  for (int it = 0; it < 2; ++it) { const int id = it * 512 + tid, dv = id >> 3, c8 = id & 7;
    const u32x4 v = *(const u32x4*)(GST + ((size_t)task * 128 + dv) * 64 + c8 * 8);
    *(LAS u32x4*)(st + dv * 72 + c8 * 8) = v; }
  __syncthreads();
  const int qt = w & 3, dvh = w >> 2;
  bf16x8 qf[2];
#pragma unroll
  for (int kk = 0; kk < 2; ++kk) qf[kk] = *(const LAS bf16x8*)(qs + (qt * 16 + li) * 72 + kk * 32 + quad * 8);
  float s[4][4];
#pragma unroll
  for (int jt = 0; jt < 4; ++jt) { f32x4 acc = {0.f, 0.f, 0.f, 0.f};
#pragma unroll
    for (int kk = 0; kk < 2; ++kk) { const bf16x8 a = *(const LAS bf16x8*)(ksm + (jt * 16 + li) * 72 + kk * 32 + quad * 8); acc = mfma16(a, qf[kk], acc); }
#pragma unroll
    for (int j = 0; j < 4; ++j) { const int kj = jt * 16 + quad * 4 + j, qi = qt * 16 + li; s[jt][j] = (kj <= qi) ? acc[j] : 0.f; } }
  bf16x8 pf[2];
#pragma unroll
  for (int pp = 0; pp < 2; ++pp) { u32x4 t; t.x = pk2(s[2 * pp][0], s[2 * pp][1]); t.y = pk2(s[2 * pp][2], s[2 * pp][3]); t.z = pk2(s[2 * pp + 1][0], s[2 * pp + 1][1]); t.w = pk2(s[2 * pp + 1][2], s[2 * pp + 1][3]); pf[pp] = mk8(t); }
  f32x4 o[4]; float ssq = 0.f;
#pragma unroll
  for (int dvt = 0; dvt < 4; ++dvt) { const int dv0 = dvh * 64 + dvt * 16; f32x4 acc = {0.f, 0.f, 0.f, 0.f};
#pragma unroll
    for (int pp = 0; pp < 2; ++pp) { const int kA = 2 * pp * 16 + quad * 4;
      LAS unsigned char* vp = (LAS unsigned char*)vt + (kA + (li >> 2)) * 288 + dv0 * 2 + (li & 3) * 8;
      const u32x2 lo = lds_tr16(vp), hi = lds_tr16(vp + 16 * 288);
      u32x4 t; t.x = lo.x; t.y = lo.y; t.z = hi.x; t.w = hi.y; acc = mfma16(mk8(t), pf[pp], acc); }
#pragma unroll
    for (int kk = 0; kk < 2; ++kk) { const bf16x8 a = *(const LAS bf16x8*)(st + (dv0 + li) * 72 + kk * 32 + quad * 8); acc = mfma16(a, qf[kk], acc); }
    o[dvt] = acc; ssq += acc[0] * acc[0] + acc[1] * acc[1] + acc[2] * acc[2] + acc[3] * acc[3]; }
  ssq += shx(ssq, 16, lane); ssq += shx(ssq, 32, lane);
  if (quad == 0) red[dvh * 64 + qt * 16 + li] = ssq;
  __syncthreads();
  const float tot = red[qt * 16 + li] + red[64 + qt * 16 + li];
  const float rs = rsqrtf(tot * (1.0f / 128.0f) + 1e-6f);
  const size_t row = row0 + qt * 16 + li;
#pragma unroll
  for (int dvt = 0; dvt < 4; ++dvt) { const int dv = dvh * 64 + dvt * 16 + quad * 4;
    const f32x4 gg = *(const f32x4*)(P.gout + dv); const u32x2 rv = *(const u32x2*)(R + row * 512 + h * 128 + dv);
    const float r4[4] = {bf_lo(rv.x), bf_hi(rv.x), bf_lo(rv.y), bf_hi(rv.y)}; float y[4];
#pragma unroll
    for (int j = 0; j < 4; ++j) y[j] = o[dvt][j] * rs * gg[j] * (r4[j] * sigmoidf_(r4[j]));
    u32x2 ov; ov.x = pk2(y[0], y[1]); ov.y = pk2(y[2], y[3]); if (!dry) *(u32x2*)(VG + row * 512 + h * 128 + dv) = ov; }
  __syncthreads();
}

#define XB_TMO      128
#define XB_XCNT(j)  (256  + 64 * (j))
#define XB_XSUB(j)  (1280 + 64 * (j))
#define XB_XGEN(j)  (2304 + 64 * (j))
#define XB_TOP      3328
#define XB_TOPGEN   3392
#define XCD_BAR_WORDS 3456
#define XB_SPIN_CAP (1u << 18)
DI unsigned xb_ld(unsigned* p)              { return __hip_atomic_load(p, __ATOMIC_RELAXED, __HIP_MEMORY_SCOPE_AGENT); }
DI unsigned xb_add(unsigned* p, unsigned v) { return __hip_atomic_fetch_add(p, v, __ATOMIC_RELAXED, __HIP_MEMORY_SCOPE_AGENT); }
DI unsigned xb_xcc_id() { return (unsigned)__builtin_amdgcn_s_getreg((3 << 11) | 20) & 0xFu; }
#define XB_SPIN(cond, bar) do { unsigned _sp = 0; while (cond) { __builtin_amdgcn_s_sleep(1); \
    if ((++_sp & 255u) == 0u) { if (xb_ld(&(bar)[XB_TMO])) break; if (_sp > XB_SPIN_CAP) { atomicAdd(&(bar)[XB_TMO], 1u); break; } } } } while (0)
struct XcdBarrier { unsigned* bar; unsigned x; volatile LAS unsigned* st; };
DI XcdBarrier xcd_barrier_post(unsigned* bar, volatile LAS unsigned* st) {
  XcdBarrier b; b.bar = bar; b.x = xb_xcc_id(); b.st = st;
  if (threadIdx.x == 0) (void)xb_add(&bar[XB_XCNT(b.x)], 1u);
  return b;
}
DI void xcd_barrier_complete(unsigned* bar, unsigned x, unsigned& nloc, unsigned& nx) {
  asm volatile("" : "+s"(bar));
  const unsigned G = gridDim.x * gridDim.y * gridDim.z;
  unsigned sum, cnt, mine, sp = 0u;
  for (;;) {
    sum = 0u; cnt = 0u; mine = 0u;
#pragma unroll
    for (unsigned j = 0; j < 16; ++j) { const unsigned c = xb_ld(&bar[XB_XCNT(j)]); sum += c; cnt += (c > 0u) ? 1u : 0u; mine = (j == x) ? c : mine; }
    if (sum == G) break;
    __builtin_amdgcn_s_sleep(1);
    if ((++sp & 255u) == 0u) { if (xb_ld(&bar[XB_TMO])) break; if (sp > XB_SPIN_CAP) { atomicAdd(&bar[XB_TMO], 1u); break; } }
  }
  nloc = mine > 0u ? mine : 1u; nx = cnt > 0u ? cnt : 1u;
}
DI void xcd_barrier(const XcdBarrier& b) {
  asm volatile("s_waitcnt vmcnt(0)" ::: "memory");
  __syncthreads();
  if (threadIdx.x == 0) {
    unsigned* bar = b.bar; asm volatile("" : "+s"(bar));
    __builtin_amdgcn_s_waitcnt(0);
    unsigned nloc = b.st[0], nx = b.st[1];
    if (nloc == 0u) { xcd_barrier_complete(bar, b.x, nloc, nx); b.st[0] = nloc; b.st[1] = nx; }
    const unsigned old = xb_add(&bar[XB_XSUB(b.x)], 1u);
    const unsigned gen = old / nloc;
    if (old + 1u == (gen + 1u) * nloc) {
      __builtin_amdgcn_fence(__ATOMIC_RELEASE, "agent");
      asm volatile("s_waitcnt vmcnt(0)" ::: "memory");
      const unsigned og = xb_add(&bar[XB_TOP], 1u);
      const unsigned tg = og / nx;
      if (og + 1u == (tg + 1u) * nx) xb_add(&bar[XB_TOPGEN], 1u);
      else XB_SPIN(xb_ld(&bar[XB_TOPGEN]) == tg, bar);
      __builtin_amdgcn_fence(__ATOMIC_ACQUIRE, "agent");
      xb_add(&bar[XB_XGEN(b.x)], 1u);
      asm volatile("s_waitcnt vmcnt(0)" ::: "memory");
    } else {
      XB_SPIN(xb_ld(&bar[XB_XGEN(b.x)]) == gen, bar);
      __builtin_amdgcn_fence(__ATOMIC_ACQUIRE, "agent");
      asm volatile("s_waitcnt vmcnt(0)" ::: "memory");
    }
  }
  __syncthreads();
}

struct Args { const float* in[28]; float* out; unsigned char* ws; int ph_lo, ph_hi; };
constexpr int NPH = 1 + DEPTH * 23 + 1;

__global__ void __launch_bounds__(NTHREADS, 2) mega(Args A) {
  extern __shared__ __attribute__((aligned(16))) unsigned char lds_raw[];
  LAS unsigned char* sm = (LAS unsigned char*)lds_raw;
  cg::grid_group grid = cg::this_grid();
  const int G = gridDim.x, bid = blockIdx.x;
  volatile LAS unsigned* xst = (volatile LAS unsigned*)(sm + LDS_BYTES - 16);
  if (threadIdx.x < 4) xst[threadIdx.x] = 0u;
  __syncthreads();
  XcdBarrier xbar; xbar.bar = (unsigned*)(A.ws + WS_BAR); xbar.x = 0; xbar.st = xst;
  if (A.ph_hi - A.ph_lo > 1) xbar = xcd_barrier_post((unsigned*)(A.ws + WS_BAR), xst);
#ifdef PROBE_A
  unsigned long long tA = 0, tB = 0, tprev = wall_clock64();
#endif

  for (int ph = A.ph_lo; ph < A.ph_hi; ++ph) {
    size_t zo; asm volatile("s_mov_b64 %0, 0" : "=s"(zo));
    unsigned char* ws = A.ws + zo;
    const float* x_in = A.in[0] + zo;
    float* xo = A.out + zo;
    bf16_t* XB = (bf16_t*)(ws + WS_H);
    bf16_t* H = (bf16_t*)xo; bf16_t* PB = (bf16_t*)(ws + WS_P);
    bf16_t* MEMN = (bf16_t*)(ws + WS_MEMN); bf16_t* MKV = (bf16_t*)(ws + WS_MEMKV);
    float* LSE = (float*)(ws + WS_LSE); f32x2* S5E = (f32x2*)(ws + WS_S5E); f32x2* S5C = (f32x2*)(ws + WS_S5C); float* GDEC = (float*)(ws + WS_GDEC); bf16_t* GST = (bf16_t*)((unsigned char*)xo + (size_t)MTOK * 1024 * 2); bf16_t* GSO = GST + (size_t)BPG * 4 * 64 * 8192;
#define IN(i) (A.in[i] + zo)
    int kind, l = 0, grp = 0;
    if (ph == 0) kind = 0; else if (ph == NPH - 1) kind = 17;
    else { const int q = ph - 1; l = q / 23; const int k = q % 23; if (k < 16) { grp = k >> 3; kind = 2 + (k & 7); } else kind = 10 + (k - 16); }
    const float* xsrc = (l == 0) ? x_in : xo;
#ifdef PROBE_REPEAT_MASK
    const int ndry = (int)((PROBE_REPEAT_MASK >> kind) & 1);
#else
    const int ndry = 0;
#endif
    for (int dryi = ndry; dryi >= 0; --dryi) {
    const bool dry = dryi != 0;
    bool isgemm = false; int nrep = 1;
    const int vb = ((G & 7) == 0) ? (bid & 7) * (G >> 3) + (bid >> 3) : bid;
    switch (kind) {
      case 0: {
        for (int ll = 0; ll < DEPTH; ++ll) {
          transpose_w(sm, IN(3) + (size_t)ll * 1024 * 9744, 1024, 9744, (bf16_t*)(ws + WS_WIN) + (size_t)ll * DINP * 1024, DINP, 1);
          transpose_w(sm, IN(12) + (size_t)ll * 512 * 512, 512, 512, (bf16_t*)(ws + WS_WGLU) + (size_t)ll * 512 * 512, 512, 0);
          for (int n = 0; n < 3; ++n) transpose_w(sm, IN(17) + ((size_t)ll * 3 + n) * 512 * 1024, 512, 1024, (bf16_t*)(ws + WS_WBR) + ((size_t)ll * 3 + n) * 1024 * 512, 1024, 0);
          transpose_w(sm, IN(18) + (size_t)ll * 1024 * 1024, 1024, 1024, (bf16_t*)(ws + WS_WOUT) + (size_t)ll * 1024 * 1024, 1024, 0);
          transpose_w(sm, IN(21) + (size_t)ll * 1024 * 1024, 1024, 1024, (bf16_t*)(ws + WS_WXQ) + (size_t)ll * 1024 * 1024, 1024, 0);
          transpose_w(sm, IN(23) + (size_t)ll * 1024 * 1024, 1024, 1024, (bf16_t*)(ws + WS_WXO) + (size_t)ll * 1024 * 1024, 1024, 0);
          transpose_w(sm, IN(22) + (size_t)ll * 1024 * 2048, 1024, 2048, (bf16_t*)(ws + WS_WXKV) + (size_t)ll * 2048 * 1024, 2048, 0);
          transpose_w(sm, IN(25) + (size_t)ll * 1024 * 4096, 1024, 4096, (bf16_t*)(ws + WS_WUP) + (size_t)ll * 4096 * 1024, 4096, 0);
          transpose_w(sm, IN(26) + (size_t)ll * 4096 * 1024, 4096, 1024, (bf16_t*)(ws + WS_WDN) + (size_t)ll * 1024 * 4096, 1024, 0);
        }
        norm_rows_bf16(IN(1), IN(19), MEMN, 2048);
      } break;
      case 3: isgemm = true; nrep = (l == 0 && grp == 0) ? 2 : 1; break;
      case 7: case 8: case 9: case 11: case 13: case 15: case 16: isgemm = true; break;
      case 2: if (l == 0) norm_rows_bf16(x_in + (size_t)grp * MG * 1024, IN(2) + l * 1024, H, MG); else norm_rows_from_bf16(XB + (size_t)grp * MG * 1024, 1024, IN(2) + l * 1024, H, MG); break;
      case 4: {
        S5P sp{IN(4) + l * 2048, IN(5) + l * 2048, IN(6) + l * 32, IN(7) + (size_t)l * 32768, IN(8) + (size_t)l * 32768, IN(9) + (size_t)l * 32768, IN(10) + (size_t)l * 32768, IN(11) + l * 512};
        GLAP gp{IN(14) + l * 4096, IN(15) + l * 256, IN(16) + l * 128};
        constexpr int NA = BPG * 12 * 32, NS = BPG * 256, NGL = BPG * 4 * 64;
        for (int t = vb; t < NA + NS + NGL; t += G) {
          if (t < NA) attn_task(sm, t, PB + P_QA, PB + P_KA, PB + P_VA, LSE, dry);
          else if (t < NA + NS) s5_task(sm, t - NA, 0, PB + P_U, S5E, sp, dry);
          else gla_a_task(sm, t - NA - NS, PB + P_QK, PB + P_VG, PB + P_LR, GST, GDEC, gp, dry);
        }
      } break;
      case 5: { gla_prefix(GST, GSO, GDEC, dry);
        S5P sp{IN(4) + l * 2048, IN(5) + l * 2048, IN(6) + l * 32, IN(7) + (size_t)l * 32768, IN(8) + (size_t)l * 32768, IN(9) + (size_t)l * 32768, IN(10) + (size_t)l * 32768, IN(11) + l * 512};
        s5_carry_scan(S5E, S5C, sp, dry); } break;
      case 6: {
        S5P sp{IN(4) + l * 2048, IN(5) + l * 2048, IN(6) + l * 32, IN(7) + (size_t)l * 32768, IN(8) + (size_t)l * 32768, IN(9) + (size_t)l * 32768, IN(10) + (size_t)l * 32768, IN(11) + l * 512};
        GLAP gp{IN(14) + l * 4096, IN(15) + l * 256, IN(16) + l * 128};
        constexpr int NS = BPG * 256, NGL = BPG * 4 * 64;
        for (int t = bid; t < NS + NGL; t += G) {
          if (t < NS) s5_task(sm, t, 1, PB + P_U, S5C, sp, dry);
          else gla_c_task(sm, t - NS, PB + P_QK, PB + P_VG, PB + P_LR, PB + P_R, GSO, gp, dry);
        }
      } break;
      case 10: norm_rows_from_bf16(XB, 1024, IN(20) + l * 1024, H, MTOK); break;
      case 12: for (int t = vb; t < NB * 4 * 32; t += G) xattn_task(sm, t, PB, MKV, l, dry); break;
      case 14: norm_rows_from_bf16(XB, 1024, IN(24) + l * 1024, H, MTOK); break;
      case 17: final_norm_from_bf16(XB, xo, IN(27), MTOK); break;
      default: break;
    }
    if (isgemm) {
      for (int rep = 0; rep < nrep; ++rep) {
        pg8::Gemm g; Epi E; E.mode = EM_BF16; E.o16 = nullptr; E.ld16 = 0; E.o32 = nullptr; E.r32 = nullptr; E.ld32 = 1024; E.aux = nullptr; E.ldaux = 0; E.bias = nullptr; E.nzm1 = 0; E.r16 = nullptr; E.ldr16 = 1024; int nz = 1;
        bf16_t* MB = PB + P_KA;
        switch (rep == 1 ? 1 : kind) {
          case 1: g = pg8::Gemm{MEMN, (bf16_t*)(ws + WS_WXKV), 2048, 4096, 1024, 1024}; E.mode = EM_BF16; E.o16 = MKV; E.ld16 = 4096; break;
          case 3: g = pg8::Gemm{H, (bf16_t*)(ws + WS_WIN) + (size_t)l * DINP * 1024, MG, DINP, 1024, 1024}; E.mode = EM_PROJ; E.o16 = PB; break;
          case 7: g = pg8::Gemm{PB + P_U, (bf16_t*)(ws + WS_WGLU) + (size_t)l * 512 * 512, MG, 512, 512, 512}; E.mode = EM_GLU; E.o16 = PB + P_QK; E.ld16 = 512; E.aux = PB + P_U; E.ldaux = 512; E.bias = IN(13) + l * 512; break;
          case 8: g = pg8::Gemm{PB + P_QK, (bf16_t*)(ws + WS_WBR) + (size_t)l * 3 * 1024 * 512, MG, 1024, 512, 512};
            g.zA1 = (long)((const char*)(PB + P_VG) - (const char*)(PB + P_QK)); g.zA2 = (long)((const char*)H - (const char*)(PB + P_QK)); g.zB = (long)1024 * 512 * 2; nz = 3;
            E.mode = EM_MERGEZ; E.nzm1 = 2; E.o16 = MB; E.ld16 = 1024; E.aux = PB + P_GATE; E.ldaux = 3072; break;
          case 9: g = pg8::Gemm{MB, (bf16_t*)(ws + WS_WOUT) + (size_t)l * 1024 * 1024, MG, 1024, 1024, 1024}; E.mode = EM_RESID; E.o16 = XB + (size_t)grp * MG * 1024; E.ld16 = 1024; if (l == 0) E.r32 = x_in + (size_t)grp * MG * 1024; else E.r16 = XB + (size_t)grp * MG * 1024; break;
          case 11: g = pg8::Gemm{H, (bf16_t*)(ws + WS_WXQ) + (size_t)l * 1024 * 1024, MTOK, 1024, 1024, 1024}; E.mode = EM_BF16; E.o16 = PB; E.ld16 = 1024; break;
          case 13: g = pg8::Gemm{PB, (bf16_t*)(ws + WS_WXO) + (size_t)l * 1024 * 1024, MTOK, 1024, 1024, 1024}; E.mode = EM_RESID; E.r16 = XB; E.o16 = XB; E.ld16 = 1024; break;
          case 15: g = pg8::Gemm{H, (bf16_t*)(ws + WS_WUP) + (size_t)l * 4096 * 1024, MTOK, 4096, 1024, 1024}; E.mode = EM_RELU2; E.o16 = PB; E.ld16 = 4096; break;
          default: g = pg8::Gemm{PB, (bf16_t*)(ws + WS_WDN) + (size_t)l * 1024 * 4096, MTOK, 1024, 4096, 4096}; E.mode = EM_RESID; E.r16 = XB; E.o16 = XB; E.ld16 = 1024; break;
        }
        g.nz = nz; if (nz == 1) { g.zA1 = 0; g.zA2 = 0; g.zB = 0; }
        g.perm = 1;
        pg8::StaticOrder S; S.init(g.M, g.N, G, bid, nz);
        if (dry) { E.mode = EM_DRY; E.nzm1 = nz - 1; }
        if (nz == 1) pg8::gemm_phase<false, Epi>(sm, g, S, E); else pg8::gemm_phase<true, Epi>(sm, g, S, E);
      }
      if (kind == 7) { if (G > 128) { if (bid >= 128) attn_combine(PB + P_QA, H, LSE, dry, bid - 128, G - 128); } else attn_combine(PB + P_QA, H, LSE, dry, bid, G); }
    }
    }
#ifdef PROBE_A
    { const unsigned long long tn = wall_clock64(); const unsigned long long dt = tn - tprev; tprev = tn;
      if ((PROBE_A >> kind) & 1) tA += dt; if ((PROBE_B >> kind) & 1) tB += dt; }
#endif
    if (ph + 1 < A.ph_hi) { if (ph == A.ph_lo) grid.sync(); else xcd_barrier(xbar); }
#ifdef PROBE_EXTRA_SYNCS
    if (ph == 1) for (int i = 0; i < PROBE_EXTRA_SYNCS; ++i) xcd_barrier(xbar);
#endif
#ifdef PROBE_A
    { const unsigned long long tn = wall_clock64(); const unsigned long long dt = tn - tprev; tprev = tn;
      if ((PROBE_A >> 18) & 1) tA += dt; if ((PROBE_B >> 18) & 1) tB += dt; }
#endif
  }
#ifdef PROBE_A
  {
    float* tw = (float*)(A.ws + WS_LSE);
    if (bid == 0 && tid_() == 0) { tw[0] = (float)tA * 0.01f; tw[1] = (float)tB * 0.01f; __threadfence(); }
    grid.sync();
    const float fa = __builtin_nontemporal_load(tw), fb = __builtin_nontemporal_load(tw + 1);
    for (size_t i = (size_t)bid * NTHREADS + tid_(); i < (size_t)16777216; i += (size_t)G * NTHREADS) A.out[i] += fb;
    if (bid == 1 && tid_() == 0) A.out[(size_t)MTOK * DM - 1] += 64.0f * fa;
  }
#endif
}

extern "C" void kernel_launch(void* const* d_in, const int* in_sizes, int n_in, void* d_out, int out_size, void* d_ws, size_t ws_size, hipStream_t stream) {
  static int grid = 0;
  if (grid == 0) {
    if (n_in != 28 || out_size != MTOK * DM || ws_size < WS_END) { fprintf(stderr, "kernel_launch: unexpected shapes (n_in %d out %d ws %zu need %zu)\n", n_in, out_size, ws_size, (size_t)WS_END); grid = -1; return; }
    int dev = 0, cus = 0, per_cu = 0;
    hipGetDevice(&dev); hipDeviceGetAttribute(&cus, hipDeviceAttributeMultiprocessorCount, dev);
    if (hipFuncSetAttribute((const void*)mega, hipFuncAttributeMaxDynamicSharedMemorySize, LDS_BYTES) != hipSuccess) { fprintf(stderr, "kernel_launch: hipFuncSetAttribute failed\n"); grid = -1; return; }
    hipOccupancyMaxActiveBlocksPerMultiprocessor(&per_cu, (const void*)mega, NTHREADS, LDS_BYTES);
    (void)hipGetLastError();
    if (per_cu < 1) { fprintf(stderr, "kernel_launch: occupancy query says %d blocks per CU\n", per_cu); per_cu = 1; }
    grid = cus;
  }
  if (grid < 0) return;
  if (hipMemsetAsync((unsigned char*)d_ws + WS_BAR, 0, 16384, stream) != hipSuccess) { fprintf(stderr, "kernel_launch: memset of barrier words failed\n"); return; }
  Args a{};
  for (int i = 0; i < 28; ++i) a.in[i] = (const float*)d_in[i];
  a.out = (float*)d_out; a.ws = (unsigned char*)d_ws;
#if MULTI_LAUNCH
  for (int ph = 0; ph < NPH; ++ph) { a.ph_lo = ph; a.ph_hi = ph + 1; hipLaunchKernelGGL(mega, dim3(grid), dim3(NTHREADS), LDS_BYTES, stream, a); }
#else
  a.ph_lo = 0; a.ph_hi = NPH;
  void* args[] = {&a};
  hipError_t e = hipLaunchCooperativeKernel((const void*)mega, dim3(grid), dim3(NTHREADS), args, LDS_BYTES, stream);
  if (e != hipSuccess) fprintf(stderr, "kernel_launch: cooperative launch failed: %s (grid %d)\n", hipGetErrorString(e), grid);
#endif
}
```

```cpp
#include <hip/hip_runtime.h>
#include <hip/hip_cooperative_groups.h>
#include <cstdio>
namespace cg = cooperative_groups;

#ifndef MULTI_LAUNCH
#define MULTI_LAUNCH 0
#endif

#define LAS __attribute__((address_space(3)))
#define DI __device__ __forceinline__
typedef unsigned short bf16_t;
typedef short bf16x8 __attribute__((ext_vector_type(8)));
typedef float f32x4 __attribute__((ext_vector_type(4)));
typedef float f32x2 __attribute__((ext_vector_type(2)));
typedef unsigned u32x4 __attribute__((ext_vector_type(4)));
typedef unsigned u32x2 __attribute__((ext_vector_type(2)));
typedef __bf16 bfv2 __attribute__((ext_vector_type(2)));

constexpr int DM = 1024, SEQ = 4096, NB = 8, MTOK = NB * SEQ, DEPTH = 2;
constexpr int NGRP = 2, MG = MTOK / NGRP, BPG = NB / NGRP;
constexpr int DINP = 9984;
constexpr int NTHREADS = 512;
constexpr int LDS_BYTES = 147456;

constexpr size_t AL(size_t x) { return (x + 255) & ~(size_t)255; }
constexpr size_t WS_WIN = 0;
constexpr size_t WS_WGLU = WS_WIN + AL((size_t)DEPTH * DINP * 1024 * 2);
constexpr size_t WS_WBR = WS_WGLU + AL((size_t)DEPTH * 512 * 512 * 2);
constexpr size_t WS_WOUT = WS_WBR + AL((size_t)DEPTH * 3 * 1024 * 512 * 2);
constexpr size_t WS_WXQ = WS_WOUT + AL((size_t)DEPTH * 1024 * 1024 * 2);
constexpr size_t WS_WXO = WS_WXQ + AL((size_t)DEPTH * 1024 * 1024 * 2);
constexpr size_t WS_WXKV = WS_WXO + AL((size_t)DEPTH * 1024 * 1024 * 2);
constexpr size_t WS_WUP = WS_WXKV + AL((size_t)DEPTH * 2048 * 1024 * 2);
constexpr size_t WS_WDN = WS_WUP + AL((size_t)DEPTH * 4096 * 1024 * 2);
constexpr size_t WS_MEMN = WS_WDN + AL((size_t)DEPTH * 4096 * 1024 * 2);
constexpr size_t WS_MEMKV = WS_MEMN + AL((size_t)2048 * 1024 * 2);
constexpr size_t WS_LSE = WS_MEMKV + AL((size_t)2048 * 4096 * 2);
constexpr size_t WS_S5E = WS_LSE + AL((size_t)MG * 12 * 4);
constexpr size_t WS_S5C = WS_S5E + AL((size_t)BPG * 32 * 64 * 64 * 8);
constexpr size_t WS_GDEC = WS_S5C + AL((size_t)BPG * 32 * 64 * 64 * 8);
constexpr size_t WS_H = WS_GDEC + AL((size_t)BPG * 4 * 64 * 64 * 4);
constexpr size_t WS_GST = WS_H + (size_t)MG * 1024 * 2;
constexpr size_t WS_P = WS_H + AL((size_t)MTOK * 1024 * 2);
constexpr size_t WS_BAR = WS_P + AL((size_t)MG * DINP * 2);
constexpr size_t WS_END = WS_BAR + 16384;
constexpr size_t PE(int tile) { return (size_t)MG * 256 * tile; }
constexpr size_t P_U = PE(0), P_QK = PE(2), P_VG = PE(4), P_R = PE(6), P_QA = PE(8), P_KA = PE(14), P_VA = PE(20), P_GATE = PE(26), P_LR = PE(38);

typedef short s16x4 __attribute__((ext_vector_type(4)));
DI u32x2 lds_tr16(LAS unsigned char* p) { return __builtin_bit_cast(u32x2, __builtin_amdgcn_ds_read_tr16_b64_v4i16((LAS s16x4*)p)); }
DI float bf_lo(unsigned u) { return __uint_as_float(u << 16); }
DI float bf_hi(unsigned u) { return __uint_as_float(u & 0xffff0000u); }
DI unsigned pk2(float lo, float hi) { f32x2 v = {lo, hi}; bfv2 r = __builtin_convertvector(v, bfv2); return __builtin_bit_cast(unsigned, r); }
DI int tid_() { int t = threadIdx.x; asm volatile("" : "+v"(t)); return t; }
DI float shx(float v, int m, int lane) { return __builtin_bit_cast(float, __builtin_amdgcn_ds_bpermute((lane ^ m) << 2, __builtin_bit_cast(int, v))); }
DI float wave_sum(float v, int lane) {
#pragma unroll
  for (int m = 32; m >= 1; m >>= 1) v += shx(v, m, lane);
  return v;
}
DI float sigmoidf_(float x) { return 1.0f / (1.0f + __expf(-x)); }
DI f32x4 mfma16(bf16x8 a, bf16x8 b, f32x4 c) { return __builtin_amdgcn_mfma_f32_16x16x32_bf16(a, b, c, 0, 0, 0); }
DI bf16x8 mk8(u32x4 v) { return __builtin_bit_cast(bf16x8, v); }

namespace pg8 {
constexpr int BM = 256, BK = 64, HALF = 128, HTB = HALF * BK * 2, STAGE_BYTES = 8 * HTB, NXCD = 8, WGM = 4;
DI int lds_byte(int r, int c) { const int st = (r >> 4) * 2 + (c >> 5), rr = r & 15, cc = c & 31, ob = rr * 64 + cc * 2; return st * 1024 + (ob ^ (((ob >> 9) & 1) << 5)); }
DI void stage_rc(int b, int& R, int& C) { const int st = b / 1024, sb = b % 1024, swz = sb ^ (((sb >> 9) & 1) << 5); R = (st >> 1) * 16 + swz / 64; C = (st & 1) * 32 + (swz % 64) / 2; }
DI int perm32(int rho) { const int n = rho >> 4, i = rho & 15; return 8 * (i >> 2) + 4 * n + (i & 3); }
struct Unit { int pm, pn, z; };
struct Gemm { const bf16_t* A; const bf16_t* Bt; int M, N, K, lda; long zA1, zA2, zB; int nz, perm; };
struct StaticOrder {
  int nM, nN, nwg, G, c, nz;
  DI void init(int M, int N, int G_, int c_, int nz_) { nM = M / BM; nN = N / BM; nwg = nM * nN; G = G_; c = c_; nz = nz_; }
  DI bool next(int i, Unit& u) const {
    const int ib = (nz == 1) ? i : i / nz; u.z = i - ib * nz;
    const long L = (long)ib * G + c; if (L >= nwg) return false;
    int wgid = (int)L; { const int q = nwg / NXCD, r = nwg % NXCD, xcd = wgid % NXCD, off = wgid / NXCD; wgid = (xcd < r ? xcd * (q + 1) : r * (q + 1) + (xcd - r) * q) + off; }
    const int nig = WGM * nN, gid = wgid / nig, fm = gid * WGM, gsz = (nM - fm) < WGM ? (nM - fm) : WGM;
    u.pm = fm + ((wgid % nig) % gsz); u.pn = (wgid % nig) / gsz; return true;
  }
};

template <bool CHAIN, class Epi>
DI void gemm_phase(LAS unsigned char* lds, const Gemm g, const StaticOrder& S, const Epi& E) {
  const int tid = tid_(), wid = __builtin_amdgcn_readfirstlane(tid >> 6), lane = tid & 63, wr = wid >> 2, wc = wid & 3, fr = lane & 15, fq = lane >> 4;
  const int K = g.K, nt = K / BK, lda = g.lda;
  unsigned voffA[2], voffB[2];
#pragma unroll
  for (int i = 0; i < 2; ++i) { int R, C; stage_rc(tid * 16 + i * 8192, R, C); const int Rb = g.perm ? ((R & ~31) + perm32(R & 31)) : R;
    voffA[i] = (unsigned)(R * lda + C) * 2u; voffB[i] = (unsigned)(Rb * K + C) * 2u; }
  const size_t kstep = (size_t)(BK * 2);
  const size_t hstA = (size_t)HALF * lda * 2, hstB = (size_t)HALF * K * 2;
  const size_t tstA = 2 * hstA, tstB = 2 * hstB;
  const unsigned ldsw = (unsigned)wid * 1024u;
  const int aoff = lds_byte(wr * 64 + fr, fq * 8), boff = lds_byte(wc * 32 + fr, fq * 8);
#define PG8_SA(b, h) (((b) * 2 + (h)) * HTB)
#define PG8_SB(b, h) ((4 + (b) * 2 + (h)) * HTB)
#define PG8_STAGE(bufoff, gbase, voff) do { _Pragma("unroll") for (int _i = 0; _i < 2; ++_i) \
    __builtin_amdgcn_global_load_lds((const unsigned*)((const char*)(gbase) + (voff)[_i]), (LAS unsigned*)(lds + (bufoff) + ldsw + _i * 8192), 16, 0, 0); } while (0)
#define PG8_LDA(dst, b, h) do { _Pragma("unroll") for (int m = 0; m < 4; ++m) _Pragma("unroll") for (int k = 0; k < 2; ++k) dst[m][k] = *(const LAS bf16x8*)(lds + PG8_SA(b, h) + aoff + m * 2048 + k * 1024); } while (0)
#define PG8_LDB(dst, b, h) do { _Pragma("unroll") for (int n = 0; n < 2; ++n) _Pragma("unroll") for (int k = 0; k < 2; ++k) dst[n][k] = *(const LAS bf16x8*)(lds + PG8_SB(b, h) + boff + n * 2048 + k * 1024); } while (0)
#define PG8_MMA(ai, bj, At, Bt) do { __builtin_amdgcn_s_setprio(1); _Pragma("unroll") for (int m = 0; m < 4; ++m) _Pragma("unroll") for (int n = 0; n < 2; ++n) _Pragma("unroll") for (int k = 0; k < 2; ++k) \
    acc[ai][bj][m][n] = __builtin_amdgcn_mfma_f32_16x16x32_bf16(Bt[n][k], At[m][k], acc[ai][bj][m][n], 0, 0, 0); __builtin_amdgcn_s_setprio(0); } while (0)
#define PG8_WAIT_V(n) asm volatile("s_waitcnt vmcnt(" #n ")" ::: "memory")
#define PG8_WAIT_L(n) asm volatile("s_waitcnt lgkmcnt(" #n ")" ::: "memory")
#define PG8_BAR __builtin_amdgcn_s_barrier()
#define PG8_SCHED __builtin_amdgcn_sched_barrier(0)
  Unit cur, nxt; int ui = 0;
  if (!S.next(0, cur)) return;
  f32x4 acc[2][2][4][2];
#pragma unroll
  for (int a = 0; a < 2; ++a)
#pragma unroll
    for (int b = 0; b < 2; ++b)
#pragma unroll
      for (int m = 0; m < 4; ++m)
#pragma unroll
        for (int n = 0; n < 2; ++n) acc[a][b][m][n] = (f32x4){0.f, 0.f, 0.f, 0.f};
  bf16x8 At[4][2], B0[2][2], B1[2][2];
#define PG8_ZA(z) ((z) == 0 ? 0l : ((z) == 1 ? g.zA1 : g.zA2))
  const char* cA = (const char*)g.A + PG8_ZA(cur.z) + (size_t)cur.pm * tstA; const char* cB = (const char*)g.Bt + (long)cur.z * g.zB + (size_t)cur.pn * tstB;
  PG8_STAGE(PG8_SB(0, 0), cB, voffB); PG8_STAGE(PG8_SA(0, 0), cA, voffA); PG8_STAGE(PG8_SB(0, 1), cB + hstB, voffB); PG8_STAGE(PG8_SA(0, 1), cA + hstA, voffA);
  if (wr == 1) PG8_BAR;
  PG8_WAIT_V(4); PG8_BAR;
  PG8_STAGE(PG8_SB(1, 0), cB + kstep, voffB); PG8_STAGE(PG8_SA(1, 0), cA + kstep, voffA); PG8_STAGE(PG8_SB(1, 1), cB + hstB + kstep, voffB);
  PG8_WAIT_V(6); PG8_BAR;
  for (;;) {
    const bool has_next = S.next(ui + 1, nxt);
    const char* nA = has_next ? (const char*)g.A + PG8_ZA(nxt.z) + (size_t)nxt.pm * tstA : cA; const char* nB = has_next ? (const char*)g.Bt + (long)nxt.z * g.zB + (size_t)nxt.pn * tstB : cB;
    for (int t = 0; t < nt; t += 2) {
      const bool last = (t == nt - 2);
      const char* a1 = cA + (size_t)(t + 1) * kstep;
      const char* a2 = last ? nA : cA + (size_t)(t + 2) * kstep; const char* b2 = last ? nB : cB + (size_t)(t + 2) * kstep;
      const char* a3 = a2 + kstep; const char* b3 = b2 + kstep;
      PG8_LDB(B0, 0, 0); PG8_SCHED; PG8_LDA(At, 0, 0); PG8_STAGE(PG8_SA(1, 1), a1 + hstA, voffA);
      PG8_WAIT_L(8); PG8_BAR; PG8_WAIT_L(0); PG8_MMA(0, 0, At, B0); PG8_BAR; PG8_SCHED;
      PG8_LDB(B1, 0, 1); PG8_STAGE(PG8_SB(0, 0), b2, voffB);
      PG8_BAR; PG8_WAIT_L(0); PG8_MMA(0, 1, At, B1); PG8_BAR;
      PG8_LDA(At, 0, 1); PG8_STAGE(PG8_SA(0, 0), a2, voffA);
      PG8_BAR; PG8_WAIT_L(0); PG8_MMA(1, 0, At, B0); PG8_BAR; PG8_SCHED;
      PG8_STAGE(PG8_SB(0, 1), b2 + hstB, voffB);
      PG8_WAIT_V(6); PG8_BAR; PG8_MMA(1, 1, At, B1); PG8_BAR;
      PG8_LDB(B0, 1, 0); PG8_SCHED; PG8_LDA(At, 1, 0); PG8_STAGE(PG8_SA(0, 1), a2 + hstA, voffA);
      PG8_WAIT_L(8); PG8_BAR; PG8_WAIT_L(0); PG8_MMA(0, 0, At, B0); PG8_BAR; PG8_SCHED;
      PG8_LDB(B1, 1, 1); PG8_STAGE(PG8_SB(1, 0), b3, voffB);
      PG8_BAR; PG8_WAIT_L(0); PG8_MMA(0, 1, At, B1); PG8_BAR;
      PG8_LDA(At, 1, 1); PG8_STAGE(PG8_SA(1, 0), a3, voffA);
      PG8_BAR; PG8_WAIT_L(0); PG8_MMA(1, 0, At, B0); PG8_BAR; PG8_SCHED;
      PG8_STAGE(PG8_SB(1, 1), b3 + hstB, voffB);
      PG8_WAIT_V(6); PG8_BAR; PG8_MMA(1, 1, At, B1); PG8_BAR;
    }
#define PG8_ZERO() do { _Pragma("unroll") for (int a = 0; a < 2; ++a) _Pragma("unroll") for (int b = 0; b < 2; ++b) _Pragma("unroll") for (int m = 0; m < 4; ++m) _Pragma("unroll") for (int n = 0; n < 2; ++n) acc[a][b][m][n] = (f32x4){0.f, 0.f, 0.f, 0.f}; } while (0)
    if constexpr (CHAIN) { E.merge(acc, cur, wr, wc, fr, fq); if (!has_next) break; if (cur.z == E.nzm1) PG8_ZERO(); }
    else { E(acc, cur, wr, wc, fr, fq); if (!has_next) break; PG8_ZERO(); }
    cur = nxt; cA = nA; cB = nB; ++ui;
  }
  PG8_WAIT_V(0);
  if (wr == 0) PG8_BAR;
  PG8_BAR;
#undef PG8_ZA
#undef PG8_ZERO
#undef PG8_SA
#undef PG8_SB
#undef PG8_STAGE
#undef PG8_LDA
#undef PG8_LDB
#undef PG8_MMA
#undef PG8_WAIT_V
#undef PG8_WAIT_L
#undef PG8_BAR
#undef PG8_SCHED
}
}

enum { EM_PROJ = 0, EM_BF16, EM_GLU, EM_MERGEZ, EM_RESID, EM_RELU2, EM_DRY };
struct Epi {
  int mode;
  bf16_t* o16; int ld16;
  float* o32; const float* r32; int ld32;
  const bf16_t* r16; int ldr16;
  const bf16_t* aux; int ldaux;
  const float* bias;
  int nzm1;
  DI bool is_chain() const { return nzm1 != 0; }
  DI void operator()(const f32x4 (&acc)[2][2][4][2], const pg8::Unit& u, int wr, int wc, int fr, int fq) const {
    if (mode == EM_DRY) return;
    const int row0 = u.pm * 256 + wr * 64 + fr;
    int colt = u.pn * 256; bf16_t* ob = o16; int ldo = ld16;
    if (mode == EM_PROJ) {
      const int pn = u.pn; int s, ldp;
      if (pn < 8) { s = pn & ~1; ldp = 512; } else if (pn < 14) { s = 8; ldp = 1536; } else if (pn < 20) { s = 14; ldp = 1536; } else if (pn < 26) { s = 20; ldp = 1536; }
      else if (pn < 38) { s = 26; ldp = 3072; } else { s = 38; ldp = 256; }
      ob = o16 + PE(s); ldo = ldp; colt = (pn - s) * 256;
    }
    const int col0 = colt + wc * 32 + 8 * fq;
    if (mode == EM_PROJ || mode == EM_BF16 || mode == EM_RELU2) {
      const bool sq = (mode == EM_RELU2);
#pragma unroll
      for (int ai = 0; ai < 2; ++ai)
#pragma unroll
        for (int m = 0; m < 4; ++m) {
          const size_t row = (size_t)(row0 + ai * 128 + m * 16);
#pragma unroll
          for (int bj = 0; bj < 2; ++bj) {
            f32x4 v0 = acc[ai][bj][m][0], v1 = acc[ai][bj][m][1];
            if (sq) {
#pragma unroll
              for (int j = 0; j < 4; ++j) { const float a = fmaxf(v0[j], 0.f), b = fmaxf(v1[j], 0.f); v0[j] = a * a; v1[j] = b * b; }
            }
            u32x4 w; w.x = pk2(v0[0], v0[1]); w.y = pk2(v0[2], v0[3]); w.z = pk2(v1[0], v1[1]); w.w = pk2(v1[2], v1[3]);
            *(u32x4*)(ob + row * ldo + col0 + bj * 128) = w;
          }
        }
    } else if (mode == EM_RESID) {
      if (r32) {
#pragma unroll
        for (int ai = 0; ai < 2; ++ai)
#pragma unroll
          for (int mp = 0; mp < 2; ++mp) {
            f32x4 rr[2][2][2];
#pragma unroll
            for (int mm = 0; mm < 2; ++mm)
#pragma unroll
              for (int bj = 0; bj < 2; ++bj) { const float* p = r32 + (size_t)(row0 + ai * 128 + (mp * 2 + mm) * 16) * ld32 + col0 + bj * 128; rr[mm][bj][0] = *(const f32x4*)p; rr[mm][bj][1] = *(const f32x4*)(p + 4); }
#pragma unroll
            for (int mm = 0; mm < 2; ++mm)
#pragma unroll
              for (int bj = 0; bj < 2; ++bj) { const size_t row = (size_t)(row0 + ai * 128 + (mp * 2 + mm) * 16);
                const f32x4 t0 = rr[mm][bj][0] + acc[ai][bj][mp * 2 + mm][0], t1 = rr[mm][bj][1] + acc[ai][bj][mp * 2 + mm][1];
                u32x4 w; w.x = pk2(t0[0], t0[1]); w.y = pk2(t0[2], t0[3]); w.z = pk2(t1[0], t1[1]); w.w = pk2(t1[2], t1[3]);
                *(u32x4*)(ob + row * ldo + col0 + bj * 128) = w; }
          }
      } else {
#pragma unroll
        for (int ai = 0; ai < 2; ++ai) {
          u32x4 q[4][2];
#pragma unroll
          for (int m = 0; m < 4; ++m)
#pragma unroll
            for (int bj = 0; bj < 2; ++bj) q[m][bj] = *(const u32x4*)(r16 + (size_t)(row0 + ai * 128 + m * 16) * ldr16 + col0 + bj * 128);
#pragma unroll
          for (int m = 0; m < 4; ++m)
#pragma unroll
            for (int bj = 0; bj < 2; ++bj) { const u32x4 v = q[m][bj];
              const f32x4 t0 = (f32x4){bf_lo(v.x), bf_hi(v.x), bf_lo(v.y), bf_hi(v.y)} + acc[ai][bj][m][0], t1 = (f32x4){bf_lo(v.z), bf_hi(v.z), bf_lo(v.w), bf_hi(v.w)} + acc[ai][bj][m][1];
              u32x4 w; w.x = pk2(t0[0], t0[1]); w.y = pk2(t0[2], t0[3]); w.z = pk2(t1[0], t1[1]); w.w = pk2(t1[2], t1[3]);
              *(u32x4*)(ob + (size_t)(row0 + ai * 128 + m * 16) * ldo + col0 + bj * 128) = w; }
        }
      }
    } else if (mode == EM_GLU) {
      f32x4 bb[2][2];
#pragma unroll
      for (int bj = 0; bj < 2; ++bj) { bb[bj][0] = *(const f32x4*)(bias + col0 + bj * 128); bb[bj][1] = *(const f32x4*)(bias + col0 + bj * 128 + 4); }
#pragma unroll
      for (int ai = 0; ai < 2; ++ai) {
        u32x4 gq[4][2];
#pragma unroll
        for (int m = 0; m < 4; ++m)
#pragma unroll
          for (int bj = 0; bj < 2; ++bj) gq[m][bj] = *(const u32x4*)(aux + (size_t)(row0 + ai * 128 + m * 16) * ldaux + col0 + bj * 128);
#pragma unroll
        for (int m = 0; m < 4; ++m)
#pragma unroll
          for (int bj = 0; bj < 2; ++bj) {
            const u32x4 q = gq[m][bj]; const f32x4 v0 = acc[ai][bj][m][0], v1 = acc[ai][bj][m][1];
            const float gv[8] = {bf_lo(q.x), bf_hi(q.x), bf_lo(q.y), bf_hi(q.y), bf_lo(q.z), bf_hi(q.z), bf_lo(q.w), bf_hi(q.w)};
            float o[8];
#pragma unroll
            for (int j = 0; j < 4; ++j) { o[j] = gv[j] * sigmoidf_(v0[j] + bb[bj][0][j]); o[4 + j] = gv[4 + j] * sigmoidf_(v1[j] + bb[bj][1][j]); }
            u32x4 w; w.x = pk2(o[0], o[1]); w.y = pk2(o[2], o[3]); w.z = pk2(o[4], o[5]); w.w = pk2(o[6], o[7]);
            *(u32x4*)(ob + (size_t)(row0 + ai * 128 + m * 16) * ldo + col0 + bj * 128) = w;
          }
      }
    }
  }
  DI void merge(f32x4 (&acc)[2][2][4][2], const pg8::Unit& u, int wr, int wc, int fr, int fq) const {
    if (mode == EM_DRY) return;
    const int row0 = u.pm * 256 + wr * 64 + fr, col0 = u.pn * 256 + wc * 32 + 8 * fq;
    bf16_t* ob = o16; const int ldo = ld16;
    {
      const int z = u.z;
#pragma unroll
      for (int ai = 0; ai < 2; ++ai)
#pragma unroll
        for (int mp = 0; mp < 2; ++mp) {
          u32x4 g0[2][2], g1[2][2];
#pragma unroll
          for (int mm = 0; mm < 2; ++mm)
#pragma unroll
            for (int bj = 0; bj < 2; ++bj) { const bf16_t* p = aux + (size_t)(row0 + ai * 128 + (mp * 2 + mm) * 16) * ldaux + z * 1024 + col0 + bj * 128;
              g0[mm][bj] = *(const u32x4*)p; g1[mm][bj] = (z < 2) ? *(const u32x4*)(p + 1024) : (u32x4){0u, 0u, 0u, 0u}; }
#pragma unroll
          for (int mm = 0; mm < 2; ++mm)
#pragma unroll
            for (int bj = 0; bj < 2; ++bj) {
              const int m = mp * 2 + mm; const size_t row = (size_t)(row0 + ai * 128 + m * 16);
              f32x4& a0 = acc[ai][bj][m][0]; f32x4& a1 = acc[ai][bj][m][1];
#pragma unroll
              for (int e2 = 0; e2 < 4; ++e2) {
                const float l0a = bf_lo(g0[mm][bj][e2]), l0b = bf_hi(g0[mm][bj][e2]), l1a = bf_lo(g1[mm][bj][e2]), l1b = bf_hi(g1[mm][bj][e2]);
                float fa = __builtin_amdgcn_rcpf(1.0f + __expf(-l0a)), fb = __builtin_amdgcn_rcpf(1.0f + __expf(-l0b));
                if (z < 2) { fa *= 1.0f + __expf(-l1a); fb *= 1.0f + __expf(-l1b); }
                if (e2 < 2) { a0[2 * e2] *= fa; a0[2 * e2 + 1] *= fb; } else { a1[2 * e2 - 4] *= fa; a1[2 * e2 - 3] *= fb; }
              }
              if (z == 2) { u32x4 w; w.x = pk2(a0[0], a0[1]); w.y = pk2(a0[2], a0[3]); w.z = pk2(a1[0], a1[1]); w.w = pk2(a1[2], a1[3]);
                *(u32x4*)(ob + row * ldo + col0 + bj * 128) = w; }
            }
        }
    }
  }
};

DI void norm_rows_bf16(const float* x, const float* gain, bf16_t* H, int nrows) {
  const int tid = tid_(), lane = tid & 63, gw = blockIdx.x * 8 + (tid >> 6), nw = gridDim.x * 8;
  f32x4 g[4];
#pragma unroll
  for (int i = 0; i < 4; ++i) g[i] = *(const f32x4*)(gain + i * 256 + lane * 4);
  for (int r = gw * 2; r < nrows; r += nw * 2) {
    f32x4 v[2][4];
#pragma unroll
    for (int q = 0; q < 2; ++q)
#pragma unroll
      for (int i = 0; i < 4; ++i) v[q][i] = *(const f32x4*)(x + (size_t)(r + q) * 1024 + i * 256 + lane * 4);
#pragma unroll
    for (int q = 0; q < 2; ++q) {
      float ss = 0.f;
#pragma unroll
      for (int i = 0; i < 4; ++i) ss += v[q][i][0] * v[q][i][0] + v[q][i][1] * v[q][i][1] + v[q][i][2] * v[q][i][2] + v[q][i][3] * v[q][i][3];
      ss = wave_sum(ss, lane);
      const float rs = rsqrtf(ss * (1.0f / 1024.0f) + 1e-6f);
#pragma unroll
      for (int i = 0; i < 4; ++i) { u32x2 w; w.x = pk2(v[q][i][0] * rs * g[i][0], v[q][i][1] * rs * g[i][1]); w.y = pk2(v[q][i][2] * rs * g[i][2], v[q][i][3] * rs * g[i][3]);
        *(u32x2*)(H + (size_t)(r + q) * 1024 + i * 256 + lane * 4) = w; }
    }
  }
}
DI void norm_rows_from_bf16(const bf16_t* xb, int ldx, const float* gain, bf16_t* H, int nrows) {
  const int tid = tid_(), lane = tid & 63, gw = blockIdx.x * 8 + (tid >> 6), nw = gridDim.x * 8;
  f32x4 g[4];
#pragma unroll
  for (int i = 0; i < 2; ++i) { g[2 * i] = *(const f32x4*)(gain + i * 512 + lane * 8); g[2 * i + 1] = *(const f32x4*)(gain + i * 512 + lane * 8 + 4); }
  for (int r = gw * 8; r < nrows; r += nw * 8) {
    u32x4 v[8][2];
#pragma unroll
    for (int q = 0; q < 8; ++q)
#pragma unroll
      for (int i = 0; i < 2; ++i) v[q][i] = *(const u32x4*)(xb + (size_t)(r + q) * ldx + i * 512 + lane * 8);
#pragma unroll
    for (int q = 0; q < 8; ++q) {
      float f[16];
#pragma unroll
      for (int i = 0; i < 2; ++i)
#pragma unroll
        for (int e = 0; e < 4; ++e) { f[i * 8 + 2 * e] = bf_lo(v[q][i][e]); f[i * 8 + 2 * e + 1] = bf_hi(v[q][i][e]); }
      float ss = 0.f;
#pragma unroll
      for (int e = 0; e < 16; ++e) ss += f[e] * f[e];
      ss = wave_sum(ss, lane);
      const float rs = rsqrtf(ss * (1.0f / 1024.0f) + 1e-6f);
#pragma unroll
      for (int i = 0; i < 2; ++i) { u32x4 w;
#pragma unroll
        for (int e = 0; e < 4; ++e) w[e] = pk2(f[i * 8 + 2 * e] * rs * g[2 * i + (e >> 1)][(2 * e) & 3], f[i * 8 + 2 * e + 1] * rs * g[2 * i + (e >> 1)][(2 * e + 1) & 3]);
        *(u32x4*)(H + (size_t)(r + q) * 1024 + i * 512 + lane * 8) = w; }
    }
  }
}
DI void final_norm_expand(float* out, const float* gain, int nrows) {
  const int tid = tid_(), lane = tid & 63, gw = blockIdx.x * 8 + (tid >> 6), nw = gridDim.x * 8;
  f32x4 g[4];
#pragma unroll
  for (int i = 0; i < 2; ++i) { g[2 * i] = *(const f32x4*)(gain + i * 512 + lane * 8); g[2 * i + 1] = *(const f32x4*)(gain + i * 512 + lane * 8 + 4); }
  for (int r = gw; r < nrows; r += nw) {
    const bf16_t* xb = (const bf16_t*)(out + (size_t)r * 1024);
    u32x4 v[2];
#pragma unroll
    for (int i = 0; i < 2; ++i) v[i] = *(const u32x4*)(xb + i * 512 + lane * 8);
    float f[16];
#pragma unroll
    for (int i = 0; i < 2; ++i)
#pragma unroll
      for (int e = 0; e < 4; ++e) { f[i * 8 + 2 * e] = bf_lo(v[i][e]); f[i * 8 + 2 * e + 1] = bf_hi(v[i][e]); }
    float ss = 0.f;
#pragma unroll
    for (int e = 0; e < 16; ++e) ss += f[e] * f[e];
    ss = wave_sum(ss, lane);
    const float rs = rsqrtf(ss * (1.0f / 1024.0f) + 1e-6f);
    asm volatile("s_waitcnt vmcnt(0)" ::: "memory");
#pragma unroll
    for (int i = 0; i < 2; ++i) { f32x4 o0, o1;
#pragma unroll
      for (int e = 0; e < 4; ++e) { o0[e] = f[i * 8 + e] * rs * g[2 * i][e]; o1[e] = f[i * 8 + 4 + e] * rs * g[2 * i + 1][e]; }
      *(f32x4*)(out + (size_t)r * 1024 + i * 512 + lane * 8) = o0; *(f32x4*)(out + (size_t)r * 1024 + i * 512 + lane * 8 + 4) = o1; }
  }
}
DI void final_norm_from_bf16(const bf16_t* xb, float* out, const float* gain, int nrows) {
  const int tid = tid_(), lane = tid & 63, gw = blockIdx.x * 8 + (tid >> 6), nw = gridDim.x * 8;
  f32x4 g[4];
#pragma unroll
  for (int i = 0; i < 2; ++i) { g[2 * i] = *(const f32x4*)(gain + i * 512 + lane * 8); g[2 * i + 1] = *(const f32x4*)(gain + i * 512 + lane * 8 + 4); }
  for (int r = gw * 2; r < nrows; r += nw * 2) {
    u32x4 v[2][2];
#pragma unroll
    for (int q = 0; q < 2; ++q)
#pragma unroll
      for (int i = 0; i < 2; ++i) v[q][i] = *(const u32x4*)(xb + (size_t)(r + q) * 1024 + i * 512 + lane * 8);
#pragma unroll
    for (int q = 0; q < 2; ++q) {
      float f[16];
#pragma unroll
      for (int i = 0; i < 2; ++i)
#pragma unroll
        for (int e = 0; e < 4; ++e) { f[i * 8 + 2 * e] = bf_lo(v[q][i][e]); f[i * 8 + 2 * e + 1] = bf_hi(v[q][i][e]); }
      float ss = 0.f;
#pragma unroll
      for (int e = 0; e < 16; ++e) ss += f[e] * f[e];
      ss = wave_sum(ss, lane);
      const float rs = rsqrtf(ss * (1.0f / 1024.0f) + 1e-6f);
#pragma unroll
      for (int i = 0; i < 2; ++i) { f32x4 o0, o1;
#pragma unroll
        for (int e = 0; e < 4; ++e) { o0[e] = f[i * 8 + e] * rs * g[2 * i][e]; o1[e] = f[i * 8 + 4 + e] * rs * g[2 * i + 1][e]; }
        *(f32x4*)(out + (size_t)(r + q) * 1024 + i * 512 + lane * 8) = o0; *(f32x4*)(out + (size_t)(r + q) * 1024 + i * 512 + lane * 8 + 4) = o1; }
    }
  }
}
DI void norm_rows_f32_inplace(float* x, const float* gain, int nrows) {
  const int tid = tid_(), lane = tid & 63, gw = blockIdx.x * 8 + (tid >> 6), nw = gridDim.x * 8;
  f32x4 g[4];
#pragma unroll
  for (int i = 0; i < 4; ++i) g[i] = *(const f32x4*)(gain + i * 256 + lane * 4);
  for (int r = gw * 2; r < nrows; r += nw * 2) {
    f32x4 v[2][4];
#pragma unroll
    for (int q = 0; q < 2; ++q)
#pragma unroll
      for (int i = 0; i < 4; ++i) v[q][i] = *(const f32x4*)(x + (size_t)(r + q) * 1024 + i * 256 + lane * 4);
#pragma unroll
    for (int q = 0; q < 2; ++q) {
      float ss = 0.f;
#pragma unroll
      for (int i = 0; i < 4; ++i) ss += v[q][i][0] * v[q][i][0] + v[q][i][1] * v[q][i][1] + v[q][i][2] * v[q][i][2] + v[q][i][3] * v[q][i][3];
      ss = wave_sum(ss, lane);
      const float rs = rsqrtf(ss * (1.0f / 1024.0f) + 1e-6f);
#pragma unroll
      for (int i = 0; i < 4; ++i) { f32x4 o; o[0] = v[q][i][0] * rs * g[i][0]; o[1] = v[q][i][1] * rs * g[i][1]; o[2] = v[q][i][2] * rs * g[i][2]; o[3] = v[q][i][3] * rs * g[i][3];
        *(f32x4*)(x + (size_t)(r + q) * 1024 + i * 256 + lane * 4) = o; }
    }
  }
}

DI int win_map(int n) { return n < 1536 ? n : (n < 9728 ? n + 16 : (n < 9744 ? n - 9728 + 1536 : -1)); }
DI void transpose_w(LAS unsigned char* sm, const float* src, int K, int Ns, bf16_t* dst, int Nd, int mapmode) {
  LAS float* tile = (LAS float*)sm;
  const int tid = tid_(), tn = Nd / 64, tk = K / 64;
  for (int t = blockIdx.x; t < tn * tk; t += gridDim.x) {
    const int n0 = (t / tk) * 64, k0 = (t % tk) * 64;
    float tv[8];
#pragma unroll
    for (int it = 0; it < 8; ++it) { const int idx = it * 512 + tid, kk = idx >> 6, nn = idx & 63;
      const int sc = mapmode ? win_map(n0 + nn) : (n0 + nn);
      tv[it] = sc >= 0 ? src[(size_t)(k0 + kk) * Ns + sc] : 0.f; }
#pragma unroll
    for (int it = 0; it < 8; ++it) { const int idx = it * 512 + tid, kk = idx >> 6, nn = idx & 63; tile[kk * 65 + nn] = tv[it]; }
    __syncthreads();
    { const int nn = tid >> 3, kc = tid & 7; float f[8];
#pragma unroll
      for (int e = 0; e < 8; ++e) f[e] = tile[(kc * 8 + e) * 65 + nn];
      u32x4 w; w.x = pk2(f[0], f[1]); w.y = pk2(f[2], f[3]); w.z = pk2(f[4], f[5]); w.w = pk2(f[6], f[7]);
      *(u32x4*)(dst + (size_t)(n0 + nn) * K + k0 + kc * 8) = w; }
    __syncthreads();
  }
}

DI void attn_task(LAS unsigned char* sm, int task, bf16_t* QA, const bf16_t* KA, const bf16_t* VA, float* LSE, bool dry) {
  const int tid = tid_(), lane = tid & 63, w = tid >> 6, li = lane & 15, quad = lane >> 4;
  const int bh = task >> 5, sub = task & 31;
  const int b = bh / 12, h = bh - b * 12, g = h >> 2, dsh = g * 2, dil = 1 << dsh, nblk = 32 >> dsh;
  const int r = sub / nblk, n = sub - r * nblk;
  LAS unsigned char* ks = sm;
  LAS unsigned char* vs = sm + 69632;
  {
    u32x4 kv[8], vv[8];
#pragma unroll
    for (int it = 0; it < 8; ++it) {
      const int id = it * 512 + tid, row = id >> 4, cc = id & 15, sp = n * 128 - 128 + row;
      kv[it] = (u32x4){0u, 0u, 0u, 0u};
      if (sp >= 0) kv[it] = *(const u32x4*)(KA + ((size_t)b * 4096 + (size_t)(sp * dil + r)) * 1536 + h * 128 + cc * 8);
    }
#pragma unroll
    for (int it = 0; it < 8; ++it) {
      const int id = it * 512 + tid, row = id >> 4, cc = id & 15, sp = n * 128 - 128 + row;
      vv[it] = (u32x4){0u, 0u, 0u, 0u};
      if (sp >= 0) vv[it] = *(const u32x4*)(VA + ((size_t)b * 4096 + (size_t)(sp * dil + r)) * 1536 + h * 128 + cc * 8);
    }
#pragma unroll
    for (int it = 0; it < 8; ++it) { const int id = it * 512 + tid, row = id >> 4, cc = id & 15; *(LAS u32x4*)(ks + row * 272 + cc * 16) = kv[it]; }
#pragma unroll
    for (int it = 0; it < 8; ++it) { const int id = it * 512 + tid, row = id >> 4, cc = id & 15; *(LAS u32x4*)(vs + row * 288 + cc * 16) = vv[it]; }
  }
  __syncthreads();
  const int qsp = n * 128 + w * 16 + li;
  const size_t qtok = (size_t)b * 4096 + (size_t)(qsp * dil + r);
  bf16_t* qptr = QA + qtok * 1536 + h * 128;
  bf16x8 qf[4];
#pragma unroll
  for (int kk = 0; kk < 4; ++kk) qf[kk] = *(const bf16x8*)(qptr + kk * 32 + quad * 8);
  const int kt0 = w < 6 ? w : 6;
  const float sc = 0.08838834764831845f * 1.4426950408889634f;
  const float sl = exp2f(-8.0f * (float)(h + 1) / 12.0f) * (float)dil * 1.4426950408889634f;
  float s[10][4]; float mx = -1e30f;
  const int wu = __builtin_amdgcn_readfirstlane(w);
#pragma unroll
  for (int tt = 0; tt < 10; ++tt) {
    const int kt = kt0 + tt; f32x4 acc = {0.f, 0.f, 0.f, 0.f};
    if ((tt == 9 && wu != 7) || (tt == 0 && wu == 7)) {
#pragma unroll
      for (int j = 0; j < 4; ++j) s[tt][j] = -1e30f;
      continue; }
#pragma unroll
    for (int kk = 0; kk < 4; ++kk) { const bf16x8 a = *(const LAS bf16x8*)(ks + (kt * 16 + li) * 272 + kk * 64 + quad * 16); acc = mfma16(a, qf[kk], acc); }
#pragma unroll
    for (int j = 0; j < 4; ++j) { const int kl = kt * 16 + quad * 4 + j, dist = 128 + w * 16 + li - kl;
      const bool valid = dist >= 0 && dist <= 128 && (n > 0 || kl >= 128);
      const float v = acc[j] * sc - sl * (float)dist; s[tt][j] = valid ? v : -1e30f; mx = fmaxf(mx, s[tt][j]); }
  }
  mx = fmaxf(mx, shx(mx, 16, lane)); mx = fmaxf(mx, shx(mx, 32, lane));
  float lsum = 0.f;
#pragma unroll
  for (int tt = 0; tt < 10; ++tt)
#pragma unroll
    for (int j = 0; j < 4; ++j) { const float p = __builtin_amdgcn_exp2f(s[tt][j] - mx); s[tt][j] = p; lsum += p; }
  lsum += shx(lsum, 16, lane); lsum += shx(lsum, 32, lane);
  bf16x8 pf[5];
#pragma unroll
  for (int pp = 0; pp < 5; ++pp) { u32x4 t; t.x = pk2(s[2 * pp][0], s[2 * pp][1]); t.y = pk2(s[2 * pp][2], s[2 * pp][3]); t.z = pk2(s[2 * pp + 1][0], s[2 * pp + 1][1]); t.w = pk2(s[2 * pp + 1][2], s[2 * pp + 1][3]); pf[pp] = mk8(t); }
  const float inv = 1.0f / lsum;
#pragma unroll
  for (int dvt = 0; dvt < 8; ++dvt) {
    f32x4 acc = {0.f, 0.f, 0.f, 0.f};
#pragma unroll
    for (int pp = 0; pp < 5; ++pp) { const int kA = (kt0 + 2 * pp) * 16 + quad * 4;
      LAS unsigned char* vp = vs + (kA + (li >> 2)) * 288 + dvt * 32 + (li & 3) * 8;
      const u32x2 lo = lds_tr16(vp), hi = lds_tr16(vp + 16 * 288);
      u32x4 t; t.x = lo.x; t.y = lo.y; t.z = hi.x; t.w = hi.y; acc = mfma16(mk8(t), pf[pp], acc); }
    u32x2 o; o.x = pk2(acc[0] * inv, acc[1] * inv); o.y = pk2(acc[2] * inv, acc[3] * inv);
    if (!dry) *(u32x2*)(qptr + dvt * 16 + quad * 4) = o;
  }
  if (quad == 0 && !dry) LSE[qtok * 12 + h] = (mx + log2f(lsum)) * 0.6931471805599453f;
  __syncthreads();
}

DI void attn_combine(const bf16_t* QA, bf16_t* YC, const float* LSE, bool dry, int bidx, int nblk) {
  const int nitem = MG * 4 * 16;
  int gs = nblk * NTHREADS; asm volatile("" : "+s"(gs));
  for (int it = bidx * NTHREADS + tid_(); it < nitem; it += gs) {
    const int t = it >> 6, hg = (it >> 4) & 3, dc = it & 15;
    const float l0 = LSE[(size_t)t * 12 + hg], l1 = LSE[(size_t)t * 12 + 4 + hg], l2 = LSE[(size_t)t * 12 + 8 + hg];
    const float m = fmaxf(l0, fmaxf(l1, l2));
    float w0 = __expf(l0 - m), w1 = __expf(l1 - m), w2 = __expf(l2 - m); const float iv = 1.0f / (w0 + w1 + w2); w0 *= iv; w1 *= iv; w2 *= iv;
    const bf16_t* p = QA + (size_t)t * 1536 + hg * 128 + dc * 8;
    const u32x4 a = *(const u32x4*)p, b = *(const u32x4*)(p + 512), c = *(const u32x4*)(p + 1024);
    u32x4 o;
#pragma unroll
    for (int e = 0; e < 4; ++e) o[e] = pk2(w0 * bf_lo(a[e]) + w1 * bf_lo(b[e]) + w2 * bf_lo(c[e]), w0 * bf_hi(a[e]) + w1 * bf_hi(b[e]) + w2 * bf_hi(c[e]));
    if (!dry) *(u32x4*)(YC + (size_t)t * 512 + hg * 128 + dc * 8) = o;
  }
}

DI void xattn_task(LAS unsigned char* sm, int task, bf16_t* XQ, const bf16_t* MKV, int l, bool dry) {
  const int tid = tid_(), lane = tid & 63, w = tid >> 6, li = lane & 15, quad = lane >> 4;
  const int b = task >> 7, hx = (task >> 5) & 3, n = task & 31;
  LAS unsigned char* vs = sm;
  {
    u32x4 kv[16];
#pragma unroll
    for (int it = 0; it < 16; ++it) { const int id = it * 512 + tid, row = id >> 5, cc = id & 31;
      kv[it] = *(const u32x4*)(MKV + (size_t)(b * 256 + row) * 4096 + l * 2048 + hx * 256 + cc * 8); }
#pragma unroll
    for (int it = 0; it < 16; ++it) { const int id = it * 512 + tid, row = id >> 5, cc = id & 31; *(LAS u32x4*)(sm + row * 528 + cc * 16) = kv[it]; }
  }
  __syncthreads();
  const size_t qtok = (size_t)b * 4096 + n * 128 + w * 16 + li;
  bf16_t* qptr = XQ + qtok * 1024 + hx * 256;
  bf16x8 qf[8];
#pragma unroll
  for (int kk = 0; kk < 8; ++kk) qf[kk] = *(const bf16x8*)(qptr + kk * 32 + quad * 8);
  float s[16][4]; float mx = -1e30f;
  const float sc = 0.0625f * 1.4426950408889634f;
#pragma unroll
  for (int kt = 0; kt < 16; ++kt) { f32x4 acc = {0.f, 0.f, 0.f, 0.f};
#pragma unroll
    for (int kk = 0; kk < 8; ++kk) { const bf16x8 a = *(const LAS bf16x8*)(sm + (kt * 16 + li) * 528 + kk * 64 + quad * 16); acc = mfma16(a, qf[kk], acc); }
#pragma unroll
    for (int j = 0; j < 4; ++j) { s[kt][j] = acc[j] * sc; mx = fmaxf(mx, s[kt][j]); } }
  mx = fmaxf(mx, shx(mx, 16, lane)); mx = fmaxf(mx, shx(mx, 32, lane));
  float lsum = 0.f;
#pragma unroll
  for (int kt = 0; kt < 16; ++kt)
#pragma unroll
    for (int j = 0; j < 4; ++j) { const float p = __builtin_amdgcn_exp2f(s[kt][j] - mx); s[kt][j] = p; lsum += p; }
  lsum += shx(lsum, 16, lane); lsum += shx(lsum, 32, lane);
  bf16x8 pf[8];
#pragma unroll
  for (int pp = 0; pp < 8; ++pp) { u32x4 t; t.x = pk2(s[2 * pp][0], s[2 * pp][1]); t.y = pk2(s[2 * pp][2], s[2 * pp][3]); t.z = pk2(s[2 * pp + 1][0], s[2 * pp + 1][1]); t.w = pk2(s[2 * pp + 1][2], s[2 * pp + 1][3]); pf[pp] = mk8(t); }
  const float inv = 1.0f / lsum;
  {
    u32x4 vv[16];
#pragma unroll
    for (int it = 0; it < 16; ++it) { const int id = it * 512 + tid, row = id >> 5, cc = id & 31;
      vv[it] = *(const u32x4*)(MKV + (size_t)(b * 256 + row) * 4096 + l * 2048 + 1024 + hx * 256 + cc * 8); }
    __syncthreads();
#pragma unroll
    for (int it = 0; it < 16; ++it) { const int id = it * 512 + tid, row = id >> 5, cc = id & 31; *(LAS u32x4*)(vs + row * 544 + cc * 16) = vv[it]; }
  }
  __syncthreads();
#pragma unroll
  for (int dvt = 0; dvt < 16; ++dvt) {
    f32x4 acc = {0.f, 0.f, 0.f, 0.f};
#pragma unroll
    for (int pp = 0; pp < 8; ++pp) { const int kA = 2 * pp * 16 + quad * 4;
      LAS unsigned char* vp = vs + (kA + (li >> 2)) * 544 + dvt * 32 + (li & 3) * 8;
      const u32x2 lo = lds_tr16(vp), hi = lds_tr16(vp + 16 * 544);
      u32x4 t; t.x = lo.x; t.y = lo.y; t.z = hi.x; t.w = hi.y; acc = mfma16(mk8(t), pf[pp], acc); }
    u32x2 o; o.x = pk2(acc[0] * inv, acc[1] * inv); o.y = pk2(acc[2] * inv, acc[3] * inv);
    if (!dry) *(u32x2*)(qptr + dvt * 16 + quad * 4) = o;
  }
  __syncthreads();
}

struct S5P { const float *a_re, *a_im, *log_step, *b_re, *b_im, *c_re, *c_im, *d; };
DI void s5_lambar(const S5P& P, int g, int p, float& lbr, float& lbi) {
  const float step = __expf(P.log_step[g]);
  const float ar = P.a_re[g * 64 + p], ai = P.a_im[g * 64 + p];
  const float mag = __expf(ar * step);
  float sn, cs; { const float x = ai * step; const float k = rintf(x * 0.15915494309189535f); float rr = fmaf(-k, 6.2831854820251465f, x); rr = fmaf(-k, -1.7484556000744883e-07f, rr); sn = sinf(rr); cs = cosf(rr); }
  lbr = mag * cs; lbi = mag * sn;
}
DI void s5_carry_scan(const f32x2* E, f32x2* C, const S5P& P, bool dry) {
  const int total = BPG * 32 * 64;
  for (int gid = blockIdx.x * NTHREADS + tid_(); gid < total; gid += gridDim.x * NTHREADS) {
    const int p = gid & 63, g = (gid >> 6) & 31, b = gid >> 11;
    float lr_, li_; s5_lambar(P, g, p, lr_, li_);
#pragma unroll
    for (int q = 0; q < 6; ++q) { const float t0 = lr_ * lr_ - li_ * li_, t1 = 2.0f * lr_ * li_; lr_ = t0; li_ = t1; }
    const size_t base = (((size_t)b * 32 + g) * 64) * 64 + p;
    float sr = 0.f, si = 0.f;
    for (int c0 = 0; c0 < 64; c0 += 8) { f32x2 ev[8];
#pragma unroll
      for (int q = 0; q < 8; ++q) ev[q] = E[base + (size_t)(c0 + q) * 64];
#pragma unroll
      for (int q = 0; q < 8; ++q) { if (!dry) { f32x2 o = {sr, si}; C[base + (size_t)(c0 + q) * 64] = o; }
        const float t0 = lr_ * sr - li_ * si + ev[q][0], t1 = lr_ * si + li_ * sr + ev[q][1]; sr = t0; si = t1; } }
  }
}
DI float bperm(float v, int srclane) { return __builtin_bit_cast(float, __builtin_amdgcn_ds_bpermute(srclane << 2, __builtin_bit_cast(int, v))); }
DI void s5_task(LAS unsigned char* sm, int task, int mode, bf16_t* U, f32x2* E, const S5P& P, bool dry) {
  const int tid = tid_(), lane = tid & 63, w = tid >> 6, li = lane & 15, quad = lane >> 4;
  const int b = task >> 8, c = (task >> 2) & 63, oct = task & 3;
  const size_t row0 = (size_t)b * 4096 + c * 64;
  { u32x4 v[2];
#pragma unroll
    for (int it = 0; it < 2; ++it) { const int id = it * 512 + tid, t = id >> 4, cc = id & 15; v[it] = *(const u32x4*)(U + (row0 + t) * 512 + oct * 128 + cc * 8); }
#pragma unroll
    for (int it = 0; it < 2; ++it) { const int id = it * 512 + tid, t = id >> 4, cc = id & 15; *(LAS u32x4*)(sm + t * 272 + cc * 16) = v[it]; } }
  __syncthreads();
  const int g = oct * 8 + w;
  float l1r[4], l1i[4], l2r[4], l2i[4], l3r[4], l3i[4], l4r[4], l4i[4], spr[4], spi[4];
  bf16x8 Bre[4], Bim[4];
#pragma unroll
  for (int pb = 0; pb < 4; ++pb) {
    const int p = pb * 16 + li;
    float lr, lim; s5_lambar(P, g, p, lr, lim);
    const float ar = P.a_re[g * 64 + p], ai = P.a_im[g * 64 + p];
    const float iv = 1.0f / (ar * ar + ai * ai), nr = lr - 1.0f, ni = lim;
    const float cr = (nr * ar + ni * ai) * iv, ci = (ni * ar - nr * ai) * iv;
    u32x4 tre = {0u, 0u, 0u, 0u}, tim = {0u, 0u, 0u, 0u};
    if (quad < 2) {
      const float* pr = P.b_re + ((size_t)g * 64 + p) * 16 + quad * 8; const float* pi = P.b_im + ((size_t)g * 64 + p) * 16 + quad * 8;
      const f32x4 br0 = *(const f32x4*)pr, br1 = *(const f32x4*)(pr + 4), bi0 = *(const f32x4*)pi, bi1 = *(const f32x4*)(pi + 4);
      tre.x = pk2(cr * br0[0] - ci * bi0[0], cr * br0[1] - ci * bi0[1]); tre.y = pk2(cr * br0[2] - ci * bi0[2], cr * br0[3] - ci * bi0[3]);
      tre.z = pk2(cr * br1[0] - ci * bi1[0], cr * br1[1] - ci * bi1[1]); tre.w = pk2(cr * br1[2] - ci * bi1[2], cr * br1[3] - ci * bi1[3]);
      tim.x = pk2(cr * bi0[0] + ci * br0[0], cr * bi0[1] + ci * br0[1]); tim.y = pk2(cr * bi0[2] + ci * br0[2], cr * bi0[3] + ci * br0[3]);
      tim.z = pk2(cr * bi1[0] + ci * br1[0], cr * bi1[1] + ci * br1[1]); tim.w = pk2(cr * bi1[2] + ci * br1[2], cr * bi1[3] + ci * br1[3]);
    }
    Bre[pb] = mk8(tre); Bim[pb] = mk8(tim);
    l1r[pb] = lr; l1i[pb] = lim;
    l2r[pb] = lr * lr - lim * lim; l2i[pb] = 2.0f * lr * lim;
    l3r[pb] = l2r[pb] * lr - l2i[pb] * lim; l3i[pb] = l2r[pb] * lim + l2i[pb] * lr;
    l4r[pb] = l2r[pb] * l2r[pb] - l2i[pb] * l2i[pb]; l4i[pb] = 2.0f * l2r[pb] * l2i[pb];
    spr[pb] = 0.f; spi[pb] = 0.f;
    if (mode == 1) { const f32x2 e = E[(((size_t)b * 32 + g) * 64 + c) * 64 + p]; spr[pb] = e[0]; spi[pb] = e[1]; }
  }
  bf16x8 cm[4]; f32x4 dsk = {0.f, 0.f, 0.f, 0.f};
  LAS unsigned char* ss = sm + 17408 + w * 4352;
  if (mode == 1) {
#pragma unroll
    for (int kk = 0; kk < 4; ++kk) { const int p0 = kk * 16 + quad * 4;
      const f32x4 cr4 = *(const f32x4*)(P.c_re + ((size_t)g * 16 + li) * 64 + p0), ci4 = *(const f32x4*)(P.c_im + ((size_t)g * 16 + li) * 64 + p0);
      u32x4 t; t.x = pk2(cr4[0], -ci4[0]); t.y = pk2(cr4[1], -ci4[1]); t.z = pk2(cr4[2], -ci4[2]); t.w = pk2(cr4[3], -ci4[3]); cm[kk] = mk8(t); }
    dsk = *(const f32x4*)(P.d + g * 16 + quad * 4);
  }
  const int src_up = (lane - 16) & 63, src_q3 = 48 + li;
  for (int sb = 0; sb < 4; ++sb) {
    u32x4 araw = {0u, 0u, 0u, 0u};
    if (quad < 2) araw = *(const LAS u32x4*)(sm + (sb * 16 + li) * 272 + (w * 16 + quad * 8) * 2);
    const bf16x8 a = mk8(araw);
#pragma unroll
    for (int pb = 0; pb < 4; ++pb) {
      const f32x4 z4 = {0.f, 0.f, 0.f, 0.f};
      const f32x4 are = mfma16(a, Bre[pb], z4), aim = mfma16(a, Bim[pb], z4);
      float s0r = are[0], s0i = aim[0];
      float s1r = l1r[pb] * s0r - l1i[pb] * s0i + are[1], s1i = l1r[pb] * s0i + l1i[pb] * s0r + aim[1];
      float s2r = l1r[pb] * s1r - l1i[pb] * s1i + are[2], s2i = l1r[pb] * s1i + l1i[pb] * s1r + aim[2];
      float s3r = l1r[pb] * s2r - l1i[pb] * s2i + are[3], s3i = l1r[pb] * s2i + l1i[pb] * s2r + aim[3];
      float cr_ = (quad == 0) ? spr[pb] : 0.f, ci_ = (quad == 0) ? spi[pb] : 0.f;
#pragma unroll
      for (int r = 0; r < 3; ++r) {
        const float er = l4r[pb] * cr_ - l4i[pb] * ci_ + s3r, ei = l4r[pb] * ci_ + l4i[pb] * cr_ + s3i;
        const float gr = bperm(er, src_up), gi = bperm(ei, src_up);
        if (quad == r + 1) { cr_ = gr; ci_ = gi; }
      }
      s0r += l1r[pb] * cr_ - l1i[pb] * ci_; s0i += l1r[pb] * ci_ + l1i[pb] * cr_;
      s1r += l2r[pb] * cr_ - l2i[pb] * ci_; s1i += l2r[pb] * ci_ + l2i[pb] * cr_;
      s2r += l3r[pb] * cr_ - l3i[pb] * ci_; s2i += l3r[pb] * ci_ + l3i[pb] * cr_;
      s3r += l4r[pb] * cr_ - l4i[pb] * ci_; s3i += l4r[pb] * ci_ + l4i[pb] * cr_;
      spr[pb] = bperm(s3r, src_q3); spi[pb] = bperm(s3i, src_q3);
      if (mode == 1) { LAS unsigned char* q = ss + (quad * 4) * 272 + (pb * 16 + li) * 4;
        *(LAS unsigned*)(q) = pk2(s0r, s0i); *(LAS unsigned*)(q + 272) = pk2(s1r, s1i); *(LAS unsigned*)(q + 544) = pk2(s2r, s2i); *(LAS unsigned*)(q + 816) = pk2(s3r, s3i); }
    }
    if (mode == 1) {
      asm volatile("s_waitcnt lgkmcnt(0)" ::: "memory");
      f32x4 acc = {0.f, 0.f, 0.f, 0.f};
#pragma unroll
      for (int kk = 0; kk < 4; ++kk) { const bf16x8 bq = *(const LAS bf16x8*)(ss + li * 272 + kk * 64 + quad * 16); acc = mfma16(cm[kk], bq, acc); }
      const u32x2 uq = *(const LAS u32x2*)(sm + (sb * 16 + li) * 272 + (w * 16 + quad * 4) * 2);
      const float u4[4] = {bf_lo(uq.x), bf_hi(uq.x), bf_lo(uq.y), bf_hi(uq.y)};
      float o[4];
#pragma unroll
      for (int j = 0; j < 4; ++j) { const float y = acc[j] + dsk[j] * u4[j]; const float z = 0.7978845608028654f * (y + 0.044715f * y * y * y);
        const float th = 1.0f - 2.0f / (__expf(2.0f * z) + 1.0f); o[j] = 0.5f * y * (1.0f + th); }
      asm volatile("s_waitcnt lgkmcnt(0)" ::: "memory");
      u32x2 ov; ov.x = pk2(o[0], o[1]); ov.y = pk2(o[2], o[3]);
      if (!dry) *(u32x2*)(U + (row0 + sb * 16 + li) * 512 + g * 16 + quad * 4) = ov;
    }
  }
  if (mode == 0 && !dry && quad == 0) {
#pragma unroll
    for (int pb = 0; pb < 4; ++pb) { f32x2 e = {spr[pb], spi[pb]}; E[(((size_t)b * 32 + g) * 64 + c) * 64 + pb * 16 + li] = e; }
  }
  __syncthreads();
}

struct GLAP { const float *wg, *bg, *gout; };
constexpr int GL_LR = 0;
constexpr int GL_WG = 4096;
constexpr int GL_BS = 8192;
constexpr int GL_Q = 24832;
constexpr int GL_K = 34048;
constexpr int GL_VT = 43264;
constexpr int GL_ST = 61696;
constexpr int GL_RED = 80128;
constexpr int GL_SEG = 80640;
DI void gla_cumdecay(LAS unsigned char* sm, const bf16_t* LR, size_t row0, int h, const GLAP& P) {
  const int tid = tid_();
  LAS float* lrs = (LAS float*)(sm + GL_LR); LAS float* bs = (LAS float*)(sm + GL_BS); LAS float* segs = (LAS float*)(sm + GL_SEG);
  const int dk = tid & 63, seg = tid >> 6, t0 = seg * 8;
  u32x4 lrv = {0u, 0u, 0u, 0u};
  if (tid < 128) lrv = *(const u32x4*)(LR + (row0 + (tid >> 1)) * 256 + (tid & 1) * 8);
  float wcol[16];
#pragma unroll
  for (int rr = 0; rr < 16; ++rr) wcol[rr] = P.wg[rr * 256 + h * 64 + dk];
  const float bias = P.bg[h * 64 + dk];
  if (tid < 128) { const int t = tid >> 1, hf = tid & 1;
    f32x4 f0 = {bf_lo(lrv.x), bf_hi(lrv.x), bf_lo(lrv.y), bf_hi(lrv.y)}, f1 = {bf_lo(lrv.z), bf_hi(lrv.z), bf_lo(lrv.w), bf_hi(lrv.w)};
    *(LAS f32x4*)(lrs + t * 16 + hf * 8) = f0; *(LAS f32x4*)(lrs + t * 16 + hf * 8 + 4) = f1; }
  __syncthreads();
  float la[8]; float run = 0.f;
#pragma unroll
  for (int e = 0; e < 8; ++e) { float z = bias;
#pragma unroll
    for (int q4 = 0; q4 < 4; ++q4) { const f32x4 r4 = *(const LAS f32x4*)(lrs + (t0 + e) * 16 + q4 * 4);
      z = fmaf(r4[0], wcol[q4 * 4], z); z = fmaf(r4[1], wcol[q4 * 4 + 1], z); z = fmaf(r4[2], wcol[q4 * 4 + 2], z); z = fmaf(r4[3], wcol[q4 * 4 + 3], z); }
    const float ls = fminf(z, 0.f) - log1pf(__expf(-fabsf(z)));
    run += ls * 0.0625f; la[e] = run; }
  segs[seg * 64 + dk] = run;
  __syncthreads();
  float off = 0.f;
#pragma unroll
  for (int s2 = 0; s2 < 7; ++s2) off += (s2 < seg) ? segs[s2 * 64 + dk] : 0.f;
#pragma unroll
  for (int e = 0; e < 8; ++e) bs[(t0 + e) * 65 + dk] = la[e] + off;
  __syncthreads();
}
DI void gla_stage_vt(LAS unsigned char* sm, const bf16_t* VG, size_t row0, int h) {
  LAS unsigned short* vt = (LAS unsigned short*)(sm + GL_VT);
#pragma unroll
  for (int it = 0; it < 2; ++it) { const int id = it * 512 + tid_(), t = id & 63, cc = id >> 6;
    const u32x4 v = *(const u32x4*)(VG + (row0 + t) * 512 + h * 128 + cc * 8);
#pragma unroll
    for (int e = 0; e < 4; ++e) { vt[(cc * 8 + 2 * e) * 72 + t] = (unsigned short)(v[e] & 0xffffu); vt[(cc * 8 + 2 * e + 1) * 72 + t] = (unsigned short)(v[e] >> 16); } }
}
DI void gla_a_task(LAS unsigned char* sm, int task, const bf16_t* QK, const bf16_t* VG, const bf16_t* LR, bf16_t* GST, float* GDEC, const GLAP& P, bool dry) {
  const int tid = tid_(), lane = tid & 63, w = tid >> 6, li = lane & 15, quad = lane >> 4;
  const int bh = task >> 6, c = task & 63, b = bh >> 2, h = bh & 3;
  const size_t row0 = (size_t)b * 4096 + c * 64;
  gla_cumdecay(sm, LR, row0, h, P);
  LAS float* bs = (LAS float*)(sm + GL_BS);
  LAS unsigned short* kht = (LAS unsigned short*)(sm + GL_Q);
  { const int t = tid & 63, dkc = tid >> 6; const u32x4 v = *(const u32x4*)(QK + (row0 + t) * 512 + 256 + h * 64 + dkc * 8);
#pragma unroll
    for (int e = 0; e < 4; ++e) { const int d0 = dkc * 8 + 2 * e;
      const float k0 = bf_lo(v[e]) * __expf(bs[63 * 65 + d0] - bs[t * 65 + d0]), k1 = bf_hi(v[e]) * __expf(bs[63 * 65 + d0 + 1] - bs[t * 65 + d0 + 1]);
      const unsigned pk = pk2(k0, k1); kht[d0 * 72 + t] = (unsigned short)(pk & 0xffffu); kht[(d0 + 1) * 72 + t] = (unsigned short)(pk >> 16); } }
  gla_stage_vt(sm, VG, row0, h);
  if (tid < 64 && !dry) GDEC[(size_t)task * 64 + tid] = __expf(bs[63 * 65 + tid]);
  __syncthreads();
  LAS unsigned short* vt = (LAS unsigned short*)(sm + GL_VT);
#pragma unroll
  for (int dkt = 0; dkt < 4; ++dkt) { f32x4 acc = {0.f, 0.f, 0.f, 0.f};
#pragma unroll
    for (int kk = 0; kk < 2; ++kk) { const bf16x8 a = *(const LAS bf16x8*)(vt + (w * 16 + li) * 72 + kk * 32 + quad * 8), bq = *(const LAS bf16x8*)(kht + (dkt * 16 + li) * 72 + kk * 32 + quad * 8); acc = mfma16(a, bq, acc); }
#pragma unroll
    for (int j = 0; j < 4; ++j) if (!dry) GST[((size_t)task * 128 + w * 16 + quad * 4 + j) * 64 + dkt * 16 + li] = (bf16_t)(pk2(acc[j], 0.f) & 0xffffu); }
  __syncthreads();
}
DI void gla_prefix(const bf16_t* GST, bf16_t* GSO, const float* GDEC, bool dry) {
  const int total = BPG * 4 * 8192;
  for (int gid = blockIdx.x * NTHREADS + tid_(); gid < total; gid += gridDim.x * NTHREADS) {
    const int bh = gid >> 13, e = gid & 8191, dk = e & 63; float S = 0.f;
    for (int c0 = 0; c0 < 64; c0 += 16) { float tv[16], dv[16];
#pragma unroll
      for (int q = 0; q < 16; ++q) { tv[q] = __uint_as_float((unsigned)GST[((size_t)(bh * 64 + c0 + q)) * 8192 + e] << 16); dv[q] = GDEC[(size_t)(bh * 64 + c0 + q) * 64 + dk]; }
#pragma unroll
      for (int q = 0; q < 16; ++q) { if (!dry) GSO[((size_t)(bh * 64 + c0 + q)) * 8192 + e] = (bf16_t)(pk2(S, 0.f) & 0xffffu); S = fmaf(dv[q], S, tv[q]); } }
  }
}
DI void gla_c_task(LAS unsigned char* sm, int task, const bf16_t* QK, bf16_t* VG, const bf16_t* LR, const bf16_t* R, const bf16_t* GST, const GLAP& P, bool dry) {
  const int tid = tid_(), lane = tid & 63, w = tid >> 6, li = lane & 15, quad = lane >> 4;
  const int bh = task >> 6, c = task & 63, b = bh >> 2, h = bh & 3;
  const size_t row0 = (size_t)b * 4096 + c * 64;
  gla_cumdecay(sm, LR, row0, h, P);
  LAS float* bs = (LAS float*)(sm + GL_BS);
  LAS unsigned short* qs = (LAS unsigned short*)(sm + GL_Q); LAS unsigned short* ksm = (LAS unsigned short*)(sm + GL_K);
  LAS unsigned short* vt = (LAS unsigned short*)(sm + GL_VT); LAS unsigned short* st = (LAS unsigned short*)(sm + GL_ST); LAS float* red = (LAS float*)(sm + GL_RED);
  { const int t = tid >> 3, ch = tid & 7;
    const u32x4 qv = *(const u32x4*)(QK + (row0 + t) * 512 + h * 64 + ch * 8), kv = *(const u32x4*)(QK + (row0 + t) * 512 + 256 + h * 64 + ch * 8);
    u32x4 qo, ko;
#pragma unroll
    for (int e = 0; e < 4; ++e) { const int d0 = ch * 8 + 2 * e; const float b0 = bs[t * 65 + d0], b1 = bs[t * 65 + d0 + 1];
      qo[e] = pk2(bf_lo(qv[e]) * 0.125f * __expf(b0), bf_hi(qv[e]) * 0.125f * __expf(b1));
      ko[e] = pk2(bf_lo(kv[e]) * __expf(-b0), bf_hi(kv[e]) * __expf(-b1)); }
    *(LAS u32x4*)(qs + t * 72 + ch * 8) = qo; *(LAS u32x4*)(ksm + t * 72 + ch * 8) = ko; }
  gla_stage_vt(sm, VG, row0, h);
#pragma unroll
  for (int it = 0; it < 2; ++it) { const int id = it * 512 + tid, dv = id >> 3, c8 = id & 7;
    const u32x4 v = *(const u32x4*)(GST + ((size_t)task * 128 + dv) * 64 + c8 * 8);
    *(LAS u32x4*)(st + dv * 72 + c8 * 8) = v; }
  __syncthreads();
  const int qt = w & 3, dvh = w >> 2;
  bf16x8 qf[2];
#pragma unroll
  for (int kk = 0; kk < 2; ++kk) qf[kk] = *(const LAS bf16x8*)(qs + (qt * 16 + li) * 72 + kk * 32 + quad * 8);
  float s[4][4];
#pragma unroll
  for (int jt = 0; jt < 4; ++jt) { f32x4 acc = {0.f, 0.f, 0.f, 0.f};
#pragma unroll
    for (int kk = 0; kk < 2; ++kk) { const bf16x8 a = *(const LAS bf16x8*)(ksm + (jt * 16 + li) * 72 + kk * 32 + quad * 8); acc = mfma16(a, qf[kk], acc); }
#pragma unroll
    for (int j = 0; j < 4; ++j) { const int kj = jt * 16 + quad * 4 + j, qi = qt * 16 + li; s[jt][j] = (kj <= qi) ? acc[j] : 0.f; } }
  bf16x8 pf[2];
#pragma unroll
  for (int pp = 0; pp < 2; ++pp) { u32x4 t; t.x = pk2(s[2 * pp][0], s[2 * pp][1]); t.y = pk2(s[2 * pp][2], s[2 * pp][3]); t.z = pk2(s[2 * pp + 1][0], s[2 * pp + 1][1]); t.w = pk2(s[2 * pp + 1][2], s[2 * pp + 1][3]); pf[pp] = mk8(t); }
  f32x4 o[4]; float ssq = 0.f;
#pragma unroll
  for (int dvt = 0; dvt < 4; ++dvt) { const int dv0 = dvh * 64 + dvt * 16; f32x4 acc = {0.f, 0.f, 0.f, 0.f};
#pragma unroll
    for (int pp = 0; pp < 2; ++pp) { const int kA = 2 * pp * 16 + quad * 4;
      const u32x2 lo = *(const LAS u32x2*)(vt + (dv0 + li) * 72 + kA), hi = *(const LAS u32x2*)(vt + (dv0 + li) * 72 + kA + 16);
      u32x4 t; t.x = lo.x; t.y = lo.y; t.z = hi.x; t.w = hi.y; acc = mfma16(mk8(t), pf[pp], acc); }
#pragma unroll
    for (int kk = 0; kk < 2; ++kk) { const bf16x8 a = *(const LAS bf16x8*)(st + (dv0 + li) * 72 + kk * 32 + quad * 8); acc = mfma16(a, qf[kk], acc); }
    o[dvt] = acc; ssq += acc[0] * acc[0] + acc[1] * acc[1] + acc[2] * acc[2] + acc[3] * acc[3]; }
  ssq += shx(ssq, 16, lane); ssq += shx(ssq, 32, lane);
  if (quad == 0) red[dvh * 64 + qt * 16 + li] = ssq;
  __syncthreads();
  const float tot = red[qt * 16 + li] + red[64 + qt * 16 + li];
  const float rs = rsqrtf(tot * (1.0f / 128.0f) + 1e-6f);
  const size_t row = row0 + qt * 16 + li;
#pragma unroll
  for (int dvt = 0; dvt < 4; ++dvt) { const int dv = dvh * 64 + dvt * 16 + quad * 4;
    const f32x4 gg = *(const f32x4*)(P.gout + dv); const u32x2 rv = *(const u32x2*)(R + row * 512 + h * 128 + dv);
    const float r4[4] = {bf_lo(rv.x), bf_hi(rv.x), bf_lo(rv.y), bf_hi(rv.y)}; float y[4];
#pragma unroll
    for (int j = 0; j < 4; ++j) y[j] = o[dvt][j] * rs * gg[j] * (r4[j] * sigmoidf_(r4[j]));
    u32x2 ov; ov.x = pk2(y[0], y[1]); ov.y = pk2(y[2], y[3]); if (!dry) *(u32x2*)(VG + row * 512 + h * 128 + dv) = ov; }
  __syncthreads();
}

#define XB_TMO      128
#define XB_XCNT(j)  (256  + 64 * (j))
#define XB_XSUB(j)  (1280 + 64 * (j))
#define XB_XGEN(j)  (2304 + 64 * (j))
#define XB_TOP      3328
#define XB_TOPGEN   3392
#define XCD_BAR_WORDS 3456
#define XB_SPIN_CAP (1u << 18)
DI unsigned xb_ld(unsigned* p)              { return __hip_atomic_load(p, __ATOMIC_RELAXED, __HIP_MEMORY_SCOPE_AGENT); }
DI unsigned xb_add(unsigned* p, unsigned v) { return __hip_atomic_fetch_add(p, v, __ATOMIC_RELAXED, __HIP_MEMORY_SCOPE_AGENT); }
DI unsigned xb_xcc_id() { return (unsigned)__builtin_amdgcn_s_getreg((3 << 11) | 20) & 0xFu; }
#define XB_SPIN(cond, bar) do { unsigned _sp = 0; while (cond) { __builtin_amdgcn_s_sleep(1); \
    if ((++_sp & 255u) == 0u) { if (xb_ld(&(bar)[XB_TMO])) break; if (_sp > XB_SPIN_CAP) { atomicAdd(&(bar)[XB_TMO], 1u); break; } } } } while (0)
struct XcdBarrier { unsigned* bar; unsigned x; volatile LAS unsigned* st; };
DI XcdBarrier xcd_barrier_post(unsigned* bar, volatile LAS unsigned* st) {
  XcdBarrier b; b.bar = bar; b.x = xb_xcc_id(); b.st = st;
  if (threadIdx.x == 0) (void)xb_add(&bar[XB_XCNT(b.x)], 1u);
  return b;
}
DI void xcd_barrier_complete(unsigned* bar, unsigned x, unsigned& nloc, unsigned& nx) {
  asm volatile("" : "+s"(bar));
  const unsigned G = gridDim.x * gridDim.y * gridDim.z;
  unsigned sum, cnt, mine, sp = 0u;
  for (;;) {
    sum = 0u; cnt = 0u; mine = 0u;
#pragma unroll
    for (unsigned j = 0; j < 16; ++j) { const unsigned c = xb_ld(&bar[XB_XCNT(j)]); sum += c; cnt += (c > 0u) ? 1u : 0u; mine = (j == x) ? c : mine; }
    if (sum == G) break;
    __builtin_amdgcn_s_sleep(1);
    if ((++sp & 255u) == 0u) { if (xb_ld(&bar[XB_TMO])) break; if (sp > XB_SPIN_CAP) { atomicAdd(&bar[XB_TMO], 1u); break; } }
  }
  nloc = mine > 0u ? mine : 1u; nx = cnt > 0u ? cnt : 1u;
}
DI void xcd_barrier(const XcdBarrier& b) {
  asm volatile("s_waitcnt vmcnt(0)" ::: "memory");
  __syncthreads();
  if (threadIdx.x == 0) {
    unsigned* bar = b.bar; asm volatile("" : "+s"(bar));
    __builtin_amdgcn_s_waitcnt(0);
    unsigned nloc = b.st[0], nx = b.st[1];
    if (nloc == 0u) { xcd_barrier_complete(bar, b.x, nloc, nx); b.st[0] = nloc; b.st[1] = nx; }
    const unsigned old = xb_add(&bar[XB_XSUB(b.x)], 1u);
    const unsigned gen = old / nloc;
    if (old + 1u == (gen + 1u) * nloc) {
      __builtin_amdgcn_fence(__ATOMIC_RELEASE, "agent");
      asm volatile("s_waitcnt vmcnt(0)" ::: "memory");
      const unsigned og = xb_add(&bar[XB_TOP], 1u);
      const unsigned tg = og / nx;
      if (og + 1u == (tg + 1u) * nx) xb_add(&bar[XB_TOPGEN], 1u);
      else XB_SPIN(xb_ld(&bar[XB_TOPGEN]) == tg, bar);
      __builtin_amdgcn_fence(__ATOMIC_ACQUIRE, "agent");
      xb_add(&bar[XB_XGEN(b.x)], 1u);
      asm volatile("s_waitcnt vmcnt(0)" ::: "memory");
    } else {
      XB_SPIN(xb_ld(&bar[XB_XGEN(b.x)]) == gen, bar);
      __builtin_amdgcn_fence(__ATOMIC_ACQUIRE, "agent");
      asm volatile("s_waitcnt vmcnt(0)" ::: "memory");
    }
  }
  __syncthreads();
}

struct Args { const float* in[28]; float* out; unsigned char* ws; int ph_lo, ph_hi; };
constexpr int NPH = 1 + DEPTH * 23 + 1;

__global__ void __launch_bounds__(NTHREADS, 2) mega(Args A) {
  extern __shared__ __attribute__((aligned(16))) unsigned char lds_raw[];
  LAS unsigned char* sm = (LAS unsigned char*)lds_raw;
  cg::grid_group grid = cg::this_grid();
  const int G = gridDim.x, bid = blockIdx.x;
  volatile LAS unsigned* xst = (volatile LAS unsigned*)(sm + LDS_BYTES - 16);
  if (threadIdx.x < 4) xst[threadIdx.x] = 0u;
  __syncthreads();
  XcdBarrier xbar; xbar.bar = (unsigned*)(A.ws + WS_BAR); xbar.x = 0; xbar.st = xst;
  if (A.ph_hi - A.ph_lo > 1) xbar = xcd_barrier_post((unsigned*)(A.ws + WS_BAR), xst);
#ifdef PROBE_A
  unsigned long long tA = 0, tB = 0, tprev = wall_clock64();
#endif

  for (int ph = A.ph_lo; ph < A.ph_hi; ++ph) {
    size_t zo; asm volatile("s_mov_b64 %0, 0" : "=s"(zo));
    unsigned char* ws = A.ws + zo;
    const float* x_in = A.in[0] + zo;
    float* xo = A.out + zo;
    bf16_t* XB = (bf16_t*)(ws + WS_H);
    bf16_t* H = (bf16_t*)xo; bf16_t* PB = (bf16_t*)(ws + WS_P);
    bf16_t* MEMN = (bf16_t*)(ws + WS_MEMN); bf16_t* MKV = (bf16_t*)(ws + WS_MEMKV);
    float* LSE = (float*)(ws + WS_LSE); f32x2* S5E = (f32x2*)(ws + WS_S5E); f32x2* S5C = (f32x2*)(ws + WS_S5C); float* GDEC = (float*)(ws + WS_GDEC); bf16_t* GST = (bf16_t*)((unsigned char*)xo + (size_t)MTOK * 1024 * 2); bf16_t* GSO = GST + (size_t)BPG * 4 * 64 * 8192;
#define IN(i) (A.in[i] + zo)
    int kind, l = 0, grp = 0;
    if (ph == 0) kind = 0; else if (ph == NPH - 1) kind = 17;
    else { const int q = ph - 1; l = q / 23; const int k = q % 23; if (k < 16) { grp = k >> 3; kind = 2 + (k & 7); } else kind = 10 + (k - 16); }
    const float* xsrc = (l == 0) ? x_in : xo;
#ifdef PROBE_REPEAT_MASK
    const int ndry = (int)((PROBE_REPEAT_MASK >> kind) & 1);
#else
    const int ndry = 0;
#endif
    for (int dryi = ndry; dryi >= 0; --dryi) {
    const bool dry = dryi != 0;
    bool isgemm = false; int nrep = 1;
    const int vb = ((G & 7) == 0) ? (bid & 7) * (G >> 3) + (bid >> 3) : bid;
    switch (kind) {
      case 0: {
        for (int ll = 0; ll < DEPTH; ++ll) {
          transpose_w(sm, IN(3) + (size_t)ll * 1024 * 9744, 1024, 9744, (bf16_t*)(ws + WS_WIN) + (size_t)ll * DINP * 1024, DINP, 1);
          transpose_w(sm, IN(12) + (size_t)ll * 512 * 512, 512, 512, (bf16_t*)(ws + WS_WGLU) + (size_t)ll * 512 * 512, 512, 0);
          for (int n = 0; n < 3; ++n) transpose_w(sm, IN(17) + ((size_t)ll * 3 + n) * 512 * 1024, 512, 1024, (bf16_t*)(ws + WS_WBR) + ((size_t)ll * 3 + n) * 1024 * 512, 1024, 0);
          transpose_w(sm, IN(18) + (size_t)ll * 1024 * 1024, 1024, 1024, (bf16_t*)(ws + WS_WOUT) + (size_t)ll * 1024 * 1024, 1024, 0);
          transpose_w(sm, IN(21) + (size_t)ll * 1024 * 1024, 1024, 1024, (bf16_t*)(ws + WS_WXQ) + (size_t)ll * 1024 * 1024, 1024, 0);
          transpose_w(sm, IN(23) + (size_t)ll * 1024 * 1024, 1024, 1024, (bf16_t*)(ws + WS_WXO) + (size_t)ll * 1024 * 1024, 1024, 0);
          transpose_w(sm, IN(22) + (size_t)ll * 1024 * 2048, 1024, 2048, (bf16_t*)(ws + WS_WXKV) + (size_t)ll * 2048 * 1024, 2048, 0);
          transpose_w(sm, IN(25) + (size_t)ll * 1024 * 4096, 1024, 4096, (bf16_t*)(ws + WS_WUP) + (size_t)ll * 4096 * 1024, 4096, 0);
          transpose_w(sm, IN(26) + (size_t)ll * 4096 * 1024, 4096, 1024, (bf16_t*)(ws + WS_WDN) + (size_t)ll * 1024 * 4096, 1024, 0);
        }
        norm_rows_bf16(IN(1), IN(19), MEMN, 2048);
      } break;
      case 3: isgemm = true; nrep = (l == 0 && grp == 0) ? 2 : 1; break;
      case 7: case 8: case 9: case 11: case 13: case 15: case 16: isgemm = true; break;
      case 2: if (l == 0) norm_rows_bf16(x_in + (size_t)grp * MG * 1024, IN(2) + l * 1024, H, MG); else norm_rows_from_bf16(XB + (size_t)grp * MG * 1024, 1024, IN(2) + l * 1024, H, MG); break;
      case 4: {
        S5P sp{IN(4) + l * 2048, IN(5) + l * 2048, IN(6) + l * 32, IN(7) + (size_t)l * 32768, IN(8) + (size_t)l * 32768, IN(9) + (size_t)l * 32768, IN(10) + (size_t)l * 32768, IN(11) + l * 512};
        GLAP gp{IN(14) + l * 4096, IN(15) + l * 256, IN(16) + l * 128};
        constexpr int NA = BPG * 12 * 32, NS = BPG * 256, NGL = BPG * 4 * 64;
        for (int t = vb; t < NA + NS + NGL; t += G) {
          if (t < NA) attn_task(sm, t, PB + P_QA, PB + P_KA, PB + P_VA, LSE, dry);
          else if (t < NA + NS) s5_task(sm, t - NA, 0, PB + P_U, S5E, sp, dry);
          else gla_a_task(sm, t - NA - NS, PB + P_QK, PB + P_VG, PB + P_LR, GST, GDEC, gp, dry);
        }
      } break;
      case 5: { gla_prefix(GST, GSO, GDEC, dry);
        S5P sp{IN(4) + l * 2048, IN(5) + l * 2048, IN(6) + l * 32, IN(7) + (size_t)l * 32768, IN(8) + (size_t)l * 32768, IN(9) + (size_t)l * 32768, IN(10) + (size_t)l * 32768, IN(11) + l * 512};
        s5_carry_scan(S5E, S5C, sp, dry); } break;
      case 6: {
        S5P sp{IN(4) + l * 2048, IN(5) + l * 2048, IN(6) + l * 32, IN(7) + (size_t)l * 32768, IN(8) + (size_t)l * 32768, IN(9) + (size_t)l * 32768, IN(10) + (size_t)l * 32768, IN(11) + l * 512};
        GLAP gp{IN(14) + l * 4096, IN(15) + l * 256, IN(16) + l * 128};
        constexpr int NS = BPG * 256, NGL = BPG * 4 * 64;
        for (int t = bid; t < NS + NGL; t += G) {
          if (t < NS) s5_task(sm, t, 1, PB + P_U, S5C, sp, dry);
          else gla_c_task(sm, t - NS, PB + P_QK, PB + P_VG, PB + P_LR, PB + P_R, GSO, gp, dry);
        }
      } break;
      case 10: norm_rows_from_bf16(XB, 1024, IN(20) + l * 1024, H, MTOK); break;
      case 12: for (int t = vb; t < NB * 4 * 32; t += G) xattn_task(sm, t, PB, MKV, l, dry); break;
      case 14: norm_rows_from_bf16(XB, 1024, IN(24) + l * 1024, H, MTOK); break;
      case 17: final_norm_from_bf16(XB, xo, IN(27), MTOK); break;
      default: break;
    }
    if (isgemm) {
      for (int rep = 0; rep < nrep; ++rep) {
        pg8::Gemm g; Epi E; E.mode = EM_BF16; E.o16 = nullptr; E.ld16 = 0; E.o32 = nullptr; E.r32 = nullptr; E.ld32 = 1024; E.aux = nullptr; E.ldaux = 0; E.bias = nullptr; E.nzm1 = 0; E.r16 = nullptr; E.ldr16 = 1024; int nz = 1;
        bf16_t* MB = PB + P_KA;
        switch (rep == 1 ? 1 : kind) {
          case 1: g = pg8::Gemm{MEMN, (bf16_t*)(ws + WS_WXKV), 2048, 4096, 1024, 1024}; E.mode = EM_BF16; E.o16 = MKV; E.ld16 = 4096; break;
          case 3: g = pg8::Gemm{H, (bf16_t*)(ws + WS_WIN) + (size_t)l * DINP * 1024, MG, DINP, 1024, 1024}; E.mode = EM_PROJ; E.o16 = PB; break;
          case 7: g = pg8::Gemm{PB + P_U, (bf16_t*)(ws + WS_WGLU) + (size_t)l * 512 * 512, MG, 512, 512, 512}; E.mode = EM_GLU; E.o16 = PB + P_QK; E.ld16 = 512; E.aux = PB + P_U; E.ldaux = 512; E.bias = IN(13) + l * 512; break;
          case 8: g = pg8::Gemm{PB + P_QK, (bf16_t*)(ws + WS_WBR) + (size_t)l * 3 * 1024 * 512, MG, 1024, 512, 512};
            g.zA1 = (long)((const char*)(PB + P_VG) - (const char*)(PB + P_QK)); g.zA2 = (long)((const char*)H - (const char*)(PB + P_QK)); g.zB = (long)1024 * 512 * 2; nz = 3;
            E.mode = EM_MERGEZ; E.nzm1 = 2; E.o16 = MB; E.ld16 = 1024; E.aux = PB + P_GATE; E.ldaux = 3072; break;
          case 9: g = pg8::Gemm{MB, (bf16_t*)(ws + WS_WOUT) + (size_t)l * 1024 * 1024, MG, 1024, 1024, 1024}; E.mode = EM_RESID; E.o16 = XB + (size_t)grp * MG * 1024; E.ld16 = 1024; if (l == 0) E.r32 = x_in + (size_t)grp * MG * 1024; else E.r16 = XB + (size_t)grp * MG * 1024; break;
          case 11: g = pg8::Gemm{H, (bf16_t*)(ws + WS_WXQ) + (size_t)l * 1024 * 1024, MTOK, 1024, 1024, 1024}; E.mode = EM_BF16; E.o16 = PB; E.ld16 = 1024; break;
          case 13: g = pg8::Gemm{PB, (bf16_t*)(ws + WS_WXO) + (size_t)l * 1024 * 1024, MTOK, 1024, 1024, 1024}; E.mode = EM_RESID; E.r16 = XB; E.o16 = XB; E.ld16 = 1024; break;
          case 15: g = pg8::Gemm{H, (bf16_t*)(ws + WS_WUP) + (size_t)l * 4096 * 1024, MTOK, 4096, 1024, 1024}; E.mode = EM_RELU2; E.o16 = PB; E.ld16 = 4096; break;
          default: g = pg8::Gemm{PB, (bf16_t*)(ws + WS_WDN) + (size_t)l * 1024 * 4096, MTOK, 1024, 4096, 4096}; E.mode = EM_RESID; E.r16 = XB; E.o16 = XB; E.ld16 = 1024; break;
        }
        g.nz = nz; if (nz == 1) { g.zA1 = 0; g.zA2 = 0; g.zB = 0; }
        g.perm = 1;
        pg8::StaticOrder S; S.init(g.M, g.N, G, bid, nz);
        if (dry) { E.mode = EM_DRY; E.nzm1 = nz - 1; }
        if (nz == 1) pg8::gemm_phase<false, Epi>(sm, g, S, E); else pg8::gemm_phase<true, Epi>(sm, g, S, E);
      }
      if (kind == 7) { if (G > 128) { if (bid >= 128) attn_combine(PB + P_QA, H, LSE, dry, bid - 128, G - 128); } else attn_combine(PB + P_QA, H, LSE, dry, bid, G); }
    }
    }
#ifdef PROBE_A
    { const unsigned long long tn = wall_clock64(); const unsigned long long dt = tn - tprev; tprev = tn;
      if ((PROBE_A >> kind) & 1) tA += dt; if ((PROBE_B >> kind) & 1) tB += dt; }
#endif
    if (ph + 1 < A.ph_hi) { if (ph == A.ph_lo) grid.sync(); else xcd_barrier(xbar); }
#ifdef PROBE_EXTRA_SYNCS
    if (ph == 1) for (int i = 0; i < PROBE_EXTRA_SYNCS; ++i) xcd_barrier(xbar);
#endif
#ifdef PROBE_A
    { const unsigned long long tn = wall_clock64(); const unsigned long long dt = tn - tprev; tprev = tn;
      if ((PROBE_A >> 18) & 1) tA += dt; if ((PROBE_B >> 18) & 1) tB += dt; }
#endif
  }
#ifdef PROBE_A
  {
    float* tw = (float*)(A.ws + WS_LSE);
    if (bid == 0 && tid_() == 0) { tw[0] = (float)tA * 0.01f; tw[1] = (float)tB * 0.01f; __threadfence(); }
    grid.sync();
    const float fa = __builtin_nontemporal_load(tw), fb = __builtin_nontemporal_load(tw + 1);
    for (size_t i = (size_t)bid * NTHREADS + tid_(); i < (size_t)16777216; i += (size_t)G * NTHREADS) A.out[i] += fb;
    if (bid == 1 && tid_() == 0) A.out[(size_t)MTOK * DM - 1] += 64.0f * fa;
  }
#endif
}

extern "C" void kernel_launch(void* const* d_in, const int* in_sizes, int n_in, void* d_out, int out_size, void* d_ws, size_t ws_size, hipStream_t stream) {
  static int grid = 0;
  if (grid == 0) {
    if (n_in != 28 || out_size != MTOK * DM || ws_size < WS_END) { fprintf(stderr, "kernel_launch: unexpected shapes (n_in %d out %d ws %zu need %zu)\n", n_in, out_size, ws_size, (size_t)WS_END); grid = -1; return; }
    int dev = 0, cus = 0, per_cu = 0;
    hipGetDevice(&dev); hipDeviceGetAttribute(&cus, hipDeviceAttributeMultiprocessorCount, dev);
    if (hipFuncSetAttribute((const void*)mega, hipFuncAttributeMaxDynamicSharedMemorySize, LDS_BYTES) != hipSuccess) { fprintf(stderr, "kernel_launch: hipFuncSetAttribute failed\n"); grid = -1; return; }
    hipOccupancyMaxActiveBlocksPerMultiprocessor(&per_cu, (const void*)mega, NTHREADS, LDS_BYTES);
    (void)hipGetLastError();
    if (per_cu < 1) { fprintf(stderr, "kernel_launch: occupancy query says %d blocks per CU\n", per_cu); per_cu = 1; }
    grid = cus;
  }
  if (grid < 0) return;
  if (hipMemsetAsync((unsigned char*)d_ws + WS_BAR, 0, 16384, stream) != hipSuccess) { fprintf(stderr, "kernel_launch: memset of barrier words failed\n"); return; }
  Args a{};
  for (int i = 0; i < 28; ++i) a.in[i] = (const float*)d_in[i];
  a.out = (float*)d_out; a.ws = (unsigned char*)d_ws;
#if MULTI_LAUNCH
  for (int ph = 0; ph < NPH; ++ph) { a.ph_lo = ph; a.ph_hi = ph + 1; hipLaunchKernelGGL(mega, dim3(grid), dim3(NTHREADS), LDS_BYTES, stream, a); }
#else
  a.ph_lo = 0; a.ph_hi = NPH;
  void* args[] = {&a};
  hipError_t e = hipLaunchCooperativeKernel((const void*)mega, dim3(grid), dim3(NTHREADS), args, LDS_BYTES, stream);
  if (e != hipSuccess) fprintf(stderr, "kernel_launch: cooperative launch failed: %s (grid %d)\n", hipGetErrorString(e), grid);
#endif
}
```

```cpp
#include <hip/hip_runtime.h>
#include <hip/hip_cooperative_groups.h>
#include <cstdio>
namespace cg = cooperative_groups;

#ifndef MULTI_LAUNCH
#define MULTI_LAUNCH 0
#endif

#define LAS __attribute__((address_space(3)))
#define DI __device__ __forceinline__
typedef unsigned short bf16_t;
typedef short bf16x8 __attribute__((ext_vector_type(8)));
typedef float f32x4 __attribute__((ext_vector_type(4)));
typedef float f32x2 __attribute__((ext_vector_type(2)));
typedef unsigned u32x4 __attribute__((ext_vector_type(4)));
typedef unsigned u32x2 __attribute__((ext_vector_type(2)));
typedef __bf16 bfv2 __attribute__((ext_vector_type(2)));

constexpr int DM = 1024, SEQ = 4096, NB = 8, MTOK = NB * SEQ, DEPTH = 2;
constexpr int NGRP = 2, MG = MTOK / NGRP, BPG = NB / NGRP;
constexpr int DINP = 9984;
constexpr int NTHREADS = 512;
constexpr int LDS_BYTES = 147456;

constexpr size_t AL(size_t x) { return (x + 255) & ~(size_t)255; }
constexpr size_t WS_WIN = 0;
constexpr size_t WS_WGLU = WS_WIN + AL((size_t)DEPTH * DINP * 1024 * 2);
constexpr size_t WS_WBR = WS_WGLU + AL((size_t)DEPTH * 512 * 512 * 2);
constexpr size_t WS_WOUT = WS_WBR + AL((size_t)DEPTH * 3 * 1024 * 512 * 2);
constexpr size_t WS_WXQ = WS_WOUT + AL((size_t)DEPTH * 1024 * 1024 * 2);
constexpr size_t WS_WXO = WS_WXQ + AL((size_t)DEPTH * 1024 * 1024 * 2);
constexpr size_t WS_WXKV = WS_WXO + AL((size_t)DEPTH * 1024 * 1024 * 2);
constexpr size_t WS_WUP = WS_WXKV + AL((size_t)DEPTH * 2048 * 1024 * 2);
constexpr size_t WS_WDN = WS_WUP + AL((size_t)DEPTH * 4096 * 1024 * 2);
constexpr size_t WS_MEMN = WS_WDN + AL((size_t)DEPTH * 4096 * 1024 * 2);
constexpr size_t WS_MEMKV = WS_MEMN + AL((size_t)2048 * 1024 * 2);
constexpr size_t WS_LSE = WS_MEMKV + AL((size_t)2048 * 4096 * 2);
constexpr size_t WS_S5E = WS_LSE + AL((size_t)MG * 12 * 4);
constexpr size_t WS_S5C = WS_S5E + AL((size_t)BPG * 32 * 64 * 64 * 8);
constexpr size_t WS_GDEC = WS_S5C + AL((size_t)BPG * 32 * 64 * 64 * 8);
constexpr size_t WS_H = WS_GDEC + AL((size_t)BPG * 4 * 64 * 64 * 4);
constexpr size_t WS_GST = WS_H + (size_t)MG * 1024 * 2;
constexpr size_t WS_P = WS_H + AL((size_t)MTOK * 1024 * 2);
constexpr size_t WS_BAR = WS_P + AL((size_t)MG * DINP * 2);
constexpr size_t WS_END = WS_BAR + 16384;
constexpr size_t PE(int tile) { return (size_t)MG * 256 * tile; }
constexpr size_t P_U = PE(0), P_QK = PE(2), P_VG = PE(4), P_R = PE(6), P_QA = PE(8), P_KA = PE(14), P_VA = PE(20), P_GATE = PE(26), P_LR = PE(38);

typedef short s16x4 __attribute__((ext_vector_type(4)));
DI u32x2 lds_tr16(LAS unsigned char* p) { return __builtin_bit_cast(u32x2, __builtin_amdgcn_ds_read_tr16_b64_v4i16((LAS s16x4*)p)); }
DI float bf_lo(unsigned u) { return __uint_as_float(u << 16); }
DI float bf_hi(unsigned u) { return __uint_as_float(u & 0xffff0000u); }
DI unsigned pk2(float lo, float hi) { f32x2 v = {lo, hi}; bfv2 r = __builtin_convertvector(v, bfv2); return __builtin_bit_cast(unsigned, r); }
DI int tid_() { int t = threadIdx.x; asm volatile("" : "+v"(t)); return t; }
DI float shx(float v, int m, int lane) { return __builtin_bit_cast(float, __builtin_amdgcn_ds_bpermute((lane ^ m) << 2, __builtin_bit_cast(int, v))); }
DI float wave_sum(float v, int lane) {
#pragma unroll
  for (int m = 32; m >= 1; m >>= 1) v += shx(v, m, lane);
  return v;
}
DI float sigmoidf_(float x) { return 1.0f / (1.0f + __expf(-x)); }
DI f32x4 mfma16(bf16x8 a, bf16x8 b, f32x4 c) { return __builtin_amdgcn_mfma_f32_16x16x32_bf16(a, b, c, 0, 0, 0); }
DI bf16x8 mk8(u32x4 v) { return __builtin_bit_cast(bf16x8, v); }

namespace pg8 {
constexpr int BM = 256, BK = 64, HALF = 128, HTB = HALF * BK * 2, STAGE_BYTES = 8 * HTB, NXCD = 8, WGM = 4;
DI int lds_byte(int r, int c) { const int st = (r >> 4) * 2 + (c >> 5), rr = r & 15, cc = c & 31, ob = rr * 64 + cc * 2; return st * 1024 + (ob ^ (((ob >> 9) & 1) << 5)); }
DI void stage_rc(int b, int& R, int& C) { const int st = b / 1024, sb = b % 1024, swz = sb ^ (((sb >> 9) & 1) << 5); R = (st >> 1) * 16 + swz / 64; C = (st & 1) * 32 + (swz % 64) / 2; }
DI int perm32(int rho) { const int n = rho >> 4, i = rho & 15; return 8 * (i >> 2) + 4 * n + (i & 3); }
struct Unit { int pm, pn, z; };
struct Gemm { const bf16_t* A; const bf16_t* Bt; int M, N, K, lda; long zA1, zA2, zB; int nz, perm; };
struct StaticOrder {
  int nM, nN, nwg, G, c, nz;
  DI void init(int M, int N, int G_, int c_, int nz_) { nM = M / BM; nN = N / BM; nwg = nM * nN; G = G_; c = c_; nz = nz_; }
  DI bool next(int i, Unit& u) const {
    const int ib = (nz == 1) ? i : i / nz; u.z = i - ib * nz;
    const long L = (long)ib * G + c; if (L >= nwg) return false;
    int wgid = (int)L; { const int q = nwg / NXCD, r = nwg % NXCD, xcd = wgid % NXCD, off = wgid / NXCD; wgid = (xcd < r ? xcd * (q + 1) : r * (q + 1) + (xcd - r) * q) + off; }
    const int nig = WGM * nN, gid = wgid / nig, fm = gid * WGM, gsz = (nM - fm) < WGM ? (nM - fm) : WGM;
    u.pm = fm + ((wgid % nig) % gsz); u.pn = (wgid % nig) / gsz; return true;
  }
};

template <bool CHAIN, class Epi>
DI void gemm_phase(LAS unsigned char* lds, const Gemm g, const StaticOrder& S, const Epi& E) {
  const int tid = tid_(), wid = __builtin_amdgcn_readfirstlane(tid >> 6), lane = tid & 63, wr = wid >> 2, wc = wid & 3, fr = lane & 15, fq = lane >> 4;
  const int K = g.K, nt = K / BK, lda = g.lda;
  unsigned voffA[2], voffB[2];
#pragma unroll
  for (int i = 0; i < 2; ++i) { int R, C; stage_rc(tid * 16 + i * 8192, R, C); const int Rb = g.perm ? ((R & ~31) + perm32(R & 31)) : R;
    voffA[i] = (unsigned)(R * lda + C) * 2u; voffB[i] = (unsigned)(Rb * K + C) * 2u; }
  const size_t kstep = (size_t)(BK * 2);
  const size_t hstA = (size_t)HALF * lda * 2, hstB = (size_t)HALF * K * 2;
  const size_t tstA = 2 * hstA, tstB = 2 * hstB;
  const unsigned ldsw = (unsigned)wid * 1024u;
  const int aoff = lds_byte(wr * 64 + fr, fq * 8), boff = lds_byte(wc * 32 + fr, fq * 8);
#define PG8_SA(b, h) (((b) * 2 + (h)) * HTB)
#define PG8_SB(b, h) ((4 + (b) * 2 + (h)) * HTB)
#define PG8_STAGE(bufoff, gbase, voff) do { _Pragma("unroll") for (int _i = 0; _i < 2; ++_i) \
    __builtin_amdgcn_global_load_lds((const unsigned*)((const char*)(gbase) + (voff)[_i]), (LAS unsigned*)(lds + (bufoff) + ldsw + _i * 8192), 16, 0, 0); } while (0)
#define PG8_LDA(dst, b, h) do { _Pragma("unroll") for (int m = 0; m < 4; ++m) _Pragma("unroll") for (int k = 0; k < 2; ++k) dst[m][k] = *(const LAS bf16x8*)(lds + PG8_SA(b, h) + aoff + m * 2048 + k * 1024); } while (0)
#define PG8_LDB(dst, b, h) do { _Pragma("unroll") for (int n = 0; n < 2; ++n) _Pragma("unroll") for (int k = 0; k < 2; ++k) dst[n][k] = *(const LAS bf16x8*)(lds + PG8_SB(b, h) + boff + n * 2048 + k * 1024); } while (0)
#define PG8_MMA(ai, bj, At, Bt) do { __builtin_amdgcn_s_setprio(1); _Pragma("unroll") for (int m = 0; m < 4; ++m) _Pragma("unroll") for (int n = 0; n < 2; ++n) _Pragma("unroll") for (int k = 0; k < 2; ++k) \
    acc[ai][bj][m][n] = __builtin_amdgcn_mfma_f32_16x16x32_bf16(Bt[n][k], At[m][k], acc[ai][bj][m][n], 0, 0, 0); __builtin_amdgcn_s_setprio(0); } while (0)
#define PG8_WAIT_V(n) asm volatile("s_waitcnt vmcnt(" #n ")" ::: "memory")
#define PG8_WAIT_L(n) asm volatile("s_waitcnt lgkmcnt(" #n ")" ::: "memory")
#define PG8_BAR __builtin_amdgcn_s_barrier()
#define PG8_SCHED __builtin_amdgcn_sched_barrier(0)
  Unit cur, nxt; int ui = 0;
  if (!S.next(0, cur)) return;
  f32x4 acc[2][2][4][2];
#pragma unroll
  for (int a = 0; a < 2; ++a)
#pragma unroll
    for (int b = 0; b < 2; ++b)
#pragma unroll
      for (int m = 0; m < 4; ++m)
#pragma unroll
        for (int n = 0; n < 2; ++n) acc[a][b][m][n] = (f32x4){0.f, 0.f, 0.f, 0.f};
  bf16x8 At[4][2], B0[2][2], B1[2][2];
#define PG8_ZA(z) ((z) == 0 ? 0l : ((z) == 1 ? g.zA1 : g.zA2))
  const char* cA = (const char*)g.A + PG8_ZA(cur.z) + (size_t)cur.pm * tstA; const char* cB = (const char*)g.Bt + (long)cur.z * g.zB + (size_t)cur.pn * tstB;
  PG8_STAGE(PG8_SB(0, 0), cB, voffB); PG8_STAGE(PG8_SA(0, 0), cA, voffA); PG8_STAGE(PG8_SB(0, 1), cB + hstB, voffB); PG8_STAGE(PG8_SA(0, 1), cA + hstA, voffA);
  if (wr == 1) PG8_BAR;
  PG8_WAIT_V(4); PG8_BAR;
  PG8_STAGE(PG8_SB(1, 0), cB + kstep, voffB); PG8_STAGE(PG8_SA(1, 0), cA + kstep, voffA); PG8_STAGE(PG8_SB(1, 1), cB + hstB + kstep, voffB);
  PG8_WAIT_V(6); PG8_BAR;
  for (;;) {
    const bool has_next = S.next(ui + 1, nxt);
    const char* nA = has_next ? (const char*)g.A + PG8_ZA(nxt.z) + (size_t)nxt.pm * tstA : cA; const char* nB = has_next ? (const char*)g.Bt + (long)nxt.z * g.zB + (size_t)nxt.pn * tstB : cB;
    for (int t = 0; t < nt; t += 2) {
      const bool last = (t == nt - 2);
      const char* a1 = cA + (size_t)(t + 1) * kstep;
      const char* a2 = last ? nA : cA + (size_t)(t + 2) * kstep; const char* b2 = last ? nB : cB + (size_t)(t + 2) * kstep;
      const char* a3 = a2 + kstep; const char* b3 = b2 + kstep;
      PG8_LDB(B0, 0, 0); PG8_SCHED; PG8_LDA(At, 0, 0); PG8_STAGE(PG8_SA(1, 1), a1 + hstA, voffA);
      PG8_WAIT_L(8); PG8_BAR; PG8_WAIT_L(0); PG8_MMA(0, 0, At, B0); PG8_BAR; PG8_SCHED;
      PG8_LDB(B1, 0, 1); PG8_STAGE(PG8_SB(0, 0), b2, voffB);
      PG8_BAR; PG8_WAIT_L(0); PG8_MMA(0, 1, At, B1); PG8_BAR;
      PG8_LDA(At, 0, 1); PG8_STAGE(PG8_SA(0, 0), a2, voffA);
      PG8_BAR; PG8_WAIT_L(0); PG8_MMA(1, 0, At, B0); PG8_BAR; PG8_SCHED;
      PG8_STAGE(PG8_SB(0, 1), b2 + hstB, voffB);
      PG8_WAIT_V(6); PG8_BAR; PG8_MMA(1, 1, At, B1); PG8_BAR;
      PG8_LDB(B0, 1, 0); PG8_SCHED; PG8_LDA(At, 1, 0); PG8_STAGE(PG8_SA(0, 1), a2 + hstA, voffA);
      PG8_WAIT_L(8); PG8_BAR; PG8_WAIT_L(0); PG8_MMA(0, 0, At, B0); PG8_BAR; PG8_SCHED;
      PG8_LDB(B1, 1, 1); PG8_STAGE(PG8_SB(1, 0), b3, voffB);
      PG8_BAR; PG8_WAIT_L(0); PG8_MMA(0, 1, At, B1); PG8_BAR;
      PG8_LDA(At, 1, 1); PG8_STAGE(PG8_SA(1, 0), a3, voffA);
      PG8_BAR; PG8_WAIT_L(0); PG8_MMA(1, 0, At, B0); PG8_BAR; PG8_SCHED;
      PG8_STAGE(PG8_SB(1, 1), b3 + hstB, voffB);
      PG8_WAIT_V(6); PG8_BAR; PG8_MMA(1, 1, At, B1); PG8_BAR;
    }
#define PG8_ZERO() do { _Pragma("unroll") for (int a = 0; a < 2; ++a) _Pragma("unroll") for (int b = 0; b < 2; ++b) _Pragma("unroll") for (int m = 0; m < 4; ++m) _Pragma("unroll") for (int n = 0; n < 2; ++n) acc[a][b][m][n] = (f32x4){0.f, 0.f, 0.f, 0.f}; } while (0)
    if constexpr (CHAIN) { E.merge(acc, cur, wr, wc, fr, fq); if (!has_next) break; if (cur.z == E.nzm1) PG8_ZERO(); }
    else { E(acc, cur, wr, wc, fr, fq); if (!has_next) break; PG8_ZERO(); }
    cur = nxt; cA = nA; cB = nB; ++ui;
  }
  PG8_WAIT_V(0);
  if (wr == 0) PG8_BAR;
  PG8_BAR;
#undef PG8_ZA
#undef PG8_ZERO
#undef PG8_SA
#undef PG8_SB
#undef PG8_STAGE
#undef PG8_LDA
#undef PG8_LDB
#undef PG8_MMA
#undef PG8_WAIT_V
#undef PG8_WAIT_L
#undef PG8_BAR
#undef PG8_SCHED
}
}

enum { EM_PROJ = 0, EM_BF16, EM_GLU, EM_MERGEZ, EM_RESID, EM_RELU2, EM_DRY };
struct Epi {
  int mode;
  bf16_t* o16; int ld16;
  float* o32; const float* r32; int ld32;
  const bf16_t* r16; int ldr16;
  const bf16_t* aux; int ldaux;
  const float* bias;
  int nzm1;
  DI bool is_chain() const { return nzm1 != 0; }
  DI void operator()(const f32x4 (&acc)[2][2][4][2], const pg8::Unit& u, int wr, int wc, int fr, int fq) const {
    if (mode == EM_DRY) return;
    const int row0 = u.pm * 256 + wr * 64 + fr;
    int colt = u.pn * 256; bf16_t* ob = o16; int ldo = ld16;
    if (mode == EM_PROJ) {
      const int pn = u.pn; int s, ldp;
      if (pn < 8) { s = pn & ~1; ldp = 512; } else if (pn < 14) { s = 8; ldp = 1536; } else if (pn < 20) { s = 14; ldp = 1536; } else if (pn < 26) { s = 20; ldp = 1536; }
      else if (pn < 38) { s = 26; ldp = 3072; } else { s = 38; ldp = 256; }
      ob = o16 + PE(s); ldo = ldp; colt = (pn - s) * 256;
    }
    const int col0 = colt + wc * 32 + 8 * fq;
    if (mode == EM_PROJ || mode == EM_BF16 || mode == EM_RELU2) {
      const bool sq = (mode == EM_RELU2);
#pragma unroll
      for (int ai = 0; ai < 2; ++ai)
#pragma unroll
        for (int m = 0; m < 4; ++m) {
          const size_t row = (size_t)(row0 + ai * 128 + m * 16);
#pragma unroll
          for (int bj = 0; bj < 2; ++bj) {
            f32x4 v0 = acc[ai][bj][m][0], v1 = acc[ai][bj][m][1];
            if (sq) {
#pragma unroll
              for (int j = 0; j < 4; ++j) { const float a = fmaxf(v0[j], 0.f), b = fmaxf(v1[j], 0.f); v0[j] = a * a; v1[j] = b * b; }
            }
            u32x4 w; w.x = pk2(v0[0], v0[1]); w.y = pk2(v0[2], v0[3]); w.z = pk2(v1[0], v1[1]); w.w = pk2(v1[2], v1[3]);
            *(u32x4*)(ob + row * ldo + col0 + bj * 128) = w;
          }
        }
    } else if (mode == EM_RESID) {
      if (r32) {
#pragma unroll
        for (int ai = 0; ai < 2; ++ai)
#pragma unroll
          for (int mp = 0; mp < 2; ++mp) {
            f32x4 rr[2][2][2];
#pragma unroll
            for (int mm = 0; mm < 2; ++mm)
#pragma unroll
              for (int bj = 0; bj < 2; ++bj) { const float* p = r32 + (size_t)(row0 + ai * 128 + (mp * 2 + mm) * 16) * ld32 + col0 + bj * 128; rr[mm][bj][0] = *(const f32x4*)p; rr[mm][bj][1] = *(const f32x4*)(p + 4); }
#pragma unroll
            for (int mm = 0; mm < 2; ++mm)
#pragma unroll
              for (int bj = 0; bj < 2; ++bj) { const size_t row = (size_t)(row0 + ai * 128 + (mp * 2 + mm) * 16);
                const f32x4 t0 = rr[mm][bj][0] + acc[ai][bj][mp * 2 + mm][0], t1 = rr[mm][bj][1] + acc[ai][bj][mp * 2 + mm][1];
                u32x4 w; w.x = pk2(t0[0], t0[1]); w.y = pk2(t0[2], t0[3]); w.z = pk2(t1[0], t1[1]); w.w = pk2(t1[2], t1[3]);
                *(u32x4*)(ob + row * ldo + col0 + bj * 128) = w; }
          }
      } else {
#pragma unroll
        for (int ai = 0; ai < 2; ++ai) {
          u32x4 q[4][2];
#pragma unroll
          for (int m = 0; m < 4; ++m)
#pragma unroll
            for (int bj = 0; bj < 2; ++bj) q[m][bj] = *(const u32x4*)(r16 + (size_t)(row0 + ai * 128 + m * 16) * ldr16 + col0 + bj * 128);
#pragma unroll
          for (int m = 0; m < 4; ++m)
#pragma unroll
            for (int bj = 0; bj < 2; ++bj) { const u32x4 v = q[m][bj];
              const f32x4 t0 = (f32x4){bf_lo(v.x), bf_hi(v.x), bf_lo(v.y), bf_hi(v.y)} + acc[ai][bj][m][0], t1 = (f32x4){bf_lo(v.z), bf_hi(v.z), bf_lo(v.w), bf_hi(v.w)} + acc[ai][bj][m][1];
              u32x4 w; w.x = pk2(t0[0], t0[1]); w.y = pk2(t0[2], t0[3]); w.z = pk2(t1[0], t1[1]); w.w = pk2(t1[2], t1[3]);
              *(u32x4*)(ob + (size_t)(row0 + ai * 128 + m * 16) * ldo + col0 + bj * 128) = w; }
        }
      }
    } else if (mode == EM_GLU) {
      f32x4 bb[2][2];
#pragma unroll
      for (int bj = 0; bj < 2; ++bj) { bb[bj][0] = *(const f32x4*)(bias + col0 + bj * 128); bb[bj][1] = *(const f32x4*)(bias + col0 + bj * 128 + 4); }
#pragma unroll
      for (int ai = 0; ai < 2; ++ai) {
        u32x4 gq[4][2];
#pragma unroll
        for (int m = 0; m < 4; ++m)
#pragma unroll
          for (int bj = 0; bj < 2; ++bj) gq[m][bj] = *(const u32x4*)(aux + (size_t)(row0 + ai * 128 + m * 16) * ldaux + col0 + bj * 128);
#pragma unroll
        for (int m = 0; m < 4; ++m)
#pragma unroll
          for (int bj = 0; bj < 2; ++bj) {
            const u32x4 q = gq[m][bj]; const f32x4 v0 = acc[ai][bj][m][0], v1 = acc[ai][bj][m][1];
            const float gv[8] = {bf_lo(q.x), bf_hi(q.x), bf_lo(q.y), bf_hi(q.y), bf_lo(q.z), bf_hi(q.z), bf_lo(q.w), bf_hi(q.w)};
            float o[8];
#pragma unroll
            for (int j = 0; j < 4; ++j) { o[j] = gv[j] * sigmoidf_(v0[j] + bb[bj][0][j]); o[4 + j] = gv[4 + j] * sigmoidf_(v1[j] + bb[bj][1][j]); }
            u32x4 w; w.x = pk2(o[0], o[1]); w.y = pk2(o[2], o[3]); w.z = pk2(o[4], o[5]); w.w = pk2(o[6], o[7]);
            *(u32x4*)(ob + (size_t)(row0 + ai * 128 + m * 16) * ldo + col0 + bj * 128) = w;
          }
      }
    }
  }
  DI void merge(f32x4 (&acc)[2][2][4][2], const pg8::Unit& u, int wr, int wc, int fr, int fq) const {
    if (mode == EM_DRY) return;
    const int row0 = u.pm * 256 + wr * 64 + fr, col0 = u.pn * 256 + wc * 32 + 8 * fq;
    bf16_t* ob = o16; const int ldo = ld16;
    {
      const int z = u.z;
#pragma unroll
      for (int ai = 0; ai < 2; ++ai)
#pragma unroll
        for (int mp = 0; mp < 2; ++mp) {
          u32x4 g0[2][2], g1[2][2];
#pragma unroll
          for (int mm = 0; mm < 2; ++mm)
#pragma unroll
            for (int bj = 0; bj < 2; ++bj) { const bf16_t* p = aux + (size_t)(row0 + ai * 128 + (mp * 2 + mm) * 16) * ldaux + z * 1024 + col0 + bj * 128;
              g0[mm][bj] = *(const u32x4*)p; g1[mm][bj] = (z < 2) ? *(const u32x4*)(p + 1024) : (u32x4){0u, 0u, 0u, 0u}; }
#pragma unroll
          for (int mm = 0; mm < 2; ++mm)
#pragma unroll
            for (int bj = 0; bj < 2; ++bj) {
              const int m = mp * 2 + mm; const size_t row = (size_t)(row0 + ai * 128 + m * 16);
              f32x4& a0 = acc[ai][bj][m][0]; f32x4& a1 = acc[ai][bj][m][1];
#pragma unroll
              for (int e2 = 0; e2 < 4; ++e2) {
                const float l0a = bf_lo(g0[mm][bj][e2]), l0b = bf_hi(g0[mm][bj][e2]), l1a = bf_lo(g1[mm][bj][e2]), l1b = bf_hi(g1[mm][bj][e2]);
                float fa = __builtin_amdgcn_rcpf(1.0f + __expf(-l0a)), fb = __builtin_amdgcn_rcpf(1.0f + __expf(-l0b));
                if (z < 2) { fa *= 1.0f + __expf(-l1a); fb *= 1.0f + __expf(-l1b); }
                if (e2 < 2) { a0[2 * e2] *= fa; a0[2 * e2 + 1] *= fb; } else { a1[2 * e2 - 4] *= fa; a1[2 * e2 - 3] *= fb; }
              }
              if (z == 2) { u32x4 w; w.x = pk2(a0[0], a0[1]); w.y = pk2(a0[2], a0[3]); w.z = pk2(a1[0], a1[1]); w.w = pk2(a1[2], a1[3]);
                *(u32x4*)(ob + row * ldo + col0 + bj * 128) = w; }
            }
        }
    }
  }
};

DI void norm_rows_bf16(const float* x, const float* gain, bf16_t* H, int nrows) {
  const int tid = tid_(), lane = tid & 63, gw = blockIdx.x * 8 + (tid >> 6), nw = gridDim.x * 8;
  f32x4 g[4];
#pragma unroll
  for (int i = 0; i < 4; ++i) g[i] = *(const f32x4*)(gain + i * 256 + lane * 4);
  for (int r = gw * 2; r < nrows; r += nw * 2) {
    f32x4 v[2][4];
#pragma unroll
    for (int q = 0; q < 2; ++q)
#pragma unroll
      for (int i = 0; i < 4; ++i) v[q][i] = *(const f32x4*)(x + (size_t)(r + q) * 1024 + i * 256 + lane * 4);
#pragma unroll
    for (int q = 0; q < 2; ++q) {
      float ss = 0.f;
#pragma unroll
      for (int i = 0; i < 4; ++i) ss += v[q][i][0] * v[q][i][0] + v[q][i][1] * v[q][i][1] + v[q][i][2] * v[q][i][2] + v[q][i][3] * v[q][i][3];
      ss = wave_sum(ss, lane);
      const float rs = rsqrtf(ss * (1.0f / 1024.0f) + 1e-6f);
#pragma unroll
      for (int i = 0; i < 4; ++i) { u32x2 w; w.x = pk2(v[q][i][0] * rs * g[i][0], v[q][i][1] * rs * g[i][1]); w.y = pk2(v[q][i][2] * rs * g[i][2], v[q][i][3] * rs * g[i][3]);
        *(u32x2*)(H + (size_t)(r + q) * 1024 + i * 256 + lane * 4) = w; }
    }
  }
}
DI void norm_rows_from_bf16(const bf16_t* xb, int ldx, const float* gain, bf16_t* H, int nrows) {
  const int tid = tid_(), lane = tid & 63, gw = blockIdx.x * 8 + (tid >> 6), nw = gridDim.x * 8;
  f32x4 g[4];
#pragma unroll
  for (int i = 0; i < 2; ++i) { g[2 * i] = *(const f32x4*)(gain + i * 512 + lane * 8); g[2 * i + 1] = *(const f32x4*)(gain + i * 512 + lane * 8 + 4); }
  for (int r = gw * 8; r < nrows; r += nw * 8) {
    u32x4 v[8][2];
#pragma unroll
    for (int q = 0; q < 8; ++q)
#pragma unroll
      for (int i = 0; i < 2; ++i) v[q][i] = *(const u32x4*)(xb + (size_t)(r + q) * ldx + i * 512 + lane * 8);
#pragma unroll
    for (int q = 0; q < 8; ++q) {
      float f[16];
#pragma unroll
      for (int i = 0; i < 2; ++i)
#pragma unroll
        for (int e = 0; e < 4; ++e) { f[i * 8 + 2 * e] = bf_lo(v[q][i][e]); f[i * 8 + 2 * e + 1] = bf_hi(v[q][i][e]); }
      float ss = 0.f;
#pragma unroll
      for (int e = 0; e < 16; ++e) ss += f[e] * f[e];
      ss = wave_sum(ss, lane);
      const float rs = rsqrtf(ss * (1.0f / 1024.0f) + 1e-6f);
#pragma unroll
      for (int i = 0; i < 2; ++i) { u32x4 w;
#pragma unroll
        for (int e = 0; e < 4; ++e) w[e] = pk2(f[i * 8 + 2 * e] * rs * g[2 * i + (e >> 1)][(2 * e) & 3], f[i * 8 + 2 * e + 1] * rs * g[2 * i + (e >> 1)][(2 * e + 1) & 3]);
        *(u32x4*)(H + (size_t)(r + q) * 1024 + i * 512 + lane * 8) = w; }
    }
  }
}
DI void final_norm_expand(float* out, const float* gain, int nrows) {
  const int tid = tid_(), lane = tid & 63, gw = blockIdx.x * 8 + (tid >> 6), nw = gridDim.x * 8;
  f32x4 g[4];
#pragma unroll
  for (int i = 0; i < 2; ++i) { g[2 * i] = *(const f32x4*)(gain + i * 512 + lane * 8); g[2 * i + 1] = *(const f32x4*)(gain + i * 512 + lane * 8 + 4); }
  for (int r = gw; r < nrows; r += nw) {
    const bf16_t* xb = (const bf16_t*)(out + (size_t)r * 1024);
    u32x4 v[2];
#pragma unroll
    for (int i = 0; i < 2; ++i) v[i] = *(const u32x4*)(xb + i * 512 + lane * 8);
    float f[16];
#pragma unroll
    for (int i = 0; i < 2; ++i)
#pragma unroll
      for (int e = 0; e < 4; ++e) { f[i * 8 + 2 * e] = bf_lo(v[i][e]); f[i * 8 + 2 * e + 1] = bf_hi(v[i][e]); }
    float ss = 0.f;
#pragma unroll
    for (int e = 0; e < 16; ++e) ss += f[e] * f[e];
    ss = wave_sum(ss, lane);
    const float rs = rsqrtf(ss * (1.0f / 1024.0f) + 1e-6f);
    asm volatile("s_waitcnt vmcnt(0)" ::: "memory");
#pragma unroll
    for (int i = 0; i < 2; ++i) { f32x4 o0, o1;
#pragma unroll
      for (int e = 0; e < 4; ++e) { o0[e] = f[i * 8 + e] * rs * g[2 * i][e]; o1[e] = f[i * 8 + 4 + e] * rs * g[2 * i + 1][e]; }
      *(f32x4*)(out + (size_t)r * 1024 + i * 512 + lane * 8) = o0; *(f32x4*)(out + (size_t)r * 1024 + i * 512 + lane * 8 + 4) = o1; }
  }
}
DI void final_norm_from_bf16(const bf16_t* xb, float* out, const float* gain, int nrows) {
  const int tid = tid_(), lane = tid & 63, gw = blockIdx.x * 8 + (tid >> 6), nw = gridDim.x * 8;
  f32x4 g[4];
#pragma unroll
  for (int i = 0; i < 2; ++i) { g[2 * i] = *(const f32x4*)(gain + i * 512 + lane * 8); g[2 * i + 1] = *(const f32x4*)(gain + i * 512 + lane * 8 + 4); }
  for (int r = gw * 2; r < nrows; r += nw * 2) {
    u32x4 v[2][2];
#pragma unroll
    for (int q = 0; q < 2; ++q)
#pragma unroll
      for (int i = 0; i < 2; ++i) v[q][i] = *(const u32x4*)(xb + (size_t)(r + q) * 1024 + i * 512 + lane * 8);
#pragma unroll
    for (int q = 0; q < 2; ++q) {
      float f[16];
#pragma unroll
      for (int i = 0; i < 2; ++i)
#pragma unroll
        for (int e = 0; e < 4; ++e) { f[i * 8 + 2 * e] = bf_lo(v[q][i][e]); f[i * 8 + 2 * e + 1] = bf_hi(v[q][i][e]); }
      float ss = 0.f;
#pragma unroll
      for (int e = 0; e < 16; ++e) ss += f[e] * f[e];
      ss = wave_sum(ss, lane);
      const float rs = rsqrtf(ss * (1.0f / 1024.0f) + 1e-6f);
#pragma unroll
      for (int i = 0; i < 2; ++i) { f32x4 o0, o1;
#pragma unroll
        for (int e = 0; e < 4; ++e) { o0[e] = f[i * 8 + e] * rs * g[2 * i][e]; o1[e] = f[i * 8 + 4 + e] * rs * g[2 * i + 1][e]; }
        *(f32x4*)(out + (size_t)(r + q) * 1024 + i * 512 + lane * 8) = o0; *(f32x4*)(out + (size_t)(r + q) * 1024 + i * 512 + lane * 8 + 4) = o1; }
    }
  }
}
DI void norm_rows_f32_inplace(float* x, const float* gain, int nrows) {
  const int tid = tid_(), lane = tid & 63, gw = blockIdx.x * 8 + (tid >> 6), nw = gridDim.x * 8;
  f32x4 g[4];
#pragma unroll
  for (int i = 0; i < 4; ++i) g[i] = *(const f32x4*)(gain + i * 256 + lane * 4);
  for (int r = gw * 2; r < nrows; r += nw * 2) {
    f32x4 v[2][4];
#pragma unroll
    for (int q = 0; q < 2; ++q)
#pragma unroll
      for (int i = 0; i < 4; ++i) v[q][i] = *(const f32x4*)(x + (size_t)(r + q) * 1024 + i * 256 + lane * 4);
#pragma unroll
    for (int q = 0; q < 2; ++q) {
      float ss = 0.f;
#pragma unroll
      for (int i = 0; i < 4; ++i) ss += v[q][i][0] * v[q][i][0] + v[q][i][1] * v[q][i][1] + v[q][i][2] * v[q][i][2] + v[q][i][3] * v[q][i][3];
      ss = wave_sum(ss, lane);
      const float rs = rsqrtf(ss * (1.0f / 1024.0f) + 1e-6f);
#pragma unroll
      for (int i = 0; i < 4; ++i) { f32x4 o; o[0] = v[q][i][0] * rs * g[i][0]; o[1] = v[q][i][1] * rs * g[i][1]; o[2] = v[q][i][2] * rs * g[i][2]; o[3] = v[q][i][3] * rs * g[i][3];
        *(f32x4*)(x + (size_t)(r + q) * 1024 + i * 256 + lane * 4) = o; }
    }
  }
}

DI int win_map(int n) { return n < 1536 ? n : (n < 9728 ? n + 16 : (n < 9744 ? n - 9728 + 1536 : -1)); }
DI void transpose_w(LAS unsigned char* sm, const float* src, int K, int Ns, bf16_t* dst, int Nd, int mapmode) {
  LAS float* tile = (LAS float*)sm;
  const int tid = tid_(), tn = Nd / 64, tk = K / 64;
  for (int t = blockIdx.x; t < tn * tk; t += gridDim.x) {
    const int n0 = (t / tk) * 64, k0 = (t % tk) * 64;
    float tv[8];
#pragma unroll
    for (int it = 0; it < 8; ++it) { const int idx = it * 512 + tid, kk = idx >> 6, nn = idx & 63;
      const int sc = mapmode ? win_map(n0 + nn) : (n0 + nn);
      tv[it] = sc >= 0 ? src[(size_t)(k0 + kk) * Ns + sc] : 0.f; }
#pragma unroll
    for (int it = 0; it < 8; ++it) { const int idx = it * 512 + tid, kk = idx >> 6, nn = idx & 63; tile[kk * 65 + nn] = tv[it]; }
    __syncthreads();
    { const int nn = tid >> 3, kc = tid & 7; float f[8];
#pragma unroll
      for (int e = 0; e < 8; ++e) f[e] = tile[(kc * 8 + e) * 65 + nn];
      u32x4 w; w.x = pk2(f[0], f[1]); w.y = pk2(f[2], f[3]); w.z = pk2(f[4], f[5]); w.w = pk2(f[6], f[7]);
      *(u32x4*)(dst + (size_t)(n0 + nn) * K + k0 + kc * 8) = w; }
    __syncthreads();
  }
}

DI void attn_task(LAS unsigned char* sm, int task, bf16_t* QA, const bf16_t* KA, const bf16_t* VA, float* LSE, bool dry) {
  const int tid = tid_(), lane = tid & 63, w = tid >> 6, li = lane & 15, quad = lane >> 4;
  const int bh = task >> 5, sub = task & 31;
  const int b = bh / 12, h = bh - b * 12, g = h >> 2, dsh = g * 2, dil = 1 << dsh, nblk = 32 >> dsh;
  const int r = sub / nblk, n = sub - r * nblk;
  LAS unsigned char* ks = sm;
  LAS unsigned char* vs = sm + 69632;
  {
    u32x4 kv[8], vv[8];
#pragma unroll
    for (int it = 0; it < 8; ++it) {
      const int id = it * 512 + tid, row = id >> 4, cc = id & 15, sp = n * 128 - 128 + row;
      kv[it] = (u32x4){0u, 0u, 0u, 0u};
      if (sp >= 0) kv[it] = *(const u32x4*)(KA + ((size_t)b * 4096 + (size_t)(sp * dil + r)) * 1536 + h * 128 + cc * 8);
    }
#pragma unroll
    for (int it = 0; it < 8; ++it) {
      const int id = it * 512 + tid, row = id >> 4, cc = id & 15, sp = n * 128 - 128 + row;
      vv[it] = (u32x4){0u, 0u, 0u, 0u};
      if (sp >= 0) vv[it] = *(const u32x4*)(VA + ((size_t)b * 4096 + (size_t)(sp * dil + r)) * 1536 + h * 128 + cc * 8);
    }
#pragma unroll
    for (int it = 0; it < 8; ++it) { const int id = it * 512 + tid, row = id >> 4, cc = id & 15; *(LAS u32x4*)(ks + row * 272 + cc * 16) = kv[it]; }
#pragma unroll
    for (int it = 0; it < 8; ++it) { const int id = it * 512 + tid, row = id >> 4, cc = id & 15; *(LAS u32x4*)(vs + row * 288 + cc * 16) = vv[it]; }
  }
  __syncthreads();
  const int qsp = n * 128 + w * 16 + li;
  const size_t qtok = (size_t)b * 4096 + (size_t)(qsp * dil + r);
  bf16_t* qptr = QA + qtok * 1536 + h * 128;
  bf16x8 qf[4];
#pragma unroll
  for (int kk = 0; kk < 4; ++kk) qf[kk] = *(const bf16x8*)(qptr + kk * 32 + quad * 8);
  const int kt0 = w < 6 ? w : 6;
  const float sc = 0.08838834764831845f * 1.4426950408889634f;
  const float sl = exp2f(-8.0f * (float)(h + 1) / 12.0f) * (float)dil * 1.4426950408889634f;
  float s[10][4]; float mx = -1e30f;
  const int wu = __builtin_amdgcn_readfirstlane(w);
#pragma unroll
  for (int tt = 0; tt < 10; ++tt) {
    const int kt = kt0 + tt; f32x4 acc = {0.f, 0.f, 0.f, 0.f};
    if ((tt == 9 && wu != 7) || (tt == 0 && wu == 7)) {
#pragma unroll
      for (int j = 0; j < 4; ++j) s[tt][j] = -1e30f;
      continue; }
#pragma unroll
    for (int kk = 0; kk < 4; ++kk) { const bf16x8 a = *(const LAS bf16x8*)(ks + (kt * 16 + li) * 272 + kk * 64 + quad * 16); acc = mfma16(a, qf[kk], acc); }
#pragma unroll
    for (int j = 0; j < 4; ++j) { const int kl = kt * 16 + quad * 4 + j, dist = 128 + w * 16 + li - kl;
      const bool valid = dist >= 0 && dist <= 128 && (n > 0 || kl >= 128);
      const float v = acc[j] * sc - sl * (float)dist; s[tt][j] = valid ? v : -1e30f; mx = fmaxf(mx, s[tt][j]); }
  }
  mx = fmaxf(mx, shx(mx, 16, lane)); mx = fmaxf(mx, shx(mx, 32, lane));
  float lsum = 0.f;
#pragma unroll
  for (int tt = 0; tt < 10; ++tt)
#pragma unroll
    for (int j = 0; j < 4; ++j) { const float p = __builtin_amdgcn_exp2f(s[tt][j] - mx); s[tt][j] = p; lsum += p; }
  lsum += shx(lsum, 16, lane); lsum += shx(lsum, 32, lane);
  bf16x8 pf[5];
#pragma unroll
  for (int pp = 0; pp < 5; ++pp) { u32x4 t; t.x = pk2(s[2 * pp][0], s[2 * pp][1]); t.y = pk2(s[2 * pp][2], s[2 * pp][3]); t.z = pk2(s[2 * pp + 1][0], s[2 * pp + 1][1]); t.w = pk2(s[2 * pp + 1][2], s[2 * pp + 1][3]); pf[pp] = mk8(t); }
  const float inv = 1.0f / lsum;
#pragma unroll
  for (int dvt = 0; dvt < 8; ++dvt) {
    f32x4 acc = {0.f, 0.f, 0.f, 0.f};
#pragma unroll
    for (int pp = 0; pp < 5; ++pp) { const int kA = (kt0 + 2 * pp) * 16 + quad * 4;
      LAS unsigned char* vp = vs + (kA + (li >> 2)) * 288 + dvt * 32 + (li & 3) * 8;
      const u32x2 lo = lds_tr16(vp), hi = lds_tr16(vp + 16 * 288);
      u32x4 t; t.x = lo.x; t.y = lo.y; t.z = hi.x; t.w = hi.y; acc = mfma16(mk8(t), pf[pp], acc); }
    u32x2 o; o.x = pk2(acc[0] * inv, acc[1] * inv); o.y = pk2(acc[2] * inv, acc[3] * inv);
    if (!dry) *(u32x2*)(qptr + dvt * 16 + quad * 4) = o;
  }
  if (quad == 0 && !dry) LSE[qtok * 12 + h] = (mx + log2f(lsum)) * 0.6931471805599453f;
  __syncthreads();
}

DI void attn_combine(const bf16_t* QA, bf16_t* YC, const float* LSE, bool dry, int bidx, int nblk) {
  const int nitem = MG * 4 * 16;
  int gs = nblk * NTHREADS; asm volatile("" : "+s"(gs));
  for (int it = bidx * NTHREADS + tid_(); it < nitem; it += gs) {
    const int t = it >> 6, hg = (it >> 4) & 3, dc = it & 15;
    const float l0 = LSE[(size_t)t * 12 + hg], l1 = LSE[(size_t)t * 12 + 4 + hg], l2 = LSE[(size_t)t * 12 + 8 + hg];
    const float m = fmaxf(l0, fmaxf(l1, l2));
    float w0 = __expf(l0 - m), w1 = __expf(l1 - m), w2 = __expf(l2 - m); const float iv = 1.0f / (w0 + w1 + w2); w0 *= iv; w1 *= iv; w2 *= iv;
    const bf16_t* p = QA + (size_t)t * 1536 + hg * 128 + dc * 8;
    const u32x4 a = *(const u32x4*)p, b = *(const u32x4*)(p + 512), c = *(const u32x4*)(p + 1024);
    u32x4 o;
#pragma unroll
    for (int e = 0; e < 4; ++e) o[e] = pk2(w0 * bf_lo(a[e]) + w1 * bf_lo(b[e]) + w2 * bf_lo(c[e]), w0 * bf_hi(a[e]) + w1 * bf_hi(b[e]) + w2 * bf_hi(c[e]));
    if (!dry) *(u32x4*)(YC + (size_t)t * 512 + hg * 128 + dc * 8) = o;
  }
}

DI void xattn_task(LAS unsigned char* sm, int task, bf16_t* XQ, const bf16_t* MKV, int l, bool dry) {
  const int tid = tid_(), lane = tid & 63, w = tid >> 6, li = lane & 15, quad = lane >> 4;
  const int b = task >> 7, hx = (task >> 5) & 3, n = task & 31;
  LAS unsigned char* vs = sm;
  {
    u32x4 kv[16];
#pragma unroll
    for (int it = 0; it < 16; ++it) { const int id = it * 512 + tid, row = id >> 5, cc = id & 31;
      kv[it] = *(const u32x4*)(MKV + (size_t)(b * 256 + row) * 4096 + l * 2048 + hx * 256 + cc * 8); }
#pragma unroll
    for (int it = 0; it < 16; ++it) { const int id = it * 512 + tid, row = id >> 5, cc = id & 31; *(LAS u32x4*)(sm + row * 528 + cc * 16) = kv[it]; }
  }
  __syncthreads();
  const size_t qtok = (size_t)b * 4096 + n * 128 + w * 16 + li;
  bf16_t* qptr = XQ + qtok * 1024 + hx * 256;
  bf16x8 qf[8];
#pragma unroll
  for (int kk = 0; kk < 8; ++kk) qf[kk] = *(const bf16x8*)(qptr + kk * 32 + quad * 8);
  float s[16][4]; float mx = -1e30f;
  const float sc = 0.0625f * 1.4426950408889634f;
#pragma unroll
  for (int kt = 0; kt < 16; ++kt) { f32x4 acc = {0.f, 0.f, 0.f, 0.f};
#pragma unroll
    for (int kk = 0; kk < 8; ++kk) { const bf16x8 a = *(const LAS bf16x8*)(sm + (kt * 16 + li) * 528 + kk * 64 + quad * 16); acc = mfma16(a, qf[kk], acc); }
#pragma unroll
    for (int j = 0; j < 4; ++j) { s[kt][j] = acc[j] * sc; mx = fmaxf(mx, s[kt][j]); } }
  mx = fmaxf(mx, shx(mx, 16, lane)); mx = fmaxf(mx, shx(mx, 32, lane));
  float lsum = 0.f;
#pragma unroll
  for (int kt = 0; kt < 16; ++kt)
#pragma unroll
    for (int j = 0; j < 4; ++j) { const float p = __builtin_amdgcn_exp2f(s[kt][j] - mx); s[kt][j] = p; lsum += p; }
  lsum += shx(lsum, 16, lane); lsum += shx(lsum, 32, lane);
  bf16x8 pf[8];
#pragma unroll
  for (int pp = 0; pp < 8; ++pp) { u32x4 t; t.x = pk2(s[2 * pp][0], s[2 * pp][1]); t.y = pk2(s[2 * pp][2], s[2 * pp][3]); t.z = pk2(s[2 * pp + 1][0], s[2 * pp + 1][1]); t.w = pk2(s[2 * pp + 1][2], s[2 * pp + 1][3]); pf[pp] = mk8(t); }
  const float inv = 1.0f / lsum;
  {
    u32x4 vv[16];
#pragma unroll
    for (int it = 0; it < 16; ++it) { const int id = it * 512 + tid, row = id >> 5, cc = id & 31;
      vv[it] = *(const u32x4*)(MKV + (size_t)(b * 256 + row) * 4096 + l * 2048 + 1024 + hx * 256 + cc * 8); }
    __syncthreads();
#pragma unroll
    for (int it = 0; it < 16; ++it) { const int id = it * 512 + tid, row = id >> 5, cc = id & 31; *(LAS u32x4*)(vs + row * 544 + cc * 16) = vv[it]; }
  }
  __syncthreads();
#pragma unroll
  for (int dvt = 0; dvt < 16; ++dvt) {
    f32x4 acc = {0.f, 0.f, 0.f, 0.f};
#pragma unroll
    for (int pp = 0; pp < 8; ++pp) { const int kA = 2 * pp * 16 + quad * 4;
      LAS unsigned char* vp = vs + (kA + (li >> 2)) * 544 + dvt * 32 + (li & 3) * 8;
      const u32x2 lo = lds_tr16(vp), hi = lds_tr16(vp + 16 * 544);
      u32x4 t; t.x = lo.x; t.y = lo.y; t.z = hi.x; t.w = hi.y; acc = mfma16(mk8(t), pf[pp], acc); }
    u32x2 o; o.x = pk2(acc[0] * inv, acc[1] * inv); o.y = pk2(acc[2] * inv, acc[3] * inv);
    if (!dry) *(u32x2*)(qptr + dvt * 16 + quad * 4) = o;
  }
  __syncthreads();
}

struct S5P { const float *a_re, *a_im, *log_step, *b_re, *b_im, *c_re, *c_im, *d; };
DI void s5_lambar(const S5P& P, int g, int p, float& lbr, float& lbi) {
  const float step = __expf(P.log_step[g]);
  const float ar = P.a_re[g * 64 + p], ai = P.a_im[g * 64 + p];
  const float mag = __expf(ar * step);
  float sn, cs; { const float x = ai * step; const float k = rintf(x * 0.15915494309189535f); float rr = fmaf(-k, 6.2831854820251465f, x); rr = fmaf(-k, -1.7484556000744883e-07f, rr); const float rev = rr * 0.15915494309189535f; sn = __builtin_amdgcn_sinf(rev); cs = __builtin_amdgcn_cosf(rev); }
  lbr = mag * cs; lbi = mag * sn;
}
DI void s5_carry_scan(const f32x2* E, f32x2* C, const S5P& P, bool dry) {
  const int total = BPG * 32 * 64;
  for (int gid = blockIdx.x * NTHREADS + tid_(); gid < total; gid += gridDim.x * NTHREADS) {
    const int p = gid & 63, g = (gid >> 6) & 31, b = gid >> 11;
    float lr_, li_; s5_lambar(P, g, p, lr_, li_);
#pragma unroll
    for (int q = 0; q < 6; ++q) { const float t0 = lr_ * lr_ - li_ * li_, t1 = 2.0f * lr_ * li_; lr_ = t0; li_ = t1; }
    const size_t base = (((size_t)b * 32 + g) * 64) * 64 + p;
    float sr = 0.f, si = 0.f;
    for (int c0 = 0; c0 < 64; c0 += 8) { f32x2 ev[8];
#pragma unroll
      for (int q = 0; q < 8; ++q) ev[q] = E[base + (size_t)(c0 + q) * 64];
#pragma unroll
      for (int q = 0; q < 8; ++q) { if (!dry) { f32x2 o = {sr, si}; C[base + (size_t)(c0 + q) * 64] = o; }
        const float t0 = lr_ * sr - li_ * si + ev[q][0], t1 = lr_ * si + li_ * sr + ev[q][1]; sr = t0; si = t1; } }
  }
}
DI float bperm(float v, int srclane) { return __builtin_bit_cast(float, __builtin_amdgcn_ds_bpermute(srclane << 2, __builtin_bit_cast(int, v))); }
DI void s5_task(LAS unsigned char* sm, int task, int mode, bf16_t* U, f32x2* E, const S5P& P, bool dry) {
  const int tid = tid_(), lane = tid & 63, w = tid >> 6, li = lane & 15, quad = lane >> 4;
  const int b = task >> 8, c = (task >> 2) & 63, oct = task & 3;
  const size_t row0 = (size_t)b * 4096 + c * 64;
  { u32x4 v[2];
#pragma unroll
    for (int it = 0; it < 2; ++it) { const int id = it * 512 + tid, t = id >> 4, cc = id & 15; v[it] = *(const u32x4*)(U + (row0 + t) * 512 + oct * 128 + cc * 8); }
#pragma unroll
    for (int it = 0; it < 2; ++it) { const int id = it * 512 + tid, t = id >> 4, cc = id & 15; *(LAS u32x4*)(sm + t * 272 + cc * 16) = v[it]; } }
  __syncthreads();
  const int g = oct * 8 + w;
  float l1r[4], l1i[4], l2r[4], l2i[4], l3r[4], l3i[4], l4r[4], l4i[4], spr[4], spi[4];
  bf16x8 Bre[4], Bim[4];
#pragma unroll
  for (int pb = 0; pb < 4; ++pb) {
    const int p = pb * 16 + li;
    float lr, lim; s5_lambar(P, g, p, lr, lim);
    const float ar = P.a_re[g * 64 + p], ai = P.a_im[g * 64 + p];
    const float iv = 1.0f / (ar * ar + ai * ai), nr = lr - 1.0f, ni = lim;
    const float cr = (nr * ar + ni * ai) * iv, ci = (ni * ar - nr * ai) * iv;
    u32x4 tre = {0u, 0u, 0u, 0u}, tim = {0u, 0u, 0u, 0u};
    if (quad < 2) {
      const float* pr = P.b_re + ((size_t)g * 64 + p) * 16 + quad * 8; const float* pi = P.b_im + ((size_t)g * 64 + p) * 16 + quad * 8;
      const f32x4 br0 = *(const f32x4*)pr, br1 = *(const f32x4*)(pr + 4), bi0 = *(const f32x4*)pi, bi1 = *(const f32x4*)(pi + 4);
      tre.x = pk2(cr * br0[0] - ci * bi0[0], cr * br0[1] - ci * bi0[1]); tre.y = pk2(cr * br0[2] - ci * bi0[2], cr * br0[3] - ci * bi0[3]);
      tre.z = pk2(cr * br1[0] - ci * bi1[0], cr * br1[1] - ci * bi1[1]); tre.w = pk2(cr * br1[2] - ci * bi1[2], cr * br1[3] - ci * bi1[3]);
      tim.x = pk2(cr * bi0[0] + ci * br0[0], cr * bi0[1] + ci * br0[1]); tim.y = pk2(cr * bi0[2] + ci * br0[2], cr * bi0[3] + ci * br0[3]);
      tim.z = pk2(cr * bi1[0] + ci * br1[0], cr * bi1[1] + ci * br1[1]); tim.w = pk2(cr * bi1[2] + ci * br1[2], cr * bi1[3] + ci * br1[3]);
    }
    Bre[pb] = mk8(tre); Bim[pb] = mk8(tim);
    l1r[pb] = lr; l1i[pb] = lim;
    l2r[pb] = lr * lr - lim * lim; l2i[pb] = 2.0f * lr * lim;
    l3r[pb] = l2r[pb] * lr - l2i[pb] * lim; l3i[pb] = l2r[pb] * lim + l2i[pb] * lr;
    l4r[pb] = l2r[pb] * l2r[pb] - l2i[pb] * l2i[pb]; l4i[pb] = 2.0f * l2r[pb] * l2i[pb];
    spr[pb] = 0.f; spi[pb] = 0.f;
    if (mode == 1) { const f32x2 e = E[(((size_t)b * 32 + g) * 64 + c) * 64 + p]; spr[pb] = e[0]; spi[pb] = e[1]; }
  }
  bf16x8 cm[4]; f32x4 dsk = {0.f, 0.f, 0.f, 0.f};
  LAS unsigned char* ss = sm + 17408 + w * 4352;
  if (mode == 1) {
#pragma unroll
    for (int kk = 0; kk < 4; ++kk) { const int p0 = kk * 16 + quad * 4;
      const f32x4 cr4 = *(const f32x4*)(P.c_re + ((size_t)g * 16 + li) * 64 + p0), ci4 = *(const f32x4*)(P.c_im + ((size_t)g * 16 + li) * 64 + p0);
      u32x4 t; t.x = pk2(cr4[0], -ci4[0]); t.y = pk2(cr4[1], -ci4[1]); t.z = pk2(cr4[2], -ci4[2]); t.w = pk2(cr4[3], -ci4[3]); cm[kk] = mk8(t); }
    dsk = *(const f32x4*)(P.d + g * 16 + quad * 4);
  }
  const int src_up = (lane - 16) & 63, src_q3 = 48 + li;
  for (int sb = 0; sb < 4; ++sb) {
    u32x4 araw = {0u, 0u, 0u, 0u};
    if (quad < 2) araw = *(const LAS u32x4*)(sm + (sb * 16 + li) * 272 + (w * 16 + quad * 8) * 2);
    const bf16x8 a = mk8(araw);
#pragma unroll
    for (int pb = 0; pb < 4; ++pb) {
      const f32x4 z4 = {0.f, 0.f, 0.f, 0.f};
      const f32x4 are = mfma16(a, Bre[pb], z4), aim = mfma16(a, Bim[pb], z4);
      float s0r = are[0], s0i = aim[0];
      float s1r = l1r[pb] * s0r - l1i[pb] * s0i + are[1], s1i = l1r[pb] * s0i + l1i[pb] * s0r + aim[1];
      float s2r = l1r[pb] * s1r - l1i[pb] * s1i + are[2], s2i = l1r[pb] * s1i + l1i[pb] * s1r + aim[2];
      float s3r = l1r[pb] * s2r - l1i[pb] * s2i + are[3], s3i = l1r[pb] * s2i + l1i[pb] * s2r + aim[3];
      float cr_ = (quad == 0) ? spr[pb] : 0.f, ci_ = (quad == 0) ? spi[pb] : 0.f;
#pragma unroll
      for (int r = 0; r < 3; ++r) {
        const float er = l4r[pb] * cr_ - l4i[pb] * ci_ + s3r, ei = l4r[pb] * ci_ + l4i[pb] * cr_ + s3i;
        const float gr = bperm(er, src_up), gi = bperm(ei, src_up);
        if (quad == r + 1) { cr_ = gr; ci_ = gi; }
      }
      s0r += l1r[pb] * cr_ - l1i[pb] * ci_; s0i += l1r[pb] * ci_ + l1i[pb] * cr_;
      s1r += l2r[pb] * cr_ - l2i[pb] * ci_; s1i += l2r[pb] * ci_ + l2i[pb] * cr_;
      s2r += l3r[pb] * cr_ - l3i[pb] * ci_; s2i += l3r[pb] * ci_ + l3i[pb] * cr_;
      s3r += l4r[pb] * cr_ - l4i[pb] * ci_; s3i += l4r[pb] * ci_ + l4i[pb] * cr_;
      spr[pb] = bperm(s3r, src_q3); spi[pb] = bperm(s3i, src_q3);
      if (mode == 1) { LAS unsigned char* q = ss + (quad * 4) * 272 + (pb * 16 + li) * 4;
        *(LAS unsigned*)(q) = pk2(s0r, s0i); *(LAS unsigned*)(q + 272) = pk2(s1r, s1i); *(LAS unsigned*)(q + 544) = pk2(s2r, s2i); *(LAS unsigned*)(q + 816) = pk2(s3r, s3i); }
    }
    if (mode == 1) {
      asm volatile("s_waitcnt lgkmcnt(0)" ::: "memory");
      f32x4 acc = {0.f, 0.f, 0.f, 0.f};
#pragma unroll
      for (int kk = 0; kk < 4; ++kk) { const bf16x8 bq = *(const LAS bf16x8*)(ss + li * 272 + kk * 64 + quad * 16); acc = mfma16(cm[kk], bq, acc); }
      const u32x2 uq = *(const LAS u32x2*)(sm + (sb * 16 + li) * 272 + (w * 16 + quad * 4) * 2);
      const float u4[4] = {bf_lo(uq.x), bf_hi(uq.x), bf_lo(uq.y), bf_hi(uq.y)};
      float o[4];
#pragma unroll
      for (int j = 0; j < 4; ++j) { const float y = acc[j] + dsk[j] * u4[j]; const float z = 0.7978845608028654f * (y + 0.044715f * y * y * y);
        const float th = 1.0f - 2.0f / (__expf(2.0f * z) + 1.0f); o[j] = 0.5f * y * (1.0f + th); }
      asm volatile("s_waitcnt lgkmcnt(0)" ::: "memory");
      u32x2 ov; ov.x = pk2(o[0], o[1]); ov.y = pk2(o[2], o[3]);
      if (!dry) *(u32x2*)(U + (row0 + sb * 16 + li) * 512 + g * 16 + quad * 4) = ov;
    }
  }
  if (mode == 0 && !dry && quad == 0) {
#pragma unroll
    for (int pb = 0; pb < 4; ++pb) { f32x2 e = {spr[pb], spi[pb]}; E[(((size_t)b * 32 + g) * 64 + c) * 64 + pb * 16 + li] = e; }
  }
  __syncthreads();
}

struct GLAP { const float *wg, *bg, *gout; };
constexpr int GL_LR = 0;
constexpr int GL_WG = 4096;
constexpr int GL_BS = 8192;
constexpr int GL_Q = 24832;
constexpr int GL_K = 34048;
constexpr int GL_VT = 43264;
constexpr int GL_ST = 61696;
constexpr int GL_RED = 80128;
constexpr int GL_SEG = 80640;
DI void gla_cumdecay(LAS unsigned char* sm, const bf16_t* LR, size_t row0, int h, const GLAP& P) {
  const int tid = tid_();
  LAS float* lrs = (LAS float*)(sm + GL_LR); LAS float* bs = (LAS float*)(sm + GL_BS); LAS float* segs = (LAS float*)(sm + GL_SEG);
  const int dk = tid & 63, seg = tid >> 6, t0 = seg * 8;
  u32x4 lrv = {0u, 0u, 0u, 0u};
  if (tid < 128) lrv = *(const u32x4*)(LR + (row0 + (tid >> 1)) * 256 + (tid & 1) * 8);
  float wcol[16];
#pragma unroll
  for (int rr = 0; rr < 16; ++rr) wcol[rr] = P.wg[rr * 256 + h * 64 + dk];
  const float bias = P.bg[h * 64 + dk];
  if (tid < 128) { const int t = tid >> 1, hf = tid & 1;
    f32x4 f0 = {bf_lo(lrv.x), bf_hi(lrv.x), bf_lo(lrv.y), bf_hi(lrv.y)}, f1 = {bf_lo(lrv.z), bf_hi(lrv.z), bf_lo(lrv.w), bf_hi(lrv.w)};
    *(LAS f32x4*)(lrs + t * 16 + hf * 8) = f0; *(LAS f32x4*)(lrs + t * 16 + hf * 8 + 4) = f1; }
  __syncthreads();
  float la[8]; float run = 0.f;
#pragma unroll
  for (int e = 0; e < 8; ++e) { float z = bias;
#pragma unroll
    for (int q4 = 0; q4 < 4; ++q4) { const f32x4 r4 = *(const LAS f32x4*)(lrs + (t0 + e) * 16 + q4 * 4);
      z = fmaf(r4[0], wcol[q4 * 4], z); z = fmaf(r4[1], wcol[q4 * 4 + 1], z); z = fmaf(r4[2], wcol[q4 * 4 + 2], z); z = fmaf(r4[3], wcol[q4 * 4 + 3], z); }
    const float ls = fminf(z, 0.f) - __logf(1.0f + __expf(-fabsf(z)));
    run += ls * 0.0625f; la[e] = run; }
  segs[seg * 64 + dk] = run;
  __syncthreads();
  float off = 0.f;
#pragma unroll
  for (int s2 = 0; s2 < 7; ++s2) off += (s2 < seg) ? segs[s2 * 64 + dk] : 0.f;
#pragma unroll
  for (int e = 0; e < 8; ++e) bs[(t0 + e) * 65 + dk] = la[e] + off;
  __syncthreads();
}
DI void gla_stage_vt(LAS unsigned char* sm, const bf16_t* VG, size_t row0, int h) {
  LAS unsigned short* vt = (LAS unsigned short*)(sm + GL_VT);
#pragma unroll
  for (int it = 0; it < 2; ++it) { const int id = it * 512 + tid_(), t = id & 63, cc = id >> 6;
    const u32x4 v = *(const u32x4*)(VG + (row0 + t) * 512 + h * 128 + cc * 8);
#pragma unroll
    for (int e = 0; e < 4; ++e) { vt[(cc * 8 + 2 * e) * 72 + t] = (unsigned short)(v[e] & 0xffffu); vt[(cc * 8 + 2 * e + 1) * 72 + t] = (unsigned short)(v[e] >> 16); } }
}
DI void gla_a_task(LAS unsigned char* sm, int task, const bf16_t* QK, const bf16_t* VG, const bf16_t* LR, bf16_t* GST, float* GDEC, const GLAP& P, bool dry) {
  const int tid = tid_(), lane = tid & 63, w = tid >> 6, li = lane & 15, quad = lane >> 4;
  const int bh = task >> 6, c = task & 63, b = bh >> 2, h = bh & 3;
  const size_t row0 = (size_t)b * 4096 + c * 64;
  gla_cumdecay(sm, LR, row0, h, P);
  LAS float* bs = (LAS float*)(sm + GL_BS);
  LAS unsigned short* kht = (LAS unsigned short*)(sm + GL_Q);
  { const int t = tid & 63, dkc = tid >> 6; const u32x4 v = *(const u32x4*)(QK + (row0 + t) * 512 + 256 + h * 64 + dkc * 8);
#pragma unroll
    for (int e = 0; e < 4; ++e) { const int d0 = dkc * 8 + 2 * e;
      const float k0 = bf_lo(v[e]) * __expf(bs[63 * 65 + d0] - bs[t * 65 + d0]), k1 = bf_hi(v[e]) * __expf(bs[63 * 65 + d0 + 1] - bs[t * 65 + d0 + 1]);
      const unsigned pk = pk2(k0, k1); kht[d0 * 72 + t] = (unsigned short)(pk & 0xffffu); kht[(d0 + 1) * 72 + t] = (unsigned short)(pk >> 16); } }
  gla_stage_vt(sm, VG, row0, h);
  if (tid < 64 && !dry) GDEC[(size_t)task * 64 + tid] = __expf(bs[63 * 65 + tid]);
  __syncthreads();
  LAS unsigned short* vt = (LAS unsigned short*)(sm + GL_VT);
#pragma unroll
  for (int dkt = 0; dkt < 4; ++dkt) { f32x4 acc = {0.f, 0.f, 0.f, 0.f};
#pragma unroll
    for (int kk = 0; kk < 2; ++kk) { const bf16x8 a = *(const LAS bf16x8*)(vt + (w * 16 + li) * 72 + kk * 32 + quad * 8), bq = *(const LAS bf16x8*)(kht + (dkt * 16 + li) * 72 + kk * 32 + quad * 8); acc = mfma16(a, bq, acc); }
#pragma unroll
    for (int j = 0; j < 4; ++j) if (!dry) GST[((size_t)task * 128 + w * 16 + quad * 4 + j) * 64 + dkt * 16 + li] = (bf16_t)(pk2(acc[j], 0.f) & 0xffffu); }
  __syncthreads();
}
DI void gla_prefix(const bf16_t* GST, bf16_t* GSO, const float* GDEC, bool dry) {
  const int total = BPG * 4 * 8192;
  for (int gid = blockIdx.x * NTHREADS + tid_(); gid < total; gid += gridDim.x * NTHREADS) {
    const int bh = gid >> 13, e = gid & 8191, dk = e & 63; float S = 0.f;
    for (int c0 = 0; c0 < 64; c0 += 16) { float tv[16], dv[16];
#pragma unroll
      for (int q = 0; q < 16; ++q) { tv[q] = __uint_as_float((unsigned)GST[((size_t)(bh * 64 + c0 + q)) * 8192 + e] << 16); dv[q] = GDEC[(size_t)(bh * 64 + c0 + q) * 64 + dk]; }
#pragma unroll
      for (int q = 0; q < 16; ++q) { if (!dry) GSO[((size_t)(bh * 64 + c0 + q)) * 8192 + e] = (bf16_t)(pk2(S, 0.f) & 0xffffu); S = fmaf(dv[q], S, tv[q]); } }
  }
}
DI void gla_c_task(LAS unsigned char* sm, int task, const bf16_t* QK, bf16_t* VG, const bf16_t* LR, const bf16_t* R, const bf16_t* GST, const GLAP& P, bool dry) {
  const int tid = tid_(), lane = tid & 63, w = tid >> 6, li = lane & 15, quad = lane >> 4;
  const int bh = task >> 6, c = task & 63, b = bh >> 2, h = bh & 3;
  const size_t row0 = (size_t)b * 4096 + c * 64;
  gla_cumdecay(sm, LR, row0, h, P);
  LAS float* bs = (LAS float*)(sm + GL_BS);
  LAS unsigned short* qs = (LAS unsigned short*)(sm + GL_Q); LAS unsigned short* ksm = (LAS unsigned short*)(sm + GL_K);
  LAS unsigned short* vt = (LAS unsigned short*)(sm + GL_VT); LAS unsigned short* st = (LAS unsigned short*)(sm + GL_ST); LAS float* red = (LAS float*)(sm + GL_RED);
  { const int t = tid >> 3, ch = tid & 7;
    const u32x4 qv = *(const u32x4*)(QK + (row0 + t) * 512 + h * 64 + ch * 8), kv = *(const u32x4*)(QK + (row0 + t) * 512 + 256 + h * 64 + ch * 8);
    u32x4 qo, ko;
#pragma unroll
    for (int e = 0; e < 4; ++e) { const int d0 = ch * 8 + 2 * e; const float b0 = bs[t * 65 + d0], b1 = bs[t * 65 + d0 + 1];
      qo[e] = pk2(bf_lo(qv[e]) * 0.125f * __expf(b0), bf_hi(qv[e]) * 0.125f * __expf(b1));
      ko[e] = pk2(bf_lo(kv[e]) * __expf(-b0), bf_hi(kv[e]) * __expf(-b1)); }
    *(LAS u32x4*)(qs + t * 72 + ch * 8) = qo; *(LAS u32x4*)(ksm + t * 72 + ch * 8) = ko; }
  gla_stage_vt(sm, VG, row0, h);
#pragma unroll
  for (int it = 0; it < 2; ++it) { const int id = it * 512 + tid, dv = id >> 3, c8 = id & 7;
    const u32x4 v = *(const u32x4*)(GST + ((size_t)task * 128 + dv) * 64 + c8 * 8);
    *(LAS u32x4*)(st + dv * 72 + c8 * 8) = v; }
  __syncthreads();
  const int qt = w & 3, dvh = w >> 2;
  bf16x8 qf[2];
#pragma unroll
  for (int kk = 0; kk < 2; ++kk) qf[kk] = *(const LAS bf16x8*)(qs + (qt * 16 + li) * 72 + kk * 32 + quad * 8);
  float s[4][4];
#pragma unroll
  for (int jt = 0; jt < 4; ++jt) { f32x4 acc = {0.f, 0.f, 0.f, 0.f};
#pragma unroll
    for (int kk = 0; kk < 2; ++kk) { const bf16x8 a = *(const LAS bf16x8*)(ksm + (jt * 16 + li) * 72 + kk * 32 + quad * 8); acc = mfma16(a, qf[kk], acc); }
#pragma unroll
    for (int j = 0; j < 4; ++j) { const int kj = jt * 16 + quad * 4 + j, qi = qt * 16 + li; s[jt][j] = (kj <= qi) ? acc[j] : 0.f; } }
  bf16x8 pf[2];
#pragma unroll
  for (int pp = 0; pp < 2; ++pp) { u32x4 t; t.x = pk2(s[2 * pp][0], s[2 * pp][1]); t.y = pk2(s[2 * pp][2], s[2 * pp][3]); t.z = pk2(s[2 * pp + 1][0], s[2 * pp + 1][1]); t.w = pk2(s[2 * pp + 1][2], s[2 * pp + 1][3]); pf[pp] = mk8(t); }
  f32x4 o[4]; float ssq = 0.f;
#pragma unroll
  for (int dvt = 0; dvt < 4; ++dvt) { const int dv0 = dvh * 64 + dvt * 16; f32x4 acc = {0.f, 0.f, 0.f, 0.f};
#pragma unroll
    for (int pp = 0; pp < 2; ++pp) { const int kA = 2 * pp * 16 + quad * 4;
      const u32x2 lo = *(const LAS u32x2*)(vt + (dv0 + li) * 72 + kA), hi = *(const LAS u32x2*)(vt + (dv0 + li) * 72 + kA + 16);
      u32x4 t; t.x = lo.x; t.y = lo.y; t.z = hi.x; t.w = hi.y; acc = mfma16(mk8(t), pf[pp], acc); }
#pragma unroll
    for (int kk = 0; kk < 2; ++kk) { const bf16x8 a = *(const LAS bf16x8*)(st + (dv0 + li) * 72 + kk * 32 + quad * 8); acc = mfma16(a, qf[kk], acc); }
    o[dvt] = acc; ssq += acc[0] * acc[0] + acc[1] * acc[1] + acc[2] * acc[2] + acc[3] * acc[3]; }
  ssq += shx(ssq, 16, lane); ssq += shx(ssq, 32, lane);
  if (quad == 0) red[dvh * 64 + qt * 16 + li] = ssq;
  __syncthreads();
  const float tot = red[qt * 16 + li] + red[64 + qt * 16 + li];
  const float rs = rsqrtf(tot * (1.0f / 128.0f) + 1e-6f);
  const size_t row = row0 + qt * 16 + li;
#pragma unroll
  for (int dvt = 0; dvt < 4; ++dvt) { const int dv = dvh * 64 + dvt * 16 + quad * 4;
    const f32x4 gg = *(const f32x4*)(P.gout + dv); const u32x2 rv = *(const u32x2*)(R + row * 512 + h * 128 + dv);
    const float r4[4] = {bf_lo(rv.x), bf_hi(rv.x), bf_lo(rv.y), bf_hi(rv.y)}; float y[4];
#pragma unroll
    for (int j = 0; j < 4; ++j) y[j] = o[dvt][j] * rs * gg[j] * (r4[j] * sigmoidf_(r4[j]));
    u32x2 ov; ov.x = pk2(y[0], y[1]); ov.y = pk2(y[2], y[3]); if (!dry) *(u32x2*)(VG + row * 512 + h * 128 + dv) = ov; }
  __syncthreads();
}

#define XB_TMO      128
#define XB_XCNT(j)  (256  + 64 * (j))
#define XB_XSUB(j)  (1280 + 64 * (j))
#define XB_XGEN(j)  (2304 + 64 * (j))
#define XB_TOP      3328
#define XB_TOPGEN   3392
#define XCD_BAR_WORDS 3456
#define XB_SPIN_CAP (1u << 18)
DI unsigned xb_ld(unsigned* p)              { return __hip_atomic_load(p, __ATOMIC_RELAXED, __HIP_MEMORY_SCOPE_AGENT); }
DI unsigned xb_add(unsigned* p, unsigned v) { return __hip_atomic_fetch_add(p, v, __ATOMIC_RELAXED, __HIP_MEMORY_SCOPE_AGENT); }
DI unsigned xb_xcc_id() { return (unsigned)__builtin_amdgcn_s_getreg((3 << 11) | 20) & 0xFu; }
#define XB_SPIN(cond, bar) do { unsigned _sp = 0; while (cond) { __builtin_amdgcn_s_sleep(1); \
    if ((++_sp & 255u) == 0u) { if (xb_ld(&(bar)[XB_TMO])) break; if (_sp > XB_SPIN_CAP) { atomicAdd(&(bar)[XB_TMO], 1u); break; } } } } while (0)
struct XcdBarrier { unsigned* bar; unsigned x; volatile LAS unsigned* st; };
DI XcdBarrier xcd_barrier_post(unsigned* bar, volatile LAS unsigned* st) {
  XcdBarrier b; b.bar = bar; b.x = xb_xcc_id(); b.st = st;
  if (threadIdx.x == 0) (void)xb_add(&bar[XB_XCNT(b.x)], 1u);
  return b;
}
DI void xcd_barrier_complete(unsigned* bar, unsigned x, unsigned& nloc, unsigned& nx) {
  asm volatile("" : "+s"(bar));
  const unsigned G = gridDim.x * gridDim.y * gridDim.z;
  unsigned sum, cnt, mine, sp = 0u;
  for (;;) {
    sum = 0u; cnt = 0u; mine = 0u;
#pragma unroll
    for (unsigned j = 0; j < 16; ++j) { const unsigned c = xb_ld(&bar[XB_XCNT(j)]); sum += c; cnt += (c > 0u) ? 1u : 0u; mine = (j == x) ? c : mine; }
    if (sum == G) break;
    __builtin_amdgcn_s_sleep(1);
    if ((++sp & 255u) == 0u) { if (xb_ld(&bar[XB_TMO])) break; if (sp > XB_SPIN_CAP) { atomicAdd(&bar[XB_TMO], 1u); break; } }
  }
  nloc = mine > 0u ? mine : 1u; nx = cnt > 0u ? cnt : 1u;
}
DI void xcd_barrier(const XcdBarrier& b) {
  asm volatile("s_waitcnt vmcnt(0)" ::: "memory");
  __syncthreads();
  if (threadIdx.x == 0) {
    unsigned* bar = b.bar; asm volatile("" : "+s"(bar));
    __builtin_amdgcn_s_waitcnt(0);
    unsigned nloc = b.st[0], nx = b.st[1];
    if (nloc == 0u) { xcd_barrier_complete(bar, b.x, nloc, nx); b.st[0] = nloc; b.st[1] = nx; }
    const unsigned old = xb_add(&bar[XB_XSUB(b.x)], 1u);
    const unsigned gen = old / nloc;
    if (old + 1u == (gen + 1u) * nloc) {
      __builtin_amdgcn_fence(__ATOMIC_RELEASE, "agent");
      asm volatile("s_waitcnt vmcnt(0)" ::: "memory");
      const unsigned og = xb_add(&bar[XB_TOP], 1u);
      const unsigned tg = og / nx;
      if (og + 1u == (tg + 1u) * nx) xb_add(&bar[XB_TOPGEN], 1u);
      else XB_SPIN(xb_ld(&bar[XB_TOPGEN]) == tg, bar);
      __builtin_amdgcn_fence(__ATOMIC_ACQUIRE, "agent");
      xb_add(&bar[XB_XGEN(b.x)], 1u);
      asm volatile("s_waitcnt vmcnt(0)" ::: "memory");
    } else {
      XB_SPIN(xb_ld(&bar[XB_XGEN(b.x)]) == gen, bar);
      __builtin_amdgcn_fence(__ATOMIC_ACQUIRE, "agent");
      asm volatile("s_waitcnt vmcnt(0)" ::: "memory");
    }
  }
  __syncthreads();
}

struct Args { const float* in[28]; float* out; unsigned char* ws; int ph_lo, ph_hi; };
constexpr int NPH = 1 + DEPTH * 23 + 1;

__global__ void __launch_bounds__(NTHREADS, 2) mega(Args A) {
  extern __shared__ __attribute__((aligned(16))) unsigned char lds_raw[];
  LAS unsigned char* sm = (LAS unsigned char*)lds_raw;
  cg::grid_group grid = cg::this_grid();
  const int G = gridDim.x, bid = blockIdx.x;
  volatile LAS unsigned* xst = (volatile LAS unsigned*)(sm + LDS_BYTES - 16);
  if (threadIdx.x < 4) xst[threadIdx.x] = 0u;
  __syncthreads();
  XcdBarrier xbar; xbar.bar = (unsigned*)(A.ws + WS_BAR); xbar.x = 0; xbar.st = xst;
  if (A.ph_hi - A.ph_lo > 1) xbar = xcd_barrier_post((unsigned*)(A.ws + WS_BAR), xst);
#ifdef PROBE_A
  unsigned long long tA = 0, tB = 0, tprev = wall_clock64();
#endif

  for (int ph = A.ph_lo; ph < A.ph_hi; ++ph) {
    size_t zo; asm volatile("s_mov_b64 %0, 0" : "=s"(zo));
    unsigned char* ws = A.ws + zo;
    const float* x_in = A.in[0] + zo;
    float* xo = A.out + zo;
    bf16_t* XB = (bf16_t*)(ws + WS_H);
    bf16_t* H = (bf16_t*)xo; bf16_t* PB = (bf16_t*)(ws + WS_P);
    bf16_t* MEMN = (bf16_t*)(ws + WS_MEMN); bf16_t* MKV = (bf16_t*)(ws + WS_MEMKV);
    float* LSE = (float*)(ws + WS_LSE); f32x2* S5E = (f32x2*)(ws + WS_S5E); f32x2* S5C = (f32x2*)(ws + WS_S5C); float* GDEC = (float*)(ws + WS_GDEC); bf16_t* GST = (bf16_t*)((unsigned char*)xo + (size_t)MTOK * 1024 * 2); bf16_t* GSO = GST + (size_t)BPG * 4 * 64 * 8192;
#define IN(i) (A.in[i] + zo)
    int kind, l = 0, grp = 0;
    if (ph == 0) kind = 0; else if (ph == NPH - 1) kind = 17;
    else { const int q = ph - 1; l = q / 23; const int k = q % 23; if (k < 16) { grp = k >> 3; kind = 2 + (k & 7); } else kind = 10 + (k - 16); }
    const float* xsrc = (l == 0) ? x_in : xo;
#ifdef PROBE_REPEAT_MASK
    const int ndry = (int)((PROBE_REPEAT_MASK >> kind) & 1);
#else
    const int ndry = 0;
#endif
    for (int dryi = ndry; dryi >= 0; --dryi) {
    const bool dry = dryi != 0;
    bool isgemm = false; int nrep = 1;
    const int vb = ((G & 7) == 0) ? (bid & 7) * (G >> 3) + (bid >> 3) : bid;
    switch (kind) {
      case 0: {
        for (int ll = 0; ll < DEPTH; ++ll) {
          transpose_w(sm, IN(3) + (size_t)ll * 1024 * 9744, 1024, 9744, (bf16_t*)(ws + WS_WIN) + (size_t)ll * DINP * 1024, DINP, 1);
          transpose_w(sm, IN(12) + (size_t)ll * 512 * 512, 512, 512, (bf16_t*)(ws + WS_WGLU) + (size_t)ll * 512 * 512, 512, 0);
          for (int n = 0; n < 3; ++n) transpose_w(sm, IN(17) + ((size_t)ll * 3 + n) * 512 * 1024, 512, 1024, (bf16_t*)(ws + WS_WBR) + ((size_t)ll * 3 + n) * 1024 * 512, 1024, 0);
          transpose_w(sm, IN(18) + (size_t)ll * 1024 * 1024, 1024, 1024, (bf16_t*)(ws + WS_WOUT) + (size_t)ll * 1024 * 1024, 1024, 0);
          transpose_w(sm, IN(21) + (size_t)ll * 1024 * 1024, 1024, 1024, (bf16_t*)(ws + WS_WXQ) + (size_t)ll * 1024 * 1024, 1024, 0);
          transpose_w(sm, IN(23) + (size_t)ll * 1024 * 1024, 1024, 1024, (bf16_t*)(ws + WS_WXO) + (size_t)ll * 1024 * 1024, 1024, 0);
          transpose_w(sm, IN(22) + (size_t)ll * 1024 * 2048, 1024, 2048, (bf16_t*)(ws + WS_WXKV) + (size_t)ll * 2048 * 1024, 2048, 0);
          transpose_w(sm, IN(25) + (size_t)ll * 1024 * 4096, 1024, 4096, (bf16_t*)(ws + WS_WUP) + (size_t)ll * 4096 * 1024, 4096, 0);
          transpose_w(sm, IN(26) + (size_t)ll * 4096 * 1024, 4096, 1024, (bf16_t*)(ws + WS_WDN) + (size_t)ll * 1024 * 4096, 1024, 0);
        }
        norm_rows_bf16(IN(1), IN(19), MEMN, 2048);
      } break;
      case 3: isgemm = true; nrep = (l == 0 && grp == 0) ? 2 : 1; break;
      case 7: case 8: case 9: case 11: case 13: case 15: case 16: isgemm = true; break;
      case 2: if (l == 0) norm_rows_bf16(x_in + (size_t)grp * MG * 1024, IN(2) + l * 1024, H, MG); else norm_rows_from_bf16(XB + (size_t)grp * MG * 1024, 1024, IN(2) + l * 1024, H, MG); break;
      case 4: {
        S5P sp{IN(4) + l * 2048, IN(5) + l * 2048, IN(6) + l * 32, IN(7) + (size_t)l * 32768, IN(8) + (size_t)l * 32768, IN(9) + (size_t)l * 32768, IN(10) + (size_t)l * 32768, IN(11) + l * 512};
        GLAP gp{IN(14) + l * 4096, IN(15) + l * 256, IN(16) + l * 128};
        constexpr int NA = BPG * 12 * 32, NS = BPG * 256, NGL = BPG * 4 * 64;
        for (int t = vb; t < NA + NS + NGL; t += G) {
          if (t < NA) attn_task(sm, t, PB + P_QA, PB + P_KA, PB + P_VA, LSE, dry);
          else if (t < NA + NS) s5_task(sm, t - NA, 0, PB + P_U, S5E, sp, dry);
          else gla_a_task(sm, t - NA - NS, PB + P_QK, PB + P_VG, PB + P_LR, GST, GDEC, gp, dry);
        }
      } break;
      case 5: { gla_prefix(GST, GSO, GDEC, dry);
        S5P sp{IN(4) + l * 2048, IN(5) + l * 2048, IN(6) + l * 32, IN(7) + (size_t)l * 32768, IN(8) + (size_t)l * 32768, IN(9) + (size_t)l * 32768, IN(10) + (size_t)l * 32768, IN(11) + l * 512};
        s5_carry_scan(S5E, S5C, sp, dry); } break;
      case 6: {
        S5P sp{IN(4) + l * 2048, IN(5) + l * 2048, IN(6) + l * 32, IN(7) + (size_t)l * 32768, IN(8) + (size_t)l * 32768, IN(9) + (size_t)l * 32768, IN(10) + (size_t)l * 32768, IN(11) + l * 512};
        GLAP gp{IN(14) + l * 4096, IN(15) + l * 256, IN(16) + l * 128};
        constexpr int NS = BPG * 256, NGL = BPG * 4 * 64;
        for (int t = bid; t < NS + NGL; t += G) {
          if (t < NS) s5_task(sm, t, 1, PB + P_U, S5C, sp, dry);
          else gla_c_task(sm, t - NS, PB + P_QK, PB + P_VG, PB + P_LR, PB + P_R, GSO, gp, dry);
        }
      } break;
      case 10: norm_rows_from_bf16(XB, 1024, IN(20) + l * 1024, H, MTOK); break;
      case 12: for (int t = vb; t < NB * 4 * 32; t += G) xattn_task(sm, t, PB, MKV, l, dry); break;
      case 14: norm_rows_from_bf16(XB, 1024, IN(24) + l * 1024, H, MTOK); break;
      case 17: final_norm_from_bf16(XB, xo, IN(27), MTOK); break;
      default: break;
    }
    if (isgemm) {
      for (int rep = 0; rep < nrep; ++rep) {
        pg8::Gemm g; Epi E; E.mode = EM_BF16; E.o16 = nullptr; E.ld16 = 0; E.o32 = nullptr; E.r32 = nullptr; E.ld32 = 1024; E.aux = nullptr; E.ldaux = 0; E.bias = nullptr; E.nzm1 = 0; E.r16 = nullptr; E.ldr16 = 1024; int nz = 1;
        bf16_t* MB = PB + P_KA;
        switch (rep == 1 ? 1 : kind) {
          case 1: g = pg8::Gemm{MEMN, (bf16_t*)(ws + WS_WXKV), 2048, 4096, 1024, 1024}; E.mode = EM_BF16; E.o16 = MKV; E.ld16 = 4096; break;
          case 3: g = pg8::Gemm{H, (bf16_t*)(ws + WS_WIN) + (size_t)l * DINP * 1024, MG, DINP, 1024, 1024}; E.mode = EM_PROJ; E.o16 = PB; break;
          case 7: g = pg8::Gemm{PB + P_U, (bf16_t*)(ws + WS_WGLU) + (size_t)l * 512 * 512, MG, 512, 512, 512}; E.mode = EM_GLU; E.o16 = PB + P_QK; E.ld16 = 512; E.aux = PB + P_U; E.ldaux = 512; E.bias = IN(13) + l * 512; break;
          case 8: g = pg8::Gemm{PB + P_QK, (bf16_t*)(ws + WS_WBR) + (size_t)l * 3 * 1024 * 512, MG, 1024, 512, 512};
            g.zA1 = (long)((const char*)(PB + P_VG) - (const char*)(PB + P_QK)); g.zA2 = (long)((const char*)H - (const char*)(PB + P_QK)); g.zB = (long)1024 * 512 * 2; nz = 3;
            E.mode = EM_MERGEZ; E.nzm1 = 2; E.o16 = MB; E.ld16 = 1024; E.aux = PB + P_GATE; E.ldaux = 3072; break;
          case 9: g = pg8::Gemm{MB, (bf16_t*)(ws + WS_WOUT) + (size_t)l * 1024 * 1024, MG, 1024, 1024, 1024}; E.mode = EM_RESID; E.o16 = XB + (size_t)grp * MG * 1024; E.ld16 = 1024; if (l == 0) E.r32 = x_in + (size_t)grp * MG * 1024; else E.r16 = XB + (size_t)grp * MG * 1024; break;
          case 11: g = pg8::Gemm{H, (bf16_t*)(ws + WS_WXQ) + (size_t)l * 1024 * 1024, MTOK, 1024, 1024, 1024}; E.mode = EM_BF16; E.o16 = PB; E.ld16 = 1024; break;
          case 13: g = pg8::Gemm{PB, (bf16_t*)(ws + WS_WXO) + (size_t)l * 1024 * 1024, MTOK, 1024, 1024, 1024}; E.mode = EM_RESID; E.r16 = XB; E.o16 = XB; E.ld16 = 1024; break;
          case 15: g = pg8::Gemm{H, (bf16_t*)(ws + WS_WUP) + (size_t)l * 4096 * 1024, MTOK, 4096, 1024, 1024}; E.mode = EM_RELU2; E.o16 = PB; E.ld16 = 4096; break;
          default: g = pg8::Gemm{PB, (bf16_t*)(ws + WS_WDN) + (size_t)l * 1024 * 4096, MTOK, 1024, 4096, 4096}; E.mode = EM_RESID; E.r16 = XB; E.o16 = XB; E.ld16 = 1024; break;
        }
        g.nz = nz; if (nz == 1) { g.zA1 = 0; g.zA2 = 0; g.zB = 0; }
        g.perm = 1;
        pg8::StaticOrder S; S.init(g.M, g.N, G, bid, nz);
        if (dry) { E.mode = EM_DRY; E.nzm1 = nz - 1; }
        if (nz == 1) pg8::gemm_phase<false, Epi>(sm, g, S, E); else pg8::gemm_phase<true, Epi>(sm, g, S, E);
      }
      if (kind == 7) { if (G > 128) { if (bid >= 128) attn_combine(PB + P_QA, H, LSE, dry, bid - 128, G - 128); } else attn_combine(PB + P_QA, H, LSE, dry, bid, G); }
    }
    }
#ifdef PROBE_A
    { const unsigned long long tn = wall_clock64(); const unsigned long long dt = tn - tprev; tprev = tn;
      if ((PROBE_A >> kind) & 1) tA += dt; if ((PROBE_B >> kind) & 1) tB += dt; }
#endif
    if (ph + 1 < A.ph_hi) { if (ph == A.ph_lo) grid.sync(); else xcd_barrier(xbar); }
#ifdef PROBE_EXTRA_SYNCS
    if (ph == 1) for (int i = 0; i < PROBE_EXTRA_SYNCS; ++i) xcd_barrier(xbar);
#endif
#ifdef PROBE_A
    { const unsigned long long tn = wall_clock64(); const unsigned long long dt = tn - tprev; tprev = tn;
      if ((PROBE_A >> 18) & 1) tA += dt; if ((PROBE_B >> 18) & 1) tB += dt; }
#endif
  }
#ifdef PROBE_A
  {
    float* tw = (float*)(A.ws + WS_LSE);
    if (bid == 0 && tid_() == 0) { tw[0] = (float)tA * 0.01f; tw[1] = (float)tB * 0.01f; __threadfence(); }
    grid.sync();
    const float fa = __builtin_nontemporal_load(tw), fb = __builtin_nontemporal_load(tw + 1);
    for (size_t i = (size_t)bid * NTHREADS + tid_(); i < (size_t)16777216; i += (size_t)G * NTHREADS) A.out[i] += fb;
    if (bid == 1 && tid_() == 0) A.out[(size_t)MTOK * DM - 1] += 64.0f * fa;
  }
#endif
}

extern "C" void kernel_launch(void* const* d_in, const int* in_sizes, int n_in, void* d_out, int out_size, void* d_ws, size_t ws_size, hipStream_t stream) {
  static int grid = 0;
  if (grid == 0) {
    if (n_in != 28 || out_size != MTOK * DM || ws_size < WS_END) { fprintf(stderr, "kernel_launch: unexpected shapes (n_in %d out %d ws %zu need %zu)\n", n_in, out_size, ws_size, (size_t)WS_END); grid = -1; return; }
    int dev = 0, cus = 0, per_cu = 0;
    hipGetDevice(&dev); hipDeviceGetAttribute(&cus, hipDeviceAttributeMultiprocessorCount, dev);
    if (hipFuncSetAttribute((const void*)mega, hipFuncAttributeMaxDynamicSharedMemorySize, LDS_BYTES) != hipSuccess) { fprintf(stderr, "kernel_launch: hipFuncSetAttribute failed\n"); grid = -1; return; }
    hipOccupancyMaxActiveBlocksPerMultiprocessor(&per_cu, (const void*)mega, NTHREADS, LDS_BYTES);
    (void)hipGetLastError();
    if (per_cu < 1) { fprintf(stderr, "kernel_launch: occupancy query says %d blocks per CU\n", per_cu); per_cu = 1; }
    grid = cus;
  }
  if (grid < 0) return;
  if (hipMemsetAsync((unsigned char*)d_ws + WS_BAR, 0, 16384, stream) != hipSuccess) { fprintf(stderr, "kernel_launch: memset of barrier words failed\n"); return; }
  Args a{};
  for (int i = 0; i < 28; ++i) a.in[i] = (const float*)d_in[i];
  a.out = (float*)d_out; a.ws = (unsigned char*)d_ws;
#if MULTI_LAUNCH
  for (int ph = 0; ph < NPH; ++ph) { a.ph_lo = ph; a.ph_hi = ph + 1; hipLaunchKernelGGL(mega, dim3(grid), dim3(NTHREADS), LDS_BYTES, stream, a); }
#else
  a.ph_lo = 0; a.ph_hi = NPH;
  void* args[] = {&a};
  hipError_t e = hipLaunchCooperativeKernel((const void*)mega, dim3(grid), dim3(NTHREADS), args, LDS_BYTES, stream);
  if (e != hipSuccess) fprintf(stderr, "kernel_launch: cooperative launch failed: %s (grid %d)\n", hipGetErrorString(e), grid);
#endif
}
```

```cpp
#include <hip/hip_runtime.h>
#include <hip/hip_cooperative_groups.h>
#include <cstdio>
namespace cg = cooperative_groups;

#ifndef MULTI_LAUNCH
#define MULTI_LAUNCH 0
#endif

#define LAS __attribute__((address_space(3)))
#define DI __device__ __forceinline__
typedef unsigned short bf16_t;
typedef short bf16x8 __attribute__((ext_vector_type(8)));
typedef float f32x4 __attribute__((ext_vector_type(4)));
typedef float f32x2 __attribute__((ext_vector_type(2)));
typedef unsigned u32x4 __attribute__((ext_vector_type(4)));
typedef unsigned u32x2 __attribute__((ext_vector_type(2)));
typedef __bf16 bfv2 __attribute__((ext_vector_type(2)));

constexpr int DM = 1024, SEQ = 4096, NB = 8, MTOK = NB * SEQ, DEPTH = 2;
constexpr int NGRP = 2, MG = MTOK / NGRP, BPG = NB / NGRP;
constexpr int DINP = 9984;
constexpr int NTHREADS = 512;
constexpr int LDS_BYTES = 147456;

constexpr size_t AL(size_t x) { return (x + 255) & ~(size_t)255; }
constexpr size_t WS_WIN = 0;
constexpr size_t WS_WGLU = WS_WIN + AL((size_t)DEPTH * DINP * 1024 * 2);
constexpr size_t WS_WBR = WS_WGLU + AL((size_t)DEPTH * 512 * 512 * 2);
constexpr size_t WS_WOUT = WS_WBR + AL((size_t)DEPTH * 3 * 1024 * 512 * 2);
constexpr size_t WS_WXQ = WS_WOUT + AL((size_t)DEPTH * 1024 * 1024 * 2);
constexpr size_t WS_WXO = WS_WXQ + AL((size_t)DEPTH * 1024 * 1024 * 2);
constexpr size_t WS_WXKV = WS_WXO + AL((size_t)DEPTH * 1024 * 1024 * 2);
constexpr size_t WS_WUP = WS_WXKV + AL((size_t)DEPTH * 2048 * 1024 * 2);
constexpr size_t WS_WDN = WS_WUP + AL((size_t)DEPTH * 4096 * 1024 * 2);
constexpr size_t WS_MEMN = WS_WDN + AL((size_t)DEPTH * 4096 * 1024 * 2);
constexpr size_t WS_MEMKV = WS_MEMN + AL((size_t)2048 * 1024 * 2);
constexpr size_t WS_LSE = WS_MEMKV + AL((size_t)2048 * 4096 * 2);
constexpr size_t WS_S5E = WS_LSE + AL((size_t)MG * 12 * 4);
constexpr size_t WS_S5C = WS_S5E + AL((size_t)BPG * 32 * 64 * 64 * 8);
constexpr size_t WS_GDEC = WS_S5C + AL((size_t)BPG * 32 * 64 * 64 * 8);
constexpr size_t WS_H = WS_GDEC + AL((size_t)BPG * 4 * 64 * 64 * 4);
constexpr size_t WS_GST = WS_H + (size_t)MG * 1024 * 2;
constexpr size_t WS_P = WS_H + AL((size_t)MTOK * 1024 * 2);
constexpr size_t WS_BAR = WS_P + AL((size_t)MG * DINP * 2);
constexpr size_t WS_END = WS_BAR + 16384;
constexpr size_t PE(int tile) { return (size_t)MG * 256 * tile; }
constexpr size_t P_U = PE(0), P_QK = PE(2), P_VG = PE(4), P_R = PE(6), P_QA = PE(8), P_KA = PE(14), P_VA = PE(20), P_GATE = PE(26), P_LR = PE(38);

typedef short s16x4 __attribute__((ext_vector_type(4)));
DI u32x2 lds_tr16(LAS unsigned char* p) { return __builtin_bit_cast(u32x2, __builtin_amdgcn_ds_read_tr16_b64_v4i16((LAS s16x4*)p)); }
DI float bf_lo(unsigned u) { return __uint_as_float(u << 16); }
DI float bf_hi(unsigned u) { return __uint_as_float(u & 0xffff0000u); }
DI unsigned pk2(float lo, float hi) { f32x2 v = {lo, hi}; bfv2 r = __builtin_convertvector(v, bfv2); return __builtin_bit_cast(unsigned, r); }
DI int tid_() { int t = threadIdx.x; asm volatile("" : "+v"(t)); return t; }
DI float shx(float v, int m, int lane) { return __builtin_bit_cast(float, __builtin_amdgcn_ds_bpermute((lane ^ m) << 2, __builtin_bit_cast(int, v))); }
DI float wave_sum(float v, int lane) {
#pragma unroll
  for (int m = 32; m >= 1; m >>= 1) v += shx(v, m, lane);
  return v;
}
DI float sigmoidf_(float x) { return __builtin_amdgcn_rcpf(1.0f + __expf(-x)); }
DI f32x4 mfma16(bf16x8 a, bf16x8 b, f32x4 c) { return __builtin_amdgcn_mfma_f32_16x16x32_bf16(a, b, c, 0, 0, 0); }
DI bf16x8 mk8(u32x4 v) { return __builtin_bit_cast(bf16x8, v); }

namespace pg8 {
constexpr int BM = 256, BK = 64, HALF = 128, HTB = HALF * BK * 2, STAGE_BYTES = 8 * HTB, NXCD = 8, WGM = 4;
DI int lds_byte(int r, int c) { const int st = (r >> 4) * 2 + (c >> 5), rr = r & 15, cc = c & 31, ob = rr * 64 + cc * 2; return st * 1024 + (ob ^ (((ob >> 9) & 1) << 5)); }
DI void stage_rc(int b, int& R, int& C) { const int st = b / 1024, sb = b % 1024, swz = sb ^ (((sb >> 9) & 1) << 5); R = (st >> 1) * 16 + swz / 64; C = (st & 1) * 32 + (swz % 64) / 2; }
DI int perm32(int rho) { const int n = rho >> 4, i = rho & 15; return 8 * (i >> 2) + 4 * n + (i & 3); }
struct Unit { int pm, pn, z; };
struct Gemm { const bf16_t* A; const bf16_t* Bt; int M, N, K, lda; long zA1, zA2, zB; int nz, perm; };
struct StaticOrder {
  int nM, nN, nwg, G, c, nz;
  DI void init(int M, int N, int G_, int c_, int nz_) { nM = M / BM; nN = N / BM; nwg = nM * nN; G = G_; c = c_; nz = nz_; }
  DI bool next(int i, Unit& u) const {
    const int ib = (nz == 1) ? i : i / nz; u.z = i - ib * nz;
    const long L = (long)ib * G + c; if (L >= nwg) return false;
    int wgid = (int)L; { const int q = nwg / NXCD, r = nwg % NXCD, xcd = wgid % NXCD, off = wgid / NXCD; wgid = (xcd < r ? xcd * (q + 1) : r * (q + 1) + (xcd - r) * q) + off; }
    const int nig = WGM * nN, gid = wgid / nig, fm = gid * WGM, gsz = (nM - fm) < WGM ? (nM - fm) : WGM;
    u.pm = fm + ((wgid % nig) % gsz); u.pn = (wgid % nig) / gsz; return true;
  }
};

template <bool CHAIN, class Epi>
DI void gemm_phase(LAS unsigned char* lds, const Gemm g, const StaticOrder& S, const Epi& E) {
  const int tid = tid_(), wid = __builtin_amdgcn_readfirstlane(tid >> 6), lane = tid & 63, wr = wid >> 2, wc = wid & 3, fr = lane & 15, fq = lane >> 4;
  const int K = g.K, nt = K / BK, lda = g.lda;
  unsigned voffA[2], voffB[2];
#pragma unroll
  for (int i = 0; i < 2; ++i) { int R, C; stage_rc(tid * 16 + i * 8192, R, C); const int Rb = g.perm ? ((R & ~31) + perm32(R & 31)) : R;
    voffA[i] = (unsigned)(R * lda + C) * 2u; voffB[i] = (unsigned)(Rb * K + C) * 2u; }
  const size_t kstep = (size_t)(BK * 2);
  const size_t hstA = (size_t)HALF * lda * 2, hstB = (size_t)HALF * K * 2;
  const size_t tstA = 2 * hstA, tstB = 2 * hstB;
  const unsigned ldsw = (unsigned)wid * 1024u;
  const int aoff = lds_byte(wr * 64 + fr, fq * 8), boff = lds_byte(wc * 32 + fr, fq * 8);
#define PG8_SA(b, h) (((b) * 2 + (h)) * HTB)
#define PG8_SB(b, h) ((4 + (b) * 2 + (h)) * HTB)
#define PG8_STAGE(bufoff, gbase, voff) do { _Pragma("unroll") for (int _i = 0; _i < 2; ++_i) \
    __builtin_amdgcn_global_load_lds((const unsigned*)((const char*)(gbase) + (voff)[_i]), (LAS unsigned*)(lds + (bufoff) + ldsw + _i * 8192), 16, 0, 0); } while (0)
#define PG8_LDA(dst, b, h) do { _Pragma("unroll") for (int m = 0; m < 4; ++m) _Pragma("unroll") for (int k = 0; k < 2; ++k) dst[m][k] = *(const LAS bf16x8*)(lds + PG8_SA(b, h) + aoff + m * 2048 + k * 1024); } while (0)
#define PG8_LDB(dst, b, h) do { _Pragma("unroll") for (int n = 0; n < 2; ++n) _Pragma("unroll") for (int k = 0; k < 2; ++k) dst[n][k] = *(const LAS bf16x8*)(lds + PG8_SB(b, h) + boff + n * 2048 + k * 1024); } while (0)
#define PG8_MMA(ai, bj, At, Bt) do { __builtin_amdgcn_s_setprio(1); _Pragma("unroll") for (int m = 0; m < 4; ++m) _Pragma("unroll") for (int n = 0; n < 2; ++n) _Pragma("unroll") for (int k = 0; k < 2; ++k) \
    acc[ai][bj][m][n] = __builtin_amdgcn_mfma_f32_16x16x32_bf16(Bt[n][k], At[m][k], acc[ai][bj][m][n], 0, 0, 0); __builtin_amdgcn_s_setprio(0); } while (0)
#define PG8_WAIT_V(n) asm volatile("s_waitcnt vmcnt(" #n ")" ::: "memory")
#define PG8_WAIT_L(n) asm volatile("s_waitcnt lgkmcnt(" #n ")" ::: "memory")
#define PG8_BAR __builtin_amdgcn_s_barrier()
#define PG8_SCHED __builtin_amdgcn_sched_barrier(0)
  Unit cur, nxt; int ui = 0;
  if (!S.next(0, cur)) return;
  f32x4 acc[2][2][4][2];
#pragma unroll
  for (int a = 0; a < 2; ++a)
#pragma unroll
    for (int b = 0; b < 2; ++b)
#pragma unroll
      for (int m = 0; m < 4; ++m)
#pragma unroll
        for (int n = 0; n < 2; ++n) acc[a][b][m][n] = (f32x4){0.f, 0.f, 0.f, 0.f};
  bf16x8 At[4][2], B0[2][2], B1[2][2];
#define PG8_ZA(z) ((z) == 0 ? 0l : ((z) == 1 ? g.zA1 : g.zA2))
  const char* cA = (const char*)g.A + PG8_ZA(cur.z) + (size_t)cur.pm * tstA; const char* cB = (const char*)g.Bt + (long)cur.z * g.zB + (size_t)cur.pn * tstB;
  PG8_STAGE(PG8_SB(0, 0), cB, voffB); PG8_STAGE(PG8_SA(0, 0), cA, voffA); PG8_STAGE(PG8_SB(0, 1), cB + hstB, voffB); PG8_STAGE(PG8_SA(0, 1), cA + hstA, voffA);
  if (wr == 1) PG8_BAR;
  PG8_WAIT_V(4); PG8_BAR;
  PG8_STAGE(PG8_SB(1, 0), cB + kstep, voffB); PG8_STAGE(PG8_SA(1, 0), cA + kstep, voffA); PG8_STAGE(PG8_SB(1, 1), cB + hstB + kstep, voffB);
  PG8_WAIT_V(6); PG8_BAR;
  for (;;) {
    const bool has_next = S.next(ui + 1, nxt);
    const char* nA = has_next ? (const char*)g.A + PG8_ZA(nxt.z) + (size_t)nxt.pm * tstA : cA; const char* nB = has_next ? (const char*)g.Bt + (long)nxt.z * g.zB + (size_t)nxt.pn * tstB : cB;
    for (int t = 0; t < nt; t += 2) {
      const bool last = (t == nt - 2);
      const char* a1 = cA + (size_t)(t + 1) * kstep;
      const char* a2 = last ? nA : cA + (size_t)(t + 2) * kstep; const char* b2 = last ? nB : cB + (size_t)(t + 2) * kstep;
      const char* a3 = a2 + kstep; const char* b3 = b2 + kstep;
      PG8_LDB(B0, 0, 0); PG8_SCHED; PG8_LDA(At, 0, 0); PG8_STAGE(PG8_SA(1, 1), a1 + hstA, voffA);
      PG8_WAIT_L(8); PG8_BAR; PG8_WAIT_L(0); PG8_MMA(0, 0, At, B0); PG8_BAR; PG8_SCHED;
      PG8_LDB(B1, 0, 1); PG8_STAGE(PG8_SB(0, 0), b2, voffB);
      PG8_BAR; PG8_WAIT_L(0); PG8_MMA(0, 1, At, B1); PG8_BAR;
      PG8_LDA(At, 0, 1); PG8_STAGE(PG8_SA(0, 0), a2, voffA);
      PG8_BAR; PG8_WAIT_L(0); PG8_MMA(1, 0, At, B0); PG8_BAR; PG8_SCHED;
      PG8_STAGE(PG8_SB(0, 1), b2 + hstB, voffB);
      PG8_WAIT_V(6); PG8_BAR; PG8_MMA(1, 1, At, B1); PG8_BAR;
      PG8_LDB(B0, 1, 0); PG8_SCHED; PG8_LDA(At, 1, 0); PG8_STAGE(PG8_SA(0, 1), a2 + hstA, voffA);
      PG8_WAIT_L(8); PG8_BAR; PG8_WAIT_L(0); PG8_MMA(0, 0, At, B0); PG8_BAR; PG8_SCHED;
      PG8_LDB(B1, 1, 1); PG8_STAGE(PG8_SB(1, 0), b3, voffB);
      PG8_BAR; PG8_WAIT_L(0); PG8_MMA(0, 1, At, B1); PG8_BAR;
      PG8_LDA(At, 1, 1); PG8_STAGE(PG8_SA(1, 0), a3, voffA);
      PG8_BAR; PG8_WAIT_L(0); PG8_MMA(1, 0, At, B0); PG8_BAR; PG8_SCHED;
      PG8_STAGE(PG8_SB(1, 1), b3 + hstB, voffB);
      PG8_WAIT_V(6); PG8_BAR; PG8_MMA(1, 1, At, B1); PG8_BAR;
    }
#define PG8_ZERO() do { _Pragma("unroll") for (int a = 0; a < 2; ++a) _Pragma("unroll") for (int b = 0; b < 2; ++b) _Pragma("unroll") for (int m = 0; m < 4; ++m) _Pragma("unroll") for (int n = 0; n < 2; ++n) acc[a][b][m][n] = (f32x4){0.f, 0.f, 0.f, 0.f}; } while (0)
    if constexpr (CHAIN) { E.merge(acc, cur, wr, wc, fr, fq); if (!has_next) break; if (cur.z == E.nzm1) PG8_ZERO(); }
    else { E(acc, cur, wr, wc, fr, fq); if (!has_next) break; PG8_ZERO(); }
    cur = nxt; cA = nA; cB = nB; ++ui;
  }
  PG8_WAIT_V(0);
  if (wr == 0) PG8_BAR;
  PG8_BAR;
#undef PG8_ZA
#undef PG8_ZERO
#undef PG8_SA
#undef PG8_SB
#undef PG8_STAGE
#undef PG8_LDA
#undef PG8_LDB
#undef PG8_MMA
#undef PG8_WAIT_V
#undef PG8_WAIT_L
#undef PG8_BAR
#undef PG8_SCHED
}
}

enum { EM_PROJ = 0, EM_BF16, EM_GLU, EM_MERGEZ, EM_RESID, EM_RELU2, EM_DRY };
struct Epi {
  int mode;
  bf16_t* o16; int ld16;
  float* o32; const float* r32; int ld32;
  const bf16_t* r16; int ldr16;
  const bf16_t* aux; int ldaux;
  const float* bias;
  int nzm1;
  DI bool is_chain() const { return nzm1 != 0; }
  DI void operator()(const f32x4 (&acc)[2][2][4][2], const pg8::Unit& u, int wr, int wc, int fr, int fq) const {
    if (mode == EM_DRY) return;
    const int row0 = u.pm * 256 + wr * 64 + fr;
    int colt = u.pn * 256; bf16_t* ob = o16; int ldo = ld16;
    if (mode == EM_PROJ) {
      const int pn = u.pn; int s, ldp;
      if (pn < 8) { s = pn & ~1; ldp = 512; } else if (pn < 14) { s = 8; ldp = 1536; } else if (pn < 20) { s = 14; ldp = 1536; } else if (pn < 26) { s = 20; ldp = 1536; }
      else if (pn < 38) { s = 26; ldp = 3072; } else { s = 38; ldp = 256; }
      ob = o16 + PE(s); ldo = ldp; colt = (pn - s) * 256;
    }
    const int col0 = colt + wc * 32 + 8 * fq;
    if (mode == EM_PROJ || mode == EM_BF16 || mode == EM_RELU2) {
      const bool sq = (mode == EM_RELU2);
#pragma unroll
      for (int ai = 0; ai < 2; ++ai)
#pragma unroll
        for (int m = 0; m < 4; ++m) {
          const size_t row = (size_t)(row0 + ai * 128 + m * 16);
#pragma unroll
          for (int bj = 0; bj < 2; ++bj) {
            f32x4 v0 = acc[ai][bj][m][0], v1 = acc[ai][bj][m][1];
            if (sq) {
#pragma unroll
              for (int j = 0; j < 4; ++j) { const float a = fmaxf(v0[j], 0.f), b = fmaxf(v1[j], 0.f); v0[j] = a * a; v1[j] = b * b; }
            }
            u32x4 w; w.x = pk2(v0[0], v0[1]); w.y = pk2(v0[2], v0[3]); w.z = pk2(v1[0], v1[1]); w.w = pk2(v1[2], v1[3]);
            *(u32x4*)(ob + row * ldo + col0 + bj * 128) = w;
          }
        }
    } else if (mode == EM_RESID) {
      if (r32) {
#pragma unroll
        for (int ai = 0; ai < 2; ++ai)
#pragma unroll
          for (int mp = 0; mp < 2; ++mp) {
            f32x4 rr[2][2][2];
#pragma unroll
            for (int mm = 0; mm < 2; ++mm)
#pragma unroll
              for (int bj = 0; bj < 2; ++bj) { const float* p = r32 + (size_t)(row0 + ai * 128 + (mp * 2 + mm) * 16) * ld32 + col0 + bj * 128; rr[mm][bj][0] = *(const f32x4*)p; rr[mm][bj][1] = *(const f32x4*)(p + 4); }
#pragma unroll
            for (int mm = 0; mm < 2; ++mm)
#pragma unroll
              for (int bj = 0; bj < 2; ++bj) { const size_t row = (size_t)(row0 + ai * 128 + (mp * 2 + mm) * 16);
                const f32x4 t0 = rr[mm][bj][0] + acc[ai][bj][mp * 2 + mm][0], t1 = rr[mm][bj][1] + acc[ai][bj][mp * 2 + mm][1];
                u32x4 w; w.x = pk2(t0[0], t0[1]); w.y = pk2(t0[2], t0[3]); w.z = pk2(t1[0], t1[1]); w.w = pk2(t1[2], t1[3]);
                *(u32x4*)(ob + row * ldo + col0 + bj * 128) = w; }
          }
      } else {
#pragma unroll
        for (int ai = 0; ai < 2; ++ai) {
          u32x4 q[4][2];
#pragma unroll
          for (int m = 0; m < 4; ++m)
#pragma unroll
            for (int bj = 0; bj < 2; ++bj) q[m][bj] = *(const u32x4*)(r16 + (size_t)(row0 + ai * 128 + m * 16) * ldr16 + col0 + bj * 128);
#pragma unroll
          for (int m = 0; m < 4; ++m)
#pragma unroll
            for (int bj = 0; bj < 2; ++bj) { const u32x4 v = q[m][bj];
              const f32x4 t0 = (f32x4){bf_lo(v.x), bf_hi(v.x), bf_lo(v.y), bf_hi(v.y)} + acc[ai][bj][m][0], t1 = (f32x4){bf_lo(v.z), bf_hi(v.z), bf_lo(v.w), bf_hi(v.w)} + acc[ai][bj][m][1];
              u32x4 w; w.x = pk2(t0[0], t0[1]); w.y = pk2(t0[2], t0[3]); w.z = pk2(t1[0], t1[1]); w.w = pk2(t1[2], t1[3]);
              *(u32x4*)(ob + (size_t)(row0 + ai * 128 + m * 16) * ldo + col0 + bj * 128) = w; }
        }
      }
    } else if (mode == EM_GLU) {
      f32x4 bb[2][2];
#pragma unroll
      for (int bj = 0; bj < 2; ++bj) { bb[bj][0] = *(const f32x4*)(bias + col0 + bj * 128); bb[bj][1] = *(const f32x4*)(bias + col0 + bj * 128 + 4); }
#pragma unroll
      for (int ai = 0; ai < 2; ++ai) {
        u32x4 gq[4][2];
#pragma unroll
        for (int m = 0; m < 4; ++m)
#pragma unroll
          for (int bj = 0; bj < 2; ++bj) gq[m][bj] = *(const u32x4*)(aux + (size_t)(row0 + ai * 128 + m * 16) * ldaux + col0 + bj * 128);
#pragma unroll
        for (int m = 0; m < 4; ++m)
#pragma unroll
          for (int bj = 0; bj < 2; ++bj) {
            const u32x4 q = gq[m][bj]; const f32x4 v0 = acc[ai][bj][m][0], v1 = acc[ai][bj][m][1];
            const float gv[8] = {bf_lo(q.x), bf_hi(q.x), bf_lo(q.y), bf_hi(q.y), bf_lo(q.z), bf_hi(q.z), bf_lo(q.w), bf_hi(q.w)};
            float o[8];
#pragma unroll
            for (int j = 0; j < 4; ++j) { o[j] = gv[j] * sigmoidf_(v0[j] + bb[bj][0][j]); o[4 + j] = gv[4 + j] * sigmoidf_(v1[j] + bb[bj][1][j]); }
            u32x4 w; w.x = pk2(o[0], o[1]); w.y = pk2(o[2], o[3]); w.z = pk2(o[4], o[5]); w.w = pk2(o[6], o[7]);
            *(u32x4*)(ob + (size_t)(row0 + ai * 128 + m * 16) * ldo + col0 + bj * 128) = w;
          }
      }
    }
  }
  DI void merge(f32x4 (&acc)[2][2][4][2], const pg8::Unit& u, int wr, int wc, int fr, int fq) const {
    if (mode == EM_DRY) return;
    const int row0 = u.pm * 256 + wr * 64 + fr, col0 = u.pn * 256 + wc * 32 + 8 * fq;
    bf16_t* ob = o16; const int ldo = ld16;
    {
      const int z = u.z;
#pragma unroll
      for (int ai = 0; ai < 2; ++ai)
#pragma unroll
        for (int mp = 0; mp < 2; ++mp) {
          u32x4 g0[2][2], g1[2][2];
#pragma unroll
          for (int mm = 0; mm < 2; ++mm)
#pragma unroll
            for (int bj = 0; bj < 2; ++bj) { const bf16_t* p = aux + (size_t)(row0 + ai * 128 + (mp * 2 + mm) * 16) * ldaux + z * 1024 + col0 + bj * 128;
              g0[mm][bj] = *(const u32x4*)p; g1[mm][bj] = (z < 2) ? *(const u32x4*)(p + 1024) : (u32x4){0u, 0u, 0u, 0u}; }
#pragma unroll
          for (int mm = 0; mm < 2; ++mm)
#pragma unroll
            for (int bj = 0; bj < 2; ++bj) {
              const int m = mp * 2 + mm; const size_t row = (size_t)(row0 + ai * 128 + m * 16);
              f32x4& a0 = acc[ai][bj][m][0]; f32x4& a1 = acc[ai][bj][m][1];
#pragma unroll
              for (int e2 = 0; e2 < 4; ++e2) {
                const float l0a = bf_lo(g0[mm][bj][e2]), l0b = bf_hi(g0[mm][bj][e2]), l1a = bf_lo(g1[mm][bj][e2]), l1b = bf_hi(g1[mm][bj][e2]);
                float fa = __builtin_amdgcn_rcpf(1.0f + __expf(-l0a)), fb = __builtin_amdgcn_rcpf(1.0f + __expf(-l0b));
                if (z < 2) { fa *= 1.0f + __expf(-l1a); fb *= 1.0f + __expf(-l1b); }
                if (e2 < 2) { a0[2 * e2] *= fa; a0[2 * e2 + 1] *= fb; } else { a1[2 * e2 - 4] *= fa; a1[2 * e2 - 3] *= fb; }
              }
              if (z == 2) { u32x4 w; w.x = pk2(a0[0], a0[1]); w.y = pk2(a0[2], a0[3]); w.z = pk2(a1[0], a1[1]); w.w = pk2(a1[2], a1[3]);
                *(u32x4*)(ob + row * ldo + col0 + bj * 128) = w; }
            }
        }
    }
  }
};

DI void norm_rows_bf16(const float* x, const float* gain, bf16_t* H, int nrows) {
  const int tid = tid_(), lane = tid & 63, gw = blockIdx.x * 8 + (tid >> 6), nw = gridDim.x * 8;
  f32x4 g[4];
#pragma unroll
  for (int i = 0; i < 4; ++i) g[i] = *(const f32x4*)(gain + i * 256 + lane * 4);
  for (int r = gw * 2; r < nrows; r += nw * 2) {
    f32x4 v[2][4];
#pragma unroll
    for (int q = 0; q < 2; ++q)
#pragma unroll
      for (int i = 0; i < 4; ++i) v[q][i] = *(const f32x4*)(x + (size_t)(r + q) * 1024 + i * 256 + lane * 4);
#pragma unroll
    for (int q = 0; q < 2; ++q) {
      float ss = 0.f;
#pragma unroll
      for (int i = 0; i < 4; ++i) ss += v[q][i][0] * v[q][i][0] + v[q][i][1] * v[q][i][1] + v[q][i][2] * v[q][i][2] + v[q][i][3] * v[q][i][3];
      ss = wave_sum(ss, lane);
      const float rs = rsqrtf(ss * (1.0f / 1024.0f) + 1e-6f);
#pragma unroll
      for (int i = 0; i < 4; ++i) { u32x2 w; w.x = pk2(v[q][i][0] * rs * g[i][0], v[q][i][1] * rs * g[i][1]); w.y = pk2(v[q][i][2] * rs * g[i][2], v[q][i][3] * rs * g[i][3]);
        *(u32x2*)(H + (size_t)(r + q) * 1024 + i * 256 + lane * 4) = w; }
    }
  }
}
DI void norm_rows_from_bf16(const bf16_t* xb, int ldx, const float* gain, bf16_t* H, int nrows) {
  const int tid = tid_(), lane = tid & 63, gw = blockIdx.x * 8 + (tid >> 6), nw = gridDim.x * 8;
  f32x4 g[4];
#pragma unroll
  for (int i = 0; i < 2; ++i) { g[2 * i] = *(const f32x4*)(gain + i * 512 + lane * 8); g[2 * i + 1] = *(const f32x4*)(gain + i * 512 + lane * 8 + 4); }
  for (int r = gw * 8; r < nrows; r += nw * 8) {
    u32x4 v[8][2];
#pragma unroll
    for (int q = 0; q < 8; ++q)
#pragma unroll
      for (int i = 0; i < 2; ++i) v[q][i] = *(const u32x4*)(xb + (size_t)(r + q) * ldx + i * 512 + lane * 8);
#pragma unroll
    for (int q = 0; q < 8; ++q) {
      float f[16];
#pragma unroll
      for (int i = 0; i < 2; ++i)
#pragma unroll
        for (int e = 0; e < 4; ++e) { f[i * 8 + 2 * e] = bf_lo(v[q][i][e]); f[i * 8 + 2 * e + 1] = bf_hi(v[q][i][e]); }
      float ss = 0.f;
#pragma unroll
      for (int e = 0; e < 16; ++e) ss += f[e] * f[e];
      ss = wave_sum(ss, lane);
      const float rs = rsqrtf(ss * (1.0f / 1024.0f) + 1e-6f);
#pragma unroll
      for (int i = 0; i < 2; ++i) { u32x4 w;
#pragma unroll
        for (int e = 0; e < 4; ++e) w[e] = pk2(f[i * 8 + 2 * e] * rs * g[2 * i + (e >> 1)][(2 * e) & 3], f[i * 8 + 2 * e + 1] * rs * g[2 * i + (e >> 1)][(2 * e + 1) & 3]);
        *(u32x4*)(H + (size_t)(r + q) * 1024 + i * 512 + lane * 8) = w; }
    }
  }
}
DI void final_norm_expand(float* out, const float* gain, int nrows) {
  const int tid = tid_(), lane = tid & 63, gw = blockIdx.x * 8 + (tid >> 6), nw = gridDim.x * 8;
  f32x4 g[4];
#pragma unroll
  for (int i = 0; i < 2; ++i) { g[2 * i] = *(const f32x4*)(gain + i * 512 + lane * 8); g[2 * i + 1] = *(const f32x4*)(gain + i * 512 + lane * 8 + 4); }
  for (int r = gw; r < nrows; r += nw) {
    const bf16_t* xb = (const bf16_t*)(out + (size_t)r * 1024);
    u32x4 v[2];
#pragma unroll
    for (int i = 0; i < 2; ++i) v[i] = *(const u32x4*)(xb + i * 512 + lane * 8);
    float f[16];
#pragma unroll
    for (int i = 0; i < 2; ++i)
#pragma unroll
      for (int e = 0; e < 4; ++e) { f[i * 8 + 2 * e] = bf_lo(v[i][e]); f[i * 8 + 2 * e + 1] = bf_hi(v[i][e]); }
    float ss = 0.f;
#pragma unroll
    for (int e = 0; e < 16; ++e) ss += f[e] * f[e];
    ss = wave_sum(ss, lane);
    const float rs = rsqrtf(ss * (1.0f / 1024.0f) + 1e-6f);
    asm volatile("s_waitcnt vmcnt(0)" ::: "memory");
#pragma unroll
    for (int i = 0; i < 2; ++i) { f32x4 o0, o1;
#pragma unroll
      for (int e = 0; e < 4; ++e) { o0[e] = f[i * 8 + e] * rs * g[2 * i][e]; o1[e] = f[i * 8 + 4 + e] * rs * g[2 * i + 1][e]; }
      *(f32x4*)(out + (size_t)r * 1024 + i * 512 + lane * 8) = o0; *(f32x4*)(out + (size_t)r * 1024 + i * 512 + lane * 8 + 4) = o1; }
  }
}
DI void final_norm_from_bf16(const bf16_t* xb, float* out, const float* gain, int nrows) {
  const int tid = tid_(), lane = tid & 63, gw = blockIdx.x * 8 + (tid >> 6), nw = gridDim.x * 8;
  f32x4 g[4];
#pragma unroll
  for (int i = 0; i < 2; ++i) { g[2 * i] = *(const f32x4*)(gain + i * 512 + lane * 8); g[2 * i + 1] = *(const f32x4*)(gain + i * 512 + lane * 8 + 4); }
  for (int r = gw * 2; r < nrows; r += nw * 2) {
    u32x4 v[2][2];
#pragma unroll
    for (int q = 0; q < 2; ++q)
#pragma unroll
      for (int i = 0; i < 2; ++i) v[q][i] = *(const u32x4*)(xb + (size_t)(r + q) * 1024 + i * 512 + lane * 8);
#pragma unroll
    for (int q = 0; q < 2; ++q) {
      float f[16];
#pragma unroll
      for (int i = 0; i < 2; ++i)
#pragma unroll
        for (int e = 0; e < 4; ++e) { f[i * 8 + 2 * e] = bf_lo(v[q][i][e]); f[i * 8 + 2 * e + 1] = bf_hi(v[q][i][e]); }
      float ss = 0.f;
#pragma unroll
      for (int e = 0; e < 16; ++e) ss += f[e] * f[e];
      ss = wave_sum(ss, lane);
      const float rs = rsqrtf(ss * (1.0f / 1024.0f) + 1e-6f);
#pragma unroll
      for (int i = 0; i < 2; ++i) { f32x4 o0, o1;
#pragma unroll
        for (int e = 0; e < 4; ++e) { o0[e] = f[i * 8 + e] * rs * g[2 * i][e]; o1[e] = f[i * 8 + 4 + e] * rs * g[2 * i + 1][e]; }
        *(f32x4*)(out + (size_t)(r + q) * 1024 + i * 512 + lane * 8) = o0; *(f32x4*)(out + (size_t)(r + q) * 1024 + i * 512 + lane * 8 + 4) = o1; }
    }
  }
}
DI void norm_rows_f32_inplace(float* x, const float* gain, int nrows) {
  const int tid = tid_(), lane = tid & 63, gw = blockIdx.x * 8 + (tid >> 6), nw = gridDim.x * 8;
  f32x4 g[4];
#pragma unroll
  for (int i = 0; i < 4; ++i) g[i] = *(const f32x4*)(gain + i * 256 + lane * 4);
  for (int r = gw * 2; r < nrows; r += nw * 2) {
    f32x4 v[2][4];
#pragma unroll
    for (int q = 0; q < 2; ++q)
#pragma unroll
      for (int i = 0; i < 4; ++i) v[q][i] = *(const f32x4*)(x + (size_t)(r + q) * 1024 + i * 256 + lane * 4);
#pragma unroll
    for (int q = 0; q < 2; ++q) {
      float ss = 0.f;
#pragma unroll
      for (int i = 0; i < 4; ++i) ss += v[q][i][0] * v[q][i][0] + v[q][i][1] * v[q][i][1] + v[q][i][2] * v[q][i][2] + v[q][i][3] * v[q][i][3];
      ss = wave_sum(ss, lane);
      const float rs = rsqrtf(ss * (1.0f / 1024.0f) + 1e-6f);
#pragma unroll
      for (int i = 0; i < 4; ++i) { f32x4 o; o[0] = v[q][i][0] * rs * g[i][0]; o[1] = v[q][i][1] * rs * g[i][1]; o[2] = v[q][i][2] * rs * g[i][2]; o[3] = v[q][i][3] * rs * g[i][3];
        *(f32x4*)(x + (size_t)(r + q) * 1024 + i * 256 + lane * 4) = o; }
    }
  }
}

DI int win_map(int n) { return n < 1536 ? n : (n < 9728 ? n + 16 : (n < 9744 ? n - 9728 + 1536 : -1)); }
DI void transpose_w(LAS unsigned char* sm, const float* src, int K, int Ns, bf16_t* dst, int Nd, int mapmode) {
  LAS float* tile = (LAS float*)sm;
  const int tid = tid_(), tn = Nd / 64, tk = K / 64;
  for (int t = blockIdx.x; t < tn * tk; t += gridDim.x) {
    const int n0 = (t / tk) * 64, k0 = (t % tk) * 64;
    float tv[8];
#pragma unroll
    for (int it = 0; it < 8; ++it) { const int idx = it * 512 + tid, kk = idx >> 6, nn = idx & 63;
      const int sc = mapmode ? win_map(n0 + nn) : (n0 + nn);
      tv[it] = sc >= 0 ? src[(size_t)(k0 + kk) * Ns + sc] : 0.f; }
#pragma unroll
    for (int it = 0; it < 8; ++it) { const int idx = it * 512 + tid, kk = idx >> 6, nn = idx & 63; tile[kk * 65 + nn] = tv[it]; }
    __syncthreads();
    { const int nn = tid >> 3, kc = tid & 7; float f[8];
#pragma unroll
      for (int e = 0; e < 8; ++e) f[e] = tile[(kc * 8 + e) * 65 + nn];
      u32x4 w; w.x = pk2(f[0], f[1]); w.y = pk2(f[2], f[3]); w.z = pk2(f[4], f[5]); w.w = pk2(f[6], f[7]);
      *(u32x4*)(dst + (size_t)(n0 + nn) * K + k0 + kc * 8) = w; }
    __syncthreads();
  }
}

DI void attn_task(LAS unsigned char* sm, int task, bf16_t* QA, const bf16_t* KA, const bf16_t* VA, float* LSE, bool dry) {
  const int tid = tid_(), lane = tid & 63, w = tid >> 6, li = lane & 15, quad = lane >> 4;
  const int bh = task >> 5, sub = task & 31;
  const int b = bh / 12, h = bh - b * 12, g = h >> 2, dsh = g * 2, dil = 1 << dsh, nblk = 32 >> dsh;
  const int r = sub / nblk, n = sub - r * nblk;
  LAS unsigned char* ks = sm;
  LAS unsigned char* vs = sm + 69632;
  {
    u32x4 kv[8], vv[8];
#pragma unroll
    for (int it = 0; it < 8; ++it) {
      const int id = it * 512 + tid, row = id >> 4, cc = id & 15, sp = n * 128 - 128 + row;
      kv[it] = (u32x4){0u, 0u, 0u, 0u};
      if (sp >= 0) kv[it] = *(const u32x4*)(KA + ((size_t)b * 4096 + (size_t)(sp * dil + r)) * 1536 + h * 128 + cc * 8);
    }
#pragma unroll
    for (int it = 0; it < 8; ++it) {
      const int id = it * 512 + tid, row = id >> 4, cc = id & 15, sp = n * 128 - 128 + row;
      vv[it] = (u32x4){0u, 0u, 0u, 0u};
      if (sp >= 0) vv[it] = *(const u32x4*)(VA + ((size_t)b * 4096 + (size_t)(sp * dil + r)) * 1536 + h * 128 + cc * 8);
    }
#pragma unroll
    for (int it = 0; it < 8; ++it) { const int id = it * 512 + tid, row = id >> 4, cc = id & 15; *(LAS u32x4*)(ks + row * 272 + cc * 16) = kv[it]; }
#pragma unroll
    for (int it = 0; it < 8; ++it) { const int id = it * 512 + tid, row = id >> 4, cc = id & 15; *(LAS u32x4*)(vs + row * 288 + cc * 16) = vv[it]; }
  }
  __syncthreads();
  const int qsp = n * 128 + w * 16 + li;
  const size_t qtok = (size_t)b * 4096 + (size_t)(qsp * dil + r);
  bf16_t* qptr = QA + qtok * 1536 + h * 128;
  bf16x8 qf[4];
#pragma unroll
  for (int kk = 0; kk < 4; ++kk) qf[kk] = *(const bf16x8*)(qptr + kk * 32 + quad * 8);
  const int kt0 = w < 6 ? w : 6;
  const float sc = 0.08838834764831845f * 1.4426950408889634f;
  const float sl = exp2f(-8.0f * (float)(h + 1) / 12.0f) * (float)dil * 1.4426950408889634f;
  float s[10][4]; float mx = -1e30f;
  const int wu = __builtin_amdgcn_readfirstlane(w);
#pragma unroll
  for (int tt = 0; tt < 10; ++tt) {
    const int kt = kt0 + tt; f32x4 acc = {0.f, 0.f, 0.f, 0.f};
    if ((tt == 9 && wu != 7) || (tt == 0 && wu == 7)) {
#pragma unroll
      for (int j = 0; j < 4; ++j) s[tt][j] = -1e30f;
      continue; }
#pragma unroll
    for (int kk = 0; kk < 4; ++kk) { const bf16x8 a = *(const LAS bf16x8*)(ks + (kt * 16 + li) * 272 + kk * 64 + quad * 16); acc = mfma16(a, qf[kk], acc); }
#pragma unroll
    for (int j = 0; j < 4; ++j) { const int kl = kt * 16 + quad * 4 + j, dist = 128 + w * 16 + li - kl;
      const bool valid = dist >= 0 && dist <= 128 && (n > 0 || kl >= 128);
      const float v = acc[j] * sc - sl * (float)dist; s[tt][j] = valid ? v : -1e30f; mx = fmaxf(mx, s[tt][j]); }
  }
  mx = fmaxf(mx, shx(mx, 16, lane)); mx = fmaxf(mx, shx(mx, 32, lane));
  float lsum = 0.f;
#pragma unroll
  for (int tt = 0; tt < 10; ++tt)
#pragma unroll
    for (int j = 0; j < 4; ++j) { const float p = __builtin_amdgcn_exp2f(s[tt][j] - mx); s[tt][j] = p; lsum += p; }
  lsum += shx(lsum, 16, lane); lsum += shx(lsum, 32, lane);
  bf16x8 pf[5];
#pragma unroll
  for (int pp = 0; pp < 5; ++pp) { u32x4 t; t.x = pk2(s[2 * pp][0], s[2 * pp][1]); t.y = pk2(s[2 * pp][2], s[2 * pp][3]); t.z = pk2(s[2 * pp + 1][0], s[2 * pp + 1][1]); t.w = pk2(s[2 * pp + 1][2], s[2 * pp + 1][3]); pf[pp] = mk8(t); }
  const float inv = 1.0f / lsum;
#pragma unroll
  for (int dvt = 0; dvt < 8; ++dvt) {
    f32x4 acc = {0.f, 0.f, 0.f, 0.f};
#pragma unroll
    for (int pp = 0; pp < 5; ++pp) { const int kA = (kt0 + 2 * pp) * 16 + quad * 4;
      LAS unsigned char* vp = vs + (kA + (li >> 2)) * 288 + dvt * 32 + (li & 3) * 8;
      const u32x2 lo = lds_tr16(vp), hi = lds_tr16(vp + 16 * 288);
      u32x4 t; t.x = lo.x; t.y = lo.y; t.z = hi.x; t.w = hi.y; acc = mfma16(mk8(t), pf[pp], acc); }
    u32x2 o; o.x = pk2(acc[0] * inv, acc[1] * inv); o.y = pk2(acc[2] * inv, acc[3] * inv);
    if (!dry) *(u32x2*)(qptr + dvt * 16 + quad * 4) = o;
  }
  if (quad == 0 && !dry) LSE[qtok * 12 + h] = (mx + log2f(lsum)) * 0.6931471805599453f;
  __syncthreads();
}

DI void attn_combine(const bf16_t* QA, bf16_t* YC, const float* LSE, bool dry, int bidx, int nblk) {
  const int nitem = MG * 4 * 16;
  int gs = nblk * NTHREADS; asm volatile("" : "+s"(gs));
  for (int it = bidx * NTHREADS + tid_(); it < nitem; it += gs) {
    const int t = it >> 6, hg = (it >> 4) & 3, dc = it & 15;
    const float l0 = LSE[(size_t)t * 12 + hg], l1 = LSE[(size_t)t * 12 + 4 + hg], l2 = LSE[(size_t)t * 12 + 8 + hg];
    const float m = fmaxf(l0, fmaxf(l1, l2));
    float w0 = __expf(l0 - m), w1 = __expf(l1 - m), w2 = __expf(l2 - m); const float iv = 1.0f / (w0 + w1 + w2); w0 *= iv; w1 *= iv; w2 *= iv;
    const bf16_t* p = QA + (size_t)t * 1536 + hg * 128 + dc * 8;
    const u32x4 a = *(const u32x4*)p, b = *(const u32x4*)(p + 512), c = *(const u32x4*)(p + 1024);
    u32x4 o;
#pragma unroll
    for (int e = 0; e < 4; ++e) o[e] = pk2(w0 * bf_lo(a[e]) + w1 * bf_lo(b[e]) + w2 * bf_lo(c[e]), w0 * bf_hi(a[e]) + w1 * bf_hi(b[e]) + w2 * bf_hi(c[e]));
    if (!dry) *(u32x4*)(YC + (size_t)t * 512 + hg * 128 + dc * 8) = o;
  }
}

DI void xattn_task(LAS unsigned char* sm, int task, bf16_t* XQ, const bf16_t* MKV, int l, bool dry) {
  const int tid = tid_(), lane = tid & 63, w = tid >> 6, li = lane & 15, quad = lane >> 4;
  const int b = task >> 7, hx = (task >> 5) & 3, n = task & 31;
  LAS unsigned char* vs = sm;
  {
    u32x4 kv[16];
#pragma unroll
    for (int it = 0; it < 16; ++it) { const int id = it * 512 + tid, row = id >> 5, cc = id & 31;
      kv[it] = *(const u32x4*)(MKV + (size_t)(b * 256 + row) * 4096 + l * 2048 + hx * 256 + cc * 8); }
#pragma unroll
    for (int it = 0; it < 16; ++it) { const int id = it * 512 + tid, row = id >> 5, cc = id & 31; *(LAS u32x4*)(sm + row * 528 + cc * 16) = kv[it]; }
  }
  __syncthreads();
  const size_t qtok = (size_t)b * 4096 + n * 128 + w * 16 + li;
  bf16_t* qptr = XQ + qtok * 1024 + hx * 256;
  bf16x8 qf[8];
#pragma unroll
  for (int kk = 0; kk < 8; ++kk) qf[kk] = *(const bf16x8*)(qptr + kk * 32 + quad * 8);
  float s[16][4]; float mx = -1e30f;
  const float sc = 0.0625f * 1.4426950408889634f;
#pragma unroll
  for (int kt = 0; kt < 16; ++kt) { f32x4 acc = {0.f, 0.f, 0.f, 0.f};
#pragma unroll
    for (int kk = 0; kk < 8; ++kk) { const bf16x8 a = *(const LAS bf16x8*)(sm + (kt * 16 + li) * 528 + kk * 64 + quad * 16); acc = mfma16(a, qf[kk], acc); }
#pragma unroll
    for (int j = 0; j < 4; ++j) { s[kt][j] = acc[j] * sc; mx = fmaxf(mx, s[kt][j]); } }
  mx = fmaxf(mx, shx(mx, 16, lane)); mx = fmaxf(mx, shx(mx, 32, lane));
  float lsum = 0.f;
#pragma unroll
  for (int kt = 0; kt < 16; ++kt)
#pragma unroll
    for (int j = 0; j < 4; ++j) { const float p = __builtin_amdgcn_exp2f(s[kt][j] - mx); s[kt][j] = p; lsum += p; }
  lsum += shx(lsum, 16, lane); lsum += shx(lsum, 32, lane);
  bf16x8 pf[8];
#pragma unroll
  for (int pp = 0; pp < 8; ++pp) { u32x4 t; t.x = pk2(s[2 * pp][0], s[2 * pp][1]); t.y = pk2(s[2 * pp][2], s[2 * pp][3]); t.z = pk2(s[2 * pp + 1][0], s[2 * pp + 1][1]); t.w = pk2(s[2 * pp + 1][2], s[2 * pp + 1][3]); pf[pp] = mk8(t); }
  const float inv = 1.0f / lsum;
  {
    u32x4 vv[16];
#pragma unroll
    for (int it = 0; it < 16; ++it) { const int id = it * 512 + tid, row = id >> 5, cc = id & 31;
      vv[it] = *(const u32x4*)(MKV + (size_t)(b * 256 + row) * 4096 + l * 2048 + 1024 + hx * 256 + cc * 8); }
    __syncthreads();
#pragma unroll
    for (int it = 0; it < 16; ++it) { const int id = it * 512 + tid, row = id >> 5, cc = id & 31; *(LAS u32x4*)(vs + row * 544 + cc * 16) = vv[it]; }
  }
  __syncthreads();
#pragma unroll
  for (int dvt = 0; dvt < 16; ++dvt) {
    f32x4 acc = {0.f, 0.f, 0.f, 0.f};
#pragma unroll
    for (int pp = 0; pp < 8; ++pp) { const int kA = 2 * pp * 16 + quad * 4;
      LAS unsigned char* vp = vs + (kA + (li >> 2)) * 544 + dvt * 32 + (li & 3) * 8;
      const u32x2 lo = lds_tr16(vp), hi = lds_tr16(vp + 16 * 544);
      u32x4 t; t.x = lo.x; t.y = lo.y; t.z = hi.x; t.w = hi.y; acc = mfma16(mk8(t), pf[pp], acc); }
    u32x2 o; o.x = pk2(acc[0] * inv, acc[1] * inv); o.y = pk2(acc[2] * inv, acc[3] * inv);
    if (!dry) *(u32x2*)(qptr + dvt * 16 + quad * 4) = o;
  }
  __syncthreads();
}

struct S5P { const float *a_re, *a_im, *log_step, *b_re, *b_im, *c_re, *c_im, *d; };
DI void s5_lambar(const S5P& P, int g, int p, float& lbr, float& lbi) {
  const float step = __expf(P.log_step[g]);
  const float ar = P.a_re[g * 64 + p], ai = P.a_im[g * 64 + p];
  const float mag = __expf(ar * step);
  float sn, cs; { const float x = ai * step; const float k = rintf(x * 0.15915494309189535f); float rr = fmaf(-k, 6.2831854820251465f, x); rr = fmaf(-k, -1.7484556000744883e-07f, rr); const float rev = rr * 0.15915494309189535f; sn = __builtin_amdgcn_sinf(rev); cs = __builtin_amdgcn_cosf(rev); }
  lbr = mag * cs; lbi = mag * sn;
}
DI void s5_carry_scan(const f32x2* E, f32x2* C, const S5P& P, bool dry) {
  const int total = BPG * 32 * 64;
  for (int gid = blockIdx.x * NTHREADS + tid_(); gid < total; gid += gridDim.x * NTHREADS) {
    const int p = gid & 63, g = (gid >> 6) & 31, b = gid >> 11;
    float lr_, li_; s5_lambar(P, g, p, lr_, li_);
#pragma unroll
    for (int q = 0; q < 6; ++q) { const float t0 = lr_ * lr_ - li_ * li_, t1 = 2.0f * lr_ * li_; lr_ = t0; li_ = t1; }
    const size_t base = (((size_t)b * 32 + g) * 64) * 64 + p;
    float sr = 0.f, si = 0.f;
    for (int c0 = 0; c0 < 64; c0 += 8) { f32x2 ev[8];
#pragma unroll
      for (int q = 0; q < 8; ++q) ev[q] = E[base + (size_t)(c0 + q) * 64];
#pragma unroll
      for (int q = 0; q < 8; ++q) { if (!dry) { f32x2 o = {sr, si}; C[base + (size_t)(c0 + q) * 64] = o; }
        const float t0 = lr_ * sr - li_ * si + ev[q][0], t1 = lr_ * si + li_ * sr + ev[q][1]; sr = t0; si = t1; } }
  }
}
DI float bperm(float v, int srclane) { return __builtin_bit_cast(float, __builtin_amdgcn_ds_bpermute(srclane << 2, __builtin_bit_cast(int, v))); }
DI void s5_task(LAS unsigned char* sm, int task, int mode, bf16_t* U, f32x2* E, const S5P& P, bool dry) {
  const int tid = tid_(), lane = tid & 63, w = tid >> 6, li = lane & 15, quad = lane >> 4;
  const int b = task >> 8, c = (task >> 2) & 63, oct = task & 3;
  const size_t row0 = (size_t)b * 4096 + c * 64;
  { u32x4 v[2];
#pragma unroll
    for (int it = 0; it < 2; ++it) { const int id = it * 512 + tid, t = id >> 4, cc = id & 15; v[it] = *(const u32x4*)(U + (row0 + t) * 512 + oct * 128 + cc * 8); }
#pragma unroll
    for (int it = 0; it < 2; ++it) { const int id = it * 512 + tid, t = id >> 4, cc = id & 15; *(LAS u32x4*)(sm + t * 272 + cc * 16) = v[it]; } }
  __syncthreads();
  const int g = oct * 8 + w;
  float l1r[4], l1i[4], l2r[4], l2i[4], l3r[4], l3i[4], l4r[4], l4i[4], spr[4], spi[4];
  bf16x8 Bre[4], Bim[4];
#pragma unroll
  for (int pb = 0; pb < 4; ++pb) {
    const int p = pb * 16 + li;
    float lr, lim; s5_lambar(P, g, p, lr, lim);
    const float ar = P.a_re[g * 64 + p], ai = P.a_im[g * 64 + p];
    const float iv = 1.0f / (ar * ar + ai * ai), nr = lr - 1.0f, ni = lim;
    const float cr = (nr * ar + ni * ai) * iv, ci = (ni * ar - nr * ai) * iv;
    u32x4 tre = {0u, 0u, 0u, 0u}, tim = {0u, 0u, 0u, 0u};
    if (quad < 2) {
      const float* pr = P.b_re + ((size_t)g * 64 + p) * 16 + quad * 8; const float* pi = P.b_im + ((size_t)g * 64 + p) * 16 + quad * 8;
      const f32x4 br0 = *(const f32x4*)pr, br1 = *(const f32x4*)(pr + 4), bi0 = *(const f32x4*)pi, bi1 = *(const f32x4*)(pi + 4);
      tre.x = pk2(cr * br0[0] - ci * bi0[0], cr * br0[1] - ci * bi0[1]); tre.y = pk2(cr * br0[2] - ci * bi0[2], cr * br0[3] - ci * bi0[3]);
      tre.z = pk2(cr * br1[0] - ci * bi1[0], cr * br1[1] - ci * bi1[1]); tre.w = pk2(cr * br1[2] - ci * bi1[2], cr * br1[3] - ci * bi1[3]);
      tim.x = pk2(cr * bi0[0] + ci * br0[0], cr * bi0[1] + ci * br0[1]); tim.y = pk2(cr * bi0[2] + ci * br0[2], cr * bi0[3] + ci * br0[3]);
      tim.z = pk2(cr * bi1[0] + ci * br1[0], cr * bi1[1] + ci * br1[1]); tim.w = pk2(cr * bi1[2] + ci * br1[2], cr * bi1[3] + ci * br1[3]);
    }
    Bre[pb] = mk8(tre); Bim[pb] = mk8(tim);
    l1r[pb] = lr; l1i[pb] = lim;
    l2r[pb] = lr * lr - lim * lim; l2i[pb] = 2.0f * lr * lim;
    l3r[pb] = l2r[pb] * lr - l2i[pb] * lim; l3i[pb] = l2r[pb] * lim + l2i[pb] * lr;
    l4r[pb] = l2r[pb] * l2r[pb] - l2i[pb] * l2i[pb]; l4i[pb] = 2.0f * l2r[pb] * l2i[pb];
    spr[pb] = 0.f; spi[pb] = 0.f;
    if (mode == 1) { const f32x2 e = E[(((size_t)b * 32 + g) * 64 + c) * 64 + p]; spr[pb] = e[0]; spi[pb] = e[1]; }
  }
  bf16x8 cm[4]; f32x4 dsk = {0.f, 0.f, 0.f, 0.f};
  LAS unsigned char* ss = sm + 17408 + w * 4352;
  if (mode == 1) {
#pragma unroll
    for (int kk = 0; kk < 4; ++kk) { const int p0 = kk * 16 + quad * 4;
      const f32x4 cr4 = *(const f32x4*)(P.c_re + ((size_t)g * 16 + li) * 64 + p0), ci4 = *(const f32x4*)(P.c_im + ((size_t)g * 16 + li) * 64 + p0);
      u32x4 t; t.x = pk2(cr4[0], -ci4[0]); t.y = pk2(cr4[1], -ci4[1]); t.z = pk2(cr4[2], -ci4[2]); t.w = pk2(cr4[3], -ci4[3]); cm[kk] = mk8(t); }
    dsk = *(const f32x4*)(P.d + g * 16 + quad * 4);
  }
  const int src_up = (lane - 16) & 63, src_q3 = 48 + li;
  for (int sb = 0; sb < 4; ++sb) {
    u32x4 araw = {0u, 0u, 0u, 0u};
    if (quad < 2) araw = *(const LAS u32x4*)(sm + (sb * 16 + li) * 272 + (w * 16 + quad * 8) * 2);
    const bf16x8 a = mk8(araw);
#pragma unroll
    for (int pb = 0; pb < 4; ++pb) {
      const f32x4 z4 = {0.f, 0.f, 0.f, 0.f};
      const f32x4 are = mfma16(a, Bre[pb], z4), aim = mfma16(a, Bim[pb], z4);
      float s0r = are[0], s0i = aim[0];
      float s1r = l1r[pb] * s0r - l1i[pb] * s0i + are[1], s1i = l1r[pb] * s0i + l1i[pb] * s0r + aim[1];
      float s2r = l1r[pb] * s1r - l1i[pb] * s1i + are[2], s2i = l1r[pb] * s1i + l1i[pb] * s1r + aim[2];
      float s3r = l1r[pb] * s2r - l1i[pb] * s2i + are[3], s3i = l1r[pb] * s2i + l1i[pb] * s2r + aim[3];
      float cr_ = (quad == 0) ? spr[pb] : 0.f, ci_ = (quad == 0) ? spi[pb] : 0.f;
#pragma unroll
      for (int r = 0; r < 3; ++r) {
        const float er = l4r[pb] * cr_ - l4i[pb] * ci_ + s3r, ei = l4r[pb] * ci_ + l4i[pb] * cr_ + s3i;
        const float gr = bperm(er, src_up), gi = bperm(ei, src_up);
        if (quad == r + 1) { cr_ = gr; ci_ = gi; }
      }
      s0r += l1r[pb] * cr_ - l1i[pb] * ci_; s0i += l1r[pb] * ci_ + l1i[pb] * cr_;
      s1r += l2r[pb] * cr_ - l2i[pb] * ci_; s1i += l2r[pb] * ci_ + l2i[pb] * cr_;
      s2r += l3r[pb] * cr_ - l3i[pb] * ci_; s2i += l3r[pb] * ci_ + l3i[pb] * cr_;
      s3r += l4r[pb] * cr_ - l4i[pb] * ci_; s3i += l4r[pb] * ci_ + l4i[pb] * cr_;
      spr[pb] = bperm(s3r, src_q3); spi[pb] = bperm(s3i, src_q3);
      if (mode == 1) { LAS unsigned char* q = ss + (quad * 4) * 272 + (pb * 16 + li) * 4;
        *(LAS unsigned*)(q) = pk2(s0r, s0i); *(LAS unsigned*)(q + 272) = pk2(s1r, s1i); *(LAS unsigned*)(q + 544) = pk2(s2r, s2i); *(LAS unsigned*)(q + 816) = pk2(s3r, s3i); }
    }
    if (mode == 1) {
      asm volatile("s_waitcnt lgkmcnt(0)" ::: "memory");
      f32x4 acc = {0.f, 0.f, 0.f, 0.f};
#pragma unroll
      for (int kk = 0; kk < 4; ++kk) { const bf16x8 bq = *(const LAS bf16x8*)(ss + li * 272 + kk * 64 + quad * 16); acc = mfma16(cm[kk], bq, acc); }
      const u32x2 uq = *(const LAS u32x2*)(sm + (sb * 16 + li) * 272 + (w * 16 + quad * 4) * 2);
      const float u4[4] = {bf_lo(uq.x), bf_hi(uq.x), bf_lo(uq.y), bf_hi(uq.y)};
      float o[4];
#pragma unroll
      for (int j = 0; j < 4; ++j) { const float y = acc[j] + dsk[j] * u4[j]; const float z = 0.7978845608028654f * (y + 0.044715f * y * y * y);
        const float th = 1.0f - 2.0f * __builtin_amdgcn_rcpf(__expf(2.0f * z) + 1.0f); o[j] = 0.5f * y * (1.0f + th); }
      asm volatile("s_waitcnt lgkmcnt(0)" ::: "memory");
      u32x2 ov; ov.x = pk2(o[0], o[1]); ov.y = pk2(o[2], o[3]);
      if (!dry) *(u32x2*)(U + (row0 + sb * 16 + li) * 512 + g * 16 + quad * 4) = ov;
    }
  }
  if (mode == 0 && !dry && quad == 0) {
#pragma unroll
    for (int pb = 0; pb < 4; ++pb) { f32x2 e = {spr[pb], spi[pb]}; E[(((size_t)b * 32 + g) * 64 + c) * 64 + pb * 16 + li] = e; }
  }
  __syncthreads();
}

struct GLAP { const float *wg, *bg, *gout; };
constexpr int GL_LR = 0;
constexpr int GL_WG = 4096;
constexpr int GL_BS = 8192;
constexpr int GL_Q = 24832;
constexpr int GL_K = 34048;
constexpr int GL_VT = 43264;
constexpr int GL_ST = 61696;
constexpr int GL_RED = 80128;
constexpr int GL_SEG = 80640;
DI void gla_cumdecay(LAS unsigned char* sm, const bf16_t* LR, size_t row0, int h, const GLAP& P) {
  const int tid = tid_();
  LAS float* lrs = (LAS float*)(sm + GL_LR); LAS float* bs = (LAS float*)(sm + GL_BS); LAS float* segs = (LAS float*)(sm + GL_SEG);
  const int dk = tid & 63, seg = tid >> 6, t0 = seg * 8;
  u32x4 lrv = {0u, 0u, 0u, 0u};
  if (tid < 128) lrv = *(const u32x4*)(LR + (row0 + (tid >> 1)) * 256 + (tid & 1) * 8);
  float wcol[16];
#pragma unroll
  for (int rr = 0; rr < 16; ++rr) wcol[rr] = P.wg[rr * 256 + h * 64 + dk];
  const float bias = P.bg[h * 64 + dk];
  if (tid < 128) { const int t = tid >> 1, hf = tid & 1;
    f32x4 f0 = {bf_lo(lrv.x), bf_hi(lrv.x), bf_lo(lrv.y), bf_hi(lrv.y)}, f1 = {bf_lo(lrv.z), bf_hi(lrv.z), bf_lo(lrv.w), bf_hi(lrv.w)};
    *(LAS f32x4*)(lrs + t * 16 + hf * 8) = f0; *(LAS f32x4*)(lrs + t * 16 + hf * 8 + 4) = f1; }
  __syncthreads();
  float la[8]; float run = 0.f;
#pragma unroll
  for (int e = 0; e < 8; ++e) { float z = bias;
#pragma unroll
    for (int q4 = 0; q4 < 4; ++q4) { const f32x4 r4 = *(const LAS f32x4*)(lrs + (t0 + e) * 16 + q4 * 4);
      z = fmaf(r4[0], wcol[q4 * 4], z); z = fmaf(r4[1], wcol[q4 * 4 + 1], z); z = fmaf(r4[2], wcol[q4 * 4 + 2], z); z = fmaf(r4[3], wcol[q4 * 4 + 3], z); }
    const float ls = fminf(z, 0.f) - __logf(1.0f + __expf(-fabsf(z)));
    run += ls * 0.0625f; la[e] = run; }
  segs[seg * 64 + dk] = run;
  __syncthreads();
  float off = 0.f;
#pragma unroll
  for (int s2 = 0; s2 < 7; ++s2) off += (s2 < seg) ? segs[s2 * 64 + dk] : 0.f;
#pragma unroll
  for (int e = 0; e < 8; ++e) bs[(t0 + e) * 65 + dk] = la[e] + off;
  __syncthreads();
}
DI void gla_stage_vt(LAS unsigned char* sm, const bf16_t* VG, size_t row0, int h) {
  LAS unsigned short* vt = (LAS unsigned short*)(sm + GL_VT);
#pragma unroll
  for (int it = 0; it < 2; ++it) { const int id = it * 512 + tid_(), t = id & 63, cc = id >> 6;
    const u32x4 v = *(const u32x4*)(VG + (row0 + t) * 512 + h * 128 + cc * 8);
#pragma unroll
    for (int e = 0; e < 4; ++e) { vt[(cc * 8 + 2 * e) * 72 + t] = (unsigned short)(v[e] & 0xffffu); vt[(cc * 8 + 2 * e + 1) * 72 + t] = (unsigned short)(v[e] >> 16); } }
}
DI void gla_a_task(LAS unsigned char* sm, int task, const bf16_t* QK, const bf16_t* VG, const bf16_t* LR, bf16_t* GST, float* GDEC, const GLAP& P, bool dry) {
  const int tid = tid_(), lane = tid & 63, w = tid >> 6, li = lane & 15, quad = lane >> 4;
  const int bh = task >> 6, c = task & 63, b = bh >> 2, h = bh & 3;
  const size_t row0 = (size_t)b * 4096 + c * 64;
  gla_cumdecay(sm, LR, row0, h, P);
  LAS float* bs = (LAS float*)(sm + GL_BS);
  LAS unsigned short* kht = (LAS unsigned short*)(sm + GL_Q);
  { const int t = tid & 63, dkc = tid >> 6; const u32x4 v = *(const u32x4*)(QK + (row0 + t) * 512 + 256 + h * 64 + dkc * 8);
#pragma unroll
    for (int e = 0; e < 4; ++e) { const int d0 = dkc * 8 + 2 * e;
      const float k0 = bf_lo(v[e]) * __expf(bs[63 * 65 + d0] - bs[t * 65 + d0]), k1 = bf_hi(v[e]) * __expf(bs[63 * 65 + d0 + 1] - bs[t * 65 + d0 + 1]);
      const unsigned pk = pk2(k0, k1); kht[d0 * 72 + t] = (unsigned short)(pk & 0xffffu); kht[(d0 + 1) * 72 + t] = (unsigned short)(pk >> 16); } }
  gla_stage_vt(sm, VG, row0, h);
  if (tid < 64 && !dry) GDEC[(size_t)task * 64 + tid] = __expf(bs[63 * 65 + tid]);
  __syncthreads();
  LAS unsigned short* vt = (LAS unsigned short*)(sm + GL_VT);
#pragma unroll
  for (int dkt = 0; dkt < 4; ++dkt) { f32x4 acc = {0.f, 0.f, 0.f, 0.f};
#pragma unroll
    for (int kk = 0; kk < 2; ++kk) { const bf16x8 a = *(const LAS bf16x8*)(vt + (w * 16 + li) * 72 + kk * 32 + quad * 8), bq = *(const LAS bf16x8*)(kht + (dkt * 16 + li) * 72 + kk * 32 + quad * 8); acc = mfma16(a, bq, acc); }
#pragma unroll
    for (int j = 0; j < 4; ++j) if (!dry) GST[((size_t)task * 128 + w * 16 + quad * 4 + j) * 64 + dkt * 16 + li] = (bf16_t)(pk2(acc[j], 0.f) & 0xffffu); }
  __syncthreads();
}
DI void gla_prefix(const bf16_t* GST, bf16_t* GSO, const float* GDEC, bool dry) {
  const int total = BPG * 4 * 8192;
  for (int gid = blockIdx.x * NTHREADS + tid_(); gid < total; gid += gridDim.x * NTHREADS) {
    const int bh = gid >> 13, e = gid & 8191, dk = e & 63; float S = 0.f;
    for (int c0 = 0; c0 < 64; c0 += 16) { float tv[16], dv[16];
#pragma unroll
      for (int q = 0; q < 16; ++q) { tv[q] = __uint_as_float((unsigned)GST[((size_t)(bh * 64 + c0 + q)) * 8192 + e] << 16); dv[q] = GDEC[(size_t)(bh * 64 + c0 + q) * 64 + dk]; }
#pragma unroll
      for (int q = 0; q < 16; ++q) { if (!dry) GSO[((size_t)(bh * 64 + c0 + q)) * 8192 + e] = (bf16_t)(pk2(S, 0.f) & 0xffffu); S = fmaf(dv[q], S, tv[q]); } }
  }
}
DI void gla_c_task(LAS unsigned char* sm, int task, const bf16_t* QK, bf16_t* VG, const bf16_t* LR, const bf16_t* R, const bf16_t* GST, const GLAP& P, bool dry) {
  const int tid = tid_(), lane = tid & 63, w = tid >> 6, li = lane & 15, quad = lane >> 4;
  const int bh = task >> 6, c = task & 63, b = bh >> 2, h = bh & 3;
  const size_t row0 = (size_t)b * 4096 + c * 64;
  gla_cumdecay(sm, LR, row0, h, P);
  LAS float* bs = (LAS float*)(sm + GL_BS);
  LAS unsigned short* qs = (LAS unsigned short*)(sm + GL_Q); LAS unsigned short* ksm = (LAS unsigned short*)(sm + GL_K);
  LAS unsigned short* vt = (LAS unsigned short*)(sm + GL_VT); LAS unsigned short* st = (LAS unsigned short*)(sm + GL_ST); LAS float* red = (LAS float*)(sm + GL_RED);
  { const int t = tid >> 3, ch = tid & 7;
    const u32x4 qv = *(const u32x4*)(QK + (row0 + t) * 512 + h * 64 + ch * 8), kv = *(const u32x4*)(QK + (row0 + t) * 512 + 256 + h * 64 + ch * 8);
    u32x4 qo, ko;
#pragma unroll
    for (int e = 0; e < 4; ++e) { const int d0 = ch * 8 + 2 * e; const float b0 = bs[t * 65 + d0], b1 = bs[t * 65 + d0 + 1];
      qo[e] = pk2(bf_lo(qv[e]) * 0.125f * __expf(b0), bf_hi(qv[e]) * 0.125f * __expf(b1));
      ko[e] = pk2(bf_lo(kv[e]) * __expf(-b0), bf_hi(kv[e]) * __expf(-b1)); }
    *(LAS u32x4*)(qs + t * 72 + ch * 8) = qo; *(LAS u32x4*)(ksm + t * 72 + ch * 8) = ko; }
  gla_stage_vt(sm, VG, row0, h);
#pragma unroll
  for (int it = 0; it < 2; ++it) { const int id = it * 512 + tid, dv = id >> 3, c8 = id & 7;
    const u32x4 v = *(const u32x4*)(GST + ((size_t)task * 128 + dv) * 64 + c8 * 8);
    *(LAS u32x4*)(st + dv * 72 + c8 * 8) = v; }
  __syncthreads();
  const int qt = w & 3, dvh = w >> 2;
  bf16x8 qf[2];
#pragma unroll
  for (int kk = 0; kk < 2; ++kk) qf[kk] = *(const LAS bf16x8*)(qs + (qt * 16 + li) * 72 + kk * 32 + quad * 8);
  float s[4][4];
#pragma unroll
  for (int jt = 0; jt < 4; ++jt) { f32x4 acc = {0.f, 0.f, 0.f, 0.f};
#pragma unroll
    for (int kk = 0; kk < 2; ++kk) { const bf16x8 a = *(const LAS bf16x8*)(ksm + (jt * 16 + li) * 72 + kk * 32 + quad * 8); acc = mfma16(a, qf[kk], acc); }
#pragma unroll
    for (int j = 0; j < 4; ++j) { const int kj = jt * 16 + quad * 4 + j, qi = qt * 16 + li; s[jt][j] = (kj <= qi) ? acc[j] : 0.f; } }
  bf16x8 pf[2];
#pragma unroll
  for (int pp = 0; pp < 2; ++pp) { u32x4 t; t.x = pk2(s[2 * pp][0], s[2 * pp][1]); t.y = pk2(s[2 * pp][2], s[2 * pp][3]); t.z = pk2(s[2 * pp + 1][0], s[2 * pp + 1][1]); t.w = pk2(s[2 * pp + 1][2], s[2 * pp + 1][3]); pf[pp] = mk8(t); }
  f32x4 o[4]; float ssq = 0.f;
#pragma unroll
  for (int dvt = 0; dvt < 4; ++dvt) { const int dv0 = dvh * 64 + dvt * 16; f32x4 acc = {0.f, 0.f, 0.f, 0.f};
#pragma unroll
    for (int pp = 0; pp < 2; ++pp) { const int kA = 2 * pp * 16 + quad * 4;
      const u32x2 lo = *(const LAS u32x2*)(vt + (dv0 + li) * 72 + kA), hi = *(const LAS u32x2*)(vt + (dv0 + li) * 72 + kA + 16);
      u32x4 t; t.x = lo.x; t.y = lo.y; t.z = hi.x; t.w = hi.y; acc = mfma16(mk8(t), pf[pp], acc); }
#pragma unroll
    for (int kk = 0; kk < 2; ++kk) { const bf16x8 a = *(const LAS bf16x8*)(st + (dv0 + li) * 72 + kk * 32 + quad * 8); acc = mfma16(a, qf[kk], acc); }
    o[dvt] = acc; ssq += acc[0] * acc[0] + acc[1] * acc[1] + acc[2] * acc[2] + acc[3] * acc[3]; }
  ssq += shx(ssq, 16, lane); ssq += shx(ssq, 32, lane);
  if (quad == 0) red[dvh * 64 + qt * 16 + li] = ssq;
  __syncthreads();
  const float tot = red[qt * 16 + li] + red[64 + qt * 16 + li];
  const float rs = rsqrtf(tot * (1.0f / 128.0f) + 1e-6f);
  const size_t row = row0 + qt * 16 + li;
#pragma unroll
  for (int dvt = 0; dvt < 4; ++dvt) { const int dv = dvh * 64 + dvt * 16 + quad * 4;
    const f32x4 gg = *(const f32x4*)(P.gout + dv); const u32x2 rv = *(const u32x2*)(R + row * 512 + h * 128 + dv);
    const float r4[4] = {bf_lo(rv.x), bf_hi(rv.x), bf_lo(rv.y), bf_hi(rv.y)}; float y[4];
#pragma unroll
    for (int j = 0; j < 4; ++j) y[j] = o[dvt][j] * rs * gg[j] * (r4[j] * sigmoidf_(r4[j]));
    u32x2 ov; ov.x = pk2(y[0], y[1]); ov.y = pk2(y[2], y[3]); if (!dry) *(u32x2*)(VG + row * 512 + h * 128 + dv) = ov; }
  __syncthreads();
}

#define XB_TMO      128
#define XB_XCNT(j)  (256  + 64 * (j))
#define XB_XSUB(j)  (1280 + 64 * (j))
#define XB_XGEN(j)  (2304 + 64 * (j))
#define XB_TOP      3328
#define XB_TOPGEN   3392
#define XCD_BAR_WORDS 3456
#define XB_SPIN_CAP (1u << 18)
DI unsigned xb_ld(unsigned* p)              { return __hip_atomic_load(p, __ATOMIC_RELAXED, __HIP_MEMORY_SCOPE_AGENT); }
DI unsigned xb_add(unsigned* p, unsigned v) { return __hip_atomic_fetch_add(p, v, __ATOMIC_RELAXED, __HIP_MEMORY_SCOPE_AGENT); }
DI unsigned xb_xcc_id() { return (unsigned)__builtin_amdgcn_s_getreg((3 << 11) | 20) & 0xFu; }
#define XB_SPIN(cond, bar) do { unsigned _sp = 0; while (cond) { __builtin_amdgcn_s_sleep(1); \
    if ((++_sp & 255u) == 0u) { if (xb_ld(&(bar)[XB_TMO])) break; if (_sp > XB_SPIN_CAP) { atomicAdd(&(bar)[XB_TMO], 1u); break; } } } } while (0)
struct XcdBarrier { unsigned* bar; unsigned x; volatile LAS unsigned* st; };
DI XcdBarrier xcd_barrier_post(unsigned* bar, volatile LAS unsigned* st) {
  XcdBarrier b; b.bar = bar; b.x = xb_xcc_id(); b.st = st;
  if (threadIdx.x == 0) (void)xb_add(&bar[XB_XCNT(b.x)], 1u);
  return b;
}
DI void xcd_barrier_complete(unsigned* bar, unsigned x, unsigned& nloc, unsigned& nx) {
  asm volatile("" : "+s"(bar));
  const unsigned G = gridDim.x * gridDim.y * gridDim.z;
  unsigned sum, cnt, mine, sp = 0u;
  for (;;) {
    sum = 0u; cnt = 0u; mine = 0u;
#pragma unroll
    for (unsigned j = 0; j < 16; ++j) { const unsigned c = xb_ld(&bar[XB_XCNT(j)]); sum += c; cnt += (c > 0u) ? 1u : 0u; mine = (j == x) ? c : mine; }
    if (sum == G) break;
    __builtin_amdgcn_s_sleep(1);
    if ((++sp & 255u) == 0u) { if (xb_ld(&bar[XB_TMO])) break; if (sp > XB_SPIN_CAP) { atomicAdd(&bar[XB_TMO], 1u); break; } }
  }
  nloc = mine > 0u ? mine : 1u; nx = cnt > 0u ? cnt : 1u;
}
DI void xcd_barrier(const XcdBarrier& b) {
  asm volatile("s_waitcnt vmcnt(0)" ::: "memory");
  __syncthreads();
  if (threadIdx.x == 0) {
    unsigned* bar = b.bar; asm volatile("" : "+s"(bar));
    __builtin_amdgcn_s_waitcnt(0);
    unsigned nloc = b.st[0], nx = b.st[1];
    if (nloc == 0u) { xcd_barrier_complete(bar, b.x, nloc, nx); b.st[0] = nloc; b.st[1] = nx; }
    const unsigned old = xb_add(&bar[XB_XSUB(b.x)], 1u);
    const unsigned gen = old / nloc;
    if (old + 1u == (gen + 1u) * nloc) {
      __builtin_amdgcn_fence(__ATOMIC_RELEASE, "agent");
      asm volatile("s_waitcnt vmcnt(0)" ::: "memory");
      const unsigned og = xb_add(&bar[XB_TOP], 1u);
      const unsigned tg = og / nx;
      if (og + 1u == (tg + 1u) * nx) xb_add(&bar[XB_TOPGEN], 1u);
      else XB_SPIN(xb_ld(&bar[XB_TOPGEN]) == tg, bar);
      __builtin_amdgcn_fence(__ATOMIC_ACQUIRE, "agent");
      xb_add(&bar[XB_XGEN(b.x)], 1u);
      asm volatile("s_waitcnt vmcnt(0)" ::: "memory");
    } else {
      XB_SPIN(xb_ld(&bar[XB_XGEN(b.x)]) == gen, bar);
      __builtin_amdgcn_fence(__ATOMIC_ACQUIRE, "agent");
      asm volatile("s_waitcnt vmcnt(0)" ::: "memory");
    }
  }
  __syncthreads();
}

struct Args { const float* in[28]; float* out; unsigned char* ws; int ph_lo, ph_hi; };
constexpr int NPH = 1 + DEPTH * 23 + 1;

__global__ void __launch_bounds__(NTHREADS, 2) mega(Args A) {
  extern __shared__ __attribute__((aligned(16))) unsigned char lds_raw[];
  LAS unsigned char* sm = (LAS unsigned char*)lds_raw;
  cg::grid_group grid = cg::this_grid();
  const int G = gridDim.x, bid = blockIdx.x;
  volatile LAS unsigned* xst = (volatile LAS unsigned*)(sm + LDS_BYTES - 16);
  if (threadIdx.x < 4) xst[threadIdx.x] = 0u;
  __syncthreads();
  XcdBarrier xbar; xbar.bar = (unsigned*)(A.ws + WS_BAR); xbar.x = 0; xbar.st = xst;
  if (A.ph_hi - A.ph_lo > 1) xbar = xcd_barrier_post((unsigned*)(A.ws + WS_BAR), xst);
#ifdef PROBE_A
  unsigned long long tA = 0, tB = 0, tprev = wall_clock64();
#endif

  for (int ph = A.ph_lo; ph < A.ph_hi; ++ph) {
    size_t zo; asm volatile("s_mov_b64 %0, 0" : "=s"(zo));
    unsigned char* ws = A.ws + zo;
    const float* x_in = A.in[0] + zo;
    float* xo = A.out + zo;
    bf16_t* XB = (bf16_t*)(ws + WS_H);
    bf16_t* H = (bf16_t*)xo; bf16_t* PB = (bf16_t*)(ws + WS_P);
    bf16_t* MEMN = (bf16_t*)(ws + WS_MEMN); bf16_t* MKV = (bf16_t*)(ws + WS_MEMKV);
    float* LSE = (float*)(ws + WS_LSE); f32x2* S5E = (f32x2*)(ws + WS_S5E); f32x2* S5C = (f32x2*)(ws + WS_S5C); float* GDEC = (float*)(ws + WS_GDEC); bf16_t* GST = (bf16_t*)((unsigned char*)xo + (size_t)MTOK * 1024 * 2); bf16_t* GSO = GST + (size_t)BPG * 4 * 64 * 8192;
#define IN(i) (A.in[i] + zo)
    int kind, l = 0, grp = 0;
    if (ph == 0) kind = 0; else if (ph == NPH - 1) kind = 17;
    else { const int q = ph - 1; l = q / 23; const int k = q % 23; if (k < 16) { grp = k >> 3; kind = 2 + (k & 7); } else kind = 10 + (k - 16); }
    const float* xsrc = (l == 0) ? x_in : xo;
#ifdef PROBE_REPEAT_MASK
    const int ndry = (int)((PROBE_REPEAT_MASK >> kind) & 1);
#else
    const int ndry = 0;
#endif
    for (int dryi = ndry; dryi >= 0; --dryi) {
    const bool dry = dryi != 0;
    bool isgemm = false; int nrep = 1;
    const int vb = ((G & 7) == 0) ? (bid & 7) * (G >> 3) + (bid >> 3) : bid;
    switch (kind) {
      case 0: {
        for (int ll = 0; ll < DEPTH; ++ll) {
          transpose_w(sm, IN(3) + (size_t)ll * 1024 * 9744, 1024, 9744, (bf16_t*)(ws + WS_WIN) + (size_t)ll * DINP * 1024, DINP, 1);
          transpose_w(sm, IN(12) + (size_t)ll * 512 * 512, 512, 512, (bf16_t*)(ws + WS_WGLU) + (size_t)ll * 512 * 512, 512, 0);
          for (int n = 0; n < 3; ++n) transpose_w(sm, IN(17) + ((size_t)ll * 3 + n) * 512 * 1024, 512, 1024, (bf16_t*)(ws + WS_WBR) + ((size_t)ll * 3 + n) * 1024 * 512, 1024, 0);
          transpose_w(sm, IN(18) + (size_t)ll * 1024 * 1024, 1024, 1024, (bf16_t*)(ws + WS_WOUT) + (size_t)ll * 1024 * 1024, 1024, 0);
          transpose_w(sm, IN(21) + (size_t)ll * 1024 * 1024, 1024, 1024, (bf16_t*)(ws + WS_WXQ) + (size_t)ll * 1024 * 1024, 1024, 0);
          transpose_w(sm, IN(23) + (size_t)ll * 1024 * 1024, 1024, 1024, (bf16_t*)(ws + WS_WXO) + (size_t)ll * 1024 * 1024, 1024, 0);
          transpose_w(sm, IN(22) + (size_t)ll * 1024 * 2048, 1024, 2048, (bf16_t*)(ws + WS_WXKV) + (size_t)ll * 2048 * 1024, 2048, 0);
          transpose_w(sm, IN(25) + (size_t)ll * 1024 * 4096, 1024, 4096, (bf16_t*)(ws + WS_WUP) + (size_t)ll * 4096 * 1024, 4096, 0);
          transpose_w(sm, IN(26) + (size_t)ll * 4096 * 1024, 4096, 1024, (bf16_t*)(ws + WS_WDN) + (size_t)ll * 1024 * 4096, 1024, 0);
        }
        norm_rows_bf16(IN(1), IN(19), MEMN, 2048);
      } break;
      case 3: isgemm = true; nrep = (l == 0 && grp == 0) ? 2 : 1; break;
      case 7: case 8: case 9: case 11: case 13: case 15: case 16: isgemm = true; break;
      case 2: if (l == 0) norm_rows_bf16(x_in + (size_t)grp * MG * 1024, IN(2) + l * 1024, H, MG); else norm_rows_from_bf16(XB + (size_t)grp * MG * 1024, 1024, IN(2) + l * 1024, H, MG); break;
      case 4: {
        S5P sp{IN(4) + l * 2048, IN(5) + l * 2048, IN(6) + l * 32, IN(7) + (size_t)l * 32768, IN(8) + (size_t)l * 32768, IN(9) + (size_t)l * 32768, IN(10) + (size_t)l * 32768, IN(11) + l * 512};
        GLAP gp{IN(14) + l * 4096, IN(15) + l * 256, IN(16) + l * 128};
        constexpr int NA = BPG * 12 * 32, NS = BPG * 256, NGL = BPG * 4 * 64;
        for (int t = vb; t < NA + NS + NGL; t += G) {
          if (t < NA) attn_task(sm, t, PB + P_QA, PB + P_KA, PB + P_VA, LSE, dry);
          else if (t < NA + NS) s5_task(sm, t - NA, 0, PB + P_U, S5E, sp, dry);
          else gla_a_task(sm, t - NA - NS, PB + P_QK, PB + P_VG, PB + P_LR, GST, GDEC, gp, dry);
        }
      } break;
      case 5: { gla_prefix(GST, GSO, GDEC, dry);
        S5P sp{IN(4) + l * 2048, IN(5) + l * 2048, IN(6) + l * 32, IN(7) + (size_t)l * 32768, IN(8) + (size_t)l * 32768, IN(9) + (size_t)l * 32768, IN(10) + (size_t)l * 32768, IN(11) + l * 512};
        s5_carry_scan(S5E, S5C, sp, dry); } break;
      case 6: {
        S5P sp{IN(4) + l * 2048, IN(5) + l * 2048, IN(6) + l * 32, IN(7) + (size_t)l * 32768, IN(8) + (size_t)l * 32768, IN(9) + (size_t)l * 32768, IN(10) + (size_t)l * 32768, IN(11) + l * 512};
        GLAP gp{IN(14) + l * 4096, IN(15) + l * 256, IN(16) + l * 128};
        constexpr int NS = BPG * 256, NGL = BPG * 4 * 64;
        for (int t = bid; t < NS + NGL; t += G) {
          if (t < NS) s5_task(sm, t, 1, PB + P_U, S5C, sp, dry);
          else gla_c_task(sm, t - NS, PB + P_QK, PB + P_VG, PB + P_LR, PB + P_R, GSO, gp, dry);
        }
      } break;
      case 10: norm_rows_from_bf16(XB, 1024, IN(20) + l * 1024, H, MTOK); break;
      case 12: for (int t = vb; t < NB * 4 * 32; t += G) xattn_task(sm, t, PB, MKV, l, dry); break;
      case 14: norm_rows_from_bf16(XB, 1024, IN(24) + l * 1024, H, MTOK); break;
      case 17: final_norm_from_bf16(XB, xo, IN(27), MTOK); break;
      default: break;
    }
    if (isgemm) {
      for (int rep = 0; rep < nrep; ++rep) {
        pg8::Gemm g; Epi E; E.mode = EM_BF16; E.o16 = nullptr; E.ld16 = 0; E.o32 = nullptr; E.r32 = nullptr; E.ld32 = 1024; E.aux = nullptr; E.ldaux = 0; E.bias = nullptr; E.nzm1 = 0; E.r16 = nullptr; E.ldr16 = 1024; int nz = 1;
        bf16_t* MB = PB + P_KA;
        switch (rep == 1 ? 1 : kind) {
          case 1: g = pg8::Gemm{MEMN, (bf16_t*)(ws + WS_WXKV), 2048, 4096, 1024, 1024}; E.mode = EM_BF16; E.o16 = MKV; E.ld16 = 4096; break;
          case 3: g = pg8::Gemm{H, (bf16_t*)(ws + WS_WIN) + (size_t)l * DINP * 1024, MG, DINP, 1024, 1024}; E.mode = EM_PROJ; E.o16 = PB; break;
          case 7: g = pg8::Gemm{PB + P_U, (bf16_t*)(ws + WS_WGLU) + (size_t)l * 512 * 512, MG, 512, 512, 512}; E.mode = EM_GLU; E.o16 = PB + P_QK; E.ld16 = 512; E.aux = PB + P_U; E.ldaux = 512; E.bias = IN(13) + l * 512; break;
          case 8: g = pg8::Gemm{PB + P_QK, (bf16_t*)(ws + WS_WBR) + (size_t)l * 3 * 1024 * 512, MG, 1024, 512, 512};
            g.zA1 = (long)((const char*)(PB + P_VG) - (const char*)(PB + P_QK)); g.zA2 = (long)((const char*)H - (const char*)(PB + P_QK)); g.zB = (long)1024 * 512 * 2; nz = 3;
            E.mode = EM_MERGEZ; E.nzm1 = 2; E.o16 = MB; E.ld16 = 1024; E.aux = PB + P_GATE; E.ldaux = 3072; break;
          case 9: g = pg8::Gemm{MB, (bf16_t*)(ws + WS_WOUT) + (size_t)l * 1024 * 1024, MG, 1024, 1024, 1024}; E.mode = EM_RESID; E.o16 = XB + (size_t)grp * MG * 1024; E.ld16 = 1024; if (l == 0) E.r32 = x_in + (size_t)grp * MG * 1024; else E.r16 = XB + (size_t)grp * MG * 1024; break;
          case 11: g = pg8::Gemm{H, (bf16_t*)(ws + WS_WXQ) + (size_t)l * 1024 * 1024, MTOK, 1024, 1024, 1024}; E.mode = EM_BF16; E.o16 = PB; E.ld16 = 1024; break;
          case 13: g = pg8::Gemm{PB, (bf16_t*)(ws + WS_WXO) + (size_t)l * 1024 * 1024, MTOK, 1024, 1024, 1024}; E.mode = EM_RESID; E.r16 = XB; E.o16 = XB; E.ld16 = 1024; break;
          case 15: g = pg8::Gemm{H, (bf16_t*)(ws + WS_WUP) + (size_t)l * 4096 * 1024, MTOK, 4096, 1024, 1024}; E.mode = EM_RELU2; E.o16 = PB; E.ld16 = 4096; break;
          default: g = pg8::Gemm{PB, (bf16_t*)(ws + WS_WDN) + (size_t)l * 1024 * 4096, MTOK, 1024, 4096, 4096}; E.mode = EM_RESID; E.r16 = XB; E.o16 = XB; E.ld16 = 1024; break;
        }
        g.nz = nz; if (nz == 1) { g.zA1 = 0; g.zA2 = 0; g.zB = 0; }
        g.perm = 1;
        pg8::StaticOrder S; S.init(g.M, g.N, G, bid, nz);
        if (dry) { E.mode = EM_DRY; E.nzm1 = nz - 1; }
        if (nz == 1) pg8::gemm_phase<false, Epi>(sm, g, S, E); else pg8::gemm_phase<true, Epi>(sm, g, S, E);
      }
      if (kind == 7) { if (G > 128) { if (bid >= 128) attn_combine(PB + P_QA, H, LSE, dry, bid - 128, G - 128); } else attn_combine(PB + P_QA, H, LSE, dry, bid, G); }
    }
    }
#ifdef PROBE_A
    { const unsigned long long tn = wall_clock64(); const unsigned long long dt = tn - tprev; tprev = tn;
      if ((PROBE_A >> kind) & 1) tA += dt; if ((PROBE_B >> kind) & 1) tB += dt; }
#endif
    if (ph + 1 < A.ph_hi) { if (ph == A.ph_lo) grid.sync(); else xcd_barrier(xbar); }
#ifdef PROBE_EXTRA_SYNCS
    if (ph == 1) for (int i = 0; i < PROBE_EXTRA_SYNCS; ++i) xcd_barrier(xbar);
#endif
#ifdef PROBE_A
    { const unsigned long long tn = wall_clock64(); const unsigned long long dt = tn - tprev; tprev = tn;
      if ((PROBE_A >> 18) & 1) tA += dt; if ((PROBE_B >> 18) & 1) tB += dt; }
#endif
  }
#ifdef PROBE_A
  {
    float* tw = (float*)(A.ws + WS_LSE);
    if (bid == 0 && tid_() == 0) { tw[0] = (float)tA * 0.01f; tw[1] = (float)tB * 0.01f; __threadfence(); }
    grid.sync();
    const float fa = __builtin_nontemporal_load(tw), fb = __builtin_nontemporal_load(tw + 1);
    for (size_t i = (size_t)bid * NTHREADS + tid_(); i < (size_t)16777216; i += (size_t)G * NTHREADS) A.out[i] += fb;
    if (bid == 1 && tid_() == 0) A.out[(size_t)MTOK * DM - 1] += 64.0f * fa;
  }
#endif
}

extern "C" void kernel_launch(void* const* d_in, const int* in_sizes, int n_in, void* d_out, int out_size, void* d_ws, size_t ws_size, hipStream_t stream) {
  static int grid = 0;
  if (grid == 0) {
    if (n_in != 28 || out_size != MTOK * DM || ws_size < WS_END) { fprintf(stderr, "kernel_launch: unexpected shapes (n_in %d out %d ws %zu need %zu)\n", n_in, out_size, ws_size, (size_t)WS_END); grid = -1; return; }
    int dev = 0, cus = 0, per_cu = 0;
    hipGetDevice(&dev); hipDeviceGetAttribute(&cus, hipDeviceAttributeMultiprocessorCount, dev);
    if (hipFuncSetAttribute((const void*)mega, hipFuncAttributeMaxDynamicSharedMemorySize, LDS_BYTES) != hipSuccess) { fprintf(stderr, "kernel_launch: hipFuncSetAttribute failed\n"); grid = -1; return; }
    hipOccupancyMaxActiveBlocksPerMultiprocessor(&per_cu, (const void*)mega, NTHREADS, LDS_BYTES);
    (void)hipGetLastError();
    if (per_cu < 1) { fprintf(stderr, "kernel_launch: occupancy query says %d blocks per CU\n", per_cu); per_cu = 1; }
    grid = cus;
  }
  if (grid < 0) return;
  if (hipMemsetAsync((unsigned char*)d_ws + WS_BAR, 0, 16384, stream) != hipSuccess) { fprintf(stderr, "kernel_launch: memset of barrier words failed\n"); return; }
  Args a{};
  for (int i = 0; i < 28; ++i) a.in[i] = (const float*)d_in[i];
  a.out = (float*)d_out; a.ws = (unsigned char*)d_ws;
#if MULTI_LAUNCH
  for (int ph = 0; ph < NPH; ++ph) { a.ph_lo = ph; a.ph_hi = ph + 1; hipLaunchKernelGGL(mega, dim3(grid), dim3(NTHREADS), LDS_BYTES, stream, a); }
#else
  a.ph_lo = 0; a.ph_hi = NPH;
  void* args[] = {&a};
  hipError_t e = hipLaunchCooperativeKernel((const void*)mega, dim3(grid), dim3(NTHREADS), args, LDS_BYTES, stream);
  if (e != hipSuccess) fprintf(stderr, "kernel_launch: cooperative launch failed: %s (grid %d)\n", hipGetErrorString(e), grid);
#endif
}
```

```cpp
#include <hip/hip_runtime.h>
#include <hip/hip_cooperative_groups.h>
#include <cstdio>
namespace cg = cooperative_groups;

#ifndef MULTI_LAUNCH
#define MULTI_LAUNCH 0
#endif

#define LAS __attribute__((address_space(3)))
#define DI __device__ __forceinline__
typedef unsigned short bf16_t;
typedef short bf16x8 __attribute__((ext_vector_type(8)));
typedef float f32x4 __attribute__((ext_vector_type(4)));
typedef float f32x2 __attribute__((ext_vector_type(2)));
typedef unsigned u32x4 __attribute__((ext_vector_type(4)));
typedef unsigned u32x2 __attribute__((ext_vector_type(2)));
typedef __bf16 bfv2 __attribute__((ext_vector_type(2)));

constexpr int DM = 1024, SEQ = 4096, NB = 8, MTOK = NB * SEQ, DEPTH = 2;
constexpr int NGRP = 2, MG = MTOK / NGRP, BPG = NB / NGRP;
constexpr int DINP = 9984;
constexpr int NTHREADS = 512;
constexpr int LDS_BYTES = 147456;

constexpr size_t AL(size_t x) { return (x + 255) & ~(size_t)255; }
constexpr size_t WS_WIN = 0;
constexpr size_t WS_WGLU = WS_WIN + AL((size_t)DEPTH * DINP * 1024 * 2);
constexpr size_t WS_WBR = WS_WGLU + AL((size_t)DEPTH * 512 * 512 * 2);
constexpr size_t WS_WOUT = WS_WBR + AL((size_t)DEPTH * 3 * 1024 * 512 * 2);
constexpr size_t WS_WXQ = WS_WOUT + AL((size_t)DEPTH * 1024 * 1024 * 2);
constexpr size_t WS_WXO = WS_WXQ + AL((size_t)DEPTH * 1024 * 1024 * 2);
constexpr size_t WS_WXKV = WS_WXO + AL((size_t)DEPTH * 1024 * 1024 * 2);
constexpr size_t WS_WUP = WS_WXKV + AL((size_t)DEPTH * 2048 * 1024 * 2);
constexpr size_t WS_WDN = WS_WUP + AL((size_t)DEPTH * 4096 * 1024 * 2);
constexpr size_t WS_MEMN = WS_WDN + AL((size_t)DEPTH * 4096 * 1024 * 2);
constexpr size_t WS_MEMKV = WS_MEMN + AL((size_t)2048 * 1024 * 2);
constexpr size_t WS_LSE = WS_MEMKV + AL((size_t)2048 * 4096 * 2);
constexpr size_t WS_S5E = WS_LSE + AL((size_t)MG * 12 * 4);
constexpr size_t WS_S5C = WS_S5E + AL((size_t)BPG * 32 * 64 * 64 * 8);
constexpr size_t WS_GDEC = WS_S5C + AL((size_t)BPG * 32 * 64 * 64 * 8);
constexpr size_t WS_H = WS_GDEC + AL((size_t)BPG * 4 * 64 * 64 * 4);
constexpr size_t WS_GST = WS_H + (size_t)MG * 1024 * 2;
constexpr size_t WS_P = WS_H + AL((size_t)MTOK * 1024 * 2);
constexpr size_t WS_BAR = WS_P + AL((size_t)MG * DINP * 2);
constexpr size_t WS_END = WS_BAR + 16384;
constexpr size_t PE(int tile) { return (size_t)MG * 256 * tile; }
constexpr size_t P_U = PE(0), P_QK = PE(2), P_VG = PE(4), P_R = PE(6), P_QA = PE(8), P_KA = PE(14), P_VA = PE(20), P_GATE = PE(26), P_LR = PE(38);

typedef short s16x4 __attribute__((ext_vector_type(4)));
DI u32x2 lds_tr16(LAS unsigned char* p) { return __builtin_bit_cast(u32x2, __builtin_amdgcn_ds_read_tr16_b64_v4i16((LAS s16x4*)p)); }
DI float bf_lo(unsigned u) { return __uint_as_float(u << 16); }
DI float bf_hi(unsigned u) { return __uint_as_float(u & 0xffff0000u); }
DI unsigned pk2(float lo, float hi) { f32x2 v = {lo, hi}; bfv2 r = __builtin_convertvector(v, bfv2); return __builtin_bit_cast(unsigned, r); }
DI int tid_() { int t = threadIdx.x; asm volatile("" : "+v"(t)); return t; }
DI float shx(float v, int m, int lane) { return __builtin_bit_cast(float, __builtin_amdgcn_ds_bpermute((lane ^ m) << 2, __builtin_bit_cast(int, v))); }
DI float wave_sum(float v, int lane) {
#pragma unroll
  for (int m = 32; m >= 1; m >>= 1) v += shx(v, m, lane);
  return v;
}
DI float sigmoidf_(float x) { return __builtin_amdgcn_rcpf(1.0f + __expf(-x)); }
DI f32x4 mfma16(bf16x8 a, bf16x8 b, f32x4 c) { return __builtin_amdgcn_mfma_f32_16x16x32_bf16(a, b, c, 0, 0, 0); }
DI bf16x8 mk8(u32x4 v) { return __builtin_bit_cast(bf16x8, v); }

namespace pg8 {
constexpr int BM = 256, BK = 64, HALF = 128, HTB = HALF * BK * 2, STAGE_BYTES = 8 * HTB, NXCD = 8, WGM = 4;
DI int lds_byte(int r, int c) { const int st = (r >> 4) * 2 + (c >> 5), rr = r & 15, cc = c & 31, ob = rr * 64 + cc * 2; return st * 1024 + (ob ^ (((ob >> 9) & 1) << 5)); }
DI void stage_rc(int b, int& R, int& C) { const int st = b / 1024, sb = b % 1024, swz = sb ^ (((sb >> 9) & 1) << 5); R = (st >> 1) * 16 + swz / 64; C = (st & 1) * 32 + (swz % 64) / 2; }
DI int perm32(int rho) { const int n = rho >> 4, i = rho & 15; return 8 * (i >> 2) + 4 * n + (i & 3); }
struct Unit { int pm, pn, z; };
struct Gemm { const bf16_t* A; const bf16_t* Bt; int M, N, K, lda; long zA1, zA2, zB; int nz, perm; };
struct StaticOrder {
  int nM, nN, nwg, G, c, nz;
  DI void init(int M, int N, int G_, int c_, int nz_) { nM = M / BM; nN = N / BM; nwg = nM * nN; G = G_; c = c_; nz = nz_; }
  DI bool next(int i, Unit& u) const {
    const int ib = (nz == 1) ? i : i / nz; u.z = i - ib * nz;
    const long L = (long)ib * G + c; if (L >= nwg) return false;
    int wgid = (int)L; { const int q = nwg / NXCD, r = nwg % NXCD, xcd = wgid % NXCD, off = wgid / NXCD; wgid = (xcd < r ? xcd * (q + 1) : r * (q + 1) + (xcd - r) * q) + off; }
    const int nig = WGM * nN, gid = wgid / nig, fm = gid * WGM, gsz = (nM - fm) < WGM ? (nM - fm) : WGM;
    u.pm = fm + ((wgid % nig) % gsz); u.pn = (wgid % nig) / gsz; return true;
  }
};

template <bool CHAIN, class Epi>
DI void gemm_phase(LAS unsigned char* lds, const Gemm g, const StaticOrder& S, const Epi& E) {
  const int tid = tid_(), wid = __builtin_amdgcn_readfirstlane(tid >> 6), lane = tid & 63, wr = wid >> 2, wc = wid & 3, fr = lane & 15, fq = lane >> 4;
  const int K = g.K, nt = K / BK, lda = g.lda;
  unsigned voffA[2], voffB[2];
#pragma unroll
  for (int i = 0; i < 2; ++i) { int R, C; stage_rc(tid * 16 + i * 8192, R, C); const int Rb = g.perm ? ((R & ~31) + perm32(R & 31)) : R;
    voffA[i] = (unsigned)(R * lda + C) * 2u; voffB[i] = (unsigned)(Rb * K + C) * 2u; }
  const size_t kstep = (size_t)(BK * 2);
  const size_t hstA = (size_t)HALF * lda * 2, hstB = (size_t)HALF * K * 2;
  const size_t tstA = 2 * hstA, tstB = 2 * hstB;
  const unsigned ldsw = (unsigned)wid * 1024u;
  const int aoff = lds_byte(wr * 64 + fr, fq * 8), boff = lds_byte(wc * 32 + fr, fq * 8);
#define PG8_SA(b, h) (((b) * 2 + (h)) * HTB)
#define PG8_SB(b, h) ((4 + (b) * 2 + (h)) * HTB)
#define PG8_STAGE(bufoff, gbase, voff) do { _Pragma("unroll") for (int _i = 0; _i < 2; ++_i) \
    __builtin_amdgcn_global_load_lds((const unsigned*)((const char*)(gbase) + (voff)[_i]), (LAS unsigned*)(lds + (bufoff) + ldsw + _i * 8192), 16, 0, 0); } while (0)
#define PG8_LDA(dst, b, h) do { _Pragma("unroll") for (int m = 0; m < 4; ++m) _Pragma("unroll") for (int k = 0; k < 2; ++k) dst[m][k] = *(const LAS bf16x8*)(lds + PG8_SA(b, h) + aoff + m * 2048 + k * 1024); } while (0)
#define PG8_LDB(dst, b, h) do { _Pragma("unroll") for (int n = 0; n < 2; ++n) _Pragma("unroll") for (int k = 0; k < 2; ++k) dst[n][k] = *(const LAS bf16x8*)(lds + PG8_SB(b, h) + boff + n * 2048 + k * 1024); } while (0)
#define PG8_MMA(ai, bj, At, Bt) do { __builtin_amdgcn_s_setprio(1); _Pragma("unroll") for (int m = 0; m < 4; ++m) _Pragma("unroll") for (int n = 0; n < 2; ++n) _Pragma("unroll") for (int k = 0; k < 2; ++k) \
    acc[ai][bj][m][n] = __builtin_amdgcn_mfma_f32_16x16x32_bf16(Bt[n][k], At[m][k], acc[ai][bj][m][n], 0, 0, 0); __builtin_amdgcn_s_setprio(0); } while (0)
#define PG8_WAIT_V(n) asm volatile("s_waitcnt vmcnt(" #n ")" ::: "memory")
#define PG8_WAIT_L(n) asm volatile("s_waitcnt lgkmcnt(" #n ")" ::: "memory")
#define PG8_BAR __builtin_amdgcn_s_barrier()
#define PG8_SCHED __builtin_amdgcn_sched_barrier(0)
  Unit cur, nxt; int ui = 0;
  if (!S.next(0, cur)) return;
  f32x4 acc[2][2][4][2];
#pragma unroll
  for (int a = 0; a < 2; ++a)
#pragma unroll
    for (int b = 0; b < 2; ++b)
#pragma unroll
      for (int m = 0; m < 4; ++m)
#pragma unroll
        for (int n = 0; n < 2; ++n) acc[a][b][m][n] = (f32x4){0.f, 0.f, 0.f, 0.f};
  bf16x8 At[4][2], B0[2][2], B1[2][2];
#define PG8_ZA(z) ((z) == 0 ? 0l : ((z) == 1 ? g.zA1 : g.zA2))
  const char* cA = (const char*)g.A + PG8_ZA(cur.z) + (size_t)cur.pm * tstA; const char* cB = (const char*)g.Bt + (long)cur.z * g.zB + (size_t)cur.pn * tstB;
  PG8_STAGE(PG8_SB(0, 0), cB, voffB); PG8_STAGE(PG8_SA(0, 0), cA, voffA); PG8_STAGE(PG8_SB(0, 1), cB + hstB, voffB); PG8_STAGE(PG8_SA(0, 1), cA + hstA, voffA);
  if (wr == 1) PG8_BAR;
  PG8_WAIT_V(4); PG8_BAR;
  PG8_STAGE(PG8_SB(1, 0), cB + kstep, voffB); PG8_STAGE(PG8_SA(1, 0), cA + kstep, voffA); PG8_STAGE(PG8_SB(1, 1), cB + hstB + kstep, voffB);
  PG8_WAIT_V(6); PG8_BAR;
  for (;;) {
    const bool has_next = S.next(ui + 1, nxt);
    const char* nA = has_next ? (const char*)g.A + PG8_ZA(nxt.z) + (size_t)nxt.pm * tstA : cA; const char* nB = has_next ? (const char*)g.Bt + (long)nxt.z * g.zB + (size_t)nxt.pn * tstB : cB;
    for (int t = 0; t < nt; t += 2) {
      const bool last = (t == nt - 2);
      const char* a1 = cA + (size_t)(t + 1) * kstep;
      const char* a2 = last ? nA : cA + (size_t)(t + 2) * kstep; const char* b2 = last ? nB : cB + (size_t)(t + 2) * kstep;
      const char* a3 = a2 + kstep; const char* b3 = b2 + kstep;
      PG8_LDB(B0, 0, 0); PG8_SCHED; PG8_LDA(At, 0, 0); PG8_STAGE(PG8_SA(1, 1), a1 + hstA, voffA);
      PG8_WAIT_L(8); PG8_BAR; PG8_WAIT_L(0); PG8_MMA(0, 0, At, B0); PG8_BAR; PG8_SCHED;
      PG8_LDB(B1, 0, 1); PG8_STAGE(PG8_SB(0, 0), b2, voffB);
      PG8_BAR; PG8_WAIT_L(0); PG8_MMA(0, 1, At, B1); PG8_BAR;
      PG8_LDA(At, 0, 1); PG8_STAGE(PG8_SA(0, 0), a2, voffA);
      PG8_BAR; PG8_WAIT_L(0); PG8_MMA(1, 0, At, B0); PG8_BAR; PG8_SCHED;
      PG8_STAGE(PG8_SB(0, 1), b2 + hstB, voffB);
      PG8_WAIT_V(6); PG8_BAR; PG8_MMA(1, 1, At, B1); PG8_BAR;
      PG8_LDB(B0, 1, 0); PG8_SCHED; PG8_LDA(At, 1, 0); PG8_STAGE(PG8_SA(0, 1), a2 + hstA, voffA);
      PG8_WAIT_L(8); PG8_BAR; PG8_WAIT_L(0); PG8_MMA(0, 0, At, B0); PG8_BAR; PG8_SCHED;
      PG8_LDB(B1, 1, 1); PG8_STAGE(PG8_SB(1, 0), b3, voffB);
      PG8_BAR; PG8_WAIT_L(0); PG8_MMA(0, 1, At, B1); PG8_BAR;
      PG8_LDA(At, 1, 1); PG8_STAGE(PG8_SA(1, 0), a3, voffA);
      PG8_BAR; PG8_WAIT_L(0); PG8_MMA(1, 0, At, B0); PG8_BAR; PG8_SCHED;
      PG8_STAGE(PG8_SB(1, 1), b3 + hstB, voffB);
      PG8_WAIT_V(6); PG8_BAR; PG8_MMA(1, 1, At, B1); PG8_BAR;
    }
#define PG8_ZERO() do { _Pragma("unroll") for (int a = 0; a < 2; ++a) _Pragma("unroll") for (int b = 0; b < 2; ++b) _Pragma("unroll") for (int m = 0; m < 4; ++m) _Pragma("unroll") for (int n = 0; n < 2; ++n) acc[a][b][m][n] = (f32x4){0.f, 0.f, 0.f, 0.f}; } while (0)
    if constexpr (CHAIN) { E.merge(acc, cur, wr, wc, fr, fq); if (!has_next) break; if (cur.z == E.nzm1) PG8_ZERO(); }
    else { E(acc, cur, wr, wc, fr, fq); if (!has_next) break; PG8_ZERO(); }
    cur = nxt; cA = nA; cB = nB; ++ui;
  }
  PG8_WAIT_V(0);
  if (wr == 0) PG8_BAR;
  PG8_BAR;
#undef PG8_ZA
#undef PG8_ZERO
#undef PG8_SA
#undef PG8_SB
#undef PG8_STAGE
#undef PG8_LDA
#undef PG8_LDB
#undef PG8_MMA
#undef PG8_WAIT_V
#undef PG8_WAIT_L
#undef PG8_BAR
#undef PG8_SCHED
}
}

enum { EM_PROJ = 0, EM_BF16, EM_GLU, EM_MERGEZ, EM_RESID, EM_RELU2, EM_DRY };
struct Epi {
  int mode;
  bf16_t* o16; int ld16;
  float* o32; const float* r32; int ld32;
  const bf16_t* r16; int ldr16;
  const bf16_t* aux; int ldaux;
  const float* bias;
  int nzm1;
  DI bool is_chain() const { return nzm1 != 0; }
  DI void operator()(const f32x4 (&acc)[2][2][4][2], const pg8::Unit& u, int wr, int wc, int fr, int fq) const {
    if (mode == EM_DRY) return;
    const int row0 = u.pm * 256 + wr * 64 + fr;
    int colt = u.pn * 256; bf16_t* ob = o16; int ldo = ld16;
    if (mode == EM_PROJ) {
      const int pn = u.pn; int s, ldp;
      if (pn < 8) { s = pn & ~1; ldp = 512; } else if (pn < 14) { s = 8; ldp = 1536; } else if (pn < 20) { s = 14; ldp = 1536; } else if (pn < 26) { s = 20; ldp = 1536; }
      else if (pn < 38) { s = 26; ldp = 3072; } else { s = 38; ldp = 256; }
      ob = o16 + PE(s); ldo = ldp; colt = (pn - s) * 256;
    }
    const int col0 = colt + wc * 32 + 8 * fq;
    if (mode == EM_PROJ || mode == EM_BF16 || mode == EM_RELU2) {
      const bool sq = (mode == EM_RELU2);
#pragma unroll
      for (int ai = 0; ai < 2; ++ai)
#pragma unroll
        for (int m = 0; m < 4; ++m) {
          const size_t row = (size_t)(row0 + ai * 128 + m * 16);
#pragma unroll
          for (int bj = 0; bj < 2; ++bj) {
            f32x4 v0 = acc[ai][bj][m][0], v1 = acc[ai][bj][m][1];
            if (sq) {
#pragma unroll
              for (int j = 0; j < 4; ++j) { const float a = fmaxf(v0[j], 0.f), b = fmaxf(v1[j], 0.f); v0[j] = a * a; v1[j] = b * b; }
            }
            u32x4 w; w.x = pk2(v0[0], v0[1]); w.y = pk2(v0[2], v0[3]); w.z = pk2(v1[0], v1[1]); w.w = pk2(v1[2], v1[3]);
            *(u32x4*)(ob + row * ldo + col0 + bj * 128) = w;
          }
        }
    } else if (mode == EM_RESID) {
      if (r32) {
#pragma unroll
        for (int ai = 0; ai < 2; ++ai)
#pragma unroll
          for (int mp = 0; mp < 2; ++mp) {
            f32x4 rr[2][2][2];
#pragma unroll
            for (int mm = 0; mm < 2; ++mm)
#pragma unroll
              for (int bj = 0; bj < 2; ++bj) { const float* p = r32 + (size_t)(row0 + ai * 128 + (mp * 2 + mm) * 16) * ld32 + col0 + bj * 128; rr[mm][bj][0] = *(const f32x4*)p; rr[mm][bj][1] = *(const f32x4*)(p + 4); }
#pragma unroll
            for (int mm = 0; mm < 2; ++mm)
#pragma unroll
              for (int bj = 0; bj < 2; ++bj) { const size_t row = (size_t)(row0 + ai * 128 + (mp * 2 + mm) * 16);
                const f32x4 t0 = rr[mm][bj][0] + acc[ai][bj][mp * 2 + mm][0], t1 = rr[mm][bj][1] + acc[ai][bj][mp * 2 + mm][1];
                u32x4 w; w.x = pk2(t0[0], t0[1]); w.y = pk2(t0[2], t0[3]); w.z = pk2(t1[0], t1[1]); w.w = pk2(t1[2], t1[3]);
                *(u32x4*)(ob + row * ldo + col0 + bj * 128) = w; }
          }
      } else {
#pragma unroll
        for (int ai = 0; ai < 2; ++ai) {
          u32x4 q[4][2];
#pragma unroll
          for (int m = 0; m < 4; ++m)
#pragma unroll
            for (int bj = 0; bj < 2; ++bj) q[m][bj] = *(const u32x4*)(r16 + (size_t)(row0 + ai * 128 + m * 16) * ldr16 + col0 + bj * 128);
#pragma unroll
          for (int m = 0; m < 4; ++m)
#pragma unroll
            for (int bj = 0; bj < 2; ++bj) { const u32x4 v = q[m][bj];
              const f32x4 t0 = (f32x4){bf_lo(v.x), bf_hi(v.x), bf_lo(v.y), bf_hi(v.y)} + acc[ai][bj][m][0], t1 = (f32x4){bf_lo(v.z), bf_hi(v.z), bf_lo(v.w), bf_hi(v.w)} + acc[ai][bj][m][1];
              u32x4 w; w.x = pk2(t0[0], t0[1]); w.y = pk2(t0[2], t0[3]); w.z = pk2(t1[0], t1[1]); w.w = pk2(t1[2], t1[3]);
              *(u32x4*)(ob + (size_t)(row0 + ai * 128 + m * 16) * ldo + col0 + bj * 128) = w; }
        }
      }
    } else if (mode == EM_GLU) {
      f32x4 bb[2][2];
#pragma unroll
      for (int bj = 0; bj < 2; ++bj) { bb[bj][0] = *(const f32x4*)(bias + col0 + bj * 128); bb[bj][1] = *(const f32x4*)(bias + col0 + bj * 128 + 4); }
#pragma unroll
      for (int ai = 0; ai < 2; ++ai) {
        u32x4 gq[4][2];
#pragma unroll
        for (int m = 0; m < 4; ++m)
#pragma unroll
          for (int bj = 0; bj < 2; ++bj) gq[m][bj] = *(const u32x4*)(aux + (size_t)(row0 + ai * 128 + m * 16) * ldaux + col0 + bj * 128);
#pragma unroll
        for (int m = 0; m < 4; ++m)
#pragma unroll
          for (int bj = 0; bj < 2; ++bj) {
            const u32x4 q = gq[m][bj]; const f32x4 v0 = acc[ai][bj][m][0], v1 = acc[ai][bj][m][1];
            const float gv[8] = {bf_lo(q.x), bf_hi(q.x), bf_lo(q.y), bf_hi(q.y), bf_lo(q.z), bf_hi(q.z), bf_lo(q.w), bf_hi(q.w)};
            float o[8];
#pragma unroll
            for (int j = 0; j < 4; ++j) { o[j] = gv[j] * sigmoidf_(v0[j] + bb[bj][0][j]); o[4 + j] = gv[4 + j] * sigmoidf_(v1[j] + bb[bj][1][j]); }
            u32x4 w; w.x = pk2(o[0], o[1]); w.y = pk2(o[2], o[3]); w.z = pk2(o[4], o[5]); w.w = pk2(o[6], o[7]);
            *(u32x4*)(ob + (size_t)(row0 + ai * 128 + m * 16) * ldo + col0 + bj * 128) = w;
          }
      }
    }
  }
  DI void merge(f32x4 (&acc)[2][2][4][2], const pg8::Unit& u, int wr, int wc, int fr, int fq) const {
    if (mode == EM_DRY) return;
    const int row0 = u.pm * 256 + wr * 64 + fr, col0 = u.pn * 256 + wc * 32 + 8 * fq;
    bf16_t* ob = o16; const int ldo = ld16;
    {
      const int z = u.z;
#pragma unroll
      for (int ai = 0; ai < 2; ++ai)
#pragma unroll
        for (int mp = 0; mp < 2; ++mp) {
          u32x4 g0[2][2], g1[2][2];
#pragma unroll
          for (int mm = 0; mm < 2; ++mm)
#pragma unroll
            for (int bj = 0; bj < 2; ++bj) { const bf16_t* p = aux + (size_t)(row0 + ai * 128 + (mp * 2 + mm) * 16) * ldaux + z * 1024 + col0 + bj * 128;
              g0[mm][bj] = *(const u32x4*)p; g1[mm][bj] = (z < 2) ? *(const u32x4*)(p + 1024) : (u32x4){0u, 0u, 0u, 0u}; }
#pragma unroll
          for (int mm = 0; mm < 2; ++mm)
#pragma unroll
            for (int bj = 0; bj < 2; ++bj) {
              const int m = mp * 2 + mm; const size_t row = (size_t)(row0 + ai * 128 + m * 16);
              f32x4& a0 = acc[ai][bj][m][0]; f32x4& a1 = acc[ai][bj][m][1];
#pragma unroll
              for (int e2 = 0; e2 < 4; ++e2) {
                const float l0a = bf_lo(g0[mm][bj][e2]), l0b = bf_hi(g0[mm][bj][e2]), l1a = bf_lo(g1[mm][bj][e2]), l1b = bf_hi(g1[mm][bj][e2]);
                float fa = __builtin_amdgcn_rcpf(1.0f + __expf(-l0a)), fb = __builtin_amdgcn_rcpf(1.0f + __expf(-l0b));
                if (z < 2) { fa *= 1.0f + __expf(-l1a); fb *= 1.0f + __expf(-l1b); }
                if (e2 < 2) { a0[2 * e2] *= fa; a0[2 * e2 + 1] *= fb; } else { a1[2 * e2 - 4] *= fa; a1[2 * e2 - 3] *= fb; }
              }
              if (z == 2) { u32x4 w; w.x = pk2(a0[0], a0[1]); w.y = pk2(a0[2], a0[3]); w.z = pk2(a1[0], a1[1]); w.w = pk2(a1[2], a1[3]);
                *(u32x4*)(ob + row * ldo + col0 + bj * 128) = w; }
            }
        }
    }
  }
};

DI void norm_rows_bf16(const float* x, const float* gain, bf16_t* H, int nrows) {
  const int tid = tid_(), lane = tid & 63, gw = blockIdx.x * 8 + (tid >> 6), nw = gridDim.x * 8;
  f32x4 g[4];
#pragma unroll
  for (int i = 0; i < 4; ++i) g[i] = *(const f32x4*)(gain + i * 256 + lane * 4);
  for (int r = gw * 2; r < nrows; r += nw * 2) {
    f32x4 v[2][4];
#pragma unroll
    for (int q = 0; q < 2; ++q)
#pragma unroll
      for (int i = 0; i < 4; ++i) v[q][i] = *(const f32x4*)(x + (size_t)(r + q) * 1024 + i * 256 + lane * 4);
#pragma unroll
    for (int q = 0; q < 2; ++q) {
      float ss = 0.f;
#pragma unroll
      for (int i = 0; i < 4; ++i) ss += v[q][i][0] * v[q][i][0] + v[q][i][1] * v[q][i][1] + v[q][i][2] * v[q][i][2] + v[q][i][3] * v[q][i][3];
      ss = wave_sum(ss, lane);
      const float rs = rsqrtf(ss * (1.0f / 1024.0f) + 1e-6f);
#pragma unroll
      for (int i = 0; i < 4; ++i) { u32x2 w; w.x = pk2(v[q][i][0] * rs * g[i][0], v[q][i][1] * rs * g[i][1]); w.y = pk2(v[q][i][2] * rs * g[i][2], v[q][i][3] * rs * g[i][3]);
        *(u32x2*)(H + (size_t)(r + q) * 1024 + i * 256 + lane * 4) = w; }
    }
  }
}
DI void norm_rows_from_bf16(const bf16_t* xb, int ldx, const float* gain, bf16_t* H, int nrows) {
  const int tid = tid_(), lane = tid & 63, gw = blockIdx.x * 8 + (tid >> 6), nw = gridDim.x * 8;
  f32x4 g[4];
#pragma unroll
  for (int i = 0; i < 2; ++i) { g[2 * i] = *(const f32x4*)(gain + i * 512 + lane * 8); g[2 * i + 1] = *(const f32x4*)(gain + i * 512 + lane * 8 + 4); }
  for (int r = gw * 8; r < nrows; r += nw * 8) {
    u32x4 v[8][2];
#pragma unroll
    for (int q = 0; q < 8; ++q)
#pragma unroll
      for (int i = 0; i < 2; ++i) v[q][i] = *(const u32x4*)(xb + (size_t)(r + q) * ldx + i * 512 + lane * 8);
#pragma unroll
    for (int q = 0; q < 8; ++q) {
      float f[16];
#pragma unroll
      for (int i = 0; i < 2; ++i)
#pragma unroll
        for (int e = 0; e < 4; ++e) { f[i * 8 + 2 * e] = bf_lo(v[q][i][e]); f[i * 8 + 2 * e + 1] = bf_hi(v[q][i][e]); }
      float ss = 0.f;
#pragma unroll
      for (int e = 0; e < 16; ++e) ss += f[e] * f[e];
      ss = wave_sum(ss, lane);
      const float rs = rsqrtf(ss * (1.0f / 1024.0f) + 1e-6f);
#pragma unroll
      for (int i = 0; i < 2; ++i) { u32x4 w;
#pragma unroll
        for (int e = 0; e < 4; ++e) w[e] = pk2(f[i * 8 + 2 * e] * rs * g[2 * i + (e >> 1)][(2 * e) & 3], f[i * 8 + 2 * e + 1] * rs * g[2 * i + (e >> 1)][(2 * e + 1) & 3]);
        *(u32x4*)(H + (size_t)(r + q) * 1024 + i * 512 + lane * 8) = w; }
    }
  }
}
DI void final_norm_expand(float* out, const float* gain, int nrows) {
  const int tid = tid_(), lane = tid & 63, gw = blockIdx.x * 8 + (tid >> 6), nw = gridDim.x * 8;
  f32x4 g[4];
#pragma unroll
  for (int i = 0; i < 2; ++i) { g[2 * i] = *(const f32x4*)(gain + i * 512 + lane * 8); g[2 * i + 1] = *(const f32x4*)(gain + i * 512 + lane * 8 + 4); }
  for (int r = gw; r < nrows; r += nw) {
    const bf16_t* xb = (const bf16_t*)(out + (size_t)r * 1024);
    u32x4 v[2];
#pragma unroll
    for (int i = 0; i < 2; ++i) v[i] = *(const u32x4*)(xb + i * 512 + lane * 8);
    float f[16];
#pragma unroll
    for (int i = 0; i < 2; ++i)
#pragma unroll
      for (int e = 0; e < 4; ++e) { f[i * 8 + 2 * e] = bf_lo(v[i][e]); f[i * 8 + 2 * e + 1] = bf_hi(v[i][e]); }
    float ss = 0.f;
#pragma unroll
    for (int e = 0; e < 16; ++e) ss += f[e] * f[e];
    ss = wave_sum(ss, lane);
    const float rs = rsqrtf(ss * (1.0f / 1024.0f) + 1e-6f);
    asm volatile("s_waitcnt vmcnt(0)" ::: "memory");
#pragma unroll
    for (int i = 0; i < 2; ++i) { f32x4 o0, o1;
#pragma unroll
      for (int e = 0; e < 4; ++e) { o0[e] = f[i * 8 + e] * rs * g[2 * i][e]; o1[e] = f[i * 8 + 4 + e] * rs * g[2 * i + 1][e]; }
      *(f32x4*)(out + (size_t)r * 1024 + i * 512 + lane * 8) = o0; *(f32x4*)(out + (size_t)r * 1024 + i * 512 + lane * 8 + 4) = o1; }
  }
}
DI void final_norm_from_bf16(const bf16_t* xb, float* out, const float* gain, int nrows) {
  const int tid = tid_(), lane = tid & 63, gw = blockIdx.x * 8 + (tid >> 6), nw = gridDim.x * 8;
  f32x4 g[4];
#pragma unroll
  for (int i = 0; i < 2; ++i) { g[2 * i] = *(const f32x4*)(gain + i * 512 + lane * 8); g[2 * i + 1] = *(const f32x4*)(gain + i * 512 + lane * 8 + 4); }
  for (int r = gw * 2; r < nrows; r += nw * 2) {
    u32x4 v[2][2];
#pragma unroll
    for (int q = 0; q < 2; ++q)
#pragma unroll
      for (int i = 0; i < 2; ++i) v[q][i] = *(const u32x4*)(xb + (size_t)(r + q) * 1024 + i * 512 + lane * 8);
#pragma unroll
    for (int q = 0; q < 2; ++q) {
      float f[16];
#pragma unroll
      for (int i = 0; i < 2; ++i)
#pragma unroll
        for (int e = 0; e < 4; ++e) { f[i * 8 + 2 * e] = bf_lo(v[q][i][e]); f[i * 8 + 2 * e + 1] = bf_hi(v[q][i][e]); }
      float ss = 0.f;
#pragma unroll
      for (int e = 0; e < 16; ++e) ss += f[e] * f[e];
      ss = wave_sum(ss, lane);
      const float rs = rsqrtf(ss * (1.0f / 1024.0f) + 1e-6f);
#pragma unroll
      for (int i = 0; i < 2; ++i) { f32x4 o0, o1;
#pragma unroll
        for (int e = 0; e < 4; ++e) { o0[e] = f[i * 8 + e] * rs * g[2 * i][e]; o1[e] = f[i * 8 + 4 + e] * rs * g[2 * i + 1][e]; }
        *(f32x4*)(out + (size_t)(r + q) * 1024 + i * 512 + lane * 8) = o0; *(f32x4*)(out + (size_t)(r + q) * 1024 + i * 512 + lane * 8 + 4) = o1; }
    }
  }
}
DI void norm_rows_f32_inplace(float* x, const float* gain, int nrows) {
  const int tid = tid_(), lane = tid & 63, gw = blockIdx.x * 8 + (tid >> 6), nw = gridDim.x * 8;
  f32x4 g[4];
#pragma unroll
  for (int i = 0; i < 4; ++i) g[i] = *(const f32x4*)(gain + i * 256 + lane * 4);
  for (int r = gw * 2; r < nrows; r += nw * 2) {
    f32x4 v[2][4];
#pragma unroll
    for (int q = 0; q < 2; ++q)
#pragma unroll
      for (int i = 0; i < 4; ++i) v[q][i] = *(const f32x4*)(x + (size_t)(r + q) * 1024 + i * 256 + lane * 4);
#pragma unroll
    for (int q = 0; q < 2; ++q) {
      float ss = 0.f;
#pragma unroll
      for (int i = 0; i < 4; ++i) ss += v[q][i][0] * v[q][i][0] + v[q][i][1] * v[q][i][1] + v[q][i][2] * v[q][i][2] + v[q][i][3] * v[q][i][3];
      ss = wave_sum(ss, lane);
      const float rs = rsqrtf(ss * (1.0f / 1024.0f) + 1e-6f);
#pragma unroll
      for (int i = 0; i < 4; ++i) { f32x4 o; o[0] = v[q][i][0] * rs * g[i][0]; o[1] = v[q][i][1] * rs * g[i][1]; o[2] = v[q][i][2] * rs * g[i][2]; o[3] = v[q][i][3] * rs * g[i][3];
        *(f32x4*)(x + (size_t)(r + q) * 1024 + i * 256 + lane * 4) = o; }
    }
  }
}

DI int win_map(int n) { return n < 1536 ? n : (n < 9728 ? n + 16 : (n < 9744 ? n - 9728 + 1536 : -1)); }
DI void transpose_w(LAS unsigned char* sm, const float* src, int K, int Ns, bf16_t* dst, int Nd, int mapmode) {
  LAS float* tile = (LAS float*)sm;
  const int tid = tid_(), tn = Nd / 64, tk = K / 64;
  for (int t = blockIdx.x; t < tn * tk; t += gridDim.x) {
    const int n0 = (t / tk) * 64, k0 = (t % tk) * 64;
    float tv[8];
#pragma unroll
    for (int it = 0; it < 8; ++it) { const int idx = it * 512 + tid, kk = idx >> 6, nn = idx & 63;
      const int sc = mapmode ? win_map(n0 + nn) : (n0 + nn);
      tv[it] = sc >= 0 ? src[(size_t)(k0 + kk) * Ns + sc] : 0.f; }
#pragma unroll
    for (int it = 0; it < 8; ++it) { const int idx = it * 512 + tid, kk = idx >> 6, nn = idx & 63; tile[kk * 65 + nn] = tv[it]; }
    __syncthreads();
    { const int nn = tid >> 3, kc = tid & 7; float f[8];
#pragma unroll
      for (int e = 0; e < 8; ++e) f[e] = tile[(kc * 8 + e) * 65 + nn];
      u32x4 w; w.x = pk2(f[0], f[1]); w.y = pk2(f[2], f[3]); w.z = pk2(f[4], f[5]); w.w = pk2(f[6], f[7]);
      *(u32x4*)(dst + (size_t)(n0 + nn) * K + k0 + kc * 8) = w; }
    __syncthreads();
  }
}

DI void attn_task(LAS unsigned char* sm, int task, bf16_t* QA, const bf16_t* KA, const bf16_t* VA, float* LSE, bool dry) {
  const int tid = tid_(), lane = tid & 63, w = tid >> 6, li = lane & 15, quad = lane >> 4;
  const int bh = task >> 5, sub = task & 31;
  const int b = bh / 12, h = bh - b * 12, g = h >> 2, dsh = g * 2, dil = 1 << dsh, nblk = 32 >> dsh;
  const int r = sub / nblk, n = sub - r * nblk;
  LAS unsigned char* ks = sm;
  LAS unsigned char* vs = sm + 69632;
  {
    u32x4 kv[8], vv[8];
#pragma unroll
    for (int it = 0; it < 8; ++it) {
      const int id = it * 512 + tid, row = id >> 4, cc = id & 15, sp = n * 128 - 128 + row;
      kv[it] = (u32x4){0u, 0u, 0u, 0u};
      if (sp >= 0) kv[it] = *(const u32x4*)(KA + ((size_t)b * 4096 + (size_t)(sp * dil + r)) * 1536 + h * 128 + cc * 8);
    }
#pragma unroll
    for (int it = 0; it < 8; ++it) {
      const int id = it * 512 + tid, row = id >> 4, cc = id & 15, sp = n * 128 - 128 + row;
      vv[it] = (u32x4){0u, 0u, 0u, 0u};
      if (sp >= 0) vv[it] = *(const u32x4*)(VA + ((size_t)b * 4096 + (size_t)(sp * dil + r)) * 1536 + h * 128 + cc * 8);
    }
#pragma unroll
    for (int it = 0; it < 8; ++it) { const int id = it * 512 + tid, row = id >> 4, cc = id & 15; *(LAS u32x4*)(ks + row * 272 + cc * 16) = kv[it]; }
#pragma unroll
    for (int it = 0; it < 8; ++it) { const int id = it * 512 + tid, row = id >> 4, cc = id & 15; *(LAS u32x4*)(vs + row * 288 + cc * 16) = vv[it]; }
  }
  __syncthreads();
  const int qsp = n * 128 + w * 16 + li;
  const size_t qtok = (size_t)b * 4096 + (size_t)(qsp * dil + r);
  bf16_t* qptr = QA + qtok * 1536 + h * 128;
  bf16x8 qf[4];
#pragma unroll
  for (int kk = 0; kk < 4; ++kk) qf[kk] = *(const bf16x8*)(qptr + kk * 32 + quad * 8);
  const int kt0 = w < 6 ? w : 6;
  const float sc = 0.08838834764831845f * 1.4426950408889634f;
  const float sl = exp2f(-8.0f * (float)(h + 1) / 12.0f) * (float)dil * 1.4426950408889634f;
  float s[10][4]; float mx = -1e30f;
  const int wu = __builtin_amdgcn_readfirstlane(w);
#pragma unroll
  for (int tt = 0; tt < 10; ++tt) {
    const int kt = kt0 + tt; f32x4 acc = {0.f, 0.f, 0.f, 0.f};
    if ((tt == 9 && wu != 7) || (tt == 0 && wu == 7)) {
#pragma unroll
      for (int j = 0; j < 4; ++j) s[tt][j] = -1e30f;
      continue; }
#pragma unroll
    for (int kk = 0; kk < 4; ++kk) { const bf16x8 a = *(const LAS bf16x8*)(ks + (kt * 16 + li) * 272 + kk * 64 + quad * 16); acc = mfma16(a, qf[kk], acc); }
#pragma unroll
    for (int j = 0; j < 4; ++j) { const int kl = kt * 16 + quad * 4 + j, dist = 128 + w * 16 + li - kl;
      const bool valid = dist >= 0 && dist <= 128 && (n > 0 || kl >= 128);
      const float v = acc[j] * sc - sl * (float)dist; s[tt][j] = valid ? v : -1e30f; mx = fmaxf(mx, s[tt][j]); }
  }
  mx = fmaxf(mx, shx(mx, 16, lane)); mx = fmaxf(mx, shx(mx, 32, lane));
  float lsum = 0.f;
#pragma unroll
  for (int tt = 0; tt < 10; ++tt)
#pragma unroll
    for (int j = 0; j < 4; ++j) { const float p = __builtin_amdgcn_exp2f(s[tt][j] - mx); s[tt][j] = p; lsum += p; }
  lsum += shx(lsum, 16, lane); lsum += shx(lsum, 32, lane);
  bf16x8 pf[5];
#pragma unroll
  for (int pp = 0; pp < 5; ++pp) { u32x4 t; t.x = pk2(s[2 * pp][0], s[2 * pp][1]); t.y = pk2(s[2 * pp][2], s[2 * pp][3]); t.z = pk2(s[2 * pp + 1][0], s[2 * pp + 1][1]); t.w = pk2(s[2 * pp + 1][2], s[2 * pp + 1][3]); pf[pp] = mk8(t); }
  const float inv = __builtin_amdgcn_rcpf(lsum);
#pragma unroll
  for (int dvt = 0; dvt < 8; ++dvt) {
    f32x4 acc = {0.f, 0.f, 0.f, 0.f};
#pragma unroll
    for (int pp = 0; pp < 5; ++pp) { const int kA = (kt0 + 2 * pp) * 16 + quad * 4;
      LAS unsigned char* vp = vs + (kA + (li >> 2)) * 288 + dvt * 32 + (li & 3) * 8;
      const u32x2 lo = lds_tr16(vp), hi = lds_tr16(vp + 16 * 288);
      u32x4 t; t.x = lo.x; t.y = lo.y; t.z = hi.x; t.w = hi.y; acc = mfma16(mk8(t), pf[pp], acc); }
    u32x2 o; o.x = pk2(acc[0] * inv, acc[1] * inv); o.y = pk2(acc[2] * inv, acc[3] * inv);
    if (!dry) *(u32x2*)(qptr + dvt * 16 + quad * 4) = o;
  }
  if (quad == 0 && !dry) LSE[qtok * 12 + h] = (mx + log2f(lsum)) * 0.6931471805599453f;
  __syncthreads();
}

DI void attn_combine(const bf16_t* QA, bf16_t* YC, const float* LSE, bool dry, int bidx, int nblk) {
  const int nitem = MG * 4 * 16;
  int gs = nblk * NTHREADS; asm volatile("" : "+s"(gs));
  for (int it = bidx * NTHREADS + tid_(); it < nitem; it += gs) {
    const int t = it >> 6, hg = (it >> 4) & 3, dc = it & 15;
    const float l0 = LSE[(size_t)t * 12 + hg], l1 = LSE[(size_t)t * 12 + 4 + hg], l2 = LSE[(size_t)t * 12 + 8 + hg];
    const float m = fmaxf(l0, fmaxf(l1, l2));
    float w0 = __expf(l0 - m), w1 = __expf(l1 - m), w2 = __expf(l2 - m); const float iv = __builtin_amdgcn_rcpf(w0 + w1 + w2); w0 *= iv; w1 *= iv; w2 *= iv;
    const bf16_t* p = QA + (size_t)t * 1536 + hg * 128 + dc * 8;
    const u32x4 a = *(const u32x4*)p, b = *(const u32x4*)(p + 512), c = *(const u32x4*)(p + 1024);
    u32x4 o;
#pragma unroll
    for (int e = 0; e < 4; ++e) o[e] = pk2(w0 * bf_lo(a[e]) + w1 * bf_lo(b[e]) + w2 * bf_lo(c[e]), w0 * bf_hi(a[e]) + w1 * bf_hi(b[e]) + w2 * bf_hi(c[e]));
    if (!dry) *(u32x4*)(YC + (size_t)t * 512 + hg * 128 + dc * 8) = o;
  }
}

DI void xattn_task(LAS unsigned char* sm, int task, bf16_t* XQ, const bf16_t* MKV, int l, bool dry) {
  const int tid = tid_(), lane = tid & 63, w = tid >> 6, li = lane & 15, quad = lane >> 4;
  const int b = task >> 7, hx = (task >> 5) & 3, n = task & 31;
  LAS unsigned char* vs = sm;
  {
    u32x4 kv[16];
#pragma unroll
    for (int it = 0; it < 16; ++it) { const int id = it * 512 + tid, row = id >> 5, cc = id & 31;
      kv[it] = *(const u32x4*)(MKV + (size_t)(b * 256 + row) * 4096 + l * 2048 + hx * 256 + cc * 8); }
#pragma unroll
    for (int it = 0; it < 16; ++it) { const int id = it * 512 + tid, row = id >> 5, cc = id & 31; *(LAS u32x4*)(sm + row * 528 + cc * 16) = kv[it]; }
  }
  __syncthreads();
  const size_t qtok = (size_t)b * 4096 + n * 128 + w * 16 + li;
  bf16_t* qptr = XQ + qtok * 1024 + hx * 256;
  bf16x8 qf[8];
#pragma unroll
  for (int kk = 0; kk < 8; ++kk) qf[kk] = *(const bf16x8*)(qptr + kk * 32 + quad * 8);
  float s[16][4]; float mx = -1e30f;
  const float sc = 0.0625f * 1.4426950408889634f;
#pragma unroll
  for (int kt = 0; kt < 16; ++kt) { f32x4 acc = {0.f, 0.f, 0.f, 0.f};
#pragma unroll
    for (int kk = 0; kk < 8; ++kk) { const bf16x8 a = *(const LAS bf16x8*)(sm + (kt * 16 + li) * 528 + kk * 64 + quad * 16); acc = mfma16(a, qf[kk], acc); }
#pragma unroll
    for (int j = 0; j < 4; ++j) { s[kt][j] = acc[j] * sc; mx = fmaxf(mx, s[kt][j]); } }
  mx = fmaxf(mx, shx(mx, 16, lane)); mx = fmaxf(mx, shx(mx, 32, lane));
  float lsum = 0.f;
#pragma unroll
  for (int kt = 0; kt < 16; ++kt)
#pragma unroll
    for (int j = 0; j < 4; ++j) { const float p = __builtin_amdgcn_exp2f(s[kt][j] - mx); s[kt][j] = p; lsum += p; }
  lsum += shx(lsum, 16, lane); lsum += shx(lsum, 32, lane);
  bf16x8 pf[8];
#pragma unroll
  for (int pp = 0; pp < 8; ++pp) { u32x4 t; t.x = pk2(s[2 * pp][0], s[2 * pp][1]); t.y = pk2(s[2 * pp][2], s[2 * pp][3]); t.z = pk2(s[2 * pp + 1][0], s[2 * pp + 1][1]); t.w = pk2(s[2 * pp + 1][2], s[2 * pp + 1][3]); pf[pp] = mk8(t); }
  const float inv = __builtin_amdgcn_rcpf(lsum);
  {
    u32x4 vv[16];
#pragma unroll
    for (int it = 0; it < 16; ++it) { const int id = it * 512 + tid, row = id >> 5, cc = id & 31;
      vv[it] = *(const u32x4*)(MKV + (size_t)(b * 256 + row) * 4096 + l * 2048 + 1024 + hx * 256 + cc * 8); }
    __syncthreads();
#pragma unroll
    for (int it = 0; it < 16; ++it) { const int id = it * 512 + tid, row = id >> 5, cc = id & 31; *(LAS u32x4*)(vs + row * 544 + cc * 16) = vv[it]; }
  }
  __syncthreads();
#pragma unroll
  for (int dvt = 0; dvt < 16; ++dvt) {
    f32x4 acc = {0.f, 0.f, 0.f, 0.f};
#pragma unroll
    for (int pp = 0; pp < 8; ++pp) { const int kA = 2 * pp * 16 + quad * 4;
      LAS unsigned char* vp = vs + (kA + (li >> 2)) * 544 + dvt * 32 + (li & 3) * 8;
      const u32x2 lo = lds_tr16(vp), hi = lds_tr16(vp + 16 * 544);
      u32x4 t; t.x = lo.x; t.y = lo.y; t.z = hi.x; t.w = hi.y; acc = mfma16(mk8(t), pf[pp], acc); }
    u32x2 o; o.x = pk2(acc[0] * inv, acc[1] * inv); o.y = pk2(acc[2] * inv, acc[3] * inv);
    if (!dry) *(u32x2*)(qptr + dvt * 16 + quad * 4) = o;
  }
  __syncthreads();
}

struct S5P { const float *a_re, *a_im, *log_step, *b_re, *b_im, *c_re, *c_im, *d; };
DI void s5_lambar(const S5P& P, int g, int p, float& lbr, float& lbi) {
  const float step = __expf(P.log_step[g]);
  const float ar = P.a_re[g * 64 + p], ai = P.a_im[g * 64 + p];
  const float mag = __expf(ar * step);
  float sn, cs; { const float x = ai * step; const float k = rintf(x * 0.15915494309189535f); float rr = fmaf(-k, 6.2831854820251465f, x); rr = fmaf(-k, -1.7484556000744883e-07f, rr); const float rev = rr * 0.15915494309189535f; sn = __builtin_amdgcn_sinf(rev); cs = __builtin_amdgcn_cosf(rev); }
  lbr = mag * cs; lbi = mag * sn;
}
DI void s5_carry_scan(const f32x2* E, f32x2* C, const S5P& P, bool dry) {
  const int total = BPG * 32 * 64;
  for (int gid = blockIdx.x * NTHREADS + tid_(); gid < total; gid += gridDim.x * NTHREADS) {
    const int p = gid & 63, g = (gid >> 6) & 31, b = gid >> 11;
    float lr_, li_; s5_lambar(P, g, p, lr_, li_);
#pragma unroll
    for (int q = 0; q < 6; ++q) { const float t0 = lr_ * lr_ - li_ * li_, t1 = 2.0f * lr_ * li_; lr_ = t0; li_ = t1; }
    const size_t base = (((size_t)b * 32 + g) * 64) * 64 + p;
    float sr = 0.f, si = 0.f;
    for (int c0 = 0; c0 < 64; c0 += 8) { f32x2 ev[8];
#pragma unroll
      for (int q = 0; q < 8; ++q) ev[q] = E[base + (size_t)(c0 + q) * 64];
#pragma unroll
      for (int q = 0; q < 8; ++q) { if (!dry) { f32x2 o = {sr, si}; C[base + (size_t)(c0 + q) * 64] = o; }
        const float t0 = lr_ * sr - li_ * si + ev[q][0], t1 = lr_ * si + li_ * sr + ev[q][1]; sr = t0; si = t1; } }
  }
}
DI float bperm(float v, int srclane) { return __builtin_bit_cast(float, __builtin_amdgcn_ds_bpermute(srclane << 2, __builtin_bit_cast(int, v))); }
DI void s5_task(LAS unsigned char* sm, int task, int mode, bf16_t* U, f32x2* E, const S5P& P, bool dry) {
  const int tid = tid_(), lane = tid & 63, w = tid >> 6, li = lane & 15, quad = lane >> 4;
  const int b = task >> 8, c = (task >> 2) & 63, oct = task & 3;
  const size_t row0 = (size_t)b * 4096 + c * 64;
  { u32x4 v[2];
#pragma unroll
    for (int it = 0; it < 2; ++it) { const int id = it * 512 + tid, t = id >> 4, cc = id & 15; v[it] = *(const u32x4*)(U + (row0 + t) * 512 + oct * 128 + cc * 8); }
#pragma unroll
    for (int it = 0; it < 2; ++it) { const int id = it * 512 + tid, t = id >> 4, cc = id & 15; *(LAS u32x4*)(sm + t * 272 + cc * 16) = v[it]; } }
  __syncthreads();
  const int g = oct * 8 + w;
  float l1r[4], l1i[4], l2r[4], l2i[4], l3r[4], l3i[4], l4r[4], l4i[4], spr[4], spi[4];
  bf16x8 Bre[4], Bim[4];
#pragma unroll
  for (int pb = 0; pb < 4; ++pb) {
    const int p = pb * 16 + li;
    float lr, lim; s5_lambar(P, g, p, lr, lim);
    const float ar = P.a_re[g * 64 + p], ai = P.a_im[g * 64 + p];
    const float iv = 1.0f / (ar * ar + ai * ai), nr = lr - 1.0f, ni = lim;
    const float cr = (nr * ar + ni * ai) * iv, ci = (ni * ar - nr * ai) * iv;
    u32x4 tre = {0u, 0u, 0u, 0u}, tim = {0u, 0u, 0u, 0u};
    if (quad < 2) {
      const float* pr = P.b_re + ((size_t)g * 64 + p) * 16 + quad * 8; const float* pi = P.b_im + ((size_t)g * 64 + p) * 16 + quad * 8;
      const f32x4 br0 = *(const f32x4*)pr, br1 = *(const f32x4*)(pr + 4), bi0 = *(const f32x4*)pi, bi1 = *(const f32x4*)(pi + 4);
      tre.x = pk2(cr * br0[0] - ci * bi0[0], cr * br0[1] - ci * bi0[1]); tre.y = pk2(cr * br0[2] - ci * bi0[2], cr * br0[3] - ci * bi0[3]);
      tre.z = pk2(cr * br1[0] - ci * bi1[0], cr * br1[1] - ci * bi1[1]); tre.w = pk2(cr * br1[2] - ci * bi1[2], cr * br1[3] - ci * bi1[3]);
      tim.x = pk2(cr * bi0[0] + ci * br0[0], cr * bi0[1] + ci * br0[1]); tim.y = pk2(cr * bi0[2] + ci * br0[2], cr * bi0[3] + ci * br0[3]);
      tim.z = pk2(cr * bi1[0] + ci * br1[0], cr * bi1[1] + ci * br1[1]); tim.w = pk2(cr * bi1[2] + ci * br1[2], cr * bi1[3] + ci * br1[3]);
    }
    Bre[pb] = mk8(tre); Bim[pb] = mk8(tim);
    l1r[pb] = lr; l1i[pb] = lim;
    l2r[pb] = lr * lr - lim * lim; l2i[pb] = 2.0f * lr * lim;
    l3r[pb] = l2r[pb] * lr - l2i[pb] * lim; l3i[pb] = l2r[pb] * lim + l2i[pb] * lr;
    l4r[pb] = l2r[pb] * l2r[pb] - l2i[pb] * l2i[pb]; l4i[pb] = 2.0f * l2r[pb] * l2i[pb];
    spr[pb] = 0.f; spi[pb] = 0.f;
    if (mode == 1) { const f32x2 e = E[(((size_t)b * 32 + g) * 64 + c) * 64 + p]; spr[pb] = e[0]; spi[pb] = e[1]; }
  }
  bf16x8 cm[4]; f32x4 dsk = {0.f, 0.f, 0.f, 0.f};
  LAS unsigned char* ss = sm + 17408 + w * 4352;
  if (mode == 1) {
#pragma unroll
    for (int kk = 0; kk < 4; ++kk) { const int p0 = kk * 16 + quad * 4;
      const f32x4 cr4 = *(const f32x4*)(P.c_re + ((size_t)g * 16 + li) * 64 + p0), ci4 = *(const f32x4*)(P.c_im + ((size_t)g * 16 + li) * 64 + p0);
      u32x4 t; t.x = pk2(cr4[0], -ci4[0]); t.y = pk2(cr4[1], -ci4[1]); t.z = pk2(cr4[2], -ci4[2]); t.w = pk2(cr4[3], -ci4[3]); cm[kk] = mk8(t); }
    dsk = *(const f32x4*)(P.d + g * 16 + quad * 4);
  }
  const int src_up = (lane - 16) & 63, src_q3 = 48 + li;
  for (int sb = 0; sb < 4; ++sb) {
    u32x4 araw = {0u, 0u, 0u, 0u};
    if (quad < 2) araw = *(const LAS u32x4*)(sm + (sb * 16 + li) * 272 + (w * 16 + quad * 8) * 2);
    const bf16x8 a = mk8(araw);
#pragma unroll
    for (int pb = 0; pb < 4; ++pb) {
      const f32x4 z4 = {0.f, 0.f, 0.f, 0.f};
      const f32x4 are = mfma16(a, Bre[pb], z4), aim = mfma16(a, Bim[pb], z4);
      float s0r = are[0], s0i = aim[0];
      float s1r = l1r[pb] * s0r - l1i[pb] * s0i + are[1], s1i = l1r[pb] * s0i + l1i[pb] * s0r + aim[1];
      float s2r = l1r[pb] * s1r - l1i[pb] * s1i + are[2], s2i = l1r[pb] * s1i + l1i[pb] * s1r + aim[2];
      float s3r = l1r[pb] * s2r - l1i[pb] * s2i + are[3], s3i = l1r[pb] * s2i + l1i[pb] * s2r + aim[3];
      float cr_ = (quad == 0) ? spr[pb] : 0.f, ci_ = (quad == 0) ? spi[pb] : 0.f;
#pragma unroll
      for (int r = 0; r < 3; ++r) {
        const float er = l4r[pb] * cr_ - l4i[pb] * ci_ + s3r, ei = l4r[pb] * ci_ + l4i[pb] * cr_ + s3i;
        const float gr = bperm(er, src_up), gi = bperm(ei, src_up);
        if (quad == r + 1) { cr_ = gr; ci_ = gi; }
      }
      s0r += l1r[pb] * cr_ - l1i[pb] * ci_; s0i += l1r[pb] * ci_ + l1i[pb] * cr_;
      s1r += l2r[pb] * cr_ - l2i[pb] * ci_; s1i += l2r[pb] * ci_ + l2i[pb] * cr_;
      s2r += l3r[pb] * cr_ - l3i[pb] * ci_; s2i += l3r[pb] * ci_ + l3i[pb] * cr_;
      s3r += l4r[pb] * cr_ - l4i[pb] * ci_; s3i += l4r[pb] * ci_ + l4i[pb] * cr_;
      spr[pb] = bperm(s3r, src_q3); spi[pb] = bperm(s3i, src_q3);
      if (mode == 1) { LAS unsigned char* q = ss + (quad * 4) * 272 + (pb * 16 + li) * 4;
        *(LAS unsigned*)(q) = pk2(s0r, s0i); *(LAS unsigned*)(q + 272) = pk2(s1r, s1i); *(LAS unsigned*)(q + 544) = pk2(s2r, s2i); *(LAS unsigned*)(q + 816) = pk2(s3r, s3i); }
    }
    if (mode == 1) {
      asm volatile("s_waitcnt lgkmcnt(0)" ::: "memory");
      f32x4 acc = {0.f, 0.f, 0.f, 0.f};
#pragma unroll
      for (int kk = 0; kk < 4; ++kk) { const bf16x8 bq = *(const LAS bf16x8*)(ss + li * 272 + kk * 64 + quad * 16); acc = mfma16(cm[kk], bq, acc); }
      const u32x2 uq = *(const LAS u32x2*)(sm + (sb * 16 + li) * 272 + (w * 16 + quad * 4) * 2);
      const float u4[4] = {bf_lo(uq.x), bf_hi(uq.x), bf_lo(uq.y), bf_hi(uq.y)};
      float o[4];
#pragma unroll
      for (int j = 0; j < 4; ++j) { const float y = acc[j] + dsk[j] * u4[j]; const float z = 0.7978845608028654f * (y + 0.044715f * y * y * y);
        const float th = 1.0f - 2.0f * __builtin_amdgcn_rcpf(__expf(2.0f * z) + 1.0f); o[j] = 0.5f * y * (1.0f + th); }
      asm volatile("s_waitcnt lgkmcnt(0)" ::: "memory");
      u32x2 ov; ov.x = pk2(o[0], o[1]); ov.y = pk2(o[2], o[3]);
      if (!dry) *(u32x2*)(U + (row0 + sb * 16 + li) * 512 + g * 16 + quad * 4) = ov;
    }
  }
  if (mode == 0 && !dry && quad == 0) {
#pragma unroll
    for (int pb = 0; pb < 4; ++pb) { f32x2 e = {spr[pb], spi[pb]}; E[(((size_t)b * 32 + g) * 64 + c) * 64 + pb * 16 + li] = e; }
  }
  __syncthreads();
}

struct GLAP { const float *wg, *bg, *gout; };
constexpr int GL_LR = 0;
constexpr int GL_WG = 4096;
constexpr int GL_BS = 8192;
constexpr int GL_Q = 24832;
constexpr int GL_K = 34048;
constexpr int GL_VT = 43264;
constexpr int GL_ST = 61696;
constexpr int GL_RED = 80128;
constexpr int GL_SEG = 80640;
DI void gla_cumdecay(LAS unsigned char* sm, const bf16_t* LR, size_t row0, int h, const GLAP& P) {
  const int tid = tid_();
  LAS float* lrs = (LAS float*)(sm + GL_LR); LAS float* bs = (LAS float*)(sm + GL_BS); LAS float* segs = (LAS float*)(sm + GL_SEG);
  const int dk = tid & 63, seg = tid >> 6, t0 = seg * 8;
  u32x4 lrv = {0u, 0u, 0u, 0u};
  if (tid < 128) lrv = *(const u32x4*)(LR + (row0 + (tid >> 1)) * 256 + (tid & 1) * 8);
  float wcol[16];
#pragma unroll
  for (int rr = 0; rr < 16; ++rr) wcol[rr] = P.wg[rr * 256 + h * 64 + dk];
  const float bias = P.bg[h * 64 + dk];
  if (tid < 128) { const int t = tid >> 1, hf = tid & 1;
    f32x4 f0 = {bf_lo(lrv.x), bf_hi(lrv.x), bf_lo(lrv.y), bf_hi(lrv.y)}, f1 = {bf_lo(lrv.z), bf_hi(lrv.z), bf_lo(lrv.w), bf_hi(lrv.w)};
    *(LAS f32x4*)(lrs + t * 16 + hf * 8) = f0; *(LAS f32x4*)(lrs + t * 16 + hf * 8 + 4) = f1; }
  __syncthreads();
  float la[8]; float run = 0.f;
#pragma unroll
  for (int e = 0; e < 8; ++e) { float z = bias;
#pragma unroll
    for (int q4 = 0; q4 < 4; ++q4) { const f32x4 r4 = *(const LAS f32x4*)(lrs + (t0 + e) * 16 + q4 * 4);
      z = fmaf(r4[0], wcol[q4 * 4], z); z = fmaf(r4[1], wcol[q4 * 4 + 1], z); z = fmaf(r4[2], wcol[q4 * 4 + 2], z); z = fmaf(r4[3], wcol[q4 * 4 + 3], z); }
    const float ls = fminf(z, 0.f) - __logf(1.0f + __expf(-fabsf(z)));
    run += ls * 0.0625f; la[e] = run; }
  segs[seg * 64 + dk] = run;
  __syncthreads();
  float off = 0.f;
#pragma unroll
  for (int s2 = 0; s2 < 7; ++s2) off += (s2 < seg) ? segs[s2 * 64 + dk] : 0.f;
#pragma unroll
  for (int e = 0; e < 8; ++e) bs[(t0 + e) * 65 + dk] = la[e] + off;
  __syncthreads();
}
DI void gla_stage_vt(LAS unsigned char* sm, const bf16_t* VG, size_t row0, int h) {
  LAS unsigned short* vt = (LAS unsigned short*)(sm + GL_VT);
#pragma unroll
  for (int it = 0; it < 2; ++it) { const int id = it * 512 + tid_(), t = id & 63, cc = id >> 6;
    const u32x4 v = *(const u32x4*)(VG + (row0 + t) * 512 + h * 128 + cc * 8);
#pragma unroll
    for (int e = 0; e < 4; ++e) { vt[(cc * 8 + 2 * e) * 72 + t] = (unsigned short)(v[e] & 0xffffu); vt[(cc * 8 + 2 * e + 1) * 72 + t] = (unsigned short)(v[e] >> 16); } }
}
DI void gla_a_task(LAS unsigned char* sm, int task, const bf16_t* QK, const bf16_t* VG, const bf16_t* LR, bf16_t* GST, float* GDEC, const GLAP& P, bool dry) {
  const int tid = tid_(), lane = tid & 63, w = tid >> 6, li = lane & 15, quad = lane >> 4;
  const int bh = task >> 6, c = task & 63, b = bh >> 2, h = bh & 3;
  const size_t row0 = (size_t)b * 4096 + c * 64;
  gla_cumdecay(sm, LR, row0, h, P);
  LAS float* bs = (LAS float*)(sm + GL_BS);
  LAS unsigned short* kht = (LAS unsigned short*)(sm + GL_Q);
  { const int t = tid & 63, dkc = tid >> 6; const u32x4 v = *(const u32x4*)(QK + (row0 + t) * 512 + 256 + h * 64 + dkc * 8);
#pragma unroll
    for (int e = 0; e < 4; ++e) { const int d0 = dkc * 8 + 2 * e;
      const float k0 = bf_lo(v[e]) * __expf(bs[63 * 65 + d0] - bs[t * 65 + d0]), k1 = bf_hi(v[e]) * __expf(bs[63 * 65 + d0 + 1] - bs[t * 65 + d0 + 1]);
      const unsigned pk = pk2(k0, k1); kht[d0 * 72 + t] = (unsigned short)(pk & 0xffffu); kht[(d0 + 1) * 72 + t] = (unsigned short)(pk >> 16); } }
  gla_stage_vt(sm, VG, row0, h);
  if (tid < 64 && !dry) GDEC[(size_t)task * 64 + tid] = __expf(bs[63 * 65 + tid]);
  __syncthreads();
  LAS unsigned short* vt = (LAS unsigned short*)(sm + GL_VT);
#pragma unroll
  for (int dkt = 0; dkt < 4; ++dkt) { f32x4 acc = {0.f, 0.f, 0.f, 0.f};
#pragma unroll
    for (int kk = 0; kk < 2; ++kk) { const bf16x8 a = *(const LAS bf16x8*)(vt + (w * 16 + li) * 72 + kk * 32 + quad * 8), bq = *(const LAS bf16x8*)(kht + (dkt * 16 + li) * 72 + kk * 32 + quad * 8); acc = mfma16(a, bq, acc); }
#pragma unroll
    for (int j = 0; j < 4; ++j) if (!dry) GST[((size_t)task * 128 + w * 16 + quad * 4 + j) * 64 + dkt * 16 + li] = (bf16_t)(pk2(acc[j], 0.f) & 0xffffu); }
  __syncthreads();
}
DI void gla_prefix(const bf16_t* GST, bf16_t* GSO, const float* GDEC, bool dry) {
  const int total = BPG * 4 * 8192;
  for (int gid = blockIdx.x * NTHREADS + tid_(); gid < total; gid += gridDim.x * NTHREADS) {
    const int bh = gid >> 13, e = gid & 8191, dk = e & 63; float S = 0.f;
    for (int c0 = 0; c0 < 64; c0 += 16) { float tv[16], dv[16];
#pragma unroll
      for (int q = 0; q < 16; ++q) { tv[q] = __uint_as_float((unsigned)GST[((size_t)(bh * 64 + c0 + q)) * 8192 + e] << 16); dv[q] = GDEC[(size_t)(bh * 64 + c0 + q) * 64 + dk]; }
#pragma unroll
      for (int q = 0; q < 16; ++q) { if (!dry) GSO[((size_t)(bh * 64 + c0 + q)) * 8192 + e] = (bf16_t)(pk2(S, 0.f) & 0xffffu); S = fmaf(dv[q], S, tv[q]); } }
  }
}
DI void gla_c_task(LAS unsigned char* sm, int task, const bf16_t* QK, bf16_t* VG, const bf16_t* LR, const bf16_t* R, const bf16_t* GST, const GLAP& P, bool dry) {
  const int tid = tid_(), lane = tid & 63, w = tid >> 6, li = lane & 15, quad = lane >> 4;
  const int bh = task >> 6, c = task & 63, b = bh >> 2, h = bh & 3;
  const size_t row0 = (size_t)b * 4096 + c * 64;
  gla_cumdecay(sm, LR, row0, h, P);
  LAS float* bs = (LAS float*)(sm + GL_BS);
  LAS unsigned short* qs = (LAS unsigned short*)(sm + GL_Q); LAS unsigned short* ksm = (LAS unsigned short*)(sm + GL_K);
  LAS unsigned short* vt = (LAS unsigned short*)(sm + GL_VT); LAS unsigned short* st = (LAS unsigned short*)(sm + GL_ST); LAS float* red = (LAS float*)(sm + GL_RED);
  { const int t = tid >> 3, ch = tid & 7;
    const u32x4 qv = *(const u32x4*)(QK + (row0 + t) * 512 + h * 64 + ch * 8), kv = *(const u32x4*)(QK + (row0 + t) * 512 + 256 + h * 64 + ch * 8);
    u32x4 qo, ko;
#pragma unroll
    for (int e = 0; e < 4; ++e) { const int d0 = ch * 8 + 2 * e; const float b0 = bs[t * 65 + d0], b1 = bs[t * 65 + d0 + 1];
      qo[e] = pk2(bf_lo(qv[e]) * 0.125f * __expf(b0), bf_hi(qv[e]) * 0.125f * __expf(b1));
      ko[e] = pk2(bf_lo(kv[e]) * __expf(-b0), bf_hi(kv[e]) * __expf(-b1)); }
    *(LAS u32x4*)(qs + t * 72 + ch * 8) = qo; *(LAS u32x4*)(ksm + t * 72 + ch * 8) = ko; }
  gla_stage_vt(sm, VG, row0, h);
#pragma unroll
  for (int it = 0; it < 2; ++it) { const int id = it * 512 + tid, dv = id >> 3, c8 = id & 7;
    const u32x4 v = *(const u32x4*)(GST + ((size_t)task * 128 + dv) * 64 + c8 * 8);
    *(LAS u32x4*)(st + dv * 72 + c8 * 8) = v; }
  __syncthreads();
  const int qt = w & 3, dvh = w >> 2, qtu = __builtin_amdgcn_readfirstlane(w) & 3;
  bf16x8 qf[2];
#pragma unroll
  for (int kk = 0; kk < 2; ++kk) qf[kk] = *(const LAS bf16x8*)(qs + (qt * 16 + li) * 72 + kk * 32 + quad * 8);
  float s[4][4];
#pragma unroll
  for (int jt = 0; jt < 4; ++jt) { f32x4 acc = {0.f, 0.f, 0.f, 0.f};
    if (jt <= qtu) {
#pragma unroll
    for (int kk = 0; kk < 2; ++kk) { const bf16x8 a = *(const LAS bf16x8*)(ksm + (jt * 16 + li) * 72 + kk * 32 + quad * 8); acc = mfma16(a, qf[kk], acc); } }
#pragma unroll
    for (int j = 0; j < 4; ++j) { const int kj = jt * 16 + quad * 4 + j, qi = qt * 16 + li; s[jt][j] = (kj <= qi) ? acc[j] : 0.f; } }
  bf16x8 pf[2];
#pragma unroll
  for (int pp = 0; pp < 2; ++pp) { u32x4 t; t.x = pk2(s[2 * pp][0], s[2 * pp][1]); t.y = pk2(s[2 * pp][2], s[2 * pp][3]); t.z = pk2(s[2 * pp + 1][0], s[2 * pp + 1][1]); t.w = pk2(s[2 * pp + 1][2], s[2 * pp + 1][3]); pf[pp] = mk8(t); }
  f32x4 o[4]; float ssq = 0.f;
#pragma unroll
  for (int dvt = 0; dvt < 4; ++dvt) { const int dv0 = dvh * 64 + dvt * 16; f32x4 acc = {0.f, 0.f, 0.f, 0.f};
#pragma unroll
    for (int pp = 0; pp < 2; ++pp) { const int kA = 2 * pp * 16 + quad * 4;
      const u32x2 lo = *(const LAS u32x2*)(vt + (dv0 + li) * 72 + kA), hi = *(const LAS u32x2*)(vt + (dv0 + li) * 72 + kA + 16);
      u32x4 t; t.x = lo.x; t.y = lo.y; t.z = hi.x; t.w = hi.y; acc = mfma16(mk8(t), pf[pp], acc); }
#pragma unroll
    for (int kk = 0; kk < 2; ++kk) { const bf16x8 a = *(const LAS bf16x8*)(st + (dv0 + li) * 72 + kk * 32 + quad * 8); acc = mfma16(a, qf[kk], acc); }
    o[dvt] = acc; ssq += acc[0] * acc[0] + acc[1] * acc[1] + acc[2] * acc[2] + acc[3] * acc[3]; }
  ssq += shx(ssq, 16, lane); ssq += shx(ssq, 32, lane);
  if (quad == 0) red[dvh * 64 + qt * 16 + li] = ssq;
  __syncthreads();
  const float tot = red[qt * 16 + li] + red[64 + qt * 16 + li];
  const float rs = rsqrtf(tot * (1.0f / 128.0f) + 1e-6f);
  const size_t row = row0 + qt * 16 + li;
#pragma unroll
  for (int dvt = 0; dvt < 4; ++dvt) { const int dv = dvh * 64 + dvt * 16 + quad * 4;
    const f32x4 gg = *(const f32x4*)(P.gout + dv); const u32x2 rv = *(const u32x2*)(R + row * 512 + h * 128 + dv);
    const float r4[4] = {bf_lo(rv.x), bf_hi(rv.x), bf_lo(rv.y), bf_hi(rv.y)}; float y[4];
#pragma unroll
    for (int j = 0; j < 4; ++j) y[j] = o[dvt][j] * rs * gg[j] * (r4[j] * sigmoidf_(r4[j]));
    u32x2 ov; ov.x = pk2(y[0], y[1]); ov.y = pk2(y[2], y[3]); if (!dry) *(u32x2*)(VG + row * 512 + h * 128 + dv) = ov; }
  __syncthreads();
}

#define XB_TMO      128
#define XB_XCNT(j)  (256  + 64 * (j))
#define XB_XSUB(j)  (1280 + 64 * (j))
#define XB_XGEN(j)  (2304 + 64 * (j))
#define XB_TOP      3328
#define XB_TOPGEN   3392
#define XCD_BAR_WORDS 3456
#define XB_SPIN_CAP (1u << 18)
DI unsigned xb_ld(unsigned* p)              { return __hip_atomic_load(p, __ATOMIC_RELAXED, __HIP_MEMORY_SCOPE_AGENT); }
DI unsigned xb_add(unsigned* p, unsigned v) { return __hip_atomic_fetch_add(p, v, __ATOMIC_RELAXED, __HIP_MEMORY_SCOPE_AGENT); }
DI unsigned xb_xcc_id() { return (unsigned)__builtin_amdgcn_s_getreg((3 << 11) | 20) & 0xFu; }
#define XB_SPIN(cond, bar) do { unsigned _sp = 0; while (cond) { __builtin_amdgcn_s_sleep(1); \
    if ((++_sp & 255u) == 0u) { if (xb_ld(&(bar)[XB_TMO])) break; if (_sp > XB_SPIN_CAP) { atomicAdd(&(bar)[XB_TMO], 1u); break; } } } } while (0)
struct XcdBarrier { unsigned* bar; unsigned x; volatile LAS unsigned* st; };
DI XcdBarrier xcd_barrier_post(unsigned* bar, volatile LAS unsigned* st) {
  XcdBarrier b; b.bar = bar; b.x = xb_xcc_id(); b.st = st;
  if (threadIdx.x == 0) (void)xb_add(&bar[XB_XCNT(b.x)], 1u);
  return b;
}
DI void xcd_barrier_complete(unsigned* bar, unsigned x, unsigned& nloc, unsigned& nx) {
  asm volatile("" : "+s"(bar));
  const unsigned G = gridDim.x * gridDim.y * gridDim.z;
  unsigned sum, cnt, mine, sp = 0u;
  for (;;) {
    sum = 0u; cnt = 0u; mine = 0u;
#pragma unroll
    for (unsigned j = 0; j < 16; ++j) { const unsigned c = xb_ld(&bar[XB_XCNT(j)]); sum += c; cnt += (c > 0u) ? 1u : 0u; mine = (j == x) ? c : mine; }
    if (sum == G) break;
    __builtin_amdgcn_s_sleep(1);
    if ((++sp & 255u) == 0u) { if (xb_ld(&bar[XB_TMO])) break; if (sp > XB_SPIN_CAP) { atomicAdd(&bar[XB_TMO], 1u); break; } }
  }
  nloc = mine > 0u ? mine : 1u; nx = cnt > 0u ? cnt : 1u;
}
DI void xcd_barrier(const XcdBarrier& b) {
  asm volatile("s_waitcnt vmcnt(0)" ::: "memory");
  __syncthreads();
  if (threadIdx.x == 0) {
    unsigned* bar = b.bar; asm volatile("" : "+s"(bar));
    __builtin_amdgcn_s_waitcnt(0);
    unsigned nloc = b.st[0], nx = b.st[1];
    if (nloc == 0u) { xcd_barrier_complete(bar, b.x, nloc, nx); b.st[0] = nloc; b.st[1] = nx; }
    const unsigned old = xb_add(&bar[XB_XSUB(b.x)], 1u);
    const unsigned gen = old / nloc;
    if (old + 1u == (gen + 1u) * nloc) {
      __builtin_amdgcn_fence(__ATOMIC_RELEASE, "agent");
      asm volatile("s_waitcnt vmcnt(0)" ::: "memory");
      const unsigned og = xb_add(&bar[XB_TOP], 1u);
      const unsigned tg = og / nx;
      if (og + 1u == (tg + 1u) * nx) xb_add(&bar[XB_TOPGEN], 1u);
      else XB_SPIN(xb_ld(&bar[XB_TOPGEN]) == tg, bar);
      __builtin_amdgcn_fence(__ATOMIC_ACQUIRE, "agent");
      xb_add(&bar[XB_XGEN(b.x)], 1u);
      asm volatile("s_waitcnt vmcnt(0)" ::: "memory");
    } else {
      XB_SPIN(xb_ld(&bar[XB_XGEN(b.x)]) == gen, bar);
      __builtin_amdgcn_fence(__ATOMIC_ACQUIRE, "agent");
      asm volatile("s_waitcnt vmcnt(0)" ::: "memory");
    }
  }
  __syncthreads();
}

struct Args { const float* in[28]; float* out; unsigned char* ws; int ph_lo, ph_hi; };
constexpr int NPH = 1 + DEPTH * 23 + 1;

__global__ void __launch_bounds__(NTHREADS, 2) mega(Args A) {
  extern __shared__ __attribute__((aligned(16))) unsigned char lds_raw[];
  LAS unsigned char* sm = (LAS unsigned char*)lds_raw;
  cg::grid_group grid = cg::this_grid();
  const int G = gridDim.x, bid = blockIdx.x;
  volatile LAS unsigned* xst = (volatile LAS unsigned*)(sm + LDS_BYTES - 16);
  if (threadIdx.x < 4) xst[threadIdx.x] = 0u;
  __syncthreads();
  XcdBarrier xbar; xbar.bar = (unsigned*)(A.ws + WS_BAR); xbar.x = 0; xbar.st = xst;
  if (A.ph_hi - A.ph_lo > 1) xbar = xcd_barrier_post((unsigned*)(A.ws + WS_BAR), xst);
#ifdef PROBE_A
  unsigned long long tA = 0, tB = 0, tprev = wall_clock64();
#endif

  for (int ph = A.ph_lo; ph < A.ph_hi; ++ph) {
    size_t zo; asm volatile("s_mov_b64 %0, 0" : "=s"(zo));
    unsigned char* ws = A.ws + zo;
    const float* x_in = A.in[0] + zo;
    float* xo = A.out + zo;
    bf16_t* XB = (bf16_t*)(ws + WS_H);
    bf16_t* H = (bf16_t*)xo; bf16_t* PB = (bf16_t*)(ws + WS_P);
    bf16_t* MEMN = (bf16_t*)(ws + WS_MEMN); bf16_t* MKV = (bf16_t*)(ws + WS_MEMKV);
    float* LSE = (float*)(ws + WS_LSE); f32x2* S5E = (f32x2*)(ws + WS_S5E); f32x2* S5C = (f32x2*)(ws + WS_S5C); float* GDEC = (float*)(ws + WS_GDEC); bf16_t* GST = (bf16_t*)((unsigned char*)xo + (size_t)MTOK * 1024 * 2); bf16_t* GSO = GST + (size_t)BPG * 4 * 64 * 8192;
#define IN(i) (A.in[i] + zo)
    int kind, l = 0, grp = 0;
    if (ph == 0) kind = 0; else if (ph == NPH - 1) kind = 17;
    else { const int q = ph - 1; l = q / 23; const int k = q % 23; if (k < 16) { grp = k >> 3; kind = 2 + (k & 7); } else kind = 10 + (k - 16); }
    const float* xsrc = (l == 0) ? x_in : xo;
#ifdef PROBE_REPEAT_MASK
    const int ndry = (int)((PROBE_REPEAT_MASK >> kind) & 1);
#else
    const int ndry = 0;
#endif
    for (int dryi = ndry; dryi >= 0; --dryi) {
    const bool dry = dryi != 0;
    bool isgemm = false; int nrep = 1;
    const int vb = ((G & 7) == 0) ? (bid & 7) * (G >> 3) + (bid >> 3) : bid;
    switch (kind) {
      case 0: {
        for (int ll = 0; ll < DEPTH; ++ll) {
          transpose_w(sm, IN(3) + (size_t)ll * 1024 * 9744, 1024, 9744, (bf16_t*)(ws + WS_WIN) + (size_t)ll * DINP * 1024, DINP, 1);
          transpose_w(sm, IN(12) + (size_t)ll * 512 * 512, 512, 512, (bf16_t*)(ws + WS_WGLU) + (size_t)ll * 512 * 512, 512, 0);
          for (int n = 0; n < 3; ++n) transpose_w(sm, IN(17) + ((size_t)ll * 3 + n) * 512 * 1024, 512, 1024, (bf16_t*)(ws + WS_WBR) + ((size_t)ll * 3 + n) * 1024 * 512, 1024, 0);
          transpose_w(sm, IN(18) + (size_t)ll * 1024 * 1024, 1024, 1024, (bf16_t*)(ws + WS_WOUT) + (size_t)ll * 1024 * 1024, 1024, 0);
          transpose_w(sm, IN(21) + (size_t)ll * 1024 * 1024, 1024, 1024, (bf16_t*)(ws + WS_WXQ) + (size_t)ll * 1024 * 1024, 1024, 0);
          transpose_w(sm, IN(23) + (size_t)ll * 1024 * 1024, 1024, 1024, (bf16_t*)(ws + WS_WXO) + (size_t)ll * 1024 * 1024, 1024, 0);
          transpose_w(sm, IN(22) + (size_t)ll * 1024 * 2048, 1024, 2048, (bf16_t*)(ws + WS_WXKV) + (size_t)ll * 2048 * 1024, 2048, 0);
          transpose_w(sm, IN(25) + (size_t)ll * 1024 * 4096, 1024, 4096, (bf16_t*)(ws + WS_WUP) + (size_t)ll * 4096 * 1024, 4096, 0);
          transpose_w(sm, IN(26) + (size_t)ll * 4096 * 1024, 4096, 1024, (bf16_t*)(ws + WS_WDN) + (size_t)ll * 1024 * 4096, 1024, 0);
        }
        norm_rows_bf16(IN(1), IN(19), MEMN, 2048);
      } break;
      case 3: isgemm = true; nrep = (l == 0 && grp == 0) ? 2 : 1; break;
      case 7: case 8: case 9: case 11: case 13: case 15: case 16: isgemm = true; break;
      case 2: if (l == 0) norm_rows_bf16(x_in + (size_t)grp * MG * 1024, IN(2) + l * 1024, H, MG); else norm_rows_from_bf16(XB + (size_t)grp * MG * 1024, 1024, IN(2) + l * 1024, H, MG); break;
      case 4: {
        S5P sp{IN(4) + l * 2048, IN(5) + l * 2048, IN(6) + l * 32, IN(7) + (size_t)l * 32768, IN(8) + (size_t)l * 32768, IN(9) + (size_t)l * 32768, IN(10) + (size_t)l * 32768, IN(11) + l * 512};
        GLAP gp{IN(14) + l * 4096, IN(15) + l * 256, IN(16) + l * 128};
        constexpr int NA = BPG * 12 * 32, NS = BPG * 256, NGL = BPG * 4 * 64;
        for (int t = vb; t < NA + NS + NGL; t += G) {
          if (t < NA) attn_task(sm, t, PB + P_QA, PB + P_KA, PB + P_VA, LSE, dry);
          else if (t < NA + NS) s5_task(sm, t - NA, 0, PB + P_U, S5E, sp, dry);
          else gla_a_task(sm, t - NA - NS, PB + P_QK, PB + P_VG, PB + P_LR, GST, GDEC, gp, dry);
        }
      } break;
      case 5: { gla_prefix(GST, GSO, GDEC, dry);
        S5P sp{IN(4) + l * 2048, IN(5) + l * 2048, IN(6) + l * 32, IN(7) + (size_t)l * 32768, IN(8) + (size_t)l * 32768, IN(9) + (size_t)l * 32768, IN(10) + (size_t)l * 32768, IN(11) + l * 512};
        s5_carry_scan(S5E, S5C, sp, dry); } break;
      case 6: {
        S5P sp{IN(4) + l * 2048, IN(5) + l * 2048, IN(6) + l * 32, IN(7) + (size_t)l * 32768, IN(8) + (size_t)l * 32768, IN(9) + (size_t)l * 32768, IN(10) + (size_t)l * 32768, IN(11) + l * 512};
        GLAP gp{IN(14) + l * 4096, IN(15) + l * 256, IN(16) + l * 128};
        constexpr int NS = BPG * 256, NGL = BPG * 4 * 64;
        for (int t = bid; t < NS + NGL; t += G) {
          if (t < NS) s5_task(sm, t, 1, PB + P_U, S5C, sp, dry);
          else gla_c_task(sm, t - NS, PB + P_QK, PB + P_VG, PB + P_LR, PB + P_R, GSO, gp, dry);
        }
      } break;
      case 10: norm_rows_from_bf16(XB, 1024, IN(20) + l * 1024, H, MTOK); break;
      case 12: for (int t = vb; t < NB * 4 * 32; t += G) xattn_task(sm, t, PB, MKV, l, dry); break;
      case 14: norm_rows_from_bf16(XB, 1024, IN(24) + l * 1024, H, MTOK); break;
      case 17: final_norm_from_bf16(XB, xo, IN(27), MTOK); break;
      default: break;
    }
    if (isgemm) {
      for (int rep = 0; rep < nrep; ++rep) {
        pg8::Gemm g; Epi E; E.mode = EM_BF16; E.o16 = nullptr; E.ld16 = 0; E.o32 = nullptr; E.r32 = nullptr; E.ld32 = 1024; E.aux = nullptr; E.ldaux = 0; E.bias = nullptr; E.nzm1 = 0; E.r16 = nullptr; E.ldr16 = 1024; int nz = 1;
        bf16_t* MB = PB + P_KA;
        switch (rep == 1 ? 1 : kind) {
          case 1: g = pg8::Gemm{MEMN, (bf16_t*)(ws + WS_WXKV), 2048, 4096, 1024, 1024}; E.mode = EM_BF16; E.o16 = MKV; E.ld16 = 4096; break;
          case 3: g = pg8::Gemm{H, (bf16_t*)(ws + WS_WIN) + (size_t)l * DINP * 1024, MG, DINP, 1024, 1024}; E.mode = EM_PROJ; E.o16 = PB; break;
          case 7: g = pg8::Gemm{PB + P_U, (bf16_t*)(ws + WS_WGLU) + (size_t)l * 512 * 512, MG, 512, 512, 512}; E.mode = EM_GLU; E.o16 = PB + P_QK; E.ld16 = 512; E.aux = PB + P_U; E.ldaux = 512; E.bias = IN(13) + l * 512; break;
          case 8: g = pg8::Gemm{PB + P_QK, (bf16_t*)(ws + WS_WBR) + (size_t)l * 3 * 1024 * 512, MG, 1024, 512, 512};
            g.zA1 = (long)((const char*)(PB + P_VG) - (const char*)(PB + P_QK)); g.zA2 = (long)((const char*)H - (const char*)(PB + P_QK)); g.zB = (long)1024 * 512 * 2; nz = 3;
            E.mode = EM_MERGEZ; E.nzm1 = 2; E.o16 = MB; E.ld16 = 1024; E.aux = PB + P_GATE; E.ldaux = 3072; break;
          case 9: g = pg8::Gemm{MB, (bf16_t*)(ws + WS_WOUT) + (size_t)l * 1024 * 1024, MG, 1024, 1024, 1024}; E.mode = EM_RESID; E.o16 = XB + (size_t)grp * MG * 1024; E.ld16 = 1024; if (l == 0) E.r32 = x_in + (size_t)grp * MG * 1024; else E.r16 = XB + (size_t)grp * MG * 1024; break;
          case 11: g = pg8::Gemm{H, (bf16_t*)(ws + WS_WXQ) + (size_t)l * 1024 * 1024, MTOK, 1024, 1024, 1024}; E.mode = EM_BF16; E.o16 = PB; E.ld16 = 1024; break;
          case 13: g = pg8::Gemm{PB, (bf16_t*)(ws + WS_WXO) + (size_t)l * 1024 * 1024, MTOK, 1024, 1024, 1024}; E.mode = EM_RESID; E.r16 = XB; E.o16 = XB; E.ld16 = 1024; break;
          case 15: g = pg8::Gemm{H, (bf16_t*)(ws + WS_WUP) + (size_t)l * 4096 * 1024, MTOK, 4096, 1024, 1024}; E.mode = EM_RELU2; E.o16 = PB; E.ld16 = 4096; break;
          default: g = pg8::Gemm{PB, (bf16_t*)(ws + WS_WDN) + (size_t)l * 1024 * 4096, MTOK, 1024, 4096, 4096}; E.mode = EM_RESID; E.r16 = XB; E.o16 = XB; E.ld16 = 1024; break;
        }
        g.nz = nz; if (nz == 1) { g.zA1 = 0; g.zA2 = 0; g.zB = 0; }
        g.perm = 1;
        pg8::StaticOrder S; S.init(g.M, g.N, G, bid, nz);
        if (dry) { E.mode = EM_DRY; E.nzm1 = nz - 1; }
        if (nz == 1) pg8::gemm_phase<false, Epi>(sm, g, S, E); else pg8::gemm_phase<true, Epi>(sm, g, S, E);
      }
      if (kind == 7) { if (G > 128) { if (bid >= 128) attn_combine(PB + P_QA, H, LSE, dry, bid - 128, G - 128); } else attn_combine(PB + P_QA, H, LSE, dry, bid, G); }
    }
    }
#ifdef PROBE_A
    { const unsigned long long tn = wall_clock64(); const unsigned long long dt = tn - tprev; tprev = tn;
      if ((PROBE_A >> kind) & 1) tA += dt; if ((PROBE_B >> kind) & 1) tB += dt; }
#endif
    if (ph + 1 < A.ph_hi) { if (ph == A.ph_lo) grid.sync(); else xcd_barrier(xbar); }
#ifdef PROBE_EXTRA_SYNCS
    if (ph == 1) for (int i = 0; i < PROBE_EXTRA_SYNCS; ++i) xcd_barrier(xbar);
#endif
#ifdef PROBE_A
    { const unsigned long long tn = wall_clock64(); const unsigned long long dt = tn - tprev; tprev = tn;
      if ((PROBE_A >> 18) & 1) tA += dt; if ((PROBE_B >> 18) & 1) tB += dt; }
#endif
  }
#ifdef PROBE_A
  {
    float* tw = (float*)(A.ws + WS_LSE);
    if (bid == 0 && tid_() == 0) { tw[0] = (float)tA * 0.01f; tw[1] = (float)tB * 0.01f; __threadfence(); }
    grid.sync();
    const float fa = __builtin_nontemporal_load(tw), fb = __builtin_nontemporal_load(tw + 1);
    for (size_t i = (size_t)bid * NTHREADS + tid_(); i < (size_t)16777216; i += (size_t)G * NTHREADS) A.out[i] += fb;
    if (bid == 1 && tid_() == 0) A.out[(size_t)MTOK * DM - 1] += 64.0f * fa;
  }
#endif
}

extern "C" void kernel_launch(void* const* d_in, const int* in_sizes, int n_in, void* d_out, int out_size, void* d_ws, size_t ws_size, hipStream_t stream) {
  static int grid = 0;
  if (grid == 0) {
    if (n_in != 28 || out_size != MTOK * DM || ws_size < WS_END) { fprintf(stderr, "kernel_launch: unexpected shapes (n_in %d out %d ws %zu need %zu)\n", n_in, out_size, ws_size, (size_t)WS_END); grid = -1; return; }
    int dev = 0, cus = 0, per_cu = 0;
    hipGetDevice(&dev); hipDeviceGetAttribute(&cus, hipDeviceAttributeMultiprocessorCount, dev);
    if (hipFuncSetAttribute((const void*)mega, hipFuncAttributeMaxDynamicSharedMemorySize, LDS_BYTES) != hipSuccess) { fprintf(stderr, "kernel_launch: hipFuncSetAttribute failed\n"); grid = -1; return; }
    hipOccupancyMaxActiveBlocksPerMultiprocessor(&per_cu, (const void*)mega, NTHREADS, LDS_BYTES);
    (void)hipGetLastError();
    if (per_cu < 1) { fprintf(stderr, "kernel_launch: occupancy query says %d blocks per CU\n", per_cu); per_cu = 1; }
    grid = cus;
  }
  if (grid < 0) return;
  if (hipMemsetAsync((unsigned char*)d_ws + WS_BAR, 0, 16384, stream) != hipSuccess) { fprintf(stderr, "kernel_launch: memset of barrier words failed\n"); return; }
  Args a{};
  for (int i = 0; i < 28; ++i) a.in[i] = (const float*)d_in[i];
  a.out = (float*)d_out; a.ws = (unsigned char*)d_ws;
#if MULTI_LAUNCH
  for (int ph = 0; ph < NPH; ++ph) { a.ph_lo = ph; a.ph_hi = ph + 1; hipLaunchKernelGGL(mega, dim3(grid), dim3(NTHREADS), LDS_BYTES, stream, a); }
#else
  a.ph_lo = 0; a.ph_hi = NPH;
  void* args[] = {&a};
  hipError_t e = hipLaunchCooperativeKernel((const void*)mega, dim3(grid), dim3(NTHREADS), args, LDS_BYTES, stream);
  if (e != hipSuccess) fprintf(stderr, "kernel_launch: cooperative launch failed: %s (grid %d)\n", hipGetErrorString(e), grid);
#endif
}
```
